# Optimizing an MI355X kernel written in HIP

```python
import math
import jax, jax.numpy as jnp
from jax import lax
import numpy as np

D_MODEL = 1024
BATCH = 4
SEQ = 4096
DEPTH = 2

CTX_LEN = 256
GRID_W = 64

SSD_D_INNER = 2 * D_MODEL
SSD_HEADDIM = 64
SSD_HEADS = SSD_D_INNER // SSD_HEADDIM
SSD_GROUPS = 8
SSD_HPG = SSD_HEADS // SSD_GROUPS
SSD_STATE = 128
SSD_CONV = 5
SSD_CHUNK = 128
SSD_GN = SSD_GROUPS * SSD_STATE
XBC_WIDTH = SSD_D_INNER + 2 * SSD_GN

POOL_WIDTH = D_MODEL
POOL_WINDOWS = (2, 4, 8, 16)
POOL_GROUP = POOL_WIDTH // len(POOL_WINDOWS)

FFN_HIDDEN = -(-(8 * D_MODEL) // (3 * 256)) * 256

IN_COLS = SSD_D_INNER + XBC_WIDTH + 2 * SSD_HEADS + POOL_WIDTH + 2 * D_MODEL
IN_SPLITS = (SSD_D_INNER,
             SSD_D_INNER + XBC_WIDTH,
             SSD_D_INNER + XBC_WIDTH + 2 * SSD_HEADS,
             SSD_D_INNER + XBC_WIDTH + 2 * SSD_HEADS + POOL_WIDTH)
EPS = 1e-6

kernel_name = "hybrid_ssd_pool_dit_block"


def rmsnorm(x, g):
    xf = x.astype(jnp.float32)
    y = xf * lax.rsqrt(jnp.mean(xf * xf, axis=-1, keepdims=True) + EPS)
    return (y * g).astype(x.dtype)


def modulate(h, shift, scale):
    return h * (1.0 + scale) + shift


def adaln(cond, w, b):
    m = jax.nn.silu(cond) @ w + b
    return jnp.split(m[:, None, :], 6, axis=-1)


def dwconv_centred(u, w, b):
    k = w.shape[0]
    pad = k // 2
    L = u.shape[1]
    up = jnp.pad(u, ((0, 0), (pad, pad), (0, 0)))
    out = b
    for i in range(k):
        out = out + w[i] * up[:, i:i + L]
    return out


def pool_minus_self(u):
    L = u.shape[-2]
    uf = u.astype(jnp.float32)
    cs = jnp.cumsum(uf, axis=-2)
    cs = jnp.concatenate([jnp.zeros_like(cs[..., :1, :]), cs], axis=-2)
    t = jnp.arange(L)
    outs = []
    for gi, k in enumerate(POOL_WINDOWS):
        lo = jnp.clip(t - k // 2, 0, L)
        hi = jnp.clip(t + k // 2, 0, L)
        seg = cs[..., gi * POOL_GROUP:(gi + 1) * POOL_GROUP]
        s = jnp.take(seg, hi, axis=-2) - jnp.take(seg, lo, axis=-2)
        outs.append(s / (hi - lo).astype(jnp.float32)[:, None])
    mean = jnp.concatenate(outs, axis=-1)
    return (mean - uf).astype(u.dtype)


def ssd_scan(xh, dt, a_log, bm, cm, init_state, return_y):
    Bsz, L, H, P = xh.shape
    G, N = bm.shape[2], bm.shape[3]
    R = H // G
    Q = SSD_CHUNK
    nc = L // Q
    A = -jnp.exp(a_log.astype(jnp.float32))
    acum = jnp.cumsum((dt * A).reshape(Bsz, nc, Q, H), axis=2)
    xc = (xh.astype(jnp.float32) * dt[..., None]).reshape(Bsz, nc, Q, G, R, P)
    bc = bm.astype(jnp.float32).reshape(Bsz, nc, Q, G, N)
    cc = cm.astype(jnp.float32).reshape(Bsz, nc, Q, G, N)
    a_last = acum[:, :, -1]
    decay_to_end = jnp.exp(a_last[:, :, None, :] - acum).reshape(Bsz, nc, Q, G, R)
    chunk_states = jnp.einsum('bcjgn,bcjgr,bcjgrp->bcgrpn', bc, decay_to_end, xc)

    def step(state, inp):
        cs, al = inp
        return state * jnp.exp(al)[..., None, None] + cs, state

    final, entering = lax.scan(
        step, init_state.reshape(Bsz, G, R, P, N),
        (jnp.moveaxis(chunk_states, 1, 0), jnp.moveaxis(a_last.reshape(Bsz, nc, G, R), 1, 0)))
    final = final.reshape(Bsz, H, P, N)
    if not return_y:
        return None, final
    entering = jnp.moveaxis(entering, 0, 1)
    mask = jnp.tril(jnp.ones((Q, Q), dtype=bool))[None, None, :, :, None]
    diff = acum[:, :, :, None, :] - acum[:, :, None, :, :]
    decay = jnp.exp(jnp.where(mask, diff, -jnp.inf)).reshape(Bsz, nc, Q, Q, G, R)
    cb = jnp.einsum('bcign,bcjgn->bcijg', cc, bc)
    y_intra = jnp.einsum('bcijgr,bcjgrp->bcigrp', cb[..., None] * decay, xc)
    y_inter = (jnp.einsum('bcign,bcgrpn->bcigrp', cc, entering)
               * jnp.exp(acum).reshape(Bsz, nc, Q, G, R)[..., None])
    y = (y_intra + y_inter).reshape(Bsz, L, H, P)
    return y.astype(xh.dtype), final


def ssd_bidir(xs, dt, bm, cm, a_log, d_skip, init_states, return_y):
    ys = []
    finals = []
    for d in range(2):
        flip = (lambda a: jnp.flip(a, axis=1)) if d == 1 else (lambda a: a)
        y, s = ssd_scan(flip(xs), flip(dt[:, :, d]), a_log[d], flip(bm), flip(cm), init_states[d], return_y)
        finals.append(s)
        if return_y:
            ys.append(flip(y) + d_skip[d][:, None] * xs)
    y = (ys[0] + ys[1]) if return_y else None
    return y, finals


def prepare(h, w_in, conv_w, conv_b, dt_bias):
    Bsz, L = h.shape[0], h.shape[1]
    proj = h @ w_in
    z, xbc, dt_raw, u_pool, gate_logits = jnp.split(proj, IN_SPLITS, axis=-1)
    xbc = jax.nn.silu(dwconv_centred(xbc, conv_w, conv_b))
    xs, bm, cm = jnp.split(xbc, (SSD_D_INNER, SSD_D_INNER + SSD_GN), axis=-1)
    xs = xs.reshape(Bsz, L, SSD_HEADS, SSD_HEADDIM)
    bm = bm.reshape(Bsz, L, SSD_GROUPS, SSD_STATE)
    cm = cm.reshape(Bsz, L, SSD_GROUPS, SSD_STATE)
    dt = jax.nn.softplus((dt_raw.reshape(Bsz, L, 2, SSD_HEADS) + dt_bias).astype(jnp.float32))
    return z, xs, bm, cm, dt, u_pool, gate_logits


def mixer_out(z, y, u_pool, gate_logits, ssd_norm_w, w_ssd_out, pool_w, pool_scale, w_pool_out, w_out, on_grid):
    Bsz, L = z.shape[0], z.shape[1]
    yz = y.reshape(Bsz, L, SSD_D_INNER) * jax.nn.silu(z)
    yn = rmsnorm(yz.reshape(Bsz, L, SSD_GROUPS, SSD_D_INNER // SSD_GROUPS), 1.0).reshape(Bsz, L, SSD_D_INNER)
    o_ssd = (yn * ssd_norm_w) @ w_ssd_out
    if on_grid:
        rows = L // GRID_W
        pm = pool_minus_self(u_pool.reshape(Bsz, rows, GRID_W, POOL_WIDTH)).reshape(Bsz, L, POOL_WIDTH)
    else:
        pm = pool_minus_self(u_pool)
    pm = jnp.einsum('blgi,gio->blgo', pm.reshape(Bsz, L, len(POOL_WINDOWS), POOL_GROUP), pool_w)
    o_pool = (pm.reshape(Bsz, L, POOL_WIDTH) * pool_scale) @ w_pool_out
    g_ssd, g_pool = jnp.split(jax.nn.sigmoid(gate_logits), 2, axis=-1)
    return (g_ssd * o_ssd + g_pool * o_pool) @ w_out


def swiglu(h, w_gate_up, w_down):
    a, b = jnp.split(h @ w_gate_up, 2, axis=-1)
    return (jax.nn.silu(a) * b) @ w_down


def setup_inputs(seed: int = 0) -> dict:
    key = jax.random.key(seed)
    ks = jax.random.split(key, 24)
    f32 = jnp.float32

    def nrm(k, shape, scale):
        return jax.random.normal(k, shape, f32) * scale

    H = SSD_HEADS
    dt0 = jnp.exp(jax.random.uniform(ks[10], (DEPTH, 2, H), f32, minval=math.log(1e-3), maxval=math.log(1e-1)))
    return {
        "x": nrm(ks[0], (BATCH, SEQ, D_MODEL), 1.0),
        "c": nrm(ks[1], (BATCH, D_MODEL), 1.0),
        "ctx": nrm(ks[2], (BATCH, CTX_LEN, D_MODEL), 1.0),
        "c_ctx": nrm(ks[3], (D_MODEL,), 1.0),
        "w_ada": nrm(ks[4], (DEPTH, D_MODEL, 6 * D_MODEL), 0.5 * D_MODEL ** -0.5),
        "b_ada": nrm(ks[5], (DEPTH, 6 * D_MODEL), 0.02),
        "g_mix": 1.0 + nrm(ks[6], (DEPTH, D_MODEL), 0.05),
        "w_in": nrm(ks[7], (DEPTH, D_MODEL, IN_COLS), D_MODEL ** -0.5),
        "conv_w": nrm(ks[8], (DEPTH, SSD_CONV, XBC_WIDTH), SSD_CONV ** -0.5),
        "conv_b": nrm(ks[9], (DEPTH, XBC_WIDTH), 0.02),
        "dt_bias": dt0 + jnp.log(-jnp.expm1(-dt0)),
        "a_log": jnp.log(jax.random.uniform(ks[11], (DEPTH, 2, H), f32, minval=1.0, maxval=16.0)),
        "d_skip": 1.0 + nrm(ks[12], (DEPTH, 2, H), 0.05),
        "ssd_norm_w": 1.0 + nrm(ks[13], (DEPTH, SSD_D_INNER), 0.05),
        "w_ssd_out": nrm(ks[14], (DEPTH, SSD_D_INNER, D_MODEL), SSD_D_INNER ** -0.5),
        "pool_w": nrm(ks[15], (DEPTH, len(POOL_WINDOWS), POOL_GROUP, POOL_GROUP), POOL_GROUP ** -0.5),
        "pool_scale": 1.0 + nrm(ks[16], (DEPTH, POOL_WIDTH), 0.1),
        "w_pool_out": nrm(ks[17], (DEPTH, POOL_WIDTH, D_MODEL), POOL_WIDTH ** -0.5),
        "w_out": nrm(ks[18], (DEPTH, D_MODEL, D_MODEL), D_MODEL ** -0.5),
        "g_ffn": 1.0 + nrm(ks[19], (DEPTH, D_MODEL), 0.05),
        "w_gate_up": nrm(ks[20], (DEPTH, D_MODEL, 2 * FFN_HIDDEN), D_MODEL ** -0.5),
        "w_down": nrm(ks[21], (DEPTH, FFN_HIDDEN, D_MODEL), FFN_HIDDEN ** -0.5),
        "g_final": 1.0 + nrm(ks[22], (D_MODEL,), 0.05),
    }


def reference(x, c, ctx, c_ctx, w_ada, b_ada, g_mix, w_in, conv_w, conv_b, dt_bias, a_log, d_skip,
              ssd_norm_w, w_ssd_out, pool_w, pool_scale, w_pool_out, w_out, g_ffn, w_gate_up, w_down,
              g_final):
    cx = ctx
    for l in range(DEPTH):
        last = l == DEPTH - 1
        sh1, sc1, ga1, sh2, sc2, ga2 = adaln(c, w_ada[l], b_ada[l])
        csh1, csc1, cga1, csh2, csc2, cga2 = adaln(c_ctx[None, :], w_ada[l], b_ada[l])

        h_lat = modulate(rmsnorm(x, g_mix[l]), sh1, sc1)
        h_ctx = modulate(rmsnorm(cx, g_mix[l]), csh1, csc1)
        zc, xsc, bmc, cmc, dtc, upc, glc = prepare(h_ctx, w_in[l], conv_w[l], conv_b[l], dt_bias[l])
        zl, xsl, bml, cml, dtl, upl, gll = prepare(h_lat, w_in[l], conv_w[l], conv_b[l], dt_bias[l])
        zero = jnp.zeros((xsc.shape[0], SSD_HEADS, SSD_HEADDIM, SSD_STATE), jnp.float32)
        y_ctx, ctx_states = ssd_bidir(xsc, dtc, bmc, cmc, a_log[l], d_skip[l], (zero, zero), not last)
        y_lat, _ = ssd_bidir(xsl, dtl, bml, cml, a_log[l], d_skip[l], ctx_states, True)
        x = x + ga1 * mixer_out(zl, y_lat, upl, gll, ssd_norm_w[l], w_ssd_out[l], pool_w[l], pool_scale[l],
                                w_pool_out[l], w_out[l], True)
        x = x + ga2 * swiglu(modulate(rmsnorm(x, g_ffn[l]), sh2, sc2), w_gate_up[l], w_down[l])

        if not last:
            cx = cx + cga1 * mixer_out(zc, y_ctx, upc, glc, ssd_norm_w[l], w_ssd_out[l], pool_w[l],
                                       pool_scale[l], w_pool_out[l], w_out[l], False)
            cx = cx + cga2 * swiglu(modulate(rmsnorm(cx, g_ffn[l]), csh2, csc2), w_gate_up[l], w_down[l])
    return rmsnorm(x, g_final)
```

```cpp
#include <hip/hip_runtime.h>
#include <cstdio>
#include <cstdint>

namespace pg8 {
#define PG8_LAS __attribute__((address_space(3)))
typedef unsigned short bf16_t;
typedef short bf16x8 __attribute__((ext_vector_type(8)));
typedef float f32x4 __attribute__((ext_vector_type(4)));
typedef float f32x2 __attribute__((ext_vector_type(2)));
typedef unsigned u32x4 __attribute__((ext_vector_type(4)));
typedef unsigned u32x2 __attribute__((ext_vector_type(2)));
constexpr int BM = 256, BK = 64, HALF = 128, HTB = HALF * BK * 2, STAGE_BYTES = 8 * HTB, NXCD = 8, WGM = 8;

__host__ __device__ __forceinline__ int lds_byte(int r, int c) { const int st = (r >> 4) * 2 + (c >> 5), rr = r & 15, cc = c & 31, ob = rr * 64 + cc * 2; return st * 1024 + (ob ^ (((ob >> 9) & 1) << 5)); }
__host__ __device__ __forceinline__ void stage_rc(int b, int& R, int& C) { const int st = b / 1024, sb = b % 1024, swz = sb ^ (((sb >> 9) & 1) << 5); R = (st >> 1) * 16 + swz / 64; C = (st & 1) * 32 + (swz % 64) / 2; }
__host__ __device__ __forceinline__ int perm32(int rho) { const int n = rho >> 4, i = rho & 15; return 8 * (i >> 2) + 4 * n + (i & 3); }

struct Unit { int pm, pn; };
struct Gemm { const bf16_t* A; const bf16_t* Bt; int lda, ldb, M, N, K, a_pn_off; };

struct StaticOrder {
    int nM, nN, nwg, G, c;
    __host__ __device__ void init(int M, int N, int G_, int c_) { nM = M / BM; nN = N / BM; nwg = nM * nN; G = G_; c = c_; }
    __host__ __device__ bool next(int i, Unit& u) const {
        const long L = (long)i * G + c; if (L >= nwg) return false;
        int wgid = (int)L; { const int q = nwg / NXCD, r = nwg % NXCD, xcd = wgid % NXCD, off = wgid / NXCD; wgid = (xcd < r ? xcd * (q + 1) : r * (q + 1) + (xcd - r) * q) + off; }
        const int nig = WGM * nN, gid = wgid / nig, fm = gid * WGM, gsz = (nM - fm) < WGM ? (nM - fm) : WGM;
        u.pm = fm + ((wgid % nig) % gsz); u.pn = (wgid % nig) / gsz; return true;
    }
};

__device__ __forceinline__ int opaque_v(int x) { asm volatile("" : "+v"(x)); return x; }
__device__ __forceinline__ int opaque_s(int x) { asm volatile("" : "+s"(x)); return x; }
template <int O> __device__ __forceinline__ float lane_xor(float v) { static_assert(O < 32, "within a 32-lane half"); return __int_as_float(__builtin_amdgcn_ds_swizzle(__float_as_int(v), (O << 10) | 0x1f)); }
__device__ __forceinline__ float half_sum(float v) { const auto r = __builtin_amdgcn_permlane32_swap(__float_as_uint(v), __float_as_uint(v), false, false); return __uint_as_float(r[0]) + __uint_as_float(r[1]); }
__device__ __forceinline__ float softplus(float x) { if (x > 20.f) return x; const float e = __expf(x), u = 1.f + e; return u == 1.f ? e : __logf(u) * e * __builtin_amdgcn_rcpf(u - 1.f); }
typedef __bf16 bf16x2_t __attribute__((ext_vector_type(2)));
__device__ __forceinline__ unsigned cvt_pk_bf16(float lo, float hi) { const f32x2 v = {lo, hi}; return __builtin_bit_cast(unsigned, __builtin_convertvector(v, bf16x2_t)); }
__device__ __forceinline__ float bflo(unsigned u) { return __uint_as_float(u << 16); }
__device__ __forceinline__ float bfhi(unsigned u) { return __uint_as_float(u & 0xffff0000u); }
__device__ __forceinline__ float sigm(float v) { return __builtin_amdgcn_rcpf(1.f + __expf(-v)); }
__device__ __forceinline__ float silu(float v) { return v * sigm(v); }
__device__ __forceinline__ u32x4 pack8(const f32x4 a, const f32x4 b) { u32x4 w; w.x = cvt_pk_bf16(a[0], a[1]); w.y = cvt_pk_bf16(a[2], a[3]); w.z = cvt_pk_bf16(b[0], b[1]); w.w = cvt_pk_bf16(b[2], b[3]); return w; }

constexpr int SEGR = 68;

struct EpiPlain {
    static constexpr bool PERM = true;
    bf16_t* O; int ldc;
    __device__ __forceinline__ void operator()(f32x4 (&acc)[2][2][4][2], const Unit& u, int wr, int wc, int fr, int fq, PG8_LAS unsigned char*) const {
        const int row0 = u.pm * BM + wr * 64 + fr, col0 = u.pn * BM + wc * 32 + 8 * fq;
#pragma unroll
        for (int ai = 0; ai < 2; ++ai)
#pragma unroll
            for (int m = 0; m < 4; ++m) { bf16_t* rowp = O + (size_t)(row0 + ai * HALF + m * 16) * ldc + col0;
#pragma unroll
                for (int bj = 0; bj < 2; ++bj) *(u32x4*)(rowp + bj * HALF) = pack8(acc[ai][bj][m][0], acc[ai][bj][m][1]); }
    }
};

struct EpiXbcDt {
    static constexpr bool PERM = true;
    bf16_t* XBC; bf16_t* HALO; float* DT; const float* dt_bias;
    __device__ __forceinline__ void operator()(f32x4 (&acc)[2][2][4][2], const Unit& u, int wr, int wc, int fr, int fq, PG8_LAS unsigned char*) const {
        const int row0 = u.pm * BM + wr * 64 + fr;
        if (u.pn < 16) {
            const int col0 = u.pn * BM + wc * 32 + 8 * fq;
#pragma unroll
            for (int ai = 0; ai < 2; ++ai)
#pragma unroll
                for (int m = 0; m < 4; ++m) { const int r = row0 + ai * HALF + m * 16; bf16_t* rowp = XBC + (size_t)r * 4096 + col0;
                    const int seg = r / SEGR, rs = r - seg * SEGR; const int hs = rs < 2 ? rs : (rs >= SEGR - 2 ? rs - (SEGR - 4) : -1);
#pragma unroll
                    for (int bj = 0; bj < 2; ++bj) { const u32x4 w = pack8(acc[ai][bj][m][0], acc[ai][bj][m][1]); *(u32x4*)(rowp + bj * HALF) = w;
                        if (hs >= 0) *(u32x4*)(HALO + (size_t)(seg * 4 + hs) * 4096 + col0 + bj * HALF) = w; } }
        } else if (wc < 2) {
            const int c0 = wc * 32 + 8 * fq;
            const f32x4 b0 = *(const f32x4*)(dt_bias + c0), b1 = *(const f32x4*)(dt_bias + c0 + 4);
#pragma unroll
            for (int ai = 0; ai < 2; ++ai)
#pragma unroll
                for (int m = 0; m < 4; ++m) { const int r = row0 + ai * HALF + m * 16; float* rowp = DT + (size_t)r * 64 + c0;
                    f32x4 v0 = acc[ai][0][m][0] + b0, v1 = acc[ai][0][m][1] + b1;
#pragma unroll
                    for (int j = 0; j < 4; ++j) { v0[j] = softplus(v0[j]); v1[j] = softplus(v1[j]); }
                    *(f32x4*)rowp = v0; *(f32x4*)(rowp + 4) = v1; }
        }
    }
};

struct EpiZPG {
    static constexpr bool PERM = true;
    bf16_t* Y; bf16_t* UPOOL; bf16_t* GATES;
    __device__ __forceinline__ void operator()(f32x4 (&acc)[2][2][4][2], const Unit& u, int wr, int wc, int fr, int fq, PG8_LAS unsigned char* xl) const {
        const int row0 = u.pm * BM + wr * 64 + fr;
#ifdef DBG_SKIPZ
        if (u.pn < 8) { return; }
#endif
        if (u.pn < 8) {
            const int col0 = u.pn * BM + wc * 32 + 8 * fq;
            PG8_LAS float* P = (PG8_LAS float*)xl;
#pragma unroll
            for (int ai = 0; ai < 2; ++ai)
#pragma unroll
                for (int m = 0; m < 4; ++m) { const bf16_t* yp = Y + (size_t)(row0 + ai * HALF + m * 16) * 2048 + col0; float s = 0.f;
#pragma unroll
                    for (int bj = 0; bj < 2; ++bj) { const u32x4 yv = *(const u32x4*)(yp + bj * HALF); f32x4 v0 = acc[ai][bj][m][0], v1 = acc[ai][bj][m][1];
                        v0[0] = bflo(yv.x) * silu(v0[0]); v0[1] = bfhi(yv.x) * silu(v0[1]); v0[2] = bflo(yv.y) * silu(v0[2]); v0[3] = bfhi(yv.y) * silu(v0[3]);
                        v1[0] = bflo(yv.z) * silu(v1[0]); v1[1] = bfhi(yv.z) * silu(v1[1]); v1[2] = bflo(yv.w) * silu(v1[2]); v1[3] = bfhi(yv.w) * silu(v1[3]);
                        s += (v0[0] * v0[0] + v0[1] * v0[1]) + (v0[2] * v0[2] + v0[3] * v0[3]) + (v1[0] * v1[0] + v1[1] * v1[1]) + (v1[2] * v1[2] + v1[3] * v1[3]);
                        acc[ai][bj][m][0] = v0; acc[ai][bj][m][1] = v1; }
                    s += lane_xor<16>(s); s = half_sum(s);
                    if (fq == 0) P[(ai * HALF + wr * 64 + m * 16 + fr) * 4 + wc] = s;
                    asm volatile("" ::: "memory"); }
#ifndef DBG_NOZBAR
            asm volatile("s_waitcnt lgkmcnt(0)" ::: "memory"); __builtin_amdgcn_s_barrier(); asm volatile("" ::: "memory");
#else
            asm volatile("s_waitcnt lgkmcnt(0)" ::: "memory");
#endif
#pragma unroll
            for (int ai = 0; ai < 2; ++ai)
#pragma unroll
                for (int m = 0; m < 4; ++m) {
#ifndef DBG_NOZBAR
                    const f32x4 p = *(const PG8_LAS f32x4*)(P + (ai * HALF + wr * 64 + m * 16 + fr) * 4);
#else
                    const float pw_ = P[(ai * HALF + wr * 64 + m * 16 + fr) * 4 + wc]; const f32x4 p = {pw_, pw_, pw_, pw_};
#endif

                    const float rstd = rsqrtf(((p[0] + p[1]) + (p[2] + p[3])) * (1.0f / 256.0f) + 1e-6f);
                    bf16_t* yp = Y + (size_t)(row0 + ai * HALF + m * 16) * 2048 + col0;
#pragma unroll
                    for (int bj = 0; bj < 2; ++bj) *(u32x4*)(yp + bj * HALF) = pack8(acc[ai][bj][m][0] * rstd, acc[ai][bj][m][1] * rstd); }
        } else if (u.pn < 12) {
            const int col0 = (u.pn - 8) * BM + wc * 32 + 8 * fq;
#pragma unroll
            for (int ai = 0; ai < 2; ++ai)
#pragma unroll
                for (int m = 0; m < 4; ++m) { bf16_t* rowp = UPOOL + (size_t)(row0 + ai * HALF + m * 16) * 1024 + col0;
#pragma unroll
                    for (int bj = 0; bj < 2; ++bj) *(u32x4*)(rowp + bj * HALF) = pack8(acc[ai][bj][m][0], acc[ai][bj][m][1]); }
        } else {
            const int col0 = (u.pn - 12) * BM + wc * 32 + 8 * fq;
#pragma unroll
            for (int ai = 0; ai < 2; ++ai)
#pragma unroll
                for (int m = 0; m < 4; ++m) { bf16_t* rowp = GATES + (size_t)(row0 + ai * HALF + m * 16) * 2048 + col0;
#pragma unroll
                    for (int bj = 0; bj < 2; ++bj) { f32x4 v0 = acc[ai][bj][m][0], v1 = acc[ai][bj][m][1];
#pragma unroll
                        for (int j = 0; j < 4; ++j) { v0[j] = sigm(v0[j]); v1[j] = sigm(v1[j]); }
                        *(u32x4*)(rowp + bj * HALF) = pack8(v0, v1); } }
        }
    }
};

template <int MODE  > struct EpiGate {
    static constexpr bool PERM = true;
    bf16_t* M1; const bf16_t* GATES;
    __device__ __forceinline__ void operator()(f32x4 (&acc)[2][2][4][2], const Unit& u, int wr, int wc, int fr, int fq, PG8_LAS unsigned char*) const {
        const int row0 = u.pm * BM + wr * 64 + fr, col0 = u.pn * BM + wc * 32 + 8 * fq;
#pragma unroll
        for (int ai = 0; ai < 2; ++ai)
#pragma unroll
            for (int m = 0; m < 4; ++m) { const int r = row0 + ai * HALF + m * 16; bf16_t* mp = M1 + (size_t)r * 1024 + col0; const bf16_t* gp = GATES + (size_t)r * 2048 + MODE * 1024 + col0;
#pragma unroll
                for (int bj = 0; bj < 2; ++bj) { const u32x4 g = *(const u32x4*)(gp + bj * HALF); f32x4 v0 = acc[ai][bj][m][0], v1 = acc[ai][bj][m][1];
                    v0[0] *= bflo(g.x); v0[1] *= bfhi(g.x); v0[2] *= bflo(g.y); v0[3] *= bfhi(g.y); v1[0] *= bflo(g.z); v1[1] *= bfhi(g.z); v1[2] *= bflo(g.w); v1[3] *= bfhi(g.w);
                    if (MODE == 1) { const u32x4 o = *(const u32x4*)(mp + bj * HALF);
                        v0[0] += bflo(o.x); v0[1] += bfhi(o.x); v0[2] += bflo(o.y); v0[3] += bfhi(o.y); v1[0] += bflo(o.z); v1[1] += bfhi(o.z); v1[2] += bflo(o.w); v1[3] += bfhi(o.w); }
                    *(u32x4*)(mp + bj * HALF) = pack8(v0, v1); }
                asm volatile("" ::: "memory"); }
    }
};

struct EpiRes {
    static constexpr bool PERM = false;
    const float* base_lat; float* out_lat; const float* base_ctx; float* out_ctx; const float* gate;
    __device__ __forceinline__ void operator()(f32x4 (&acc)[2][2][4][2], const Unit& u, int wr, int wc, int fr, int fq, PG8_LAS unsigned char*) const {
        const bool lat = u.pm < 64;
        const int row0 = (lat ? u.pm : u.pm - 64) * BM + wr * 64 + fr, col0 = u.pn * BM + wc * 32 + 4 * fq;
        const float* base = lat ? base_lat : base_ctx; float* out = lat ? out_lat : out_ctx;
        const float* gp = gate + (lat ? (u.pm >> 4) : 4) * 6144 + col0;
        f32x4 gv[2][2];
#pragma unroll
        for (int bj = 0; bj < 2; ++bj)
#pragma unroll
            for (int n = 0; n < 2; ++n) gv[bj][n] = *(const f32x4*)(gp + bj * HALF + n * 16);
#pragma unroll
        for (int ai = 0; ai < 2; ++ai)
#pragma unroll
            for (int m = 0; m < 4; ++m) { const size_t off = (size_t)(row0 + ai * HALF + m * 16) * 1024 + col0;
#pragma unroll
                for (int bj = 0; bj < 2; ++bj)
#pragma unroll
                    for (int n = 0; n < 2; ++n) { const f32x4 bs = *(const f32x4*)(base + off + bj * HALF + n * 16); *(f32x4*)(out + off + bj * HALF + n * 16) = bs + gv[bj][n] * acc[ai][bj][m][n]; }
                asm volatile("" ::: "memory"); }
    }
};

struct EpiSwiglu {
    static constexpr bool PERM = true;
    bf16_t* ACT;
    __device__ __forceinline__ void operator()(f32x4 (&acc)[2][2][4][2], const Unit& u, int wr, int wc, int fr, int fq, PG8_LAS unsigned char*) const {
        const int row0 = u.pm * BM + wr * 64 + fr, j0 = u.pn * 128 + wc * 16 + 4 * fq;
#pragma unroll
        for (int ai = 0; ai < 2; ++ai)
#pragma unroll
            for (int m = 0; m < 4; ++m) { bf16_t* rowp = ACT + (size_t)(row0 + ai * HALF + m * 16) * 2816 + j0;
#pragma unroll
                for (int bj = 0; bj < 2; ++bj) { const f32x4 a = acc[ai][bj][m][0], b = acc[ai][bj][m][1];
                    u32x2 w; w.x = cvt_pk_bf16(silu(a[0]) * b[0], silu(a[1]) * b[1]); w.y = cvt_pk_bf16(silu(a[2]) * b[2], silu(a[3]) * b[3]);
                    *(u32x2*)(rowp + bj * 64) = w; } }
    }
};

template <class Epi, class Sched, bool ALIGN_EPI = true, bool SP2 = true>
__device__ __forceinline__ void gemm_phase(PG8_LAS unsigned char* lds, PG8_LAS unsigned char* xl, const Gemm g, const Sched& S, const Epi& E) {
    const int tid = opaque_v(threadIdx.x), wid = __builtin_amdgcn_readfirstlane(tid >> 6), lane = tid & 63, wr = wid >> 2, wc = wid & 3, fr = lane & 15, fq = lane >> 4;
    const int K = g.K, nt = K / BK;
    unsigned voffA[2], voffB[2];
#pragma unroll
    for (int i = 0; i < 2; ++i) { int R, C; stage_rc(tid * 16 + i * 8192, R, C); const int Rb = Epi::PERM ? ((R & ~31) + perm32(R & 31)) : R;
        voffA[i] = (unsigned)(R * g.lda + C) * 2u; voffB[i] = (unsigned)(Rb * g.ldb + C) * 2u; }
    const size_t kstep = (size_t)(BK * 2);
    const size_t hsA = (size_t)HALF * g.lda * 2, hsB = (size_t)HALF * g.ldb * 2;
    const size_t tsA = 2 * hsA, tsB = 2 * hsB;
    const unsigned ldsw = (unsigned)wid * 1024u;
    const int aoff = lds_byte(wr * 64 + fr, fq * 8), boff = lds_byte(wc * 32 + fr, fq * 8);
#define PG8_SA(b, h) (((b) * 2 + (h)) * HTB)
#define PG8_SB(b, h) ((4 + (b) * 2 + (h)) * HTB)
#define PG8_STAGE(bufoff, gbase, voff) do { _Pragma("unroll") for (int _i = 0; _i < 2; ++_i) \
        __builtin_amdgcn_global_load_lds((const unsigned*)((const char*)(gbase) + (voff)[_i]), (PG8_LAS unsigned*)(lds + (bufoff) + ldsw + _i * 8192), 16, 0, 0); } while (0)
#define PG8_LDA(dst, b, h) do { _Pragma("unroll") for (int m = 0; m < 4; ++m) _Pragma("unroll") for (int k = 0; k < 2; ++k) dst[m][k] = *(const PG8_LAS bf16x8*)(lds + PG8_SA(b, h) + aoff + m * 2048 + k * 1024); } while (0)
#define PG8_LDB(dst, b, h) do { _Pragma("unroll") for (int n = 0; n < 2; ++n) _Pragma("unroll") for (int k = 0; k < 2; ++k) dst[n][k] = *(const PG8_LAS bf16x8*)(lds + PG8_SB(b, h) + boff + n * 2048 + k * 1024); } while (0)
#define PG8_MMA(ai, bj, At, Bt) do { __builtin_amdgcn_s_setprio(1); _Pragma("unroll") for (int m = 0; m < 4; ++m) _Pragma("unroll") for (int n = 0; n < 2; ++n) _Pragma("unroll") for (int k = 0; k < 2; ++k) \
        acc[ai][bj][m][n] = __builtin_amdgcn_mfma_f32_16x16x32_bf16(Bt[n][k], At[m][k], acc[ai][bj][m][n], 0, 0, 0); __builtin_amdgcn_s_setprio(0); } while (0)
#define PG8_WAIT_V(n) asm volatile("s_waitcnt vmcnt(" #n ")" ::: "memory")
#define PG8_WAIT_L(n) asm volatile("s_waitcnt lgkmcnt(" #n ")" ::: "memory")
#define PG8_BAR __builtin_amdgcn_s_barrier()
#define PG8_SCHED __builtin_amdgcn_sched_barrier(0)
    Unit cur, nxt; int ui = 0;
    if (!S.next(0, cur)) return;
    f32x4 acc[2][2][4][2];
#pragma unroll
    for (int a = 0; a < 2; ++a)
#pragma unroll
        for (int b = 0; b < 2; ++b)
#pragma unroll
            for (int m = 0; m < 4; ++m)
#pragma unroll
                for (int n = 0; n < 2; ++n) acc[a][b][m][n] = (f32x4){0.f, 0.f, 0.f, 0.f};
    bf16x8 At[4][2], B0[2][2], B1[2][2];
    const char* cA = (const char*)g.A + (size_t)cur.pm * tsA + (size_t)cur.pn * g.a_pn_off * 2; const char* cB = (const char*)g.Bt + (size_t)cur.pn * tsB;
    if constexpr (SP2) {
        PG8_STAGE(PG8_SB(0, 0), cB, voffB); PG8_STAGE(PG8_SB(0, 1), cB + hsB, voffB); PG8_STAGE(PG8_SA(0, 0), cA, voffA); PG8_STAGE(PG8_SA(0, 1), cA + hsA, voffA);
        if (wr == 1) PG8_BAR;
        PG8_WAIT_V(2); PG8_BAR;
        PG8_STAGE(PG8_SB(1, 0), cB + kstep, voffB); PG8_STAGE(PG8_SA(1, 0), cA + kstep, voffA); PG8_STAGE(PG8_SB(1, 1), cB + hsB + kstep, voffB);
        PG8_WAIT_V(6); PG8_BAR;
    } else {
        PG8_STAGE(PG8_SB(0, 0), cB, voffB); PG8_STAGE(PG8_SA(0, 0), cA, voffA); PG8_STAGE(PG8_SB(0, 1), cB + hsB, voffB); PG8_STAGE(PG8_SA(0, 1), cA + hsA, voffA);
        if (wr == 1) PG8_BAR;
        PG8_WAIT_V(4); PG8_BAR;
        PG8_STAGE(PG8_SB(1, 0), cB + kstep, voffB); PG8_STAGE(PG8_SA(1, 0), cA + kstep, voffA); PG8_STAGE(PG8_SB(1, 1), cB + hsB + kstep, voffB);
        PG8_WAIT_V(6); PG8_BAR;
    }
    for (;;) {
        const bool has_next = S.next(ui + 1, nxt);
        const char* nA = has_next ? (const char*)g.A + (size_t)nxt.pm * tsA + (size_t)nxt.pn * g.a_pn_off * 2 : cA; const char* nB = has_next ? (const char*)g.Bt + (size_t)nxt.pn * tsB : cB;
        for (int t = 0; t < nt; t += 2) {
            const bool last = (t == nt - 2);
            const char* a1 = cA + (size_t)(t + 1) * kstep;
            const char* a2 = last ? nA : cA + (size_t)(t + 2) * kstep; const char* b2 = last ? nB : cB + (size_t)(t + 2) * kstep;
            const char* a3 = a2 + kstep; const char* b3 = b2 + kstep;
            if constexpr (SP2) {
            PG8_LDB(B0, 0, 0); PG8_LDB(B1, 0, 1); PG8_SCHED; PG8_LDA(At, 0, 0); PG8_STAGE(PG8_SA(1, 1), a1 + hsA, voffA);
            PG8_WAIT_V(8); PG8_WAIT_L(0); PG8_BAR; PG8_MMA(0, 0, At, B0); PG8_MMA(0, 1, At, B1); PG8_BAR; PG8_SCHED;
            PG8_LDA(At, 0, 1); PG8_STAGE(PG8_SB(0, 0), b2, voffB); PG8_STAGE(PG8_SB(0, 1), b2 + hsB, voffB); PG8_STAGE(PG8_SA(0, 0), a2, voffA);
            PG8_WAIT_V(8); PG8_WAIT_L(0); PG8_BAR; PG8_MMA(1, 0, At, B0); PG8_MMA(1, 1, At, B1); PG8_BAR; PG8_SCHED;
            PG8_LDB(B0, 1, 0); PG8_LDB(B1, 1, 1); PG8_SCHED; PG8_LDA(At, 1, 0); PG8_STAGE(PG8_SA(0, 1), a2 + hsA, voffA);
            PG8_WAIT_V(8); PG8_WAIT_L(0); PG8_BAR; PG8_MMA(0, 0, At, B0); PG8_MMA(0, 1, At, B1); PG8_BAR; PG8_SCHED;
            PG8_LDA(At, 1, 1); PG8_STAGE(PG8_SB(1, 0), b3, voffB); PG8_STAGE(PG8_SB(1, 1), b3 + hsB, voffB); PG8_STAGE(PG8_SA(1, 0), a3, voffA);
            PG8_WAIT_V(8); PG8_WAIT_L(0); PG8_BAR; PG8_MMA(1, 0, At, B0); PG8_MMA(1, 1, At, B1); PG8_BAR; PG8_SCHED;
            } else {
            PG8_LDB(B0, 0, 0); PG8_SCHED; PG8_LDA(At, 0, 0); PG8_STAGE(PG8_SA(1, 1), a1 + hsA, voffA);
            PG8_WAIT_L(8); PG8_BAR; PG8_WAIT_L(0); PG8_MMA(0, 0, At, B0); PG8_BAR; PG8_SCHED;
            PG8_LDB(B1, 0, 1); PG8_STAGE(PG8_SB(0, 0), b2, voffB);
            PG8_BAR; PG8_WAIT_L(0); PG8_MMA(0, 1, At, B1); PG8_BAR;
            PG8_LDA(At, 0, 1); PG8_STAGE(PG8_SA(0, 0), a2, voffA);
            PG8_BAR; PG8_WAIT_L(0); PG8_MMA(1, 0, At, B0); PG8_BAR; PG8_SCHED;
            PG8_STAGE(PG8_SB(0, 1), b2 + hsB, voffB);
            PG8_WAIT_V(6); PG8_BAR; PG8_MMA(1, 1, At, B1); PG8_BAR;
            PG8_LDB(B0, 1, 0); PG8_SCHED; PG8_LDA(At, 1, 0); PG8_STAGE(PG8_SA(0, 1), a2 + hsA, voffA);
            PG8_WAIT_L(8); PG8_BAR; PG8_WAIT_L(0); PG8_MMA(0, 0, At, B0); PG8_BAR; PG8_SCHED;
            PG8_LDB(B1, 1, 1); PG8_STAGE(PG8_SB(1, 0), b3, voffB);
            PG8_BAR; PG8_WAIT_L(0); PG8_MMA(0, 1, At, B1); PG8_BAR;
            PG8_LDA(At, 1, 1); PG8_STAGE(PG8_SA(1, 0), a3, voffA);
            PG8_BAR; PG8_WAIT_L(0); PG8_MMA(1, 0, At, B0); PG8_BAR; PG8_SCHED;
            PG8_STAGE(PG8_SB(1, 1), b3 + hsB, voffB);
            PG8_WAIT_V(6); PG8_BAR; PG8_MMA(1, 1, At, B1); PG8_BAR;
            }
        }
        if constexpr (ALIGN_EPI) { if (wr == 0) PG8_BAR; }
        E(acc, cur, wr, wc, fr, fq, xl);
        if (!has_next) break;
#pragma unroll
        for (int a = 0; a < 2; ++a)
#pragma unroll
            for (int b = 0; b < 2; ++b)
#pragma unroll
                for (int m = 0; m < 4; ++m)
#pragma unroll
                    for (int n = 0; n < 2; ++n) acc[a][b][m][n] = (f32x4){0.f, 0.f, 0.f, 0.f};
        cur = nxt; cA = nA; cB = nB; ++ui;
        if constexpr (ALIGN_EPI) { if (wr == 1) PG8_BAR; }
    }
    PG8_WAIT_V(0);
    if constexpr (!ALIGN_EPI) { if (wr == 0) PG8_BAR; }
    PG8_BAR;
#undef PG8_SA
#undef PG8_SB
#undef PG8_STAGE
#undef PG8_LDA
#undef PG8_LDB
#undef PG8_MMA
#undef PG8_WAIT_V
#undef PG8_WAIT_L
#undef PG8_BAR
#undef PG8_SCHED
}
}

#define GAS __attribute__((address_space(1)))
#define LAS __attribute__((address_space(3)))
typedef unsigned short bf16;
typedef unsigned v4u __attribute__((ext_vector_type(4)));
typedef unsigned v2u __attribute__((ext_vector_type(2)));
typedef float f32x4 __attribute__((ext_vector_type(4)));
#define LDS_WAIT() asm volatile("s_waitcnt lgkmcnt(0)" ::: "memory")
#define VM_WAIT() asm volatile("s_waitcnt vmcnt(0)" ::: "memory")

constexpr int D = 1024, NB = 4, SEQ = 4096, CTXL = 256, MLAT = NB * SEQ, MCTX = NB * CTXL, MTOT = MLAT + MCTX;
constexpr int DI = 2048, XBCW = 4096, NHEAD = 32, FFH = 2816, INC = 9280;
constexpr int NB1 = 4352  , NB2 = 5120  ;
constexpr int NWAVES = 8;

constexpr size_t MiB = 1u << 20;
constexpr size_t WS_CTL = 0, CTL_ZERO_BYTES = 1 * MiB;
constexpr size_t WS_MOD = 1 * MiB;
constexpr size_t WS_WIN = 2 * MiB;
constexpr size_t WS_WSSD = WS_WIN + (size_t)(NB1 + NB2) * 1024 * 2;
constexpr size_t WS_WPC = WS_WSSD + (size_t)1024 * 2048 * 2;
constexpr size_t WS_WOUT = WS_WPC + (size_t)1024 * 1024 * 2;
constexpr size_t WS_CX = WS_WOUT + (size_t)1024 * 1024 * 2;
constexpr size_t WS_H = WS_CX + (size_t)MCTX * D * 4;
constexpr size_t WS_DT = WS_H + (size_t)MTOT * D * 2;
constexpr size_t WS_Y = WS_DT + (size_t)MTOT * 64 * 4;
constexpr size_t WS_XBC = WS_Y + (size_t)MTOT * DI * 2;
constexpr size_t WS_END = WS_XBC + (size_t)MTOT * XBCW * 2;
constexpr size_t XO_GATES = 0, XO_UPOOL = (size_t)MTOT * 2048 * 2, XO_M1 = XO_UPOOL + (size_t)MTOT * 1024 * 2;
constexpr size_t XO_ACT = 0, XO_WGU = (size_t)MTOT * FFH * 2, XO_WDN = XO_WGU + (size_t)2 * FFH * 1024 * 2;
static_assert(XO_M1 + (size_t)MTOT * 1024 * 2 <= (size_t)MTOT * XBCW * 2 && XO_WDN + (size_t)1024 * FFH * 2 <= (size_t)MTOT * XBCW * 2, "xbc overlay map");
constexpr int CW_BAR = 4096;

constexpr int RING_BYTES = 131072, MISC_OFF = RING_BYTES, XL_OFF = RING_BYTES + 1024, LDS_BYTES = 147456;

__device__ __forceinline__ unsigned pk2(float lo, float hi) { return pg8::cvt_pk_bf16(lo, hi); }
__device__ __forceinline__ float bf_lo(unsigned u) { return __uint_as_float(u << 16); }
__device__ __forceinline__ float bf_hi(unsigned u) { return __uint_as_float(u & 0xffff0000u); }

#define XB_TMO      128
#define XB_XCNT(j)  (256  + 64 * (j))
#define XB_XSUB(j)  (1280 + 64 * (j))
#define XB_XGEN(j)  (2304 + 64 * (j))
#define XB_TOP      3328
#define XB_TOPGEN   3392
#define XCD_BAR_WORDS 3456
#define XB_SPIN_CAP (1u << 20)
typedef GAS unsigned gu32;
__device__ __forceinline__ unsigned xb_ld(gu32* p)              { return __hip_atomic_load(p, __ATOMIC_RELAXED, __HIP_MEMORY_SCOPE_AGENT); }
__device__ __forceinline__ unsigned xb_add(gu32* p, unsigned v) { return __hip_atomic_fetch_add(p, v, __ATOMIC_RELAXED, __HIP_MEMORY_SCOPE_AGENT); }
__device__ __forceinline__ unsigned xb_xcc_id() { return (unsigned)__builtin_amdgcn_s_getreg((3 << 11) | 20) & 0xFu; }
#define XB_SPIN(cond, bar) do { unsigned _sp = 0; while (cond) { __builtin_amdgcn_s_sleep(1); \
    if ((++_sp & 255u) == 0u) { if (xb_ld(&(bar)[XB_TMO])) break; if (_sp > XB_SPIN_CAP) { xb_add(&(bar)[XB_TMO], 1u); break; } } } } while (0)
struct XcdBarrier { gu32* bar; unsigned x; volatile LAS unsigned* st; };
__device__ __forceinline__ XcdBarrier xcd_barrier_post(gu32* bar, volatile LAS unsigned* st) {
    XcdBarrier b; b.bar = bar; b.x = xb_xcc_id(); b.st = st;
    if (threadIdx.x == 0) (void)xb_add(&bar[XB_XCNT(b.x)], 1u);
    return b;
}
__device__ __forceinline__ void xcd_barrier_complete(gu32* bar, unsigned x, unsigned& nloc, unsigned& nx) {
    const unsigned G = gridDim.x * gridDim.y * gridDim.z;
    unsigned sum, cnt, mine, sp = 0u;
    for (;;) {
        sum = 0u; cnt = 0u; mine = 0u;
#pragma unroll
        for (unsigned j = 0; j < 16; ++j) { const unsigned c = xb_ld(&bar[XB_XCNT(j)]); sum += c; cnt += (c > 0u) ? 1u : 0u; mine = (j == x) ? c : mine; }
        if (sum == G) break;
        __builtin_amdgcn_s_sleep(1);
        if ((++sp & 255u) == 0u) { if (xb_ld(&bar[XB_TMO])) break; if (sp > XB_SPIN_CAP) { xb_add(&bar[XB_TMO], 1u); break; } }
    }
    nloc = mine > 0u ? mine : 1u; nx = cnt > 0u ? cnt : 1u;
}
__device__ __forceinline__ void xcd_barrier(const XcdBarrier& b) {
    asm volatile("s_waitcnt vmcnt(0)" ::: "memory");
    __syncthreads();
    if (threadIdx.x == 0) {
        gu32* bar = b.bar; unsigned bx_ = b.x;
        asm volatile("" : "+s"(bar), "+s"(bx_));
        __builtin_amdgcn_s_waitcnt(0);
        unsigned nloc = b.st[0], nx = b.st[1];
        if (nloc == 0u) { xcd_barrier_complete(bar, bx_, nloc, nx); b.st[0] = nloc; b.st[1] = nx; }
        const unsigned old = xb_add(&bar[XB_XSUB(bx_)], 1u);
        const unsigned gen = old / nloc;
        if (old + 1u == (gen + 1u) * nloc) {
            __builtin_amdgcn_fence(__ATOMIC_RELEASE, "agent");
            asm volatile("s_waitcnt vmcnt(0)" ::: "memory");
            const unsigned og = xb_add(&bar[XB_TOP], 1u);
            const unsigned tg = og / nx;
            if (og + 1u == (tg + 1u) * nx) xb_add(&bar[XB_TOPGEN], 1u);
            else XB_SPIN(xb_ld(&bar[XB_TOPGEN]) == tg, bar);
            __builtin_amdgcn_fence(__ATOMIC_ACQUIRE, "agent");
            xb_add(&bar[XB_XGEN(bx_)], 1u);
            asm volatile("s_waitcnt vmcnt(0)" ::: "memory");
        } else {
            XB_SPIN(xb_ld(&bar[XB_XGEN(bx_)]) == gen, bar);
            __builtin_amdgcn_fence(__ATOMIC_ACQUIRE, "agent");
            asm volatile("s_waitcnt vmcnt(0)" ::: "memory");
        }
    }
    __syncthreads();
}

__device__ __forceinline__ float wave_sum(float v) {
    v += pg8::lane_xor<1>(v); v += pg8::lane_xor<2>(v); v += pg8::lane_xor<4>(v); v += pg8::lane_xor<8>(v); v += pg8::lane_xor<16>(v);
    return pg8::half_sum(v);
}

template <int MODE> __device__ __forceinline__ int srccol(int n) {
    if (MODE == 0) {
        if (n < 4096) return 2048 + n;
        if (n < 4160) return 6144 + (n - 4096);
        if (n < 4352) return -1;
        if (n < 6400) return n - 4352;
        if (n < 7424) return 6208 + (n - 6400);
        return 7232 + (n - 7424);
    }
    if (MODE == 2) { const int j = (n >> 3) * 4 + (n & 3), sel = (n >> 2) & 1; return sel * FFH + j; }
    return n;
}
template <int MODE> __device__ __forceinline__ void conv_item(const float* W, int K, int Nsrc, int Ndst, bf16* WT, const float* kscale, LAS float* scr, int item, int lane) {
    const int nblk = Ndst / 32, kb = item / nblk, nb = item % nblk, k0 = 64 * kb, n0 = 32 * nb;
    const int sc = srccol<MODE>(n0 + (lane & 31));
#pragma unroll 8
    for (int i = 0; i < 32; ++i) { const int kk = 2 * i + (lane >> 5); float v = 0.f;
        if (sc >= 0) { v = W[(size_t)(k0 + kk) * Nsrc + sc]; if (kscale) v *= kscale[k0 + kk]; }
        scr[kk * 33 + (lane & 31)] = v; }
    LDS_WAIT(); asm volatile("" ::: "memory");
    const int c = lane & 7;
#pragma unroll
    for (int j = 0; j < 4; ++j) { const int n = (lane >> 3) + 8 * j; const LAS float* s = scr + (8 * c) * 33 + n;
        v4u o; o.x = pk2(s[0 * 33], s[1 * 33]); o.y = pk2(s[2 * 33], s[3 * 33]); o.z = pk2(s[4 * 33], s[5 * 33]); o.w = pk2(s[6 * 33], s[7 * 33]);
        *(v4u*)(WT + (size_t)(n0 + n) * K + k0 + 8 * c) = o; }
    LDS_WAIT(); asm volatile("" ::: "memory");
}

struct Args { const float* in[23]; float* out; unsigned char* ws; };
typedef const __attribute__((address_space(4))) unsigned long long* KA;
__device__ __forceinline__ KA ka_fresh() { KA p = (KA)__builtin_amdgcn_kernarg_segment_ptr(); asm volatile("" : "+s"(p)); return p; }
#define KIN(ka, k) ((const float*)(const GAS float*)(ka)[k])
#define KOUT(ka) ((float*)(GAS float*)(ka)[23])
#define KWS(ka) ((unsigned char*)(GAS unsigned char*)(ka)[24])

struct Ids { int tid, lane, wave, G, bx, vcu, gw, NGW; };
__device__ __forceinline__ Ids fresh(Ids I) { I.tid = pg8::opaque_v(I.tid); I.lane = I.tid & 63; I.wave = pg8::opaque_s(I.wave); I.vcu = pg8::opaque_s(I.vcu); I.bx = pg8::opaque_s(I.bx); I.gw = I.vcu * NWAVES + I.wave; return I; }

__device__ __forceinline__ void norm_row(const float* xrow, bf16* orow, const float* g, const float* sh, const float* sc, int lane) {
    const f32x4* xr = (const f32x4*)xrow + lane;
    f32x4 v[4]; float s = 0.f;
#pragma unroll
    for (int j = 0; j < 4; ++j) { v[j] = xr[64 * j]; s += (v[j].x * v[j].x + v[j].y * v[j].y) + (v[j].z * v[j].z + v[j].w * v[j].w); }
    const float rstd = rsqrtf(wave_sum(s) * (1.f / D) + 1e-6f);
    unsigned long long* o8 = (unsigned long long*)orow + lane;
#pragma unroll
    for (int j = 0; j < 4; ++j) { const f32x4 gg = ((const f32x4*)g)[lane + 64 * j], s1 = ((const f32x4*)sc)[lane + 64 * j], s0 = ((const f32x4*)sh)[lane + 64 * j];
        const f32x4 y = v[j] * rstd * gg * (s1 + 1.0f) + s0;
        o8[64 * j] = (unsigned long long)pk2(y.x, y.y) | ((unsigned long long)pk2(y.z, y.w) << 32); }
}

__device__ __forceinline__ void conv_mixer(const Ids I_, LAS unsigned char* lds, int l) {
    const Ids I = fresh(I_);
    const KA ka = ka_fresh(); unsigned char* ws = KWS(ka);
    LAS float* scr = (LAS float*)(lds + I.wave * 8448);
    constexpr int I_IN = 16 * ((NB1 + NB2) / 32), I_SSD = 32 * 32, I_O = 16 * 32, NIT = I_IN + I_SSD + I_O;
    for (int it = I.gw; it < NIT; it += I.NGW) { int r = it;
        if (r < I_IN) { conv_item<0>(KIN(ka, 7) + (size_t)l * D * INC, D, INC, NB1 + NB2, (bf16*)(ws + WS_WIN), nullptr, scr, r, I.lane); continue; } r -= I_IN;
        if (r < I_SSD) { conv_item<1>(KIN(ka, 14) + (size_t)l * DI * D, DI, D, D, (bf16*)(ws + WS_WSSD), KIN(ka, 13) + (size_t)l * DI, scr, r, I.lane); continue; } r -= I_SSD;
        conv_item<1>(KIN(ka, 18) + (size_t)l * D * D, D, D, D, (bf16*)(ws + WS_WOUT), nullptr, scr, r, I.lane); }
    const float* pw = KIN(ka, 15) + (size_t)l * 4 * 256 * 256; const float* psc = KIN(ka, 16) + (size_t)l * D; const float* wpo = KIN(ka, 17) + (size_t)l * D * D; bf16* WPC = (bf16*)(ws + WS_WPC);
    for (int item = I.vcu; item < 128; item += I.G) {
        const int g = item >> 5, i0 = (item & 31) * 8, n = 2 * I.tid;
        float a0[8], a1[8];
#pragma unroll
        for (int q = 0; q < 8; ++q) { a0[q] = 0.f; a1[q] = 0.f; }
        const float* pwr = pw + ((size_t)g * 256 + i0) * 256; const float* wr_ = wpo + (size_t)g * 256 * D + n; const float* sr = psc + g * 256;
#pragma unroll 4
        for (int o = 0; o < 256; ++o) { const pg8::f32x2 wv = *(const pg8::f32x2*)(wr_ + (size_t)o * D); const float sc = sr[o]; const float w0 = wv.x * sc, w1 = wv.y * sc;
#pragma unroll
            for (int q = 0; q < 8; ++q) { const float pv = pwr[q * 256 + o]; a0[q] += pv * w0; a1[q] += pv * w1; } }
        v4u o0, o1; o0.x = pk2(a0[0], a0[1]); o0.y = pk2(a0[2], a0[3]); o0.z = pk2(a0[4], a0[5]); o0.w = pk2(a0[6], a0[7]); o1.x = pk2(a1[0], a1[1]); o1.y = pk2(a1[2], a1[3]); o1.z = pk2(a1[4], a1[5]); o1.w = pk2(a1[6], a1[7]);
        *(v4u*)(WPC + (size_t)n * D + g * 256 + i0) = o0; *(v4u*)(WPC + (size_t)(n + 1) * D + g * 256 + i0) = o1;
    }
}
__device__ __forceinline__ void conv_ffn(const Ids I_, LAS unsigned char* lds, int l) {
    const Ids I = fresh(I_);
    const KA ka = ka_fresh(); unsigned char* ws = KWS(ka);
    LAS float* scr = (LAS float*)(lds + I.wave * 8448);
    constexpr int I_GU = 16 * (2 * FFH / 32), I_DN = (FFH / 64) * 32, NIT = I_GU + I_DN;
    for (int it = I.gw; it < NIT; it += I.NGW) { int r = it;
        if (r < I_GU) { conv_item<2>(KIN(ka, 20) + (size_t)l * D * 2 * FFH, D, 2 * FFH, 2 * FFH, (bf16*)(ws + WS_XBC + XO_WGU), nullptr, scr, r, I.lane); continue; } r -= I_GU;
        conv_item<1>(KIN(ka, 21) + (size_t)l * FFH * D, FFH, D, D, (bf16*)(ws + WS_XBC + XO_WDN), nullptr, scr, r, I.lane); }
}
__device__ __forceinline__ void phase_mod(const Ids I_, LAS unsigned char* lds) {
    const Ids I = fresh(I_);
    const KA ka = ka_fresh(); float* MOD = (float*)(KWS(ka) + WS_MOD);
    LAS float* sv = (LAS float*)lds;
    LAS float* red = (LAS float*)(lds + 20480);
    if (I.bx < 192) {
        const float* cvec = KIN(ka, 1); const float* cctx = KIN(ka, 3);
        for (int i = I.tid; i < 5 * 1024; i += NWAVES * 64) { const int c = i >> 10, k = i & 1023; const float v = c < 4 ? cvec[c * 1024 + k] : cctx[k]; sv[i] = v / (1.f + __expf(-v)); }
        __syncthreads();
        for (int item = I.bx; item < 192; item += I.G) {
            const int l = item / 96, c0 = (item % 96) * 64, kg = I.tid >> 6, col = I.tid & 63;
            const float* w = KIN(ka, 4) + (size_t)l * D * 6144 + c0 + col;
            float a0 = 0.f, a1 = 0.f, a2 = 0.f, a3 = 0.f, a4 = 0.f;
#pragma unroll 8
            for (int k = kg * 128; k < kg * 128 + 128; ++k) { const float wv = w[(size_t)k * 6144]; a0 += sv[k] * wv; a1 += sv[1024 + k] * wv; a2 += sv[2048 + k] * wv; a3 += sv[3072 + k] * wv; a4 += sv[4096 + k] * wv; }
            red[(kg * 5 + 0) * 64 + col] = a0; red[(kg * 5 + 1) * 64 + col] = a1; red[(kg * 5 + 2) * 64 + col] = a2; red[(kg * 5 + 3) * 64 + col] = a3; red[(kg * 5 + 4) * 64 + col] = a4;
            __syncthreads();
            if (I.tid < 320) { const int c = I.tid >> 6; float s = KIN(ka, 5)[l * 6144 + c0 + col];
#pragma unroll
                for (int q = 0; q < 8; ++q) s += red[(q * 5 + c) * 64 + col];
                MOD[((size_t)l * 5 + c) * 6144 + c0 + col] = s; }
            __syncthreads();
        }
    }
    __syncthreads();
}

__device__ __forceinline__ void phase_norm(const Ids I_, int l, int which  , int nrows, bool from_input) {
    const Ids I = fresh(I_);
    const KA ka = ka_fresh(); unsigned char* ws = KWS(ka);
    const float* modl = (const float*)(ws + WS_MOD) + (size_t)l * 5 * 6144 + which * 3072;
    const float* g = KIN(ka, which ? 19 : 6) + l * D;
    const float* xlat = from_input ? KIN(ka, 0) : KOUT(ka); const float* xctx = from_input ? KIN(ka, 2) : (const float*)(ws + WS_CX);
    bf16* H = (bf16*)(ws + WS_H);
    for (int m = I.gw; m < nrows; m += I.NGW) { const int cond = m < MLAT ? m / SEQ : 4; const float* src = m < MLAT ? xlat + (size_t)m * D : xctx + (size_t)(m - MLAT) * D;
        norm_row(src, H + (size_t)m * D, g, modl + cond * 6144 + 0, modl + cond * 6144 + 1024, I.lane); }
}

__device__ __forceinline__ void phase_conv(const Ids I_, int l) {
    const Ids I = fresh(I_);
    const KA ka = ka_fresh(); unsigned char* ws = KWS(ka);
    bf16* XBC = (bf16*)(ws + WS_XBC); const bf16* HALO = (const bf16*)(ws + WS_Y);
    const int seg = I.vcu, c0 = I.tid * 8, rbase = seg * pg8::SEGR;
    const float* cw = KIN(ka, 8) + (size_t)l * 5 * XBCW + c0; const float* cb = KIN(ka, 9) + (size_t)l * XBCW + c0;
    float w[5][8], bias[8];
#pragma unroll
    for (int i = 0; i < 5; ++i) { const f32x4 a = *(const f32x4*)(cw + i * XBCW), b = *(const f32x4*)(cw + i * XBCW + 4); w[i][0] = a.x; w[i][1] = a.y; w[i][2] = a.z; w[i][3] = a.w; w[i][4] = b.x; w[i][5] = b.y; w[i][6] = b.z; w[i][7] = b.w; }
    { const f32x4 a = *(const f32x4*)cb, b = *(const f32x4*)(cb + 4); bias[0] = a.x; bias[1] = a.y; bias[2] = a.z; bias[3] = a.w; bias[4] = b.x; bias[5] = b.y; bias[6] = b.z; bias[7] = b.w; }
    const v4u zero4 = {0u, 0u, 0u, 0u};
#define LDROW(q_) ([&](int q) -> v4u { if (q < 0 || q >= MTOT) return zero4; \
        const bf16* p = q < rbase ? HALO + (size_t)((seg - 1) * 4 + 2 + (q - (rbase - 2))) * XBCW : (q >= rbase + pg8::SEGR ? HALO + (size_t)((seg + 1) * 4 + (q - rbase - pg8::SEGR)) * XBCW : XBC + (size_t)q * XBCW); \
        return *(const v4u*)(p + c0); })(q_)
    v4u w0 = LDROW(rbase - 2), w1 = LDROW(rbase - 1), w2 = LDROW(rbase), w3 = LDROW(rbase + 1);
    v4u q0 = LDROW(rbase + 2), q1 = LDROW(rbase + 3), q2 = LDROW(rbase + 4), q3 = LDROW(rbase + 5);
    for (int it = 0; it < pg8::SEGR / 4; ++it) {
        const v4u c0v = q0, c1v = q1, c2v = q2, c3v = q3;
        const int nb = rbase + 2 + 4 * (it + 1);
        if (it + 1 < pg8::SEGR / 4) { q0 = LDROW(nb); q1 = LDROW(nb + 1); q2 = LDROW(nb + 2); q3 = LDROW(nb + 3); }
#pragma unroll
        for (int k = 0; k < 4; ++k) {
            const v4u w4 = k == 0 ? c0v : (k == 1 ? c1v : (k == 2 ? c2v : c3v));
            const int r = rbase + 4 * it + k;
            const int s0 = r < MLAT ? (r & ~(SEQ - 1)) : (MLAT + ((r - MLAT) & ~(CTXL - 1))), e0 = s0 + (r < MLAT ? SEQ : CTXL);
            const float m0 = (r - 2 >= s0) ? 1.f : 0.f, m1 = (r - 1 >= s0) ? 1.f : 0.f, m3 = (r + 1 < e0) ? 1.f : 0.f, m4 = (r + 2 < e0) ? 1.f : 0.f;
            float o[8];
#pragma unroll
            for (int j = 0; j < 4; ++j) {
                const unsigned u0 = w0[j], u1 = w1[j], u2 = w2[j], u3 = w3[j], u4 = w4[j];
                const float lo = bias[2 * j] + m0 * w[0][2 * j] * bf_lo(u0) + m1 * w[1][2 * j] * bf_lo(u1) + w[2][2 * j] * bf_lo(u2) + m3 * w[3][2 * j] * bf_lo(u3) + m4 * w[4][2 * j] * bf_lo(u4);
                const float hi = bias[2 * j + 1] + m0 * w[0][2 * j + 1] * bf_hi(u0) + m1 * w[1][2 * j + 1] * bf_hi(u1) + w[2][2 * j + 1] * bf_hi(u2) + m3 * w[3][2 * j + 1] * bf_hi(u3) + m4 * w[4][2 * j + 1] * bf_hi(u4);
                o[2 * j] = lo / (1.f + __expf(-lo)); o[2 * j + 1] = hi / (1.f + __expf(-hi)); }
            v4u ov; ov.x = pk2(o[0], o[1]); ov.y = pk2(o[2], o[3]); ov.z = pk2(o[4], o[5]); ov.w = pk2(o[6], o[7]);
            *(v4u*)(XBC + (size_t)r * XBCW + c0) = ov;
            w0 = w1; w1 = w2; w2 = w3; w3 = w4;
        }
    }
#undef LDROW
}

__device__ __forceinline__ void phase_ssd(const Ids I_, LAS unsigned char* lds, int l) {
    const Ids I = fresh(I_);
    const KA ka = ka_fresh(); unsigned char* ws = KWS(ka);
    const bf16* XBC = (const bf16*)(ws + WS_XBC); const float* DT = (const float*)(ws + WS_DT); bf16* Y = (bf16*)(ws + WS_Y);
    const int tid = I.tid, id = I.vcu, b = id >> 6, h = (id >> 1) & 31, ph = id & 1, grp = h >> 2;
    const int pl = tid >> 4, nq = tid & 15;
    LAS float* XS = (LAS float*)lds;
    LAS unsigned char* BT = lds + 8192;
    LAS unsigned char* CT = lds + 24576;
    LAS float* DTT = (LAS float*)(lds + 40960);
    LAS float* YB = (LAS float*)(lds + 41216);
    const float Dsum = KIN(ka, 12)[l * 64 + h] + KIN(ka, 12)[l * 64 + 32 + h];
    for (int dir = 0; dir < 2; ++dir) {
        const float A = -__expf(KIN(ka, 11)[l * 64 + dir * 32 + h]);
        float S[8];
#pragma unroll
        for (int i = 0; i < 8; ++i) S[i] = 0.f;
        for (int part = 0; part < 2; ++part) {
            const int rows0 = part == 0 ? MLAT + b * CTXL : b * SEQ, ntile = (part == 0 ? CTXL : SEQ) / 64;
            for (int ti = 0; ti < ntile; ++ti) {
                const int tile = dir ? ntile - 1 - ti : ti, r0 = rows0 + tile * 64;
                __syncthreads();
#pragma unroll
                for (int q = 0; q < 2; ++q) { const int ch = tid + q * 512, row = ch >> 4, c16 = ch & 15;
                    *(LAS v4u*)(BT + ch * 16) = *(const v4u*)(XBC + (size_t)(r0 + row) * XBCW + 2048 + grp * 128 + c16 * 8);
                    *(LAS v4u*)(CT + ch * 16) = *(const v4u*)(XBC + (size_t)(r0 + row) * XBCW + 3072 + grp * 128 + c16 * 8); }
                if (tid < 256) { const int row = tid >> 2, c = tid & 3; const v4u xv = *(const v4u*)(XBC + (size_t)(r0 + row) * XBCW + h * 64 + ph * 32 + c * 8);
                    LAS float* d = XS + row * 32 + c * 8; d[0] = bf_lo(xv.x); d[1] = bf_hi(xv.x); d[2] = bf_lo(xv.y); d[3] = bf_hi(xv.y); d[4] = bf_lo(xv.z); d[5] = bf_hi(xv.z); d[6] = bf_lo(xv.w); d[7] = bf_hi(xv.w);
                    if (dir == 1) { const v4u yv = *(const v4u*)(Y + (size_t)(r0 + row) * DI + h * 64 + ph * 32 + c * 8);
                        LAS float* e = YB + row * 32 + c * 8; e[0] = bf_lo(yv.x); e[1] = bf_hi(yv.x); e[2] = bf_lo(yv.y); e[3] = bf_hi(yv.y); e[4] = bf_lo(yv.z); e[5] = bf_hi(yv.z); e[6] = bf_lo(yv.w); e[7] = bf_hi(yv.w); } }
                else if (tid < 320) DTT[tid - 256] = DT[(size_t)(r0 + tid - 256) * 64 + dir * 32 + h];
                __syncthreads();
                for (int s = 0; s < 64; ++s) {
                    const int tt = dir ? 63 - s : s;
                    const float dtv = DTT[tt], a = __expf(dtv * A), xv = XS[tt * 32 + pl], xdt = xv * dtv;
                    const v4u bv = *(const LAS v4u*)(BT + tt * 256 + nq * 16), cv = *(const LAS v4u*)(CT + tt * 256 + nq * 16);
                    float yp;
                    S[0] = S[0] * a + xdt * bf_lo(bv.x); yp = bf_lo(cv.x) * S[0];
                    S[1] = S[1] * a + xdt * bf_hi(bv.x); yp += bf_hi(cv.x) * S[1];
                    S[2] = S[2] * a + xdt * bf_lo(bv.y); yp += bf_lo(cv.y) * S[2];
                    S[3] = S[3] * a + xdt * bf_hi(bv.y); yp += bf_hi(cv.y) * S[3];
                    S[4] = S[4] * a + xdt * bf_lo(bv.z); yp += bf_lo(cv.z) * S[4];
                    S[5] = S[5] * a + xdt * bf_hi(bv.z); yp += bf_hi(cv.z) * S[5];
                    S[6] = S[6] * a + xdt * bf_lo(bv.w); yp += bf_lo(cv.w) * S[6];
                    S[7] = S[7] * a + xdt * bf_hi(bv.w); yp += bf_hi(cv.w) * S[7];
                    yp += pg8::lane_xor<1>(yp); yp += pg8::lane_xor<2>(yp); yp += pg8::lane_xor<4>(yp); yp += pg8::lane_xor<8>(yp);
                    if (nq == 0) { if (dir == 0) YB[tt * 32 + pl] = yp + Dsum * xv; else YB[tt * 32 + pl] += yp; }
                }
                __syncthreads();
                if (tid < 256) { const int row = tid >> 2, c = tid & 3; const LAS float* e = YB + row * 32 + c * 8;
                    v4u o; o.x = pk2(e[0], e[1]); o.y = pk2(e[2], e[3]); o.z = pk2(e[4], e[5]); o.w = pk2(e[6], e[7]);
                    *(v4u*)(Y + (size_t)(r0 + row) * DI + h * 64 + ph * 32 + c * 8) = o; }
            }
        }
        VM_WAIT(); __syncthreads();
    }
}

__device__ __forceinline__ void phase_pool(const Ids I_, int l) {
    const Ids I = fresh(I_);
    const KA ka = ka_fresh(); unsigned char* ws = KWS(ka);
    const bf16* UPOOL = (const bf16*)(ws + WS_XBC + XO_UPOOL); bf16* PM = (bf16*)(ws + WS_H);
    const int nitems = (l == 0) ? 1024 + 64 : 1024;
    for (int item = I.vcu; item < nitems; item += I.G) {
        int seqb, L, w0, gi;
        if (item < 1024) { seqb = (item >> 2) * 64; L = 64; w0 = 0; gi = item & 3; }
        else { const int ci = item - 1024; gi = ci & 3; w0 = 64 * ((ci >> 2) & 3); seqb = MLAT + 256 * (ci >> 4); L = 256; }
        const int cp = I.tid & 127, rs = I.tid >> 7, t0 = w0 + 16 * rs, col = gi * 256 + 2 * cp;
        float ulo[32], uhi[32];
#pragma unroll
        for (int i = 0; i < 32; ++i) { const int t = t0 - 8 + i; unsigned v = 0u; if (t >= 0 && t < L) v = *(const unsigned*)(UPOOL + (size_t)(seqb + t) * 1024 + col); ulo[i] = bf_lo(v); uhi[i] = bf_hi(v); }
        const int hk = 1 << gi;
#pragma unroll
        for (int i = 0; i < 16; ++i) { const int t = t0 + i; float slo = 0.f, shi = 0.f;
#pragma unroll
            for (int d = -8; d < 8; ++d) { const bool in = (d >= -hk) && (d < hk); slo += in ? ulo[i + 8 + d] : 0.f; shi += in ? uhi[i + 8 + d] : 0.f; }
            const int lo = t - hk < 0 ? 0 : t - hk, hi = t + hk > L ? L : t + hk; const float inv = 1.0f / (float)(hi - lo);
            *(unsigned*)(PM + (size_t)(seqb + t) * 1024 + col) = pk2(slo * inv - ulo[i + 8], shi * inv - uhi[i + 8]); }
    }
}

__device__ __forceinline__ void phase_final(const Ids I_) {
    const Ids I = fresh(I_);
    const KA ka = ka_fresh(); float* OUT = KOUT(ka); const float* g = KIN(ka, 22);
    const bool dead = xb_ld((gu32*)(KWS(ka) + WS_CTL) + CW_BAR + XB_TMO) != 0u;
    for (int m = I.gw; m < MLAT; m += I.NGW) {
        f32x4* xr = (f32x4*)(OUT + (size_t)m * D) + I.lane;
        f32x4 v[4]; float s = 0.f;
#pragma unroll
        for (int j = 0; j < 4; ++j) { v[j] = xr[64 * j]; s += (v[j].x * v[j].x + v[j].y * v[j].y) + (v[j].z * v[j].z + v[j].w * v[j].w); }
        const float rstd = rsqrtf(wave_sum(s) * (1.f / D) + 1e-6f);
#pragma unroll
        for (int j = 0; j < 4; ++j) { f32x4 o = v[j] * rstd * ((const f32x4*)g)[I.lane + 64 * j]; if (dead) { const float q = __builtin_nanf(""); o = (f32x4){q, q, q, q}; } xr[64 * j] = o; }
    }
}

#ifndef DBG_STOP
#define DBG_STOP 0
#endif
__device__ __forceinline__ void phase_dump(const Ids I_, size_t ws_off, int cols, bool ctx_rows, bool isf32, bool accum = false) {
    const Ids I = fresh(I_);
    const KA ka = ka_fresh(); float* OUT = KOUT(ka); unsigned char* base = KWS(ka) + ws_off;
    for (int m = I.gw; m < MLAT; m += I.NGW) {
        for (int c = I.lane; c < 1024; c += 64) { float s = 0.f;
            for (int j = 0; j < cols / 1024; ++j) {
                if (isf32) { s += ((const float*)base)[(size_t)m * cols + c + 1024 * j]; }
                else {
#ifdef DBG_ATOMIC_DUMP
                    { const size_t e = (size_t)m * cols + c + 1024 * j; const unsigned w = __hip_atomic_fetch_or((unsigned*)base + (e >> 1), 0u, __ATOMIC_RELAXED, __HIP_MEMORY_SCOPE_AGENT); s += (e & 1) ? bf_hi(w) : bf_lo(w); }
                    if (ctx_rows) { const size_t e = (size_t)(MLAT + (m & 1023)) * cols + c + 1024 * j; const unsigned w = __hip_atomic_fetch_or((unsigned*)base + (e >> 1), 0u, __ATOMIC_RELAXED, __HIP_MEMORY_SCOPE_AGENT); s += (e & 1) ? bf_hi(w) : bf_lo(w); }
#else
                    s += bf_lo(((const bf16*)base)[(size_t)m * cols + c + 1024 * j]); if (ctx_rows) s += bf_lo(((const bf16*)base)[(size_t)(MLAT + (m & 1023)) * cols + c + 1024 * j]);
#endif
                } }
            if (accum) s += OUT[(size_t)m * D + c]; OUT[(size_t)m * D + c] = s; } }
}

__global__ void __launch_bounds__(NWAVES * 64, 2) fwd_kernel(Args args) {
    extern __shared__ __attribute__((aligned(16))) unsigned char lds_raw[];
    LAS unsigned char* lds = (LAS unsigned char*)lds_raw;
    volatile LAS unsigned* MISC = (volatile LAS unsigned*)(lds + MISC_OFF);
    LAS unsigned char* xl = lds + XL_OFF;
    Ids I; I.tid = threadIdx.x; I.lane = I.tid & 63; I.wave = __builtin_amdgcn_readfirstlane(I.tid >> 6);
    I.G = gridDim.x; I.bx = blockIdx.x; I.vcu = (I.G % 8 == 0) ? (I.bx % 8) * (I.G / 8) + I.bx / 8 : I.bx;
    I.gw = I.vcu * NWAVES + I.wave; I.NGW = I.G * NWAVES;
    const int G = I.G, bx = I.bx;

    for (int u = I.tid; u < 64; u += NWAVES * 64) MISC[u] = 0u;
    __syncthreads();
    XcdBarrier bar = xcd_barrier_post((gu32*)(KWS(ka_fresh()) + WS_CTL) + CW_BAR, MISC + 8);
#define GRID_BAR() xcd_barrier(bar)

    phase_mod(I, lds);
    conv_mixer(I, lds, 0);
    GRID_BAR();

    for (int l = 0; l < 2; ++l) {
        const int Mfull = (l == 0) ? MTOT : MLAT;
        phase_norm(I, l, 0, MTOT, l == 0);
        GRID_BAR();
        if (DBG_STOP != 11) {
            const KA ka = ka_fresh(); unsigned char* ws = KWS(ka);
            pg8::Gemm g{(const bf16*)(ws + WS_H), (const bf16*)(ws + WS_WIN), 1024, 1024, MTOT, NB1, 1024, 0}; pg8::StaticOrder S; S.init(MTOT, NB1, G, bx);
            pg8::EpiXbcDt E{(bf16*)(ws + WS_XBC), (bf16*)(ws + WS_Y), (float*)(ws + WS_DT), KIN(ka, 10) + l * 64};
            pg8::gemm_phase<pg8::EpiXbcDt, pg8::StaticOrder>(lds, xl, g, S, E);
        }
        GRID_BAR();
        if (DBG_STOP == 10 || DBG_STOP == 11) {
            const KA ka = ka_fresh(); unsigned char* ws = KWS(ka);
            pg8::Gemm g{(const bf16*)(ws + WS_H), (const bf16*)(ws + WS_WIN) + (size_t)NB1 * 1024, 1024, 1024, Mfull, NB2, 1024, 0}; pg8::StaticOrder S; S.init(Mfull, NB2, G, bx);
            pg8::EpiPlain E{(bf16*)(ws + WS_DT), NB2};
            pg8::gemm_phase<pg8::EpiPlain, pg8::StaticOrder>(lds, xl, g, S, E);
            GRID_BAR();
            phase_dump(I, WS_DT, NB2, true, false); return;
        }
        phase_conv(I, l);
        GRID_BAR();
        if (DBG_STOP == 2) { phase_dump(I, WS_XBC, 4096, true, false); return; }
        phase_ssd(I, lds, l);
        GRID_BAR();
        if (DBG_STOP == 1) { phase_dump(I, WS_Y, 2048, true, false); return; }
        if (DBG_STOP == 9) { phase_dump(I, WS_H, 1024, true, false); phase_dump(I, WS_WIN, 1024, false, false, true); return; }
        {
            const KA ka = ka_fresh(); unsigned char* ws = KWS(ka);
            pg8::Gemm g{(const bf16*)(ws + WS_H), (const bf16*)(ws + WS_WIN) + (size_t)NB1 * 1024, 1024, 1024, Mfull, NB2, 1024, 0}; pg8::StaticOrder S; S.init(Mfull, NB2, G, bx);
            pg8::EpiZPG E{(bf16*)(ws + WS_Y), (bf16*)(ws + WS_XBC + XO_UPOOL), (bf16*)(ws + WS_XBC + XO_GATES)};
            pg8::gemm_phase<pg8::EpiZPG, pg8::StaticOrder>(lds, xl, g, S, E);
        }
        GRID_BAR();
        if (DBG_STOP == 5) { phase_dump(I, WS_Y, 2048, true, false); phase_dump(I, WS_XBC + XO_GATES, 2048, true, false, true); phase_dump(I, WS_XBC + XO_UPOOL, 1024, true, false, true); return; }
        if (DBG_STOP == 8) { { const unsigned long long t0 = __builtin_amdgcn_s_memrealtime(); while (__builtin_amdgcn_s_memrealtime() - t0 < 50000ull) __builtin_amdgcn_s_sleep(32); } GRID_BAR(); phase_dump(I, WS_XBC + XO_GATES, 2048, true, false); phase_dump(I, WS_XBC + XO_UPOOL, 1024, true, false, true); return; }
        phase_pool(I, l);
        __syncthreads();
        {
            const KA ka = ka_fresh(); unsigned char* ws = KWS(ka);
            pg8::Gemm g{(const bf16*)(ws + WS_Y), (const bf16*)(ws + WS_WSSD), 2048, 2048, Mfull, 1024, 2048, 0}; pg8::StaticOrder S; S.init(Mfull, 1024, G, bx);
            pg8::EpiGate<0> E{(bf16*)(ws + WS_XBC + XO_M1), (const bf16*)(ws + WS_XBC + XO_GATES)};
            pg8::gemm_phase<pg8::EpiGate<0>, pg8::StaticOrder>(lds, xl, g, S, E);
        }
        GRID_BAR();
        if (DBG_STOP == 6) { phase_dump(I, WS_XBC + XO_M1, 1024, true, false); phase_dump(I, WS_H, 1024, true, false, true); return; }
        {
            const KA ka = ka_fresh(); unsigned char* ws = KWS(ka);
            pg8::Gemm g{(const bf16*)(ws + WS_H), (const bf16*)(ws + WS_WPC), 1024, 1024, Mfull, 1024, 1024, 0}; pg8::StaticOrder S; S.init(Mfull, 1024, G, bx);
            pg8::EpiGate<1> E{(bf16*)(ws + WS_XBC + XO_M1), (const bf16*)(ws + WS_XBC + XO_GATES)};
            pg8::gemm_phase<pg8::EpiGate<1>, pg8::StaticOrder>(lds, xl, g, S, E);
        }
        GRID_BAR();
        if (DBG_STOP == 7) { phase_dump(I, WS_XBC + XO_M1, 1024, true, false); return; }
        {
            const KA ka = ka_fresh(); unsigned char* ws = KWS(ka);
            pg8::Gemm g{(const bf16*)(ws + WS_XBC + XO_M1), (const bf16*)(ws + WS_WOUT), 1024, 1024, Mfull, 1024, 1024, 0}; pg8::StaticOrder S; S.init(Mfull, 1024, G, bx);
            pg8::EpiRes E{l == 0 ? KIN(ka, 0) : KOUT(ka), KOUT(ka), l == 0 ? KIN(ka, 2) : (const float*)(ws + WS_CX), (float*)(ws + WS_CX), (const float*)(ws + WS_MOD) + (size_t)l * 5 * 6144 + 2048};
            pg8::gemm_phase<pg8::EpiRes, pg8::StaticOrder>(lds, xl, g, S, E);
        }
        GRID_BAR();
        if (DBG_STOP == 3) return;
        phase_norm(I, l, 1, Mfull, false);
        __syncthreads();
        conv_ffn(I, lds, l);
        if (l == 0) conv_mixer(I, lds, 1);
        GRID_BAR();
        {
            const KA ka = ka_fresh(); unsigned char* ws = KWS(ka);
            pg8::Gemm g{(const bf16*)(ws + WS_H), (const bf16*)(ws + WS_XBC + XO_WGU), 1024, 1024, Mfull, 2 * FFH, 1024, 0}; pg8::StaticOrder S; S.init(Mfull, 2 * FFH, G, bx);
            pg8::EpiSwiglu E{(bf16*)(ws + WS_XBC + XO_ACT)};
            pg8::gemm_phase<pg8::EpiSwiglu, pg8::StaticOrder>(lds, xl, g, S, E);
        }
        GRID_BAR();
        if (DBG_STOP == 4) { phase_dump(I, WS_XBC + XO_ACT, 2048, false, false); return; }
        {
            const KA ka = ka_fresh(); unsigned char* ws = KWS(ka);
            pg8::Gemm g{(const bf16*)(ws + WS_XBC + XO_ACT), (const bf16*)(ws + WS_XBC + XO_WDN), FFH, FFH, Mfull, 1024, FFH, 0}; pg8::StaticOrder S; S.init(Mfull, 1024, G, bx);
            pg8::EpiRes E{KOUT(ka), KOUT(ka), (const float*)(ws + WS_CX), (float*)(ws + WS_CX), (const float*)(ws + WS_MOD) + (size_t)l * 5 * 6144 + 5120};
            pg8::gemm_phase<pg8::EpiRes, pg8::StaticOrder>(lds, xl, g, S, E);
        }
        GRID_BAR();
    }
    phase_final(I);
}

extern "C" void kernel_launch(void* const* d_in, const int* in_sizes, int n_in, void* d_out, int out_size, void* d_ws, size_t ws_size, hipStream_t stream) {
    static int grid = 0;
    if (grid == 0) {
        if (n_in != 23 || in_sizes[0] != MLAT * D || out_size != MLAT * D || ws_size < WS_END) { fprintf(stderr, "kernel_launch: unexpected shapes / workspace (n_in %d, ws %zu, need %zu); nothing launched\n", n_in, ws_size, (size_t)WS_END); grid = -1; return; }
        int dev = 0, cus = 0, per_cu = 0;
        if (hipGetDevice(&dev) != hipSuccess || hipDeviceGetAttribute(&cus, hipDeviceAttributeMultiprocessorCount, dev) != hipSuccess) { grid = -1; return; }
        if (hipFuncSetAttribute((const void*)fwd_kernel, hipFuncAttributeMaxDynamicSharedMemorySize, LDS_BYTES) != hipSuccess) { fprintf(stderr, "kernel_launch: hipFuncSetAttribute failed\n"); grid = -1; return; }
        if (hipOccupancyMaxActiveBlocksPerMultiprocessor(&per_cu, (const void*)fwd_kernel, NWAVES * 64, LDS_BYTES) != hipSuccess || per_cu < 1) { fprintf(stderr, "kernel_launch: occupancy query says %d blocks per CU; nothing launched\n", per_cu); (void)hipGetLastError(); grid = -1; return; }
        grid = cus;
        if (grid != 256) { fprintf(stderr, "kernel_launch: built for a 256-CU device (got %d)\n", grid); grid = -1; return; }
    }
    if (grid < 0) return;
    if (hipMemsetAsync((char*)d_ws + WS_CTL, 0, CTL_ZERO_BYTES, stream) != hipSuccess) return;
    Args a{};
    for (int i = 0; i < 23; ++i) a.in[i] = (const float*)d_in[i];
    a.out = (float*)d_out; a.ws = (unsigned char*)d_ws;
    hipLaunchKernelGGL(fwd_kernel, dim3(grid), dim3(NWAVES * 64), LDS_BYTES, stream, a);
}
```

```cpp
#include <hip/hip_runtime.h>
#define SSD_V2 1
#define TSEL_OFF 0ull
#define TMUL 4ull
#include <cstdio>
#include <cstdint>

namespace pg8 {
#define PG8_LAS __attribute__((address_space(3)))
typedef unsigned short bf16_t;
typedef short bf16x8 __attribute__((ext_vector_type(8)));
typedef float f32x4 __attribute__((ext_vector_type(4)));
typedef float f32x2 __attribute__((ext_vector_type(2)));
typedef unsigned u32x4 __attribute__((ext_vector_type(4)));
typedef unsigned u32x2 __attribute__((ext_vector_type(2)));
constexpr int BM = 256, BK = 64, HALF = 128, HTB = HALF * BK * 2, STAGE_BYTES = 8 * HTB, NXCD = 8, WGM = 8;

__host__ __device__ __forceinline__ int lds_byte(int r, int c) { const int st = (r >> 4) * 2 + (c >> 5), rr = r & 15, cc = c & 31, ob = rr * 64 + cc * 2; return st * 1024 + (ob ^ (((ob >> 9) & 1) << 5)); }
__host__ __device__ __forceinline__ void stage_rc(int b, int& R, int& C) { const int st = b / 1024, sb = b % 1024, swz = sb ^ (((sb >> 9) & 1) << 5); R = (st >> 1) * 16 + swz / 64; C = (st & 1) * 32 + (swz % 64) / 2; }
__host__ __device__ __forceinline__ int perm32(int rho) { const int n = rho >> 4, i = rho & 15; return 8 * (i >> 2) + 4 * n + (i & 3); }

extern __shared__ __attribute__((aligned(16))) unsigned char lds_dyn[];
constexpr int WAVE_TAB_OFF = 159744 + 1024;
__device__ __forceinline__ int lane_now() { return (int)__builtin_amdgcn_mbcnt_hi(~0u, __builtin_amdgcn_mbcnt_lo(~0u, 0u)); }
__device__ __forceinline__ int hw_slot() { return (int)(__builtin_amdgcn_s_getreg(4 | (0 << 6) | (5 << 11)) & 63u); }
__device__ __forceinline__ int wave_now() { return __builtin_amdgcn_readfirstlane((int)((volatile PG8_LAS unsigned*)(lds_dyn + WAVE_TAB_OFF))[hw_slot()]); }
__device__ __forceinline__ int tid_now() { return wave_now() * 64 + lane_now(); }
struct Unit { int pm, pn; };
struct Gemm { const bf16_t* A; const bf16_t* Bt; int lda, ldb, M, N, K, a_pn_off; };

struct StaticOrder {
    int nM, nN, nwg, G, c;
    __host__ __device__ void init(int M, int N, int G_, int c_) { nM = M / BM; nN = N / BM; nwg = nM * nN; G = G_; c = c_; }
    __host__ __device__ bool next(int i, Unit& u) const {
        const long L = (long)i * G + c; if (L >= nwg) return false;
        int wgid = (int)L; { const int q = nwg / NXCD, r = nwg % NXCD, xcd = wgid % NXCD, off = wgid / NXCD; wgid = (xcd < r ? xcd * (q + 1) : r * (q + 1) + (xcd - r) * q) + off; }
        const int nig = WGM * nN, gid = wgid / nig, fm = gid * WGM, gsz = (nM - fm) < WGM ? (nM - fm) : WGM;
        u.pm = fm + ((wgid % nig) % gsz); u.pn = (wgid % nig) / gsz; return true;
    }
    __device__ __forceinline__ size_t a_off(const Unit& u, const Gemm& g, size_t tsA) const { return (size_t)u.pm * tsA + (size_t)u.pn * g.a_pn_off * 2; }
    __device__ __forceinline__ size_t b_off(const Unit& u, const Gemm&, size_t tsB) const { return (size_t)u.pn * tsB; }
    __device__ __forceinline__ void a_ready(const Unit&) const {}
    __device__ __forceinline__ void done(const Unit&) const {}
};
#define PG8_GAS __attribute__((address_space(1)))
typedef PG8_GAS unsigned pg8_gu32;
struct ChainOrder : StaticOrder {
    unsigned ctl_lo, ctl_hi;
    int wait0, wait1, done_cnt, tmo;
    unsigned need0, need1;
    __device__ __forceinline__ void set_base(const void* ctl) { const unsigned long long a = (unsigned long long)ctl; ctl_lo = (unsigned)__builtin_amdgcn_readfirstlane((int)(unsigned)a); ctl_hi = (unsigned)__builtin_amdgcn_readfirstlane((int)(unsigned)(a >> 32)); }
    __device__ __forceinline__ pg8_gu32* word(int off) const { return (pg8_gu32*)(((unsigned long long)ctl_hi << 32) | (unsigned long long)ctl_lo) + off; }
    __device__ __forceinline__ void a_ready(const Unit& u) const {
        if (wait0 >= 0) {
            if (wave_now() == 0) {
                unsigned sp = 0;
                for (;;) {
                    bool ok = (unsigned)__builtin_amdgcn_readfirstlane(__hip_atomic_load(word(wait0 + 64 * u.pm), __ATOMIC_RELAXED, __HIP_MEMORY_SCOPE_AGENT)) >= need0;
                    if (ok && wait1 >= 0) ok = (unsigned)__builtin_amdgcn_readfirstlane(__hip_atomic_load(word(wait1 + 64 * u.pm), __ATOMIC_RELAXED, __HIP_MEMORY_SCOPE_AGENT)) >= need1;
                    if (ok) break;
                    __builtin_amdgcn_s_sleep(2);
                    if ((++sp & 255u) == 0u) { if (__builtin_amdgcn_readfirstlane(__hip_atomic_load(word(tmo), __ATOMIC_RELAXED, __HIP_MEMORY_SCOPE_AGENT)) != 0u) break;
                        if (sp > (1u << 20)) { if (lane_now() == 0) __hip_atomic_fetch_add(word(tmo), 1u, __ATOMIC_RELAXED, __HIP_MEMORY_SCOPE_AGENT); break; } }
                }
                __builtin_amdgcn_fence(__ATOMIC_ACQUIRE, "agent");
                asm volatile("s_waitcnt vmcnt(0)" ::: "memory");
            }
            asm volatile("" ::: "memory"); __builtin_amdgcn_s_barrier(); asm volatile("" ::: "memory");
        }
    }
    __device__ __forceinline__ void done(const Unit& u) const {
        if (done_cnt >= 0) { asm volatile("s_waitcnt vmcnt(0)" ::: "memory");
            if (lane_now() == 0) __hip_atomic_fetch_add(word(done_cnt + 64 * u.pm), 1u, __ATOMIC_RELAXED, __HIP_MEMORY_SCOPE_AGENT); }
    }
};

struct PanelOrder : ChainOrder {
    __device__ __forceinline__ bool next(int i, Unit& u) const {
        const int x = c & 7, j = c >> 3, k0 = (nwg * x) >> 3, k1 = (nwg * (x + 1)) >> 3, k = k0 + j + (G >> 3) * i;
        if (k >= k1) return false;
        u.pm = k / nN; u.pn = k - u.pm * nN; return true;
    }
};
struct PoolChainOrder : PanelOrder {
    __device__ __forceinline__ void done(const Unit& u) const { if (u.pn >= 8 && u.pn < 12) ChainOrder::done(u); }
};
struct RelChainOrder : ChainOrder {
    unsigned lds_word;
    __device__ __forceinline__ void done(const Unit& u) const {
        asm volatile("s_waitcnt vmcnt(0)" ::: "memory");
        unsigned prev = 0u;
        if (lane_now() == 0) prev = __hip_atomic_fetch_add((PG8_LAS unsigned*)(size_t)lds_word, 1u, __ATOMIC_RELAXED, __HIP_MEMORY_SCOPE_WORKGROUP);
        prev = (unsigned)__builtin_amdgcn_readfirstlane((int)prev);
        if (prev == 7u) {
            if (lane_now() == 0) __hip_atomic_store((PG8_LAS unsigned*)(size_t)lds_word, 0u, __ATOMIC_RELAXED, __HIP_MEMORY_SCOPE_WORKGROUP);
            __builtin_amdgcn_fence(__ATOMIC_RELEASE, "agent"); asm volatile("s_waitcnt vmcnt(0)" ::: "memory");
            if (lane_now() == 0) __hip_atomic_fetch_add(word(done_cnt + 64 * u.pm), 8u, __ATOMIC_RELAXED, __HIP_MEMORY_SCOPE_AGENT);
        }
    }
};
struct FOrder : ChainOrder {
    size_t ctx_delta;
    __device__ __forceinline__ size_t a_off(const Unit& u, const Gemm& g, size_t tsA) const { return (size_t)u.pm * tsA + (u.pm >= 64 ? ctx_delta : (size_t)0); }
};
__device__ __forceinline__ int opaque_v(int x) { asm volatile("" : "+v"(x)); return x; }
__device__ __forceinline__ int opaque_s(int x) { asm volatile("" : "+s"(x)); return x; }
template <int O> __device__ __forceinline__ float lane_xor(float v) { static_assert(O < 32, "within a 32-lane half"); return __int_as_float(__builtin_amdgcn_ds_swizzle(__float_as_int(v), (O << 10) | 0x1f)); }
__device__ __forceinline__ float half_sum(float v) { const auto r = __builtin_amdgcn_permlane32_swap(__float_as_uint(v), __float_as_uint(v), false, false); return __uint_as_float(r[0]) + __uint_as_float(r[1]); }
__device__ __forceinline__ float softplus(float x) { if (x > 20.f) return x; const float e = __expf(x), u = 1.f + e; return u == 1.f ? e : __logf(u) * e * __builtin_amdgcn_rcpf(u - 1.f); }
typedef __bf16 bf16x2_t __attribute__((ext_vector_type(2)));
__device__ __forceinline__ unsigned cvt_pk_bf16(float lo, float hi) { const f32x2 v = {lo, hi}; return __builtin_bit_cast(unsigned, __builtin_convertvector(v, bf16x2_t)); }
__device__ __forceinline__ float bflo(unsigned u) { return __uint_as_float(u << 16); }
__device__ __forceinline__ float bfhi(unsigned u) { return __uint_as_float(u & 0xffff0000u); }
__device__ __forceinline__ float sigm(float v) { return __builtin_amdgcn_rcpf(1.f + __expf(-v)); }
__device__ __forceinline__ float silu(float v) { return v * sigm(v); }
__device__ __forceinline__ u32x4 pack8(const f32x4 a, const f32x4 b) { u32x4 w; w.x = cvt_pk_bf16(a[0], a[1]); w.y = cvt_pk_bf16(a[2], a[3]); w.z = cvt_pk_bf16(b[0], b[1]); w.w = cvt_pk_bf16(b[2], b[3]); return w; }

constexpr int SEGR = 68;
constexpr int MTOT_ROWS = 17408;

struct EpiPlain {
    static constexpr bool PERM = true;
    bf16_t* O; int ldc;
    __device__ __forceinline__ void operator()(f32x4 (&acc)[2][2][4][2], const Unit& u, int wr, int wc, int fr, int fq, PG8_LAS unsigned char*) const {
        const int row0 = u.pm * BM + wr * 64 + fr, col0 = u.pn * BM + wc * 32 + 8 * fq;
#pragma unroll
        for (int ai = 0; ai < 2; ++ai)
#pragma unroll
            for (int m = 0; m < 4; ++m) { bf16_t* rowp = O + (size_t)(row0 + ai * HALF + m * 16) * ldc + col0;
#pragma unroll
                for (int bj = 0; bj < 2; ++bj) *(u32x4*)(rowp + bj * HALF) = pack8(acc[ai][bj][m][0], acc[ai][bj][m][1]); }
    }
};

struct EpiXbcDt {
    static constexpr bool PERM = true;
    bf16_t* XBC; bf16_t* HALO; float* DT; const float* dt_bias;
    __device__ __forceinline__ void operator()(f32x4 (&acc)[2][2][4][2], const Unit& u, int wr, int wc, int fr, int fq, PG8_LAS unsigned char*) const {
        const int row0 = u.pm * BM + wr * 64 + fr;
        if (u.pn < 16) {
            const int col0 = u.pn * BM + wc * 32 + 8 * fq;
            const __amdgpu_buffer_rsrc_t rsx = __builtin_amdgcn_make_buffer_rsrc((void*)XBC, (short)0, 17408 * 4096 * 2, 0x00020000), rsh = __builtin_amdgcn_make_buffer_rsrc((void*)HALO, (short)0, 544 * 4 * 4096 * 2, 0x00020000);
#pragma unroll
            for (int ai = 0; ai < 2; ++ai)
#pragma unroll
                for (int m = 0; m < 4; ++m) { const int r = row0 + ai * HALF + m * 16; const unsigned ro = (unsigned)(((size_t)r * 4096 + col0) * 2);
                    const int seg = r >> 5, rs = r & 31; const int hs = rs < 2 ? rs : (rs >= 30 ? rs - 28 : -1);
#pragma unroll
                    for (int bj = 0; bj < 2; ++bj) { const u32x4 w = pack8(acc[ai][bj][m][0], acc[ai][bj][m][1]); __builtin_amdgcn_raw_buffer_store_b128(w, rsx, ro + bj * HALF * 2, 0, 16);
                        if (hs >= 0) __builtin_amdgcn_raw_buffer_store_b128(w, rsh, (unsigned)(((size_t)(seg * 4 + hs) * 4096 + col0 + bj * HALF) * 2), 0, 16); } }
        } else if (wc < 2) {
            const int c0 = wc * 32 + 8 * fq;
            const f32x4 b0 = *(const f32x4*)(dt_bias + c0), b1 = *(const f32x4*)(dt_bias + c0 + 4);
#pragma unroll
            for (int ai = 0; ai < 2; ++ai)
#pragma unroll
                for (int m = 0; m < 4; ++m) { const int r = row0 + ai * HALF + m * 16; float* colp = DT + (size_t)c0 * MTOT_ROWS + r;
                    f32x4 v0 = acc[ai][0][m][0] + b0, v1 = acc[ai][0][m][1] + b1;
#pragma unroll
                    for (int j = 0; j < 4; ++j) { colp[(size_t)j * MTOT_ROWS] = softplus(v0[j]); colp[(size_t)(4 + j) * MTOT_ROWS] = softplus(v1[j]); } }
        }
    }
};

struct EpiZPG {
    static constexpr bool PERM = true;
    bf16_t* Y; bf16_t* UPOOL; bf16_t* GATES;
    __device__ __forceinline__ void operator()(f32x4 (&acc)[2][2][4][2], const Unit& u, int wr, int wc, int fr, int fq, PG8_LAS unsigned char* xl) const {
        const int row0 = u.pm * BM + wr * 64 + fr;
#ifdef DBG_SKIPZ
        if (u.pn < 8) { return; }
#endif
        if (u.pn < 8) {
            const int col0 = u.pn * BM + wc * 32 + 8 * fq;
            PG8_LAS float* P = (PG8_LAS float*)xl;
            u32x4 yva[2][4][2];
#pragma unroll
            for (int ai = 0; ai < 2; ++ai)
#pragma unroll
                for (int m = 0; m < 4; ++m) { const bf16_t* yp = Y + (size_t)(row0 + ai * HALF + m * 16) * 2048 + col0; yva[ai][m][0] = *(const u32x4*)yp; yva[ai][m][1] = *(const u32x4*)(yp + HALF); }
#pragma unroll
            for (int ai = 0; ai < 2; ++ai) {
#pragma unroll
                for (int m = 0; m < 4; ++m) { float s = 0.f;
#pragma unroll
                    for (int bj = 0; bj < 2; ++bj) { const u32x4 yv = yva[ai][m][bj]; f32x4 v0 = acc[ai][bj][m][0], v1 = acc[ai][bj][m][1];
                        v0[0] = bflo(yv.x) * silu(v0[0]); v0[1] = bfhi(yv.x) * silu(v0[1]); v0[2] = bflo(yv.y) * silu(v0[2]); v0[3] = bfhi(yv.y) * silu(v0[3]);
                        v1[0] = bflo(yv.z) * silu(v1[0]); v1[1] = bfhi(yv.z) * silu(v1[1]); v1[2] = bflo(yv.w) * silu(v1[2]); v1[3] = bfhi(yv.w) * silu(v1[3]);
                        s += (v0[0] * v0[0] + v0[1] * v0[1]) + (v0[2] * v0[2] + v0[3] * v0[3]) + (v1[0] * v1[0] + v1[1] * v1[1]) + (v1[2] * v1[2] + v1[3] * v1[3]);
                        acc[ai][bj][m][0] = v0; acc[ai][bj][m][1] = v1; }
                    s += lane_xor<16>(s); s = half_sum(s);
                    if (fq == 0) P[(ai * HALF + wr * 64 + m * 16 + fr) * 4 + wc] = s; }
                asm volatile("" ::: "memory"); }
#ifndef DBG_NOZBAR
            asm volatile("s_waitcnt lgkmcnt(0)" ::: "memory"); __builtin_amdgcn_s_barrier(); asm volatile("" ::: "memory");
#else
            asm volatile("s_waitcnt lgkmcnt(0)" ::: "memory");
#endif
#pragma unroll
            for (int ai = 0; ai < 2; ++ai)
#pragma unroll
                for (int m = 0; m < 4; ++m) {
#ifndef DBG_NOZBAR
                    const f32x4 p = *(const PG8_LAS f32x4*)(P + (ai * HALF + wr * 64 + m * 16 + fr) * 4);
#else
                    const float pw_ = P[(ai * HALF + wr * 64 + m * 16 + fr) * 4 + wc]; const f32x4 p = {pw_, pw_, pw_, pw_};
#endif

                    const float rstd = rsqrtf(((p[0] + p[1]) + (p[2] + p[3])) * (1.0f / 256.0f) + 1e-6f);
                    bf16_t* yp = Y + (size_t)(row0 + ai * HALF + m * 16) * 2048 + col0;
#pragma unroll
                    for (int bj = 0; bj < 2; ++bj) *(u32x4*)(yp + bj * HALF) = pack8(acc[ai][bj][m][0] * rstd, acc[ai][bj][m][1] * rstd); }
        } else if (u.pn < 12) {
            const int col0 = (u.pn - 8) * BM + wc * 32 + 8 * fq;
            const __amdgpu_buffer_rsrc_t rsU = __builtin_amdgcn_make_buffer_rsrc((void*)UPOOL, (short)0, 17408 * 1024 * 2, 0x00020000);
#pragma unroll
            for (int ai = 0; ai < 2; ++ai)
#pragma unroll
                for (int m = 0; m < 4; ++m) { const unsigned ro = (unsigned)(((size_t)(row0 + ai * HALF + m * 16) * 1024 + col0) * 2);
#pragma unroll
                    for (int bj = 0; bj < 2; ++bj) __builtin_amdgcn_raw_buffer_store_b128(pack8(acc[ai][bj][m][0], acc[ai][bj][m][1]), rsU, ro + bj * HALF * 2, 0, 16); }
        } else {
            const int col0 = (u.pn - 12) * BM + wc * 32 + 8 * fq;
#pragma unroll
            for (int ai = 0; ai < 2; ++ai)
#pragma unroll
                for (int m = 0; m < 4; ++m) { bf16_t* rowp = GATES + (size_t)(row0 + ai * HALF + m * 16) * 2048 + col0;
#pragma unroll
                    for (int bj = 0; bj < 2; ++bj) { f32x4 v0 = acc[ai][bj][m][0], v1 = acc[ai][bj][m][1];
#pragma unroll
                        for (int j = 0; j < 4; ++j) { v0[j] = sigm(v0[j]); v1[j] = sigm(v1[j]); }
                        *(u32x4*)(rowp + bj * HALF) = pack8(v0, v1); } }
        }
    }
};

template <int MODE  > struct EpiGate {
    static constexpr bool PERM = true;
    bf16_t* M1; const bf16_t* GATES;
    __device__ __forceinline__ void operator()(f32x4 (&acc)[2][2][4][2], const Unit& u, int wr, int wc, int fr, int fq, PG8_LAS unsigned char*) const {
        const int row0 = u.pm * BM + wr * 64 + fr, col0 = u.pn * BM + wc * 32 + 8 * fq;
        const __amdgpu_buffer_rsrc_t rs = __builtin_amdgcn_make_buffer_rsrc((void*)M1, (short)0, 17408 * 1024 * 2, 0x00020000);
#pragma unroll
        for (int ai = 0; ai < 2; ++ai) {
            u32x4 gv[4][2], ov[4][2];
#pragma unroll
            for (int m = 0; m < 4; ++m) { const int r = row0 + ai * HALF + m * 16; const bf16_t* gp = GATES + (size_t)r * 2048 + MODE * 1024 + col0; const bf16_t* mp = M1 + (size_t)r * 1024 + col0;
                gv[m][0] = *(const u32x4*)gp; gv[m][1] = *(const u32x4*)(gp + HALF);
                if (MODE == 1) { ov[m][0] = *(const u32x4*)mp; ov[m][1] = *(const u32x4*)(mp + HALF); } }
#pragma unroll
            for (int m = 0; m < 4; ++m) { bf16_t* mp = M1 + (size_t)(row0 + ai * HALF + m * 16) * 1024 + col0;
#pragma unroll
                for (int bj = 0; bj < 2; ++bj) { const u32x4 g = gv[m][bj]; f32x4 v0 = acc[ai][bj][m][0], v1 = acc[ai][bj][m][1];
                    v0[0] *= bflo(g.x); v0[1] *= bfhi(g.x); v0[2] *= bflo(g.y); v0[3] *= bfhi(g.y); v1[0] *= bflo(g.z); v1[1] *= bfhi(g.z); v1[2] *= bflo(g.w); v1[3] *= bfhi(g.w);
                    if (MODE == 1) { const u32x4 o = ov[m][bj];
                        v0[0] += bflo(o.x); v0[1] += bfhi(o.x); v0[2] += bflo(o.y); v0[3] += bfhi(o.y); v1[0] += bflo(o.z); v1[1] += bfhi(o.z); v1[2] += bflo(o.w); v1[3] += bfhi(o.w); }
                    __builtin_amdgcn_raw_buffer_store_b128(pack8(v0, v1), rs, (unsigned)((size_t)((const char*)(mp + bj * HALF) - (const char*)M1)), 0,   16); } }
            asm volatile("" ::: "memory"); }
    }
};

template <bool LAT_BASE_BF16> struct EpiRes {
    static constexpr bool PERM = true;
    const float* base_lat_f32; bf16_t* xr; const float* base_ctx; float* out_ctx; const float* gate;
    __device__ __forceinline__ void operator()(f32x4 (&acc)[2][2][4][2], const Unit& u, int wr, int wc, int fr, int fq, PG8_LAS unsigned char*) const {
        const bool lat = u.pm < 64;
        const int row0 = (lat ? u.pm : u.pm - 64) * BM + wr * 64 + fr, col0 = u.pn * BM + wc * 32 + 8 * fq;
        const float* gp = gate + (lat ? (u.pm >> 4) : 4) * 6144 + col0;
        f32x4 gv[2][2];
#pragma unroll
        for (int bj = 0; bj < 2; ++bj)
#pragma unroll
            for (int n = 0; n < 2; ++n) gv[bj][n] = *(const f32x4*)(gp + bj * HALF + 4 * n);
        if (lat && LAT_BASE_BF16) {
#pragma unroll
            for (int ai = 0; ai < 2; ++ai) {
                u32x4 bb[4][2];
#pragma unroll
                for (int m = 0; m < 4; ++m)
#pragma unroll
                    for (int bj = 0; bj < 2; ++bj) bb[m][bj] = *(const u32x4*)(xr + (size_t)(row0 + ai * HALF + m * 16) * 2048 + col0 + bj * HALF);
#pragma unroll
                for (int m = 0; m < 4; ++m)
#pragma unroll
                    for (int bj = 0; bj < 2; ++bj) { const u32x4 o = bb[m][bj]; f32x4 v0 = gv[bj][0] * acc[ai][bj][m][0], v1 = gv[bj][1] * acc[ai][bj][m][1];
                        v0[0] += bflo(o.x); v0[1] += bfhi(o.x); v0[2] += bflo(o.y); v0[3] += bfhi(o.y); v1[0] += bflo(o.z); v1[1] += bfhi(o.z); v1[2] += bflo(o.w); v1[3] += bfhi(o.w);
                        *(u32x4*)(xr + (size_t)(row0 + ai * HALF + m * 16) * 2048 + col0 + bj * HALF) = pack8(v0, v1); }
                asm volatile("" ::: "memory"); }
        } else {
            const float* base = lat ? base_lat_f32 : base_ctx;
#pragma unroll
            for (int ai = 0; ai < 2; ++ai) {
                f32x4 bs[4][2][2];
#pragma unroll
                for (int m = 0; m < 4; ++m) { const size_t off = (size_t)(row0 + ai * HALF + m * 16) * 1024 + col0;
#pragma unroll
                    for (int bj = 0; bj < 2; ++bj)
#pragma unroll
                        for (int n = 0; n < 2; ++n) bs[m][bj][n] = *(const f32x4*)(base + off + bj * HALF + 4 * n); }
#pragma unroll
                for (int m = 0; m < 4; ++m) { const int r = row0 + ai * HALF + m * 16;
#pragma unroll
                    for (int bj = 0; bj < 2; ++bj) { const f32x4 v0 = bs[m][bj][0] + gv[bj][0] * acc[ai][bj][m][0], v1 = bs[m][bj][1] + gv[bj][1] * acc[ai][bj][m][1];
                        if (lat) *(u32x4*)(xr + (size_t)r * 2048 + col0 + bj * HALF) = pack8(v0, v1);
                        else { float* op = out_ctx + (size_t)r * 1024 + col0 + bj * HALF; *(f32x4*)op = v0; *(f32x4*)(op + 4) = v1; } } }
                asm volatile("" ::: "memory"); }
        }
    }
};

struct SplitKOrder {
    int G, c;
    __device__ __forceinline__ bool next(int i, Unit& u) const { const int L = i * G + c; if (L >= 176) return false; const int ks = L % 11, tile = L / 11; u.pm = 64 + (tile >> 2); u.pn = (tile & 3) + 4 * ks; return true; }
    __device__ __forceinline__ size_t a_off(const Unit& u, const Gemm&, size_t tsA) const { return (size_t)u.pm * tsA + (size_t)(u.pn >> 2) * 512; }
    __device__ __forceinline__ size_t b_off(const Unit& u, const Gemm&, size_t tsB) const { return (size_t)(u.pn & 3) * tsB + (size_t)(u.pn >> 2) * 512; }
    __device__ __forceinline__ void a_ready(const Unit&) const {}
    __device__ __forceinline__ void done(const Unit&) const {}
};
struct EpiPart {
    static constexpr bool PERM = true;
    float* P;
    __device__ __forceinline__ void operator()(f32x4 (&acc)[2][2][4][2], const Unit& u, int wr, int wc, int fr, int fq, PG8_LAS unsigned char*) const {
        const int ks = u.pn >> 2, row0 = (u.pm - 64) * BM + wr * 64 + fr, col0 = (u.pn & 3) * BM + wc * 32 + 8 * fq;
#pragma unroll
        for (int ai = 0; ai < 2; ++ai)
#pragma unroll
            for (int m = 0; m < 4; ++m) { float* op = P + ((size_t)ks * 1024 + row0 + ai * HALF + m * 16) * 1024 + col0;
#pragma unroll
                for (int bj = 0; bj < 2; ++bj) { *(f32x4*)(op + bj * HALF) = acc[ai][bj][m][0]; *(f32x4*)(op + bj * HALF + 4) = acc[ai][bj][m][1]; } }
    }
};

struct EpiSwiglu {
    static constexpr bool PERM = true;
    bf16_t* ACT;
    __device__ __forceinline__ void operator()(f32x4 (&acc)[2][2][4][2], const Unit& u, int wr, int wc, int fr, int fq, PG8_LAS unsigned char*) const {
        const int row0 = u.pm * BM + wr * 64 + fr, j0 = u.pn * 128 + wc * 32 + 8 * fq;
#pragma unroll
        for (int ai = 0; ai < 2; ++ai)
#pragma unroll
            for (int m = 0; m < 4; ++m) { bf16_t* rowp = ACT + (size_t)(row0 + ai * HALF + m * 16) * 2816 + j0;
                const f32x4 a0 = acc[ai][0][m][0], b0 = acc[ai][0][m][1], a1 = acc[ai][1][m][0], b1 = acc[ai][1][m][1];
                u32x4 w; w.x = cvt_pk_bf16(silu(a0[0]) * b0[0], silu(a0[1]) * b0[1]); w.y = cvt_pk_bf16(silu(a0[2]) * b0[2], silu(a0[3]) * b0[3]);
                w.z = cvt_pk_bf16(silu(a1[0]) * b1[0], silu(a1[1]) * b1[1]); w.w = cvt_pk_bf16(silu(a1[2]) * b1[2], silu(a1[3]) * b1[3]);
                *(u32x4*)rowp = w; }
    }
};

template <class Epi, class Sched, bool ALIGN_EPI = true, bool SP2 = true>
__device__ __forceinline__ void gemm_phase(PG8_LAS unsigned char* lds, PG8_LAS unsigned char* xl, const Gemm g, const Sched& S, const Epi& E) {
    const int tid = opaque_v(tid_now()), wid = __builtin_amdgcn_readfirstlane(tid >> 6), lane = tid & 63, wr = wid >> 2, wc = wid & 3, fr = lane & 15, fq = lane >> 4;
    const int K = g.K, nt = K / BK;
    unsigned voffA[2], voffB[2];
#pragma unroll
    for (int i = 0; i < 2; ++i) { int R, C; stage_rc(tid * 16 + i * 8192, R, C); const int Rb = Epi::PERM ? ((R & ~31) + perm32(R & 31)) : R;
        voffA[i] = (unsigned)(R * g.lda + C) * 2u; voffB[i] = (unsigned)(Rb * g.ldb + C) * 2u; }
    const size_t kstep = (size_t)(BK * 2);
    const size_t hsA = (size_t)HALF * g.lda * 2, hsB = (size_t)HALF * g.ldb * 2;
    const size_t tsA = 2 * hsA, tsB = 2 * hsB;
    const unsigned ldsw = (unsigned)wid * 1024u;
    const int aoff = lds_byte(wr * 64 + fr, fq * 8), boff = lds_byte(wc * 32 + fr, fq * 8);
#define PG8_SA(b, h) (((b) * 2 + (h)) * HTB)
#define PG8_SB(b, h) ((4 + (b) * 2 + (h)) * HTB)
#define PG8_STAGE(bufoff, gbase, voff) do { _Pragma("unroll") for (int _i = 0; _i < 2; ++_i) \
        __builtin_amdgcn_global_load_lds((const unsigned*)((const char*)(gbase) + (voff)[_i]), (PG8_LAS unsigned*)(lds + (bufoff) + ldsw + _i * 8192), 16, 0, 0); } while (0)
#define PG8_LDA(dst, b, h) do { _Pragma("unroll") for (int m = 0; m < 4; ++m) _Pragma("unroll") for (int k = 0; k < 2; ++k) dst[m][k] = *(const PG8_LAS bf16x8*)(lds + PG8_SA(b, h) + aoff + m * 2048 + k * 1024); } while (0)
#define PG8_LDB(dst, b, h) do { _Pragma("unroll") for (int n = 0; n < 2; ++n) _Pragma("unroll") for (int k = 0; k < 2; ++k) dst[n][k] = *(const PG8_LAS bf16x8*)(lds + PG8_SB(b, h) + boff + n * 2048 + k * 1024); } while (0)
#define PG8_MMA(ai, bj, At, Bt) do { __builtin_amdgcn_s_setprio(1); _Pragma("unroll") for (int m = 0; m < 4; ++m) _Pragma("unroll") for (int n = 0; n < 2; ++n) _Pragma("unroll") for (int k = 0; k < 2; ++k) \
        acc[ai][bj][m][n] = __builtin_amdgcn_mfma_f32_16x16x32_bf16(Bt[n][k], At[m][k], acc[ai][bj][m][n], 0, 0, 0); __builtin_amdgcn_s_setprio(0); } while (0)
#define PG8_WAIT_V(n) asm volatile("s_waitcnt vmcnt(" #n ")" ::: "memory")
#define PG8_WAIT_L(n) asm volatile("s_waitcnt lgkmcnt(" #n ")" ::: "memory")
#define PG8_BAR __builtin_amdgcn_s_barrier()
#define PG8_SCHED __builtin_amdgcn_sched_barrier(0)
    Unit cur, nxt; int ui = 0;
    if (!S.next(0, cur)) return;
    f32x4 acc[2][2][4][2];
#pragma unroll
    for (int a = 0; a < 2; ++a)
#pragma unroll
        for (int b = 0; b < 2; ++b)
#pragma unroll
            for (int m = 0; m < 4; ++m)
#pragma unroll
                for (int n = 0; n < 2; ++n) acc[a][b][m][n] = (f32x4){0.f, 0.f, 0.f, 0.f};
    bf16x8 At[4][2], B0[2][2], B1[2][2];
    const char* cA = (const char*)g.A + S.a_off(cur, g, tsA); const char* cB = (const char*)g.Bt + S.b_off(cur, g, tsB);
    S.a_ready(cur);
    if constexpr (SP2) {
        PG8_STAGE(PG8_SB(0, 0), cB, voffB); PG8_STAGE(PG8_SB(0, 1), cB + hsB, voffB); PG8_STAGE(PG8_SA(0, 0), cA, voffA); PG8_STAGE(PG8_SA(0, 1), cA + hsA, voffA);
        if (wr == 1) PG8_BAR;
        PG8_WAIT_V(2); PG8_BAR;
        PG8_STAGE(PG8_SB(1, 0), cB + kstep, voffB); PG8_STAGE(PG8_SA(1, 0), cA + kstep, voffA); PG8_STAGE(PG8_SB(1, 1), cB + hsB + kstep, voffB);
        PG8_WAIT_V(6); PG8_BAR;
    } else {
        PG8_STAGE(PG8_SB(0, 0), cB, voffB); PG8_STAGE(PG8_SA(0, 0), cA, voffA); PG8_STAGE(PG8_SB(0, 1), cB + hsB, voffB); PG8_STAGE(PG8_SA(0, 1), cA + hsA, voffA);
        if (wr == 1) PG8_BAR;
        PG8_WAIT_V(4); PG8_BAR;
        PG8_STAGE(PG8_SB(1, 0), cB + kstep, voffB); PG8_STAGE(PG8_SA(1, 0), cA + kstep, voffA); PG8_STAGE(PG8_SB(1, 1), cB + hsB + kstep, voffB);
        PG8_WAIT_V(6); PG8_BAR;
    }
    for (;;) {
        const bool has_next = S.next(ui + 1, nxt);
        const char* nA = has_next ? (const char*)g.A + S.a_off(nxt, g, tsA) : cA; const char* nB = has_next ? (const char*)g.Bt + S.b_off(nxt, g, tsB) : cB;
        for (int t = 0; t < nt; t += 2) {
            const bool last = (t == nt - 2);
            const char* a1 = cA + (size_t)(t + 1) * kstep;
            const char* a2 = last ? nA : cA + (size_t)(t + 2) * kstep; const char* b2 = last ? nB : cB + (size_t)(t + 2) * kstep;
            const char* a3 = a2 + kstep; const char* b3 = b2 + kstep;
            if (last && has_next) S.a_ready(nxt);
            if constexpr (SP2) {
            PG8_LDB(B0, 0, 0); PG8_LDB(B1, 0, 1); PG8_SCHED; PG8_LDA(At, 0, 0); PG8_STAGE(PG8_SA(1, 1), a1 + hsA, voffA);
            PG8_WAIT_V(8); PG8_WAIT_L(0); PG8_BAR; PG8_MMA(0, 0, At, B0); PG8_MMA(0, 1, At, B1); PG8_BAR; PG8_SCHED;
            PG8_LDA(At, 0, 1); PG8_STAGE(PG8_SB(0, 0), b2, voffB); PG8_STAGE(PG8_SB(0, 1), b2 + hsB, voffB); PG8_STAGE(PG8_SA(0, 0), a2, voffA);
            PG8_WAIT_V(8); PG8_WAIT_L(0); PG8_BAR; PG8_MMA(1, 0, At, B0); PG8_MMA(1, 1, At, B1); PG8_BAR; PG8_SCHED;
            PG8_LDB(B0, 1, 0); PG8_LDB(B1, 1, 1); PG8_SCHED; PG8_LDA(At, 1, 0); PG8_STAGE(PG8_SA(0, 1), a2 + hsA, voffA);
            PG8_WAIT_V(8); PG8_WAIT_L(0); PG8_BAR; PG8_MMA(0, 0, At, B0); PG8_MMA(0, 1, At, B1); PG8_BAR; PG8_SCHED;
            PG8_LDA(At, 1, 1); PG8_STAGE(PG8_SB(1, 0), b3, voffB); PG8_STAGE(PG8_SB(1, 1), b3 + hsB, voffB); PG8_STAGE(PG8_SA(1, 0), a3, voffA);
            PG8_WAIT_V(8); PG8_WAIT_L(0); PG8_BAR; PG8_MMA(1, 0, At, B0); PG8_MMA(1, 1, At, B1); PG8_BAR; PG8_SCHED;
            } else {
            PG8_LDB(B0, 0, 0); PG8_SCHED; PG8_LDA(At, 0, 0); PG8_STAGE(PG8_SA(1, 1), a1 + hsA, voffA);
            PG8_WAIT_L(8); PG8_BAR; PG8_WAIT_L(0); PG8_MMA(0, 0, At, B0); PG8_BAR; PG8_SCHED;
            PG8_LDB(B1, 0, 1); PG8_STAGE(PG8_SB(0, 0), b2, voffB);
            PG8_BAR; PG8_WAIT_L(0); PG8_MMA(0, 1, At, B1); PG8_BAR;
            PG8_LDA(At, 0, 1); PG8_STAGE(PG8_SA(0, 0), a2, voffA);
            PG8_BAR; PG8_WAIT_L(0); PG8_MMA(1, 0, At, B0); PG8_BAR; PG8_SCHED;
            PG8_STAGE(PG8_SB(0, 1), b2 + hsB, voffB);
            PG8_WAIT_V(6); PG8_BAR; PG8_MMA(1, 1, At, B1); PG8_BAR;
            PG8_LDB(B0, 1, 0); PG8_SCHED; PG8_LDA(At, 1, 0); PG8_STAGE(PG8_SA(0, 1), a2 + hsA, voffA);
            PG8_WAIT_L(8); PG8_BAR; PG8_WAIT_L(0); PG8_MMA(0, 0, At, B0); PG8_BAR; PG8_SCHED;
            PG8_LDB(B1, 1, 1); PG8_STAGE(PG8_SB(1, 0), b3, voffB);
            PG8_BAR; PG8_WAIT_L(0); PG8_MMA(0, 1, At, B1); PG8_BAR;
            PG8_LDA(At, 1, 1); PG8_STAGE(PG8_SA(1, 0), a3, voffA);
            PG8_BAR; PG8_WAIT_L(0); PG8_MMA(1, 0, At, B0); PG8_BAR; PG8_SCHED;
            PG8_STAGE(PG8_SB(1, 1), b3 + hsB, voffB);
            PG8_WAIT_V(6); PG8_BAR; PG8_MMA(1, 1, At, B1); PG8_BAR;
            }
        }
        if constexpr (ALIGN_EPI) { if (wr == 0) PG8_BAR; }
        E(acc, cur, wr, wc, fr, fq, xl); S.done(cur);
        if (!has_next) break;
#pragma unroll
        for (int a = 0; a < 2; ++a)
#pragma unroll
            for (int b = 0; b < 2; ++b)
#pragma unroll
                for (int m = 0; m < 4; ++m)
#pragma unroll
                    for (int n = 0; n < 2; ++n) acc[a][b][m][n] = (f32x4){0.f, 0.f, 0.f, 0.f};
        cur = nxt; cA = nA; cB = nB; ++ui;
        if constexpr (ALIGN_EPI) { if (wr == 1) PG8_BAR; }
    }
    PG8_WAIT_V(0);
    if constexpr (!ALIGN_EPI) { if (wr == 0) PG8_BAR; }
    PG8_BAR;
#undef PG8_SA
#undef PG8_SB
#undef PG8_STAGE
#undef PG8_LDA
#undef PG8_LDB
#undef PG8_MMA
#undef PG8_WAIT_V
#undef PG8_WAIT_L
#undef PG8_BAR
#undef PG8_SCHED
}
}

#define GAS __attribute__((address_space(1)))
#define LAS __attribute__((address_space(3)))
typedef unsigned short bf16;
typedef unsigned v4u __attribute__((ext_vector_type(4)));
typedef unsigned v2u __attribute__((ext_vector_type(2)));
typedef float f32x4 __attribute__((ext_vector_type(4)));
#define LDS_WAIT() asm volatile("s_waitcnt lgkmcnt(0)" ::: "memory")
#define VM_WAIT() asm volatile("s_waitcnt vmcnt(0)" ::: "memory")

constexpr int D = 1024, NB = 4, SEQ = 4096, CTXL = 256, MLAT = NB * SEQ, MCTX = NB * CTXL, MTOT = MLAT + MCTX;
constexpr int DI = 2048, XBCW = 4096, NHEAD = 32, FFH = 2816, INC = 9280;
constexpr int NB1 = 4352  , NB2 = 5120  ;
constexpr int NWAVES = 8;

constexpr size_t MiB = 1u << 20;
constexpr size_t WS_CTL = 0, CTL_ZERO_BYTES = 1 * MiB;
constexpr size_t WS_MOD = 1 * MiB;
constexpr size_t WS_WIN = 2 * MiB;
constexpr size_t WS_WSSD = WS_WIN + (size_t)(NB1 + NB2) * 1024 * 2;
constexpr size_t WS_WPC = WS_WSSD + (size_t)1024 * 2048 * 2;
constexpr size_t WS_WOUT = WS_WPC + (size_t)1024 * 1024 * 2;
constexpr size_t WS_CX = WS_WOUT + (size_t)1024 * 1024 * 2;
constexpr size_t WS_H = WS_CX + (size_t)MCTX * D * 4;
constexpr size_t WS_DT = WS_H + (size_t)MTOT * D * 2;
constexpr size_t WS_Y = WS_DT + (size_t)MTOT * 64 * 4;
constexpr size_t WS_XBC = WS_Y + (size_t)MTOT * DI * 2;
constexpr size_t WS_END = WS_XBC + (size_t)MTOT * XBCW * 2;
constexpr size_t XO_GATES = 0, XO_UPOOL = (size_t)MTOT * 2048 * 2, XO_M1 = XO_UPOOL + (size_t)MTOT * 1024 * 2;
constexpr size_t XO_ACT = 0, XO_WGU = (size_t)MTOT * FFH * 2, XO_WDN = XO_WGU + (size_t)2 * FFH * 1024 * 2;
static_assert(XO_M1 + (size_t)MTOT * 1024 * 2 <= (size_t)MTOT * XBCW * 2 && XO_WDN + (size_t)1024 * FFH * 2 <= (size_t)MTOT * XBCW * 2, "xbc overlay map");
constexpr int CW_BAR = 4096;
constexpr int CW_WORK = 12288;
constexpr int CW_CNT = 16384, CNT_ARR = 68 * 64;
__device__ __forceinline__ int cnt_off(int l, int kind) { return CW_CNT + (l * 8 + kind) * CNT_ARR; }
__device__ __forceinline__ pg8::pg8_gu32* cnt_arr(unsigned char* ws, int l, int kind) { return (pg8::pg8_gu32*)(ws + WS_CTL) + cnt_off(l, kind); }

constexpr int RING_BYTES = 131072, LDS_BYTES = 163840  , XL_OFF = 155648  , MISC_OFF = 159744  ;

__device__ __forceinline__ unsigned pk2(float lo, float hi) { return pg8::cvt_pk_bf16(lo, hi); }
__device__ __forceinline__ float bf_lo(unsigned u) { return __uint_as_float(u << 16); }
__device__ __forceinline__ float bf_hi(unsigned u) { return __uint_as_float(u & 0xffff0000u); }

#define XB_TMO      128
#define XB_XCNT(j)  (256  + 64 * (j))
#define XB_XSUB(j)  (1280 + 64 * (j))
#define XB_XGEN(j)  (2304 + 64 * (j))
#define XB_TOP      3328
#define XB_TOPGEN   3392
#define XCD_BAR_WORDS 3456
#define XB_SPIN_CAP (1u << 20)
typedef GAS unsigned gu32;
__device__ __forceinline__ unsigned xb_ld(gu32* p)              { return __hip_atomic_load(p, __ATOMIC_RELAXED, __HIP_MEMORY_SCOPE_AGENT); }
__device__ __forceinline__ unsigned xb_add(gu32* p, unsigned v) { return __hip_atomic_fetch_add(p, v, __ATOMIC_RELAXED, __HIP_MEMORY_SCOPE_AGENT); }
__device__ __forceinline__ unsigned xb_xcc_id() { return (unsigned)__builtin_amdgcn_s_getreg((3 << 11) | 20) & 0xFu; }
#define XB_SPIN(cond, bar) do { unsigned _sp = 0; while (cond) { __builtin_amdgcn_s_sleep(1); \
    if ((++_sp & 255u) == 0u) { if (xb_ld(&(bar)[XB_TMO])) break; if (_sp > XB_SPIN_CAP) { xb_add(&(bar)[XB_TMO], 1u); break; } } } } while (0)
struct XcdBarrier { gu32* bar; unsigned x; volatile LAS unsigned* st; };
__device__ __forceinline__ XcdBarrier xcd_barrier_post(gu32* bar, volatile LAS unsigned* st) {
    XcdBarrier b; b.bar = bar; b.x = xb_xcc_id(); b.st = st;
    if (pg8::tid_now() == 0) (void)xb_add(&bar[XB_XCNT(b.x)], 1u);
    return b;
}
__device__ __forceinline__ void xcd_barrier_complete(gu32* bar, unsigned x, unsigned& nloc, unsigned& nx) {
    const unsigned G = gridDim.x * gridDim.y * gridDim.z;
    unsigned sum, cnt, mine, sp = 0u;
    for (;;) {
        sum = 0u; cnt = 0u; mine = 0u;
#pragma unroll
        for (unsigned j = 0; j < 16; ++j) { const unsigned c = xb_ld(&bar[XB_XCNT(j)]); sum += c; cnt += (c > 0u) ? 1u : 0u; mine = (j == x) ? c : mine; }
        if (sum == G) break;
        __builtin_amdgcn_s_sleep(1);
        if ((++sp & 255u) == 0u) { if (xb_ld(&bar[XB_TMO])) break; if (sp > XB_SPIN_CAP) { xb_add(&bar[XB_TMO], 1u); break; } }
    }
    nloc = mine > 0u ? mine : 1u; nx = cnt > 0u ? cnt : 1u;
}
__device__ __forceinline__ void xcd_barrier(const XcdBarrier& b) {
    asm volatile("s_waitcnt vmcnt(0)" ::: "memory");
    __syncthreads();
    if (pg8::tid_now() == 0) {
        gu32* bar = b.bar; unsigned bx_ = b.x;
        asm volatile("" : "+s"(bar), "+s"(bx_));
        __builtin_amdgcn_s_waitcnt(0);
        unsigned nloc = b.st[0], nx = b.st[1];
        if (nloc == 0u) { xcd_barrier_complete(bar, bx_, nloc, nx); b.st[0] = nloc; b.st[1] = nx; }
        const unsigned old = xb_add(&bar[XB_XSUB(bx_)], 1u);
        const unsigned gen = old / nloc;
        if (old + 1u == (gen + 1u) * nloc) {
            __builtin_amdgcn_fence(__ATOMIC_RELEASE, "agent");
            asm volatile("s_waitcnt vmcnt(0)" ::: "memory");
            const unsigned og = xb_add(&bar[XB_TOP], 1u);
            const unsigned tg = og / nx;
            if (og + 1u == (tg + 1u) * nx) xb_add(&bar[XB_TOPGEN], 1u);
            else XB_SPIN(xb_ld(&bar[XB_TOPGEN]) == tg, bar);
            __builtin_amdgcn_fence(__ATOMIC_ACQUIRE, "agent");
            xb_add(&bar[XB_XGEN(bx_)], 1u);
            asm volatile("s_waitcnt vmcnt(0)" ::: "memory");
        } else {
            XB_SPIN(xb_ld(&bar[XB_XGEN(bx_)]) == gen, bar);
            __builtin_amdgcn_fence(__ATOMIC_ACQUIRE, "agent");
            asm volatile("s_waitcnt vmcnt(0)" ::: "memory");
        }
    }
    __syncthreads();
}

__device__ __forceinline__ float wave_sum(float v) {
    v += pg8::lane_xor<1>(v); v += pg8::lane_xor<2>(v); v += pg8::lane_xor<4>(v); v += pg8::lane_xor<8>(v); v += pg8::lane_xor<16>(v);
    return pg8::half_sum(v);
}

template <int MODE> __device__ __forceinline__ int srccol(int n) {
    if (MODE == 0) {
        if (n < 4096) return 2048 + n;
        if (n < 4160) return 6144 + (n - 4096);
        if (n < 4352) return -1;
        if (n < 6400) return n - 4352;
        if (n < 7424) return 6208 + (n - 6400);
        return 7232 + (n - 7424);
    }
    if (MODE == 2) { const int pn = n >> 8, c = n & 255, bj = c >> 7, wc = (c >> 5) & 3, fq = (c >> 3) & 3, sel = (c >> 2) & 1, j = pn * 128 + wc * 32 + 8 * fq + 4 * bj + (c & 3); return sel * FFH + j; }
    return n;
}
struct Args { const float* in[23]; float* out; unsigned char* ws; };
typedef const __attribute__((address_space(4))) unsigned long long* KA;
__device__ __forceinline__ KA ka_fresh() { KA p = (KA)__builtin_amdgcn_kernarg_segment_ptr(); asm volatile("" : "+s"(p)); return p; }
#define KIN(ka, k) ((const float*)(const GAS float*)(ka)[k])
#define KOUT(ka) ((float*)(GAS float*)(ka)[23])
#define KWS(ka) ((unsigned char*)(GAS unsigned char*)(ka)[24])

struct Ids { int tid, lane, wave, G, bx, vcu, gw, NGW; };
__device__ __forceinline__ Ids fresh(Ids I) { I.wave = pg8::opaque_s(pg8::wave_now()); I.tid = pg8::opaque_v(I.wave * 64 + pg8::lane_now()); I.lane = I.tid & 63; I.vcu = pg8::opaque_s(I.vcu); I.bx = pg8::opaque_s(I.bx); I.gw = I.vcu * NWAVES + I.wave; return I; }

struct ConvJob { const float* W; bf16* WT; const float* kscale; int K, Nsrc, Ndst, mode, item; };
__device__ __forceinline__ int srccol_rt(int mode, int n) { return mode == 0 ? srccol<0>(n) : (mode == 2 ? srccol<2>(n) : n); }
__device__ __forceinline__ void conv_load(const ConvJob& j, int lane, f32x4 (&v)[8]) {
    const int nblk = j.Ndst / 32, kb = j.item / nblk, nb = j.item % nblk, k0 = 64 * kb, n0 = 32 * nb;
    const int r8 = lane >> 3, c4 = lane & 7, sc = srccol_rt(j.mode, n0 + 4 * c4);
#pragma unroll
    for (int i = 0; i < 8; ++i) v[i] = sc >= 0 ? *(const f32x4*)(j.W + (size_t)(k0 + 8 * i + r8) * j.Nsrc + sc) : (f32x4){0.f, 0.f, 0.f, 0.f};
}
__device__ __forceinline__ void conv_store(const ConvJob& j, int lane, const f32x4 (&v)[8], LAS float* scr) {
    const int nblk = j.Ndst / 32, kb = j.item / nblk, nb = j.item % nblk, k0 = 64 * kb, n0 = 32 * nb;
    const int r8 = lane >> 3, c4 = lane & 7;
#pragma unroll
    for (int i = 0; i < 8; ++i) { const int kk = 8 * i + r8; f32x4 t = v[i]; if (j.kscale) t = t * j.kscale[k0 + kk];
        LAS float* d = scr + kk * 33 + 4 * c4; d[0] = t.x; d[1] = t.y; d[2] = t.z; d[3] = t.w; }
    LDS_WAIT(); asm volatile("" ::: "memory");
    const int c = lane & 7;
#pragma unroll
    for (int q = 0; q < 4; ++q) { const int n = (lane >> 3) + 8 * q; const LAS float* sp = scr + (8 * c) * 33 + n;
        v4u o; o.x = pk2(sp[0 * 33], sp[1 * 33]); o.y = pk2(sp[2 * 33], sp[3 * 33]); o.z = pk2(sp[4 * 33], sp[5 * 33]); o.w = pk2(sp[6 * 33], sp[7 * 33]);
        *(v4u*)(j.WT + (size_t)(n0 + n) * j.K + k0 + 8 * c) = o; }
    LDS_WAIT(); asm volatile("" ::: "memory");
}
__device__ __forceinline__ ConvJob conv_job(KA ka, unsigned char* ws, int which, int l, int it) {
    ConvJob j;
    if (which == 0) {
        constexpr int I_IN = 16 * ((NB1 + NB2) / 32), I_SSD = 32 * 32;
        if (it < I_IN) { j.W = KIN(ka, 7) + (size_t)l * D * INC; j.WT = (bf16*)(ws + WS_WIN); j.kscale = nullptr; j.K = D; j.Nsrc = INC; j.Ndst = NB1 + NB2; j.mode = 0; j.item = it; }
        else if (it < I_IN + I_SSD) { j.W = KIN(ka, 14) + (size_t)l * DI * D; j.WT = (bf16*)(ws + WS_WSSD); j.kscale = KIN(ka, 13) + (size_t)l * DI; j.K = DI; j.Nsrc = D; j.Ndst = D; j.mode = 1; j.item = it - I_IN; }
        else { j.W = KIN(ka, 18) + (size_t)l * D * D; j.WT = (bf16*)(ws + WS_WOUT); j.kscale = nullptr; j.K = D; j.Nsrc = D; j.Ndst = D; j.mode = 1; j.item = it - I_IN - I_SSD; }
    } else {
        constexpr int I_GU = 16 * (2 * FFH / 32);
        if (it < I_GU) { j.W = KIN(ka, 20) + (size_t)l * D * 2 * FFH; j.WT = (bf16*)(ws + WS_XBC + XO_WGU); j.kscale = nullptr; j.K = D; j.Nsrc = 2 * FFH; j.Ndst = 2 * FFH; j.mode = 2; j.item = it; }
        else { j.W = KIN(ka, 21) + (size_t)l * FFH * D; j.WT = (bf16*)(ws + WS_XBC + XO_WDN); j.kscale = nullptr; j.K = FFH; j.Nsrc = D; j.Ndst = D; j.mode = 1; j.item = it - I_GU; }
    }
    return j;
}
__device__ __forceinline__ void conv_pass(const Ids I, LAS unsigned char* lds, KA ka, unsigned char* ws, int which, int l, int it0, int nit, int gw, int ngw) {
    LAS float* scr = (LAS float*)(lds + I.wave * 8448);
    f32x4 va[8], vb[8], vc[8];
    for (int it = it0 + gw; it < nit; it += 3 * ngw) {
        const bool h1 = it + ngw < nit, h2 = it + 2 * ngw < nit;
        const ConvJob ja = conv_job(ka, ws, which, l, it); conv_load(ja, I.lane, va);
        ConvJob jb = ja, jc = ja;
        if (h1) { jb = conv_job(ka, ws, which, l, it + ngw); conv_load(jb, I.lane, vb); }
        if (h2) { jc = conv_job(ka, ws, which, l, it + 2 * ngw); conv_load(jc, I.lane, vc); }
        conv_store(ja, I.lane, va, scr);
        if (h1) conv_store(jb, I.lane, vb, scr);
        if (h2) conv_store(jc, I.lane, vc, scr);
    }
}

__device__ __forceinline__ void norm_row(const float* xrow, bf16* orow, const float* g, const float* sh, const float* sc, int lane) {
    const f32x4* xr = (const f32x4*)xrow + lane;
    f32x4 v[4]; float s = 0.f;
#pragma unroll
    for (int j = 0; j < 4; ++j) { v[j] = xr[64 * j]; s += (v[j].x * v[j].x + v[j].y * v[j].y) + (v[j].z * v[j].z + v[j].w * v[j].w); }
    const float rstd = rsqrtf(wave_sum(s) * (1.f / D) + 1e-6f);
    unsigned long long* o8 = (unsigned long long*)orow + lane;
#pragma unroll
    for (int j = 0; j < 4; ++j) { const f32x4 gg = ((const f32x4*)g)[lane + 64 * j], s1 = ((const f32x4*)sc)[lane + 64 * j], s0 = ((const f32x4*)sh)[lane + 64 * j];
        const f32x4 y = v[j] * rstd * gg * (s1 + 1.0f) + s0;
        o8[64 * j] = (unsigned long long)pk2(y.x, y.y) | ((unsigned long long)pk2(y.z, y.w) << 32); }
}

__device__ __forceinline__ void conv_mixer(const Ids I_, LAS unsigned char* lds, int l, bool skip_win = false) {
    const Ids I = fresh(I_);
    const KA ka = ka_fresh(); unsigned char* ws = KWS(ka);
    conv_pass(I, lds, ka, ws, 0, l, skip_win ? 16 * ((NB1 + NB2) / 32) : 0, 16 * ((NB1 + NB2) / 32) + 32 * 32 + 16 * 32, I.gw, I.NGW);
    const float* pw = KIN(ka, 15) + (size_t)l * 4 * 256 * 256; const float* psc = KIN(ka, 16) + (size_t)l * D; const float* wpo = KIN(ka, 17) + (size_t)l * D * D; bf16* WPC = (bf16*)(ws + WS_WPC);
    __syncthreads();
    for (int item = I.vcu; item < 256; item += I.G) {
        const int g = item >> 6, i0 = (item & 63) * 4, n = 2 * I.tid;
        LAS float* tab = (LAS float*)lds;
        for (int e = I.tid; e < 1024; e += NWAVES * 64) { const int q = e >> 8, o = e & 255; tab[o * 4 + q] = pw[((size_t)g * 256 + i0 + q) * 256 + o] * psc[g * 256 + o]; }
        __syncthreads();
        float a0[4] = {0.f, 0.f, 0.f, 0.f}, a1[4] = {0.f, 0.f, 0.f, 0.f};
        const float* wr_ = wpo + (size_t)g * 256 * D + n;
#pragma unroll 32
        for (int o = 0; o < 256; ++o) { const pg8::f32x2 wv = *(const pg8::f32x2*)(wr_ + (size_t)o * D); const f32x4 t = *(const LAS f32x4*)(tab + o * 4);
            a0[0] += t.x * wv.x; a0[1] += t.y * wv.x; a0[2] += t.z * wv.x; a0[3] += t.w * wv.x; a1[0] += t.x * wv.y; a1[1] += t.y * wv.y; a1[2] += t.z * wv.y; a1[3] += t.w * wv.y; }
        v2u o0, o1; o0.x = pk2(a0[0], a0[1]); o0.y = pk2(a0[2], a0[3]); o1.x = pk2(a1[0], a1[1]); o1.y = pk2(a1[2], a1[3]);
        *(v2u*)(WPC + (size_t)n * D + g * 256 + i0) = o0; *(v2u*)(WPC + (size_t)(n + 1) * D + g * 256 + i0) = o1;
        __syncthreads();
    }
}
__device__ __forceinline__ void conv_ffn(const Ids I_, LAS unsigned char* lds, int l) {
    const Ids I = fresh(I_);
    const KA ka = ka_fresh(); unsigned char* ws = KWS(ka);
    conv_pass(I, lds, ka, ws, 1, l, 0, 16 * (2 * FFH / 32) + (FFH / 64) * 32, I.gw, I.NGW);
}

__device__ __forceinline__ void conv_win_dyn(const Ids I_, LAS unsigned char* lds, int l) {
    const Ids I = fresh(I_);
    const KA ka = ka_fresh(); unsigned char* ws = KWS(ka);
    constexpr int NIT = 16 * ((NB1 + NB2) / 32), NCH = (NIT + 23) / 24;
    pg8::pg8_gu32* work = (pg8::pg8_gu32*)(ws + WS_CTL) + CW_WORK + 64 * 4;
    volatile LAS unsigned* slot = (volatile LAS unsigned*)(lds + MISC_OFF) + 48;
    if (I.tid == 0) slot[0] = __hip_atomic_fetch_add(work, 1u, __ATOMIC_RELAXED, __HIP_MEMORY_SCOPE_AGENT);
    __syncthreads();
    int ch = (int)slot[0], par = 0;
    while (ch < NCH) {
        unsigned nclaim = 0u;
        if (I.tid == 0) nclaim = __hip_atomic_fetch_add(work, 1u, __ATOMIC_RELAXED, __HIP_MEMORY_SCOPE_AGENT);
        { const int e = 24 * ch + 24; conv_pass(I, lds, ka, ws, 0, l, 24 * ch, e < NIT ? e : NIT, I.wave, NWAVES); }
        if (I.tid == 0) slot[par ^ 1] = nclaim;
        __syncthreads();
        par ^= 1; ch = (int)slot[par];
    }
}

__device__ __forceinline__ void phase_mod(const Ids I_, LAS unsigned char* lds) {
    const Ids I = fresh(I_);
    const KA ka = ka_fresh(); float* MOD = (float*)(KWS(ka) + WS_MOD);
    LAS float* sv = (LAS float*)lds;
    LAS float* red = (LAS float*)(lds + 20480);
    if (I.bx < 192) {
        const float* cvec = KIN(ka, 1); const float* cctx = KIN(ka, 3);
        for (int i = I.tid; i < 5 * 1024; i += NWAVES * 64) { const int c = i >> 10, k = i & 1023; const float v = c < 4 ? cvec[c * 1024 + k] : cctx[k]; sv[i] = v / (1.f + __expf(-v)); }
        __syncthreads();
        for (int item = I.bx; item < 192; item += I.G) {
            const int l = item / 96, c0 = (item % 96) * 64, kg = I.tid >> 4, cq = I.tid & 15;
            const float* w = KIN(ka, 4) + (size_t)l * D * 6144 + c0 + 4 * cq;
            f32x4 a[5];
#pragma unroll
            for (int c = 0; c < 5; ++c) a[c] = (f32x4){0.f, 0.f, 0.f, 0.f};
#pragma unroll 16
            for (int k = kg * 32; k < kg * 32 + 32; ++k) { const f32x4 wv = *(const f32x4*)(w + (size_t)k * 6144);
#pragma unroll
                for (int c = 0; c < 5; ++c) a[c] += wv * sv[c * 1024 + k]; }
#pragma unroll
            for (int c = 0; c < 5; ++c) *(LAS f32x4*)(red + (kg * 5 + c) * 64 + 4 * cq) = a[c];
            __syncthreads();
            if (I.tid < 320) { const int c = I.tid >> 6, col = I.tid & 63; float s = KIN(ka, 5)[l * 6144 + c0 + col];
#pragma unroll 8
                for (int q = 0; q < 32; ++q) s += red[(q * 5 + c) * 64 + col];
                MOD[((size_t)l * 5 + c) * 6144 + c0 + col] = s; }
            __syncthreads();
        }
    }
    __syncthreads();
}

__device__ __forceinline__ void phase_norm(const Ids I_, int l, int which  , int nrows, bool from_input) {
    const Ids I = fresh(I_);
    const KA ka = ka_fresh(); unsigned char* ws = KWS(ka);
    const float* modl = (const float*)(ws + WS_MOD) + (size_t)l * 5 * 6144 + which * 3072;
    const float* g = KIN(ka, which ? 19 : 6) + l * D;
    const float* xlat = from_input ? KIN(ka, 0) : KOUT(ka); const float* xctx = from_input ? KIN(ka, 2) : (const float*)(ws + WS_CX);
    bf16* H = (bf16*)(ws + WS_H);
    const bf16* xr = (const bf16*)KOUT(ka);
    const bool parts = (l == 1 && which == 0);
    const float* PP = (const float*)(ws + WS_Y); const float* gctx = (const float*)(ws + WS_MOD) + 5120 + 4 * 6144;
    f32x4 nxa[4], nxb[4];
#define NORM_LOAD(nx, mm) do { if ((mm) < MLAT && !from_input) { const v2u* q_ = (const v2u*)(xr + (size_t)(mm) * 2048) + I.lane; \
            _Pragma("unroll") for (int j = 0; j < 4; ++j) { const v2u t_ = q_[64 * j]; nx[j] = (f32x4){bf_lo(t_.x), bf_hi(t_.x), bf_lo(t_.y), bf_hi(t_.y)}; } } \
        else { const f32x4* q_ = (const f32x4*)((mm) < MLAT ? KIN(ka, 0) + (size_t)(mm) * D : xctx + (size_t)((mm) - MLAT) * D) + I.lane; \
            _Pragma("unroll") for (int j = 0; j < 4; ++j) nx[j] = q_[64 * j]; \
            if (parts && (mm) >= MLAT) { f32x4 s_[4]; _Pragma("unroll") for (int j = 0; j < 4; ++j) s_[j] = (f32x4){0.f, 0.f, 0.f, 0.f}; \
                _Pragma("unroll 4") for (int ks_ = 0; ks_ < 11; ++ks_) { const f32x4* p_ = (const f32x4*)(PP + ((size_t)ks_ * 1024 + ((mm) - MLAT)) * 1024) + I.lane; _Pragma("unroll") for (int j = 0; j < 4; ++j) s_[j] += p_[64 * j]; } \
                _Pragma("unroll") for (int j = 0; j < 4; ++j) nx[j] += ((const f32x4*)gctx)[I.lane + 64 * j] * s_[j]; } } } while (0)
#define NORM_ROW(nx, mm) do { f32x4 v[4]; float ss = 0.f; \
        _Pragma("unroll") for (int j = 0; j < 4; ++j) { v[j] = nx[j]; ss += (v[j].x * v[j].x + v[j].y * v[j].y) + (v[j].z * v[j].z + v[j].w * v[j].w); } \
        if ((mm) + 2 * I.NGW < nrows) NORM_LOAD(nx, (mm) + 2 * I.NGW); \
        const int cond = (mm) < MLAT ? (mm) / SEQ : 4; const float* sh = modl + cond * 6144; const float* sc = sh + 1024; \
        const float rstd = rsqrtf(wave_sum(ss) * (1.f / D) + 1e-6f); \
        unsigned long long* o8 = (unsigned long long*)(H + (size_t)(mm) * D) + I.lane; \
        _Pragma("unroll") for (int j = 0; j < 4; ++j) { const f32x4 gg = ((const f32x4*)g)[I.lane + 64 * j], s1 = ((const f32x4*)sc)[I.lane + 64 * j], s0 = ((const f32x4*)sh)[I.lane + 64 * j]; \
            const f32x4 y = v[j] * rstd * gg * (s1 + 1.0f) + s0; \
            o8[64 * j] = (unsigned long long)pk2(y.x, y.y) | ((unsigned long long)pk2(y.z, y.w) << 32); } } while (0)
    int m = I.gw;
    if (m < nrows) NORM_LOAD(nxa, m);
    if (m + I.NGW < nrows) NORM_LOAD(nxb, m + I.NGW);
    for (; m < nrows; m += 2 * I.NGW) {
        NORM_ROW(nxa, m);
        const int m1 = m + I.NGW; if (m1 >= nrows) break;
        NORM_ROW(nxb, m1);
    }
#undef NORM_ROW
#undef NORM_LOAD
}

__device__ __forceinline__ void phase_norm2_dyn(const Ids I_, LAS unsigned char* lds_base, int l, int nrows) {
    const Ids I = fresh(I_);
    const KA ka = ka_fresh(); unsigned char* ws = KWS(ka);
    const float* modl = (const float*)(ws + WS_MOD) + (size_t)l * 5 * 6144 + 3072;
    const float* g = KIN(ka, 19) + l * D;
    const float* xctx = (const float*)(ws + WS_CX); const bf16* xr = (const bf16*)KOUT(ka);
    bf16* H = (bf16*)(ws + WS_H);
    pg8::pg8_gu32* work = (pg8::pg8_gu32*)(ws + WS_CTL) + CW_WORK + 64 * (2 + l); pg8::pg8_gu32* cp_ = cnt_arr(ws, l, 4); pg8::pg8_gu32* tmo = (pg8::pg8_gu32*)(ws + WS_CTL) + CW_BAR + XB_TMO;
    const int nblk = nrows / 64;
#define N2_CLAIM_WAIT(claim_) do { const int b_ = (int)(claim_); \
        if (b_ < nblk) { unsigned sp_ = 0; \
            while (__hip_atomic_load(cp_ + 64 * (b_ >> 2), __ATOMIC_RELAXED, __HIP_MEMORY_SCOPE_AGENT) < 32u) { __builtin_amdgcn_s_sleep(2); \
                if ((++sp_ & 255u) == 0u) { if (__hip_atomic_load(tmo, __ATOMIC_RELAXED, __HIP_MEMORY_SCOPE_AGENT) != 0u) break; if (sp_ > (1u << 20)) { __hip_atomic_fetch_add(tmo, 1u, __ATOMIC_RELAXED, __HIP_MEMORY_SCOPE_AGENT); break; } } } \
            __builtin_amdgcn_fence(__ATOMIC_ACQUIRE, "agent"); asm volatile("s_waitcnt vmcnt(0)" ::: "memory"); } } while (0)
#define N2_LOAD(nx, mm) do { if ((mm) < MLAT) { const v2u* q_ = (const v2u*)(xr + (size_t)(mm) * 2048) + I.lane; \
            _Pragma("unroll") for (int j = 0; j < 4; ++j) { const v2u t_ = q_[64 * j]; nx[j] = (f32x4){bf_lo(t_.x), bf_hi(t_.x), bf_lo(t_.y), bf_hi(t_.y)}; } } \
        else { const f32x4* q_ = (const f32x4*)(xctx + (size_t)((mm) - MLAT) * D) + I.lane; _Pragma("unroll") for (int j = 0; j < 4; ++j) nx[j] = q_[64 * j]; } } while (0)
#define N2_ROW(nx, mm, mend) do { f32x4 v[4]; float ss = 0.f; \
        _Pragma("unroll") for (int j = 0; j < 4; ++j) { v[j] = nx[j]; ss += (v[j].x * v[j].x + v[j].y * v[j].y) + (v[j].z * v[j].z + v[j].w * v[j].w); } \
        if ((mm) + 16 < (mend)) N2_LOAD(nx, (mm) + 16); \
        const int cond = (mm) < MLAT ? (mm) / SEQ : 4; const float* sh = modl + cond * 6144; const float* sc = sh + 1024; \
        const float rstd = rsqrtf(wave_sum(ss) * (1.f / D) + 1e-6f); \
        unsigned long long* o8 = (unsigned long long*)(H + (size_t)(mm) * D) + I.lane; \
        _Pragma("unroll") for (int j = 0; j < 4; ++j) { const f32x4 gg = ((const f32x4*)g)[I.lane + 64 * j], s1 = ((const f32x4*)sc)[I.lane + 64 * j], s0 = ((const f32x4*)sh)[I.lane + 64 * j]; \
            const f32x4 y = v[j] * rstd * gg * (s1 + 1.0f) + s0; \
            o8[64 * j] = (unsigned long long)pk2(y.x, y.y) | ((unsigned long long)pk2(y.z, y.w) << 32); } } while (0)
    volatile LAS unsigned* slot = (volatile LAS unsigned*)(lds_base + MISC_OFF) + 44;
    if (I.tid == 0) { const unsigned c0 = __hip_atomic_fetch_add(work, 1u, __ATOMIC_RELAXED, __HIP_MEMORY_SCOPE_AGENT); N2_CLAIM_WAIT(c0); slot[0] = c0; }
    __syncthreads();
    int blk = (int)slot[0], par = 0;
    while (blk < nblk) {
        unsigned nclaim = 0u;
        if (I.tid == 0) nclaim = __hip_atomic_fetch_add(work, 1u, __ATOMIC_RELAXED, __HIP_MEMORY_SCOPE_AGENT);
        {
            const int mend = blk * 64 + 64; int m = blk * 64 + I.wave;
            f32x4 nxa[4], nxb[4];
            N2_LOAD(nxa, m); N2_LOAD(nxb, m + 8);
            for (; m < mend; m += 16) { N2_ROW(nxa, m, mend); N2_ROW(nxb, m + 8, mend); }
        }
        if (I.tid == 0) { N2_CLAIM_WAIT(nclaim); slot[par ^ 1] = nclaim; }
        __syncthreads();
        par ^= 1; blk = (int)slot[par];
    }
    if (I.tid < 64) {
        const int np = nrows / 256; unsigned sp = 0;
        for (;;) { bool ok = true; for (int p = I.lane; p < np; p += 64) ok = ok && __hip_atomic_load(cp_ + 64 * p, __ATOMIC_RELAXED, __HIP_MEMORY_SCOPE_AGENT) >= 32u;
            if (__builtin_amdgcn_ballot_w64(!ok) == 0ull) break;
            __builtin_amdgcn_s_sleep(127);
            if ((++sp & 15u) == 0u) { if (__hip_atomic_load(tmo, __ATOMIC_RELAXED, __HIP_MEMORY_SCOPE_AGENT) != 0u) break; if (sp > (1u << 14)) { if (I.tid == 0) __hip_atomic_fetch_add(tmo, 1u, __ATOMIC_RELAXED, __HIP_MEMORY_SCOPE_AGENT); break; } } }
    }
    __syncthreads();
#undef N2_ROW
#undef N2_LOAD
#undef N2_CLAIM_WAIT
}

__device__ const unsigned short CONV_PERM[544] = { 0, 1, 2, 3, 4, 5, 6, 73, 74, 75, 76, 77, 78, 137, 138, 139, 140, 141, 142, 209, 210, 211, 212, 213, 214, 273, 274, 275, 276, 277, 278, 345, 346, 347, 348, 349, 350, 409, 410, 411, 412, 413, 414, 481, 482, 483, 484, 485, 486, 7, 8, 9, 10, 11, 12, 13, 14, 15, 16, 17, 18, 19, 20, 21, 22, 79, 80, 81, 82, 83, 84, 85, 86, 87, 88, 89, 90, 91, 92, 93, 94, 143, 144, 145, 146, 147, 148, 149, 150, 151, 152, 153, 154, 155, 156, 157, 158, 215, 216, 217, 218, 219, 220, 221, 222, 223, 224, 225, 226, 227, 228, 229, 230, 279, 280, 281, 282, 283, 284, 285, 286, 287, 288, 289, 290, 291, 292, 293, 294, 351, 352, 353, 354, 355, 356, 357, 358, 359, 360, 361, 362, 363, 364, 365, 366, 415, 416, 417, 418, 419, 420, 421, 422, 423, 424, 425, 426, 427, 428, 429, 430, 487, 488, 489, 490, 491, 492, 493, 494, 495, 496, 497, 498, 499, 500, 501, 502, 23, 24, 25, 26, 27, 28, 29, 30, 31, 32, 33, 34, 35, 36, 37, 38, 95, 96, 97, 98, 99, 100, 101, 102, 103, 104, 105, 106, 107, 108, 109, 110, 159, 160, 161, 162, 163, 164, 165, 166, 167, 168, 169, 170, 171, 172, 173, 174, 231, 232, 233, 234, 235, 236, 237, 238, 239, 240, 241, 242, 243, 244, 245, 246, 295, 296, 297, 298, 299, 300, 301, 302, 303, 304, 305, 306, 307, 308, 309, 310, 367, 368, 369, 370, 371, 372, 373, 374, 375, 376, 377, 378, 379, 380, 381, 382, 431, 432, 433, 434, 435, 436, 437, 438, 439, 440, 441, 442, 443, 444, 445, 446, 503, 504, 505, 506, 507, 508, 509, 510, 511, 512, 513, 514, 515, 516, 517, 518, 39, 40, 41, 42, 43, 44, 45, 46, 47, 48, 49, 50, 51, 52, 53, 54, 111, 112, 113, 114, 115, 116, 117, 118, 119, 120, 121, 122, 123, 124, 125, 126, 175, 176, 177, 178, 179, 180, 181, 182, 183, 184, 185, 186, 187, 188, 189, 190, 247, 248, 249, 250, 251, 252, 253, 254, 255, 256, 257, 258, 259, 260, 261, 262, 311, 312, 313, 314, 315, 316, 317, 318, 319, 320, 321, 322, 323, 324, 325, 326, 383, 384, 385, 386, 387, 388, 389, 390, 391, 392, 393, 394, 395, 396, 397, 398, 447, 448, 449, 450, 451, 452, 453, 454, 455, 456, 457, 458, 459, 460, 461, 462, 519, 520, 521, 522, 523, 524, 525, 526, 527, 528, 529, 530, 531, 532, 533, 534, 55, 56, 57, 58, 59, 60, 61, 62, 63, 64, 65, 66, 67, 68, 69, 70, 71, 72, 127, 128, 129, 130, 131, 132, 133, 134, 135, 136, 191, 192, 193, 194, 195, 196, 197, 198, 199, 200, 201, 202, 203, 204, 205, 206, 207, 208, 263, 264, 265, 266, 267, 268, 269, 270, 271, 272, 327, 328, 329, 330, 331, 332, 333, 334, 335, 336, 337, 338, 339, 340, 341, 342, 343, 344, 399, 400, 401, 402, 403, 404, 405, 406, 407, 408, 463, 464, 465, 466, 467, 468, 469, 470, 471, 472, 473, 474, 475, 476, 477, 478, 479, 480, 535, 536, 537, 538, 539, 540, 541, 542, 543 };
__device__ __forceinline__ void phase_conv(const Ids I_, LAS unsigned char* lds_base, int l) {
    const Ids I = fresh(I_);
    const KA ka = ka_fresh(); unsigned char* ws = KWS(ka);
    bf16* XBC = (bf16*)(ws + WS_XBC); const bf16* HALO = (const bf16*)(ws + WS_Y);
    const int c0 = I.tid * 8;
    pg8::pg8_gu32* work = (pg8::pg8_gu32*)(ws + WS_CTL) + CW_WORK + 64 * (5 + l); const pg8::pg8_gu32* cb_ = cnt_arr(ws, l, 3); pg8::pg8_gu32* tmo = (pg8::pg8_gu32*)(ws + WS_CTL) + CW_BAR + XB_TMO;
#define CV_CLAIM_WAIT(claim_, out_) do { unsigned id_ = 0xffffu; \
        if ((claim_) < 544u) { id_ = CONV_PERM[claim_]; const int rb_ = 32 * (int)id_; const int p0_ = (rb_ - 2 < 0 ? 0 : rb_ - 2) >> 8, p1_ = (rb_ + 33 >= MTOT ? MTOT - 1 : rb_ + 33) >> 8; unsigned sp_ = 0; \
            for (;;) { bool ok_ = __hip_atomic_load(cb_ + 64 * p0_, __ATOMIC_RELAXED, __HIP_MEMORY_SCOPE_AGENT) >= 136u; if (ok_ && p1_ != p0_) ok_ = __hip_atomic_load(cb_ + 64 * p1_, __ATOMIC_RELAXED, __HIP_MEMORY_SCOPE_AGENT) >= 136u; \
                if (ok_) break; __builtin_amdgcn_s_sleep(2); \
                if ((++sp_ & 255u) == 0u) { if (__hip_atomic_load(tmo, __ATOMIC_RELAXED, __HIP_MEMORY_SCOPE_AGENT) != 0u) break; if (sp_ > (1u << 20)) { __hip_atomic_fetch_add(tmo, 1u, __ATOMIC_RELAXED, __HIP_MEMORY_SCOPE_AGENT); break; } } } \
            __builtin_amdgcn_fence(__ATOMIC_ACQUIRE, "agent"); asm volatile("s_waitcnt vmcnt(0)" ::: "memory"); } \
        out_ = id_; } while (0)
    volatile LAS unsigned* slot = (volatile LAS unsigned*)(lds_base + MISC_OFF) + 50;
    if (I.tid == 0) { const unsigned c0_ = __hip_atomic_fetch_add(work, 1u, __ATOMIC_RELAXED, __HIP_MEMORY_SCOPE_AGENT); unsigned id0; CV_CLAIM_WAIT(c0_, id0); slot[0] = id0; }
    __syncthreads();
    unsigned uid = slot[0]; int par = 0;
    const float* cw = KIN(ka, 8) + (size_t)l * 5 * XBCW + c0; const float* cb = KIN(ka, 9) + (size_t)l * XBCW + c0;
    float w[5][8], bias[8];
#pragma unroll
    for (int i = 0; i < 5; ++i) { const f32x4 a = *(const f32x4*)(cw + i * XBCW), b = *(const f32x4*)(cw + i * XBCW + 4); w[i][0] = a.x; w[i][1] = a.y; w[i][2] = a.z; w[i][3] = a.w; w[i][4] = b.x; w[i][5] = b.y; w[i][6] = b.z; w[i][7] = b.w; }
    { const f32x4 a = *(const f32x4*)cb, b = *(const f32x4*)(cb + 4); bias[0] = a.x; bias[1] = a.y; bias[2] = a.z; bias[3] = a.w; bias[4] = b.x; bias[5] = b.y; bias[6] = b.z; bias[7] = b.w; }
    const v4u zero4 = {0u, 0u, 0u, 0u};
    while (uid != 0xffffu) {
    unsigned nclaim = 0u;
    if (I.tid == 0) nclaim = __hip_atomic_fetch_add(work, 1u, __ATOMIC_RELAXED, __HIP_MEMORY_SCOPE_AGENT);
    const int u0 = (int)uid, rbase = 32 * u0;
#define LDROW(q_) ([&](int q) -> v4u { if (q < 0 || q >= MTOT) return zero4; \
        const bf16* p = q < rbase ? HALO + (size_t)((u0 - 1) * 4 + 2 + (q - (rbase - 2))) * XBCW : (q >= rbase + 32 ? HALO + (size_t)((u0 + 1) * 4 + (q - rbase - 32)) * XBCW : XBC + (size_t)q * XBCW); \
        return *(const v4u*)(p + c0); })(q_)
#define UNPK(dst, v_) do { dst[0] = bf_lo(v_.x); dst[1] = bf_hi(v_.x); dst[2] = bf_lo(v_.y); dst[3] = bf_hi(v_.y); dst[4] = bf_lo(v_.z); dst[5] = bf_hi(v_.z); dst[6] = bf_lo(v_.w); dst[7] = bf_hi(v_.w); } while (0)
    float f0[8], f1[8], f2[8], f3[8];
    { const v4u a0 = LDROW(rbase - 2), a1 = LDROW(rbase - 1), a2 = LDROW(rbase), a3 = LDROW(rbase + 1); UNPK(f0, a0); UNPK(f1, a1); UNPK(f2, a2); UNPK(f3, a3); }
    v4u q0 = LDROW(rbase + 2), q1 = LDROW(rbase + 3), q2 = LDROW(rbase + 4), q3 = LDROW(rbase + 5);
    for (int it = 0; it < 8; ++it) {
        const v4u c0v = q0, c1v = q1, c2v = q2, c3v = q3;
        const int nb = rbase + 2 + 4 * (it + 1);
        if (it + 1 < 8) { q0 = LDROW(nb); q1 = LDROW(nb + 1); q2 = LDROW(nb + 2); q3 = LDROW(nb + 3); }
#pragma unroll
        for (int k = 0; k < 4; ++k) {
            const v4u w4 = k == 0 ? c0v : (k == 1 ? c1v : (k == 2 ? c2v : c3v));
            float f4[8]; UNPK(f4, w4);
            const int r = rbase + 4 * it + k;
            const int s0 = r < MLAT ? (r & ~(SEQ - 1)) : (MLAT + ((r - MLAT) & ~(CTXL - 1))), e0 = s0 + (r < MLAT ? SEQ : CTXL);
            float o[8];
            if (r - 2 >= s0 && r + 2 < e0) {
#pragma unroll
                for (int j = 0; j < 8; ++j) o[j] = bias[j] + w[0][j] * f0[j] + w[1][j] * f1[j] + w[2][j] * f2[j] + w[3][j] * f3[j] + w[4][j] * f4[j];
            } else {
                const float m0 = (r - 2 >= s0) ? 1.f : 0.f, m1 = (r - 1 >= s0) ? 1.f : 0.f, m3 = (r + 1 < e0) ? 1.f : 0.f, m4 = (r + 2 < e0) ? 1.f : 0.f;
#pragma unroll
                for (int j = 0; j < 8; ++j) o[j] = bias[j] + m0 * w[0][j] * f0[j] + m1 * w[1][j] * f1[j] + w[2][j] * f2[j] + m3 * w[3][j] * f3[j] + m4 * w[4][j] * f4[j];
            }
#pragma unroll
            for (int j = 0; j < 8; ++j) o[j] = o[j] * __builtin_amdgcn_rcpf(1.f + __expf(-o[j]));
            v4u ov; ov.x = pk2(o[0], o[1]); ov.y = pk2(o[2], o[3]); ov.z = pk2(o[4], o[5]); ov.w = pk2(o[6], o[7]);
            *(v4u*)(XBC + (size_t)r * XBCW + c0) = ov;
#pragma unroll
            for (int j = 0; j < 8; ++j) { f0[j] = f1[j]; f1[j] = f2[j]; f2[j] = f3[j]; f3[j] = f4[j]; }
        }
    }
    if (I.tid == 0) { unsigned idn; CV_CLAIM_WAIT(nclaim, idn); slot[par ^ 1] = idn; }
    __syncthreads();
    par ^= 1; uid = slot[par];
    }
#undef UNPK
#undef LDROW
#undef CV_CLAIM_WAIT
}

__device__ __forceinline__ void phase_ssd(const Ids I_, LAS unsigned char* lds, int l) {
    const Ids I = fresh(I_);
    const KA ka = ka_fresh(); unsigned char* ws = KWS(ka);
    const bf16* XBC = (const bf16*)(ws + WS_XBC); const float* DT = (const float*)(ws + WS_DT); bf16* Y = (bf16*)(ws + WS_Y);
    const int tid = I.tid, id = I.vcu, b = id >> 6, h = (id >> 1) & 31, ph = id & 1, grp = h >> 2;
    const int pl = tid >> 4, nq = tid & 15;
    LAS float* XS = (LAS float*)lds;
    LAS unsigned char* BT = lds + 8192;
    LAS unsigned char* CT = lds + 24576;
    LAS float* DTT = (LAS float*)(lds + 40960);
    LAS float* YB = (LAS float*)(lds + 41216);
    const float Dsum = KIN(ka, 12)[l * 64 + h] + KIN(ka, 12)[l * 64 + 32 + h];
    for (int dir = 0; dir < 2; ++dir) {
        const float A = -__expf(KIN(ka, 11)[l * 64 + dir * 32 + h]);
        float S[8];
#pragma unroll
        for (int i = 0; i < 8; ++i) S[i] = 0.f;
        for (int part = 0; part < 2; ++part) {
            const int rows0 = part == 0 ? MLAT + b * CTXL : b * SEQ, ntile = (part == 0 ? CTXL : SEQ) / 64;
            for (int ti = 0; ti < ntile; ++ti) {
                const int tile = dir ? ntile - 1 - ti : ti, r0 = rows0 + tile * 64;
                __syncthreads();
#pragma unroll
                for (int q = 0; q < 2; ++q) { const int ch = tid + q * 512, row = ch >> 4, c16 = ch & 15;
                    *(LAS v4u*)(BT + ch * 16) = *(const v4u*)(XBC + (size_t)(r0 + row) * XBCW + 2048 + grp * 128 + c16 * 8);
                    *(LAS v4u*)(CT + ch * 16) = *(const v4u*)(XBC + (size_t)(r0 + row) * XBCW + 3072 + grp * 128 + c16 * 8); }
                if (tid < 256) { const int row = tid >> 2, c = tid & 3; const v4u xv = *(const v4u*)(XBC + (size_t)(r0 + row) * XBCW + h * 64 + ph * 32 + c * 8);
                    LAS float* d = XS + row * 32 + c * 8; d[0] = bf_lo(xv.x); d[1] = bf_hi(xv.x); d[2] = bf_lo(xv.y); d[3] = bf_hi(xv.y); d[4] = bf_lo(xv.z); d[5] = bf_hi(xv.z); d[6] = bf_lo(xv.w); d[7] = bf_hi(xv.w);
                    if (dir == 1) { const v4u yv = *(const v4u*)(Y + (size_t)(r0 + row) * DI + h * 64 + ph * 32 + c * 8);
                        LAS float* e = YB + row * 32 + c * 8; e[0] = bf_lo(yv.x); e[1] = bf_hi(yv.x); e[2] = bf_lo(yv.y); e[3] = bf_hi(yv.y); e[4] = bf_lo(yv.z); e[5] = bf_hi(yv.z); e[6] = bf_lo(yv.w); e[7] = bf_hi(yv.w); } }
                else if (tid < 320) DTT[tid - 256] = DT[(size_t)(dir * 32 + h) * MTOT + r0 + tid - 256];
                __syncthreads();
                for (int s = 0; s < 64; ++s) {
                    const int tt = dir ? 63 - s : s;
                    const float dtv = DTT[tt], a = __expf(dtv * A), xv = XS[tt * 32 + pl], xdt = xv * dtv;
                    const v4u bv = *(const LAS v4u*)(BT + tt * 256 + nq * 16), cv = *(const LAS v4u*)(CT + tt * 256 + nq * 16);
                    float yp;
                    S[0] = S[0] * a + xdt * bf_lo(bv.x); yp = bf_lo(cv.x) * S[0];
                    S[1] = S[1] * a + xdt * bf_hi(bv.x); yp += bf_hi(cv.x) * S[1];
                    S[2] = S[2] * a + xdt * bf_lo(bv.y); yp += bf_lo(cv.y) * S[2];
                    S[3] = S[3] * a + xdt * bf_hi(bv.y); yp += bf_hi(cv.y) * S[3];
                    S[4] = S[4] * a + xdt * bf_lo(bv.z); yp += bf_lo(cv.z) * S[4];
                    S[5] = S[5] * a + xdt * bf_hi(bv.z); yp += bf_hi(cv.z) * S[5];
                    S[6] = S[6] * a + xdt * bf_lo(bv.w); yp += bf_lo(cv.w) * S[6];
                    S[7] = S[7] * a + xdt * bf_hi(bv.w); yp += bf_hi(cv.w) * S[7];
                    yp += pg8::lane_xor<1>(yp); yp += pg8::lane_xor<2>(yp); yp += pg8::lane_xor<4>(yp); yp += pg8::lane_xor<8>(yp);
                    if (nq == 0) { if (dir == 0) YB[tt * 32 + pl] = yp + Dsum * xv; else YB[tt * 32 + pl] += yp; }
                }
                __syncthreads();
                if (tid < 256) { const int row = tid >> 2, c = tid & 3; const LAS float* e = YB + row * 32 + c * 8;
                    v4u o; o.x = pk2(e[0], e[1]); o.y = pk2(e[2], e[3]); o.z = pk2(e[4], e[5]); o.w = pk2(e[6], e[7]);
                    *(v4u*)(Y + (size_t)(r0 + row) * DI + h * 64 + ph * 32 + c * 8) = o; }
            }
        }
        VM_WAIT(); __syncthreads();
    }
}

namespace ssd {
typedef short bf16x8 __attribute__((ext_vector_type(8)));
typedef short s16x4 __attribute__((ext_vector_type(4)));
constexpr int ROW = 272;
constexpr int L_CS = 0, L_BS = 34816, L_XN = 69632  , L_XF = 79872, L_XB = 88576, L_XD = 97280, L_SS0 = 105984, L_SS1 = 114688;
constexpr int L_TAB = 123392;
constexpr int L_DT = L_TAB + 4096;
#define SSD_MFMA(a, b, c) __builtin_amdgcn_mfma_f32_16x16x32_bf16((a), (b), (c), 0, 0, 0)
template <int N> __device__ __forceinline__ float row_shr(float v) { return __int_as_float(__builtin_amdgcn_update_dpp(0, __float_as_int(v), 0x110 + N, 0xf, 0xf, false)); }
__device__ __forceinline__ void scan128(LAS float* dst, LAS float* ej, const LAS float* dt, float A, bool reverse, int lane) {
    const int e0 = reverse ? 127 - 2 * lane : 2 * lane, e1 = reverse ? 126 - 2 * lane : 2 * lane + 1;
    const float v0 = dt[e0] * A, v1 = dt[e1] * A; float sc = v0 + v1;
    sc += row_shr<1>(sc); sc += row_shr<2>(sc); sc += row_shr<4>(sc); sc += row_shr<8>(sc);
    const float t0 = __int_as_float(__builtin_amdgcn_readlane(__float_as_int(sc), 15)), t1 = __int_as_float(__builtin_amdgcn_readlane(__float_as_int(sc), 31)), t2 = __int_as_float(__builtin_amdgcn_readlane(__float_as_int(sc), 47));
    const int row = lane >> 4; sc += (row >= 1 ? t0 : 0.f) + (row >= 2 ? t1 : 0.f) + (row >= 3 ? t2 : 0.f);
    const float ex = sc - (v0 + v1), c0 = ex + v0, c1 = ex + v0 + v1; dst[e0] = c0; dst[e1] = c1;
    LDS_WAIT(); asm volatile("" ::: "memory");
    const float ref = dst[reverse ? (e0 & ~15) : (e0 | 15)];
    ej[e0] = __expf(ref - c0) * dt[e0]; ej[e1] = __expf(ref - c1) * dt[e1];
}
__device__ __forceinline__ bf16x8 pack8f(const float (&m)[8]) { v4u t; t.x = pk2(m[0], m[1]); t.y = pk2(m[2], m[3]); t.z = pk2(m[4], m[5]); t.w = pk2(m[6], m[7]); return __builtin_bit_cast(bf16x8, t); }
__device__ __forceinline__ bf16x8 ld2x8(const LAS unsigned char* p0, const LAS unsigned char* p1) { const v2u a = *(const LAS v2u*)p0, b = *(const LAS v2u*)p1; v4u t; t.x = a.x; t.y = a.y; t.z = b.x; t.w = b.y; return __builtin_bit_cast(bf16x8, t); }
__device__ __forceinline__ unsigned short bf1(float v) { return (unsigned short)(pk2(v, 0.f) & 0xffffu); }
}

template <int SWEEP> __device__ __forceinline__ void ssd_sweep(const Ids I_, LAS unsigned char* lds, int l) {
    constexpr int sweep = SWEEP, NSET = SWEEP ? 2 : 1;
    using namespace ssd;
    const Ids I = fresh(I_);
    const KA ka = ka_fresh(); unsigned char* ws = KWS(ka);
    const bf16* XBC = (const bf16*)(ws + WS_XBC); const float* DT = (const float*)(ws + WS_DT); bf16* Y = (bf16*)(ws + WS_Y);
    const int tid = I.tid, lane = I.lane, w = I.wave, li = lane & 15, lg = lane >> 4;
    const int id = I.vcu, b = id >> 6, h = (id >> 1) & 31, ph = id & 1, grp = h >> 2;
    const float Dsum = KIN(ka, 12)[l * 64 + h] + KIN(ka, 12)[l * 64 + 32 + h];
    const float A_f = -__expf(KIN(ka, 11)[l * 64 + h]), A_b = -__expf(KIN(ka, 11)[l * 64 + 32 + h]);
    const size_t xcol = (size_t)h * 64 + ph * 32;
    const int srow = tid >> 2, sc4 = tid & 3;

    {
        auto row_of = [&](int idx) -> int { const int c = idx < 2 ? (sweep ? 1 - idx : idx) : (sweep ? 31 - (idx - 2) : idx - 2); return idx < 2 ? MLAT + b * CTXL + 128 * c : b * SEQ + 128 * c; };
#define SSD_TAB(par) ((LAS float*)(lds + L_TAB + (par) * 2048))
#define SSD_DTP(par) ((LAS float*)(lds + L_DT + (par) * 1024))
#define SSD_LDDT(idx_) (DT[(size_t)((tid >> 7) * 32 + h) * MTOT + row_of(idx_) + (tid & 127)])
#define SSD_SCAN(par) do { if (sweep == 0) { if (w == 0) scan128(SSD_TAB(par), SSD_TAB(par) + 256, SSD_DTP(par), A_f, false, lane); else if (w == 1) scan128(SSD_TAB(par) + 128, SSD_TAB(par) + 384, SSD_DTP(par) + 128, A_b, true, lane); } \
        else { if (w == 0) scan128(SSD_TAB(par) + 128, SSD_TAB(par) + 384, SSD_DTP(par) + 128, A_b, true, lane); } } while (0)
        v4u pc[NSET][4], pb[NSET][4], px[NSET]; float pdt = 0.f;
#define SSD_ISSUE(idx_, u_) do { const int r0_ = row_of(idx_); \
        _Pragma("unroll") for (int q = 0; q < 4; ++q) { const int ch = tid + 512 * q, row = ch >> 4, c16 = ch & 15; \
            pc[u_][q] = *(const v4u*)(XBC + (size_t)(r0_ + row) * XBCW + 3072 + grp * 128 + c16 * 8); pb[u_][q] = *(const v4u*)(XBC + (size_t)(r0_ + row) * XBCW + 2048 + grp * 128 + c16 * 8); } \
        px[u_] = *(const v4u*)(XBC + (size_t)(r0_ + srow) * XBCW + xcol + sc4 * 8); } while (0)
        __syncthreads();
        for (int i = tid; i < (2 * 8704) / 4; i += NWAVES * 64) ((LAS unsigned*)(lds + L_SS0))[i] = 0u;
        f32x4 sacc[2] = {{0.f, 0.f, 0.f, 0.f}, {0.f, 0.f, 0.f, 0.f}};
        _Pragma("unroll") for (int u = 0; u < NSET; ++u) SSD_ISSUE(u, u);
        if (tid < 256) SSD_DTP(0)[tid] = SSD_LDDT(0);
        __syncthreads();
        SSD_SCAN(0);
        if (tid < 256) pdt = SSD_LDDT(1);
        for (int idx0 = 0; idx0 < 34; idx0 += NSET)
#pragma unroll
        for (int u = 0; u < NSET; ++u) {
            const int idx = idx0 + u;
            const int r0 = row_of(idx), par = idx & 1;
            const bool need_y = !(l == 1 && idx < 2);
            LAS unsigned char* SScur = lds + (par ? L_SS1 : L_SS0); LAS unsigned char* SSnxt = lds + (par ? L_SS0 : L_SS1);
            LAS float* AF = SSD_TAB(par); LAS float* RB = AF + 128; LAS float* EJF = AF + 256; LAS float* EJB = AF + 384; LAS float* DTF = SSD_DTP(par); LAS float* DTB = DTF + 128;
            __syncthreads();
#pragma unroll
            for (int q = 0; q < 4; ++q) { const int ch = tid + 512 * q, row = ch >> 4, c16 = ch & 15; *(LAS v4u*)(lds + L_CS + row * ROW + c16 * 16) = pc[u][q]; *(LAS v4u*)(lds + L_BS + row * ROW + c16 * 16) = pb[u][q]; }
            *(LAS v4u*)(lds + L_XN + srow * 80 + sc4 * 16) = px[u];
            {
                const v4u pxu = px[u]; const float xv[8] = {bf_lo(pxu.x), bf_hi(pxu.x), bf_lo(pxu.y), bf_hi(pxu.y), bf_lo(pxu.z), bf_hi(pxu.z), bf_lo(pxu.w), bf_hi(pxu.w)};
                LAS unsigned short* xf = (LAS unsigned short*)(lds + L_XF + (4 * sc4) * ROW) + srow; LAS unsigned short* xb = (LAS unsigned short*)(lds + L_XB + (4 * sc4) * ROW) + srow; LAS unsigned short* xd = (LAS unsigned short*)(lds + L_XD + (4 * sc4) * ROW) + srow;
                if (sweep == 0) { const float f = DTF[srow], gg = DTB[srow], e = f * __expf(AF[127] - AF[srow]);
#pragma unroll
                    for (int q = 0; q < 8; ++q) { const int ro = (16 * (q >> 2) + (q & 3)) * (ROW / 2); xf[ro] = bf1(xv[q]); xd[ro] = bf1(xv[q] * e); } (void)gg; (void)xb; }
                else { const float e = DTB[srow] * __expf(RB[0] - RB[srow]);
#pragma unroll
                    for (int q = 0; q < 8; ++q) xd[(16 * (q >> 2) + (q & 3)) * (ROW / 2)] = bf1(xv[q] * e); }
            }
            if (tid < 256 && idx + 1 < 34) SSD_DTP(par ^ 1)[tid] = pdt;
            __syncthreads();
            if (idx + NSET < 34) SSD_ISSUE(idx + NSET, u);
            if (idx + 1 < 34) SSD_SCAN(par ^ 1);
            if (tid < 256 && idx + 2 < 34) pdt = SSD_LDDT(idx + 2);
            v4u yold = {0u, 0u, 0u, 0u};
            if (sweep == 1 && need_y) yold = *(const v4u*)(Y + (size_t)(r0 + 16 * w + li) * DI + xcol + 8 * lg);
            bf16x8 cf[4];
#pragma unroll
            for (int ks = 0; ks < 4; ++ks) cf[ks] = *(const LAS bf16x8*)(lds + L_CS + (16 * w + li) * ROW + (32 * ks + 8 * lg) * 2);
            f32x4 yacc[2] = {{0.f, 0.f, 0.f, 0.f}, {0.f, 0.f, 0.f, 0.f}}, yi[2] = {{0.f, 0.f, 0.f, 0.f}, {0.f, 0.f, 0.f, 0.f}};
            if (need_y) {
            {
                bf16x8 sf[8];
#pragma unroll
                for (int ks = 0; ks < 4; ++ks)
#pragma unroll
                    for (int pt = 0; pt < 2; ++pt) sf[2 * ks + pt] = *(const LAS bf16x8*)(SScur + (16 * pt + li) * ROW + (32 * ks + 8 * lg) * 2);
                __builtin_amdgcn_sched_barrier(0);
#pragma unroll
                for (int ks = 0; ks < 4; ++ks)
#pragma unroll
                    for (int pt = 0; pt < 2; ++pt) yi[pt] = SSD_MFMA(sf[2 * ks + pt], cf[ks], yi[pt]);
            }
            float escale;
            if (sweep == 0) {
                const float af_i = AF[16 * w + li], rb_i = RB[16 * w + li];
                escale = __expf(af_i);
                f32x4 g[8];
                {
                    bf16x8 fa[8], fb[8];
#define SSD_GLOAD(dst, jp) do { _Pragma("unroll") for (int q_ = 0; q_ < 8; ++q_) dst[q_] = *(const LAS bf16x8*)(lds + L_BS + (16 * (2 * (jp) + (q_ >> 2)) + li) * ROW + (32 * (q_ & 3) + 8 * lg) * 2); } while (0)
#define SSD_GMMA(src, jp) do { g[2 * (jp)] = (f32x4){0.f, 0.f, 0.f, 0.f}; g[2 * (jp) + 1] = (f32x4){0.f, 0.f, 0.f, 0.f}; \
                        _Pragma("unroll") for (int q_ = 0; q_ < 8; ++q_) g[2 * (jp) + (q_ >> 2)] = SSD_MFMA(src[q_], cf[q_ & 3], g[2 * (jp) + (q_ >> 2)]); } while (0)
                    SSD_GLOAD(fa, 0); __builtin_amdgcn_sched_barrier(0);
                    SSD_GLOAD(fb, 1); __builtin_amdgcn_sched_barrier(0); SSD_GMMA(fa, 0); __builtin_amdgcn_sched_barrier(0);
                    SSD_GLOAD(fa, 2); __builtin_amdgcn_sched_barrier(0); SSD_GMMA(fb, 1); __builtin_amdgcn_sched_barrier(0);
                    SSD_GLOAD(fb, 3); __builtin_amdgcn_sched_barrier(0); SSD_GMMA(fa, 2); __builtin_amdgcn_sched_barrier(0);
                    SSD_GMMA(fb, 3); __builtin_amdgcn_sched_barrier(0);
#undef SSD_GLOAD
#undef SSD_GMMA
                }
#define SSD_TILE_F(t, mo) do { if ((t) < w) { const float ei = __expf(af_i - AF[16 * (t) + 15]); const f32x4 ejv = *(const LAS f32x4*)(EJF + 16 * (t) + 4 * lg); \
                        _Pragma("unroll") for (int r = 0; r < 4; ++r) m[(mo) + r] = g[t][r] * (ei * ejv[r]); } \
                    else if ((t) == w) { const f32x4 av = *(const LAS f32x4*)(AF + 16 * (t) + 4 * lg), dv = *(const LAS f32x4*)(DTF + 16 * (t) + 4 * lg); \
                        _Pragma("unroll") for (int r = 0; r < 4; ++r) m[(mo) + r] = (4 * lg + r <= li) ? g[t][r] * (dv[r] * __expf(fminf(af_i - av[r], 0.f))) : 0.f; } \
                    else { _Pragma("unroll") for (int r = 0; r < 4; ++r) m[(mo) + r] = 0.f; } } while (0)
#define SSD_TILE_B(t, mo) do { if ((t) > w) { const float ei = __expf(rb_i - RB[16 * (t)]); const f32x4 ejv = *(const LAS f32x4*)(EJB + 16 * (t) + 4 * lg); \
                        _Pragma("unroll") for (int r = 0; r < 4; ++r) m[(mo) + r] = g[t][r] * (ei * ejv[r]); } \
                    else if ((t) == w) { const f32x4 av = *(const LAS f32x4*)(RB + 16 * (t) + 4 * lg), dv = *(const LAS f32x4*)(DTB + 16 * (t) + 4 * lg); \
                        _Pragma("unroll") for (int r = 0; r < 4; ++r) m[(mo) + r] = (4 * lg + r >= li) ? g[t][r] * (dv[r] * __expf(fminf(rb_i - av[r], 0.f))) : 0.f; } \
                    else { _Pragma("unroll") for (int r = 0; r < 4; ++r) m[(mo) + r] = 0.f; } } while (0)
#pragma unroll
                for (int kk = 0; kk < 4; ++kk) {
                    const int t0 = 2 * kk, t1 = 2 * kk + 1;
                    if (t0 <= w) {
                        float m[8]; SSD_TILE_F(t0, 0); SSD_TILE_F(t1, 4);
                        const bf16x8 bfr = pack8f(m);
#pragma unroll
                        for (int pt = 0; pt < 2; ++pt) { const LAS unsigned char* rp = lds + L_XF + (16 * pt + li) * ROW; const bf16x8 a = ld2x8(rp + (32 * kk + 4 * lg) * 2, rp + (32 * kk + 16 + 4 * lg) * 2); yacc[pt] = SSD_MFMA(a, bfr, yacc[pt]); }
                    }
                    if (t1 >= w) {
                        float m[8]; SSD_TILE_B(t0, 0); SSD_TILE_B(t1, 4);
                        const bf16x8 bfr = pack8f(m);
#pragma unroll
                        for (int pt = 0; pt < 2; ++pt) { const LAS unsigned char* rp = lds + L_XF + (16 * pt + li) * ROW; const bf16x8 a = ld2x8(rp + (32 * kk + 4 * lg) * 2, rp + (32 * kk + 16 + 4 * lg) * 2); yacc[pt] = SSD_MFMA(a, bfr, yacc[pt]); }
                    }
                }
#undef SSD_TILE_F
#undef SSD_TILE_B
            } else escale = __expf(RB[16 * w + li]);
            {
                bf16* yp = Y + (size_t)(r0 + 16 * w + li) * DI + xcol + 8 * lg;
                float o[8];
                if (sweep == 0) { const v4u xv = *(const LAS v4u*)(lds + L_XN + (16 * w + li) * 80 + (8 * lg) * 2);
                    const float xs[8] = {bf_lo(xv.x), bf_hi(xv.x), bf_lo(xv.y), bf_hi(xv.y), bf_lo(xv.z), bf_hi(xv.z), bf_lo(xv.w), bf_hi(xv.w)};
#pragma unroll
                    for (int pt = 0; pt < 2; ++pt)
#pragma unroll
                        for (int r = 0; r < 4; ++r) o[4 * pt + r] = yacc[pt][r] + escale * yi[pt][r] + Dsum * xs[4 * pt + r]; }
                else { const float ys[8] = {bf_lo(yold.x), bf_hi(yold.x), bf_lo(yold.y), bf_hi(yold.y), bf_lo(yold.z), bf_hi(yold.z), bf_lo(yold.w), bf_hi(yold.w)};
#pragma unroll
                    for (int pt = 0; pt < 2; ++pt)
#pragma unroll
                        for (int r = 0; r < 4; ++r) o[4 * pt + r] = ys[4 * pt + r] + escale * yi[pt][r]; }
                v4u ov; ov.x = pk2(o[0], o[1]); ov.y = pk2(o[2], o[3]); ov.z = pk2(o[4], o[5]); ov.w = pk2(o[6], o[7]); *(v4u*)yp = ov;
            }
            }
            {
                const float atot = __expf(sweep == 0 ? AF[127] : RB[0]);
                sacc[0] = sacc[0] * atot; sacc[1] = sacc[1] * atot;
                const int q = li >> 2, pq = li & 3;
                bf16x8 ta[4], xd[8];
#pragma unroll
                for (int ks = 0; ks < 4; ++ks) {
                    const LAS unsigned char* tp = lds + L_BS + (32 * ks + 8 * lg + q) * ROW + (16 * w + 4 * pq) * 2;
                    const s16x4 lo = __builtin_amdgcn_ds_read_tr16_b64_v4i16((LAS s16x4*)tp), hi = __builtin_amdgcn_ds_read_tr16_b64_v4i16((LAS s16x4*)(tp + 4 * ROW));
                    ta[ks] = __builtin_shufflevector(lo, hi, 0, 1, 2, 3, 4, 5, 6, 7);
#pragma unroll
                    for (int pt = 0; pt < 2; ++pt) xd[2 * ks + pt] = *(const LAS bf16x8*)(lds + L_XD + (16 * pt + li) * ROW + (32 * ks + 8 * lg) * 2);
                }
                __builtin_amdgcn_sched_barrier(0);
#pragma unroll
                for (int ks = 0; ks < 4; ++ks)
#pragma unroll
                    for (int pt = 0; pt < 2; ++pt) sacc[pt] = SSD_MFMA(ta[ks], xd[2 * ks + pt], sacc[pt]);
#pragma unroll
                for (int pt = 0; pt < 2; ++pt) { v2u sv; sv.x = pk2(sacc[pt][0], sacc[pt][1]); sv.y = pk2(sacc[pt][2], sacc[pt][3]); *(LAS v2u*)(SSnxt + (16 * pt + li) * ROW + (16 * w + 4 * lg) * 2) = sv; }
            }
        }
#undef SSD_ISSUE
#undef SSD_SCAN
#undef SSD_LDDT
#undef SSD_TAB
#undef SSD_DTP
        VM_WAIT(); __syncthreads();
    }
}
__device__ __forceinline__ void phase_ssd_mfma(const Ids I, LAS unsigned char* lds, int l) { ssd_sweep<0>(I, lds, l); ssd_sweep<1>(I, lds, l); }

namespace ssd3 {
typedef short bf16x8 __attribute__((ext_vector_type(8)));
typedef short s16x4 __attribute__((ext_vector_type(4)));
constexpr int ROW = 272;
constexpr int L_BS = 0, L_XF = 69632, L_XB = L_XF + 17408, L_XD = L_XB + 17408, L_SS = L_XD + 17408, L_TAB = L_SS + 17408;
constexpr int T_AFL = 0, T_RBL = 128, T_EJF = 256, T_EJB = 384, T_TF = 512, T_TB = 520, T_FLOATS = 528;
#define SSD3_MFMA32(a, b, c) __builtin_amdgcn_mfma_f32_16x16x32_bf16((a), (b), (c), 0, 0, 0)
#define SSD3_MFMA16(a, b, c) __builtin_amdgcn_mfma_f32_16x16x16bf16_1k((a), (b), (c), 0, 0, 0)
template <int N> __device__ __forceinline__ float row_shr(float v) { return __int_as_float(__builtin_amdgcn_update_dpp(0, __float_as_int(v), 0x110 + N, 0xf, 0xf, false)); }
__device__ __forceinline__ float rdlane(float v, int l) { return __int_as_float(__builtin_amdgcn_readlane(__float_as_int(v), l)); }
__device__ __forceinline__ float scan16x4(float a, int lane, float& tot) {
    float s = a; s += row_shr<4>(s); s += row_shr<8>(s);
    const float t0 = rdlane(s, 15), t1 = rdlane(s, 31), t2 = rdlane(s, 47), t3 = rdlane(s, 63); const int dr = lane >> 4;
    s += (dr >= 1 ? t0 : 0.f) + (dr >= 2 ? t1 : 0.f) + (dr >= 3 ? t2 : 0.f); tot = (t0 + t1) + (t2 + t3); return s;
}
__device__ __forceinline__ bf16x8 pack8f(const float (&m)[8]) { v4u t; t.x = pk2(m[0], m[1]); t.y = pk2(m[2], m[3]); t.z = pk2(m[4], m[5]); t.w = pk2(m[6], m[7]); return __builtin_bit_cast(bf16x8, t); }
__device__ __forceinline__ bf16x8 ld2x8(const LAS unsigned char* p0, const LAS unsigned char* p1) { const v2u a = *(const LAS v2u*)p0, b = *(const LAS v2u*)p1; v4u t; t.x = a.x; t.y = a.y; t.z = b.x; t.w = b.y; return __builtin_bit_cast(bf16x8, t); }
__device__ __forceinline__ unsigned short bf1(float v) { return (unsigned short)(pk2(v, 0.f) & 0xffffu); }
}

template <int SWEEP> __device__ __forceinline__ void ssd3_sweep(const Ids I_, LAS unsigned char* lds, int l) {
    using namespace ssd3;
    constexpr int sweep = SWEEP;
    const Ids I = fresh(I_);
    const KA ka = ka_fresh(); unsigned char* ws = KWS(ka);
    const bf16* XBC = (const bf16*)(ws + WS_XBC); const float* DT = (const float*)(ws + WS_DT); bf16* Y = (bf16*)(ws + WS_Y);
    const int tid = I.tid, lane = I.lane, w = I.wave, li = lane & 15, lg = lane >> 4;
    const int id = I.vcu, b = id >> 6, h = (id >> 1) & 31, ph = id & 1, grp = h >> 2;
    const float Dsum = KIN(ka, 12)[l * 64 + h] + KIN(ka, 12)[l * 64 + 32 + h];
    const float A_f = -__expf(KIN(ka, 11)[l * 64 + h]), A_b = -__expf(KIN(ka, 11)[l * 64 + 32 + h]);
    const size_t xcol = (size_t)h * 64 + ph * 32;
    const int srow = tid >> 2, sc4 = tid & 3;
    auto row_of = [&](int idx) -> int { const int c = idx < 2 ? (sweep ? 1 - idx : idx) : (sweep ? 31 - (idx - 2) : idx - 2); return idx < 2 ? MLAT + b * CTXL + 128 * c : b * SEQ + 128 * c; };

    v4u pb[4], px; float pdf = 0.f, pdb = 0.f; v4u pcn[4]; v2u pxo[2];
#define SSD3_LOAD_S(idx_) do { const int r0_ = row_of(idx_); \
        _Pragma("unroll") for (int q = 0; q < 4; ++q) { const int ch = tid + 512 * q; pb[q] = *(const v4u*)(XBC + (size_t)(r0_ + (ch >> 4)) * XBCW + 2048 + grp * 128 + (ch & 15) * 8); } \
        px = *(const v4u*)(XBC + (size_t)(r0_ + srow) * XBCW + xcol + sc4 * 8); pdf = DT[(size_t)h * MTOT + r0_ + srow]; pdb = DT[(size_t)(32 + h) * MTOT + r0_ + srow]; } while (0)
#define SSD3_LOAD_C(idx_) do { const int r0_ = row_of(idx_); \
        _Pragma("unroll") for (int q = 0; q < 4; ++q) pcn[q] = *(const v4u*)(XBC + (size_t)(r0_ + 16 * w + li) * XBCW + 3072 + grp * 128 + (4 * q + lg) * 8); \
        if (sweep == 0) { _Pragma("unroll") for (int pt = 0; pt < 2; ++pt) pxo[pt] = *(const v2u*)(XBC + (size_t)(r0_ + 16 * w + li) * XBCW + xcol + 16 * pt + 4 * lg); } } while (0)
#define SSD3_STAGE(gen) do { \
        LAS float* T_ = (LAS float*)(lds + L_TAB) + (gen) * T_FLOATS; \
        float tf_, tb_; const float af_ = scan16x4(pdf * A_f, lane, tf_); const float bv_ = pdb * A_b; const float sb_ = scan16x4(bv_, lane, tb_); \
        const float rb_ = tb_ - sb_ + bv_, ejf_ = __expf(tf_ - af_), ejb_ = __expf(tb_ - rb_); \
        if (sc4 == 0) { T_[T_AFL + srow] = af_; T_[T_RBL + srow] = rb_; T_[T_EJF + srow] = ejf_; T_[T_EJB + srow] = ejb_; } \
        if (lane == 0) { T_[T_TF + w] = tf_; T_[T_TB + w] = tb_; } \
        _Pragma("unroll") for (int q = 0; q < 4; ++q) { const int ch = tid + 512 * q; *(LAS v4u*)(lds + L_BS + (gen) * 34816 + (ch >> 4) * ROW + (ch & 15) * 16) = pb[q]; } \
        const float xv_[8] = {bf_lo(px.x), bf_hi(px.x), bf_lo(px.y), bf_hi(px.y), bf_lo(px.z), bf_hi(px.z), bf_lo(px.w), bf_hi(px.w)}; \
        LAS unsigned short* xd_ = (LAS unsigned short*)(lds + L_XD + (gen) * 8704 + (8 * sc4) * ROW) + srow; \
        if (sweep == 0) { LAS unsigned short* xf_ = (LAS unsigned short*)(lds + L_XF + (gen) * 8704 + (8 * sc4) * ROW) + srow; LAS unsigned short* xb_ = (LAS unsigned short*)(lds + L_XB + (gen) * 8704 + (8 * sc4) * ROW) + srow; \
            const float e_ = pdf * ejf_; \
            _Pragma("unroll") for (int q = 0; q < 8; ++q) { xf_[q * (ROW / 2)] = bf1(xv_[q] * pdf); xb_[q * (ROW / 2)] = bf1(xv_[q] * pdb); xd_[q * (ROW / 2)] = bf1(xv_[q] * e_); } } \
        else { const float e_ = pdb * ejb_; _Pragma("unroll") for (int q = 0; q < 8; ++q) xd_[q * (ROW / 2)] = bf1(xv_[q] * e_); } } while (0)

    __syncthreads();
    for (int i = tid; i < 17408 / 4; i += NWAVES * 64) ((LAS unsigned*)(lds + L_SS))[i] = 0u;
    f32x4 sacc[2] = {{0.f, 0.f, 0.f, 0.f}, {0.f, 0.f, 0.f, 0.f}};
    SSD3_LOAD_S(0); SSD3_STAGE(0);
    SSD3_LOAD_S(1); SSD3_LOAD_C(0);
    for (int idx = 0; idx < 34; ++idx) {
        const int r0 = row_of(idx), par = idx & 1;
        const bool need_y = !(l == 1 && idx < 2);
        __syncthreads();
        if (idx + 1 < 34) SSD3_STAGE(par ^ 1);
        bf16x8 cf[4]; v2u xo[2] = {{0u, 0u}, {0u, 0u}};
#pragma unroll
        for (int ks = 0; ks < 4; ++ks) cf[ks] = __builtin_bit_cast(bf16x8, pcn[ks]);
        if (sweep == 0) { xo[0] = pxo[0]; xo[1] = pxo[1]; }
        if (idx + 2 < 34) SSD3_LOAD_S(idx + 2);
        if (idx + 1 < 34) SSD3_LOAD_C(idx + 1);
        const LAS unsigned char* BSc = lds + L_BS + par * 34816; const LAS unsigned char* XFc = lds + L_XF + par * 8704; const LAS unsigned char* XBc = lds + L_XB + par * 8704; const LAS unsigned char* XDc = lds + L_XD + par * 8704;
        const LAS unsigned char* SScur = lds + L_SS + par * 8704; LAS unsigned char* SSnxt = lds + L_SS + (par ^ 1) * 8704;
        const LAS float* T = (const LAS float*)(lds + L_TAB) + par * T_FLOATS;
        v2u yold[2] = {{0u, 0u}, {0u, 0u}};
        if (sweep == 1 && need_y) { _Pragma("unroll") for (int pt = 0; pt < 2; ++pt) yold[pt] = *(const v2u*)(Y + (size_t)(r0 + 16 * w + li) * DI + xcol + 16 * pt + 4 * lg); }
        float PF[9], SB[9], TFv[8], TBv[8];
#pragma unroll
        for (int t = 0; t < 8; ++t) { TFv[t] = T[T_TF + t]; TBv[t] = T[T_TB + t]; }
        PF[0] = 0.f; SB[8] = 0.f;
#pragma unroll
        for (int t = 0; t < 8; ++t) { PF[t + 1] = PF[t] + TFv[t]; SB[7 - t] = SB[8 - t] + TBv[7 - t]; }
        float PFw = 0.f, SBw1 = 0.f;
#pragma unroll
        for (int t = 0; t < 8; ++t) { PFw = (t == w) ? PF[t] : PFw; SBw1 = (t == w) ? SB[t + 1] : SBw1; }
        const float afl_i = T[T_AFL + 16 * w + li], rbl_i = T[T_RBL + 16 * w + li];
        const float af_i = PFw + afl_i, rb_i = SBw1 + rbl_i;
        if (need_y) {
        f32x4 yacc[2] = {{0.f, 0.f, 0.f, 0.f}, {0.f, 0.f, 0.f, 0.f}}, yi[2] = {{0.f, 0.f, 0.f, 0.f}, {0.f, 0.f, 0.f, 0.f}};
        {
            bf16x8 sf[8];
#pragma unroll
            for (int ks = 0; ks < 4; ++ks)
#pragma unroll
                for (int pt = 0; pt < 2; ++pt) sf[2 * ks + pt] = *(const LAS bf16x8*)(SScur + (16 * pt + li) * ROW + (32 * ks + 8 * lg) * 2);
            __builtin_amdgcn_sched_barrier(0);
#pragma unroll
            for (int ks = 0; ks < 4; ++ks)
#pragma unroll
                for (int pt = 0; pt < 2; ++pt) yi[pt] = SSD3_MFMA32(sf[2 * ks + pt], cf[ks], yi[pt]);
        }
        const float escale = __expf(sweep == 0 ? af_i : rb_i);
        if (sweep == 0) {
            f32x4 g[8];
            {
                bf16x8 fa[8], fb[8];
#define SSD3_GLOAD(dst, jp) do { _Pragma("unroll") for (int q_ = 0; q_ < 8; ++q_) dst[q_] = *(const LAS bf16x8*)(BSc + (16 * (2 * (jp) + (q_ >> 2)) + li) * ROW + (32 * (q_ & 3) + 8 * lg) * 2); } while (0)
#define SSD3_GMMA(src, jp) do { g[2 * (jp)] = (f32x4){0.f, 0.f, 0.f, 0.f}; g[2 * (jp) + 1] = (f32x4){0.f, 0.f, 0.f, 0.f}; \
                    _Pragma("unroll") for (int q_ = 0; q_ < 8; ++q_) g[2 * (jp) + (q_ >> 2)] = SSD3_MFMA32(src[q_], cf[q_ & 3], g[2 * (jp) + (q_ >> 2)]); } while (0)
                SSD3_GLOAD(fa, 0); __builtin_amdgcn_sched_barrier(0);
                SSD3_GLOAD(fb, 1); __builtin_amdgcn_sched_barrier(0); SSD3_GMMA(fa, 0); __builtin_amdgcn_sched_barrier(0);
                SSD3_GLOAD(fa, 2); __builtin_amdgcn_sched_barrier(0); SSD3_GMMA(fb, 1); __builtin_amdgcn_sched_barrier(0);
                SSD3_GLOAD(fb, 3); __builtin_amdgcn_sched_barrier(0); SSD3_GMMA(fa, 2); __builtin_amdgcn_sched_barrier(0);
                SSD3_GMMA(fb, 3); __builtin_amdgcn_sched_barrier(0);
#undef SSD3_GLOAD
#undef SSD3_GMMA
            }
#define SSD3_TILE_F(t, mo) do { if ((t) < w) { const float ei = __expf(af_i - PF[(t) + 1]); const f32x4 ejv = *(const LAS f32x4*)(T + T_EJF + 16 * (t) + 4 * lg); \
                    _Pragma("unroll") for (int r = 0; r < 4; ++r) m[(mo) + r] = g[t][r] * (ei * ejv[r]); } \
                else if ((t) == w) { const f32x4 av = *(const LAS f32x4*)(T + T_AFL + 16 * (t) + 4 * lg); \
                    _Pragma("unroll") for (int r = 0; r < 4; ++r) m[(mo) + r] = (4 * lg + r <= li) ? g[t][r] * __expf(fminf(afl_i - av[r], 0.f)) : 0.f; } \
                else { _Pragma("unroll") for (int r = 0; r < 4; ++r) m[(mo) + r] = 0.f; } } while (0)
#define SSD3_TILE_B(t, mo) do { if ((t) > w) { const float ei = __expf(rb_i - SB[t]); const f32x4 ejv = *(const LAS f32x4*)(T + T_EJB + 16 * (t) + 4 * lg); \
                    _Pragma("unroll") for (int r = 0; r < 4; ++r) m[(mo) + r] = g[t][r] * (ei * ejv[r]); } \
                else if ((t) == w) { const f32x4 av = *(const LAS f32x4*)(T + T_RBL + 16 * (t) + 4 * lg); \
                    _Pragma("unroll") for (int r = 0; r < 4; ++r) m[(mo) + r] = (4 * lg + r >= li) ? g[t][r] * __expf(fminf(rbl_i - av[r], 0.f)) : 0.f; } \
                else { _Pragma("unroll") for (int r = 0; r < 4; ++r) m[(mo) + r] = 0.f; } } while (0)
#pragma unroll
            for (int kk = 0; kk < 4; ++kk) {
                const int t0 = 2 * kk, t1 = 2 * kk + 1;
                if (t0 <= w) {
                    float m[8]; SSD3_TILE_F(t0, 0); SSD3_TILE_F(t1, 4);
                    const bf16x8 bfr = pack8f(m);
#pragma unroll
                    for (int pt = 0; pt < 2; ++pt) { const LAS unsigned char* rp = XFc + (16 * pt + li) * ROW; const bf16x8 a = ld2x8(rp + (32 * kk + 4 * lg) * 2, rp + (32 * kk + 16 + 4 * lg) * 2); yacc[pt] = SSD3_MFMA32(a, bfr, yacc[pt]); }
                }
                if (t1 >= w) {
                    float m[8]; SSD3_TILE_B(t0, 0); SSD3_TILE_B(t1, 4);
                    const bf16x8 bfr = pack8f(m);
#pragma unroll
                    for (int pt = 0; pt < 2; ++pt) { const LAS unsigned char* rp = XBc + (16 * pt + li) * ROW; const bf16x8 a = ld2x8(rp + (32 * kk + 4 * lg) * 2, rp + (32 * kk + 16 + 4 * lg) * 2); yacc[pt] = SSD3_MFMA32(a, bfr, yacc[pt]); }
                }
            }
#undef SSD3_TILE_F
#undef SSD3_TILE_B
        }
#pragma unroll
        for (int pt = 0; pt < 2; ++pt) {
            bf16* yp = Y + (size_t)(r0 + 16 * w + li) * DI + xcol + 16 * pt + 4 * lg;
            float o[4];
            if (sweep == 0) { const v2u xv = xo[pt];
                o[0] = yacc[pt][0] + escale * yi[pt][0] + Dsum * bf_lo(xv.x); o[1] = yacc[pt][1] + escale * yi[pt][1] + Dsum * bf_hi(xv.x);
                o[2] = yacc[pt][2] + escale * yi[pt][2] + Dsum * bf_lo(xv.y); o[3] = yacc[pt][3] + escale * yi[pt][3] + Dsum * bf_hi(xv.y); }
            else { const v2u yv = yold[pt];
                o[0] = bf_lo(yv.x) + escale * yi[pt][0]; o[1] = bf_hi(yv.x) + escale * yi[pt][1]; o[2] = bf_lo(yv.y) + escale * yi[pt][2]; o[3] = bf_hi(yv.y) + escale * yi[pt][3]; }
            v2u ov; ov.x = pk2(o[0], o[1]); ov.y = pk2(o[2], o[3]); *(v2u*)yp = ov;
        }
        }
        {
            const int q = li >> 2, pq = li & 3;
            s16x4 ta[8]; s16x4 xd[8][2];
#pragma unroll
            for (int t = 0; t < 8; ++t) { ta[t] = __builtin_amdgcn_ds_read_tr16_b64_v4i16((LAS s16x4*)(BSc + (16 * t + 4 * lg + q) * ROW + (16 * w + 4 * pq) * 2));
#pragma unroll
                for (int pt = 0; pt < 2; ++pt) xd[t][pt] = *(const LAS s16x4*)(XDc + (16 * pt + li) * ROW + (16 * t + 4 * lg) * 2); }
            __builtin_amdgcn_sched_barrier(0);
#pragma unroll
            for (int tt = 0; tt < 8; ++tt) { const int t = sweep == 0 ? tt : 7 - tt; const float dec = __expf(sweep == 0 ? TFv[t] : TBv[t]);
#pragma unroll
                for (int pt = 0; pt < 2; ++pt) { sacc[pt] = sacc[pt] * dec; sacc[pt] = SSD3_MFMA16(ta[t], xd[t][pt], sacc[pt]); } }
#pragma unroll
            for (int pt = 0; pt < 2; ++pt) { v2u sv; sv.x = pk2(sacc[pt][0], sacc[pt][1]); sv.y = pk2(sacc[pt][2], sacc[pt][3]); *(LAS v2u*)(SSnxt + (16 * pt + li) * ROW + (16 * w + 4 * lg) * 2) = sv; }
        }
    }
#undef SSD3_LOAD_S
#undef SSD3_LOAD_C
#undef SSD3_STAGE
    VM_WAIT(); __syncthreads();
}
__device__ __forceinline__ void phase_ssd3(const Ids I, LAS unsigned char* lds, int l) { ssd3_sweep<0>(I, lds, l); ssd3_sweep<1>(I, lds, l); }

__device__ __forceinline__ void phase_pool(const Ids I_, LAS unsigned char* lds_base, int l) {
    LAS unsigned char* lds_misc = lds_base + MISC_OFF;
    const Ids I = fresh(I_);
    const KA ka = ka_fresh(); unsigned char* ws = KWS(ka);
    const bf16* UPOOL = (const bf16*)(ws + WS_XBC + XO_UPOOL);
    bf16* PML = (bf16*)(ws + WS_XBC + XO_UPOOL); bf16* PMC = (bf16*)(ws + WS_DT);
    const int nitems = (l == 0) ? 1024 + 64 : 1024;
    pg8::pg8_gu32* work = (pg8::pg8_gu32*)(ws + WS_CTL) + CW_WORK + 64 * l; pg8::pg8_gu32* cp_ = cnt_arr(ws, l, 0); pg8::pg8_gu32* tmo = (pg8::pg8_gu32*)(ws + WS_CTL) + CW_BAR + XB_TMO;
#define POOL_GEOM(item_) int seqb, L, w0, gi; \
        if ((item_) < 1024) { seqb = ((item_) >> 2) * 64; L = 64; w0 = 0; gi = (item_) & 3; } \
        else { const int ci = (item_) - 1024; gi = ci & 3; w0 = 64 * ((ci >> 2) & 3); seqb = MLAT + 256 * (ci >> 4); L = 256; } \
        const int cp = I.tid & 127, rs = I.tid >> 7, t0 = w0 + 16 * rs, col = gi * 256 + 2 * cp;
#define POOL_OUT(HK) do { _Pragma("unroll") for (int i = 0; i < 16; ++i) { const int t = t0 + i; const float slo = plo[i + 8 + HK] - plo[i + 8 - HK], shi = phi[i + 8 + HK] - phi[i + 8 - HK]; \
            const int lo = t - HK < 0 ? 0 : t - HK, hi = t + HK > L ? L : t + HK; const float inv = __builtin_amdgcn_rcpf((float)(hi - lo)); \
            *(unsigned*)(pout + (size_t)t * 1024 + col) = pk2(slo * inv - bf_lo(r_[i + 8]), shi * inv - bf_hi(r_[i + 8])); } } while (0)
#define POOL_CLAIM_WAIT(claim_) do { const int it_ = 2 * (int)(claim_); \
        if (it_ < nitems) { const int pmi_ = it_ < 1024 ? (it_ >> 4) : 64 + ((it_ - 1024) >> 4); unsigned sp_ = 0; \
            while (__hip_atomic_load(cp_ + 64 * pmi_, __ATOMIC_RELAXED, __HIP_MEMORY_SCOPE_AGENT) < 32u) { __builtin_amdgcn_s_sleep(2); \
                if ((++sp_ & 255u) == 0u) { if (__hip_atomic_load(tmo, __ATOMIC_RELAXED, __HIP_MEMORY_SCOPE_AGENT) != 0u) break; if (sp_ > (1u << 20)) { __hip_atomic_fetch_add(tmo, 1u, __ATOMIC_RELAXED, __HIP_MEMORY_SCOPE_AGENT); break; } } } \
            __builtin_amdgcn_fence(__ATOMIC_ACQUIRE, "agent"); asm volatile("s_waitcnt vmcnt(0)" ::: "memory"); } } while (0)
#define POOL_LOAD(r_, item_) do { POOL_GEOM(item_) \
        _Pragma("unroll") for (int i = 0; i < 32; ++i) { const int t = t0 - 8 + i; unsigned v = 0u; if (t >= 0 && t < L) v = *(const unsigned*)(UPOOL + (size_t)(seqb + t) * 1024 + col); r_[i] = v; } } while (0)
#define POOL_COMP(rr_, item_) do { POOL_GEOM(item_) const unsigned (&r_)[32] = rr_; bf16* pout = (item_) < 1024 ? PML + (size_t)seqb * 1024 : PMC + (size_t)(seqb - MLAT) * 1024; \
        float plo[33], phi[33]; plo[0] = 0.f; phi[0] = 0.f; \
        _Pragma("unroll") for (int i = 0; i < 32; ++i) { plo[i + 1] = plo[i] + bf_lo(r_[i]); phi[i + 1] = phi[i] + bf_hi(r_[i]); } \
        if (gi == 0) POOL_OUT(1); else if (gi == 1) POOL_OUT(2); else if (gi == 2) POOL_OUT(4); else POOL_OUT(8); } while (0)
    volatile LAS unsigned* slot = (volatile LAS unsigned*)(lds_misc) + 40;
    if (I.tid == 0) { const unsigned c0 = __hip_atomic_fetch_add(work, 1u, __ATOMIC_RELAXED, __HIP_MEMORY_SCOPE_AGENT); POOL_CLAIM_WAIT(c0); slot[0] = c0; }
    __syncthreads();
    int item = 2 * (int)slot[0], par = 0;
    while (item < nitems) {
        unsigned nclaim = 0u;
        unsigned ra[32], rb[32];
        POOL_LOAD(ra, item); POOL_LOAD(rb, item + 1);
        asm volatile("s_waitcnt vmcnt(0)" ::: "memory"); __syncthreads();
        if (I.tid == 0) nclaim = __hip_atomic_fetch_add(work, 1u, __ATOMIC_RELAXED, __HIP_MEMORY_SCOPE_AGENT);
        POOL_COMP(ra, item); POOL_COMP(rb, item + 1);
        if (I.tid == 0) { POOL_CLAIM_WAIT(nclaim); slot[par ^ 1] = nclaim; }
        __syncthreads();
        par ^= 1; item = 2 * (int)slot[par];
    }
#undef POOL_COMP
#undef POOL_LOAD
#undef POOL_CLAIM_WAIT
#undef POOL_OUT
#undef POOL_GEOM
}

__device__ __forceinline__ void phase_final(const Ids I_) {
    const Ids I = fresh(I_);
    const KA ka = ka_fresh(); float* OUT = KOUT(ka); const float* g = KIN(ka, 22);
    const bool dead = xb_ld((gu32*)(KWS(ka) + WS_CTL) + CW_BAR + XB_TMO) != 0u;
    v2u ta[4], tb[4];
#define FIN_LOAD(t_, mm) do { const v2u* q_ = (const v2u*)((const bf16*)OUT + (size_t)(mm) * 2048) + I.lane; _Pragma("unroll") for (int j = 0; j < 4; ++j) t_[j] = q_[64 * j]; } while (0)
#define FIN_ROW(t_, mm) do { f32x4 v[4]; float s = 0.f; \
        _Pragma("unroll") for (int j = 0; j < 4; ++j) { const v2u t = t_[j]; v[j] = (f32x4){bf_lo(t.x), bf_hi(t.x), bf_lo(t.y), bf_hi(t.y)}; s += (v[j].x * v[j].x + v[j].y * v[j].y) + (v[j].z * v[j].z + v[j].w * v[j].w); } \
        if ((mm) + 2 * I.NGW < MLAT) FIN_LOAD(t_, (mm) + 2 * I.NGW); \
        const float rstd = rsqrtf(wave_sum(s) * (1.f / D) + 1e-6f); \
        f32x4* xr = (f32x4*)(OUT + (size_t)(mm) * D) + I.lane; \
        _Pragma("unroll") for (int j = 0; j < 4; ++j) { f32x4 o = v[j] * rstd * ((const f32x4*)g)[I.lane + 64 * j]; if (dead) { const float qn = __builtin_nanf(""); o = (f32x4){qn, qn, qn, qn}; } xr[64 * j] = o; } } while (0)
    int m = I.gw;
    if (m < MLAT) FIN_LOAD(ta, m);
    if (m + I.NGW < MLAT) FIN_LOAD(tb, m + I.NGW);
    for (; m < MLAT; m += 2 * I.NGW) {
        FIN_ROW(ta, m);
        const int m1 = m + I.NGW; if (m1 >= MLAT) break;
        FIN_ROW(tb, m1);
    }
#undef FIN_ROW
#undef FIN_LOAD
}

#ifndef DBG_STOP
#define DBG_STOP 0
#endif
__device__ __forceinline__ void phase_dump(const Ids I_, size_t ws_off, int cols, bool ctx_rows, bool isf32, bool accum = false) {
    const Ids I = fresh(I_);
    const KA ka = ka_fresh(); float* OUT = KOUT(ka); unsigned char* base = KWS(ka) + ws_off;
    for (int m = I.gw; m < MLAT; m += I.NGW) {
        for (int c = I.lane; c < 1024; c += 64) { float s = 0.f;
            for (int j = 0; j < cols / 1024; ++j) {
                if (isf32) { s += ((const float*)base)[(size_t)m * cols + c + 1024 * j]; }
                else {
#ifdef DBG_ATOMIC_DUMP
                    { const size_t e = (size_t)m * cols + c + 1024 * j; const unsigned w = __hip_atomic_fetch_or((unsigned*)base + (e >> 1), 0u, __ATOMIC_RELAXED, __HIP_MEMORY_SCOPE_AGENT); s += (e & 1) ? bf_hi(w) : bf_lo(w); }
                    if (ctx_rows) { const size_t e = (size_t)(MLAT + (m & 1023)) * cols + c + 1024 * j; const unsigned w = __hip_atomic_fetch_or((unsigned*)base + (e >> 1), 0u, __ATOMIC_RELAXED, __HIP_MEMORY_SCOPE_AGENT); s += (e & 1) ? bf_hi(w) : bf_lo(w); }
#else
                    s += bf_lo(((const bf16*)base)[(size_t)m * cols + c + 1024 * j]); if (ctx_rows) s += bf_lo(((const bf16*)base)[(size_t)(MLAT + (m & 1023)) * cols + c + 1024 * j]);
#endif
                } }
            if (accum) s += OUT[(size_t)m * D + c]; OUT[(size_t)m * D + c] = s; } }
}

__global__ void __launch_bounds__(NWAVES * 64, 2) fwd_kernel(Args args) {
    LAS unsigned char* lds = (LAS unsigned char*)pg8::lds_dyn;
    volatile LAS unsigned* MISC = (volatile LAS unsigned*)(lds + MISC_OFF);
    LAS unsigned char* xl = lds + XL_OFF;
    if ((threadIdx.x & 63u) == 0u) ((volatile LAS unsigned*)(lds + pg8::WAVE_TAB_OFF))[pg8::hw_slot()] = threadIdx.x >> 6;
    __syncthreads();
    Ids I; I.wave = pg8::wave_now(); I.tid = I.wave * 64 + pg8::lane_now(); I.lane = I.tid & 63;
    I.G = gridDim.x; I.bx = blockIdx.x; I.vcu = (I.G % 8 == 0) ? (I.bx % 8) * (I.G / 8) + I.bx / 8 : I.bx;
    I.gw = I.vcu * NWAVES + I.wave; I.NGW = I.G * NWAVES;
    const int G = I.G, bx = I.bx;

    for (int u = I.tid; u < 64; u += NWAVES * 64) MISC[u] = 0u;
    __syncthreads();
    XcdBarrier bar = xcd_barrier_post((gu32*)(KWS(ka_fresh()) + WS_CTL) + CW_BAR, MISC + 8);
#ifdef TSEL
    unsigned long long t_prev = __builtin_amdgcn_s_memrealtime(), t_acc = 0ull; int t_stage = 0;
#define GRID_BAR() do { xcd_barrier(bar); { const unsigned long long t_now = __builtin_amdgcn_s_memrealtime(); if ((TSEL >> t_stage) & 1ull) t_acc += t_now - t_prev; t_prev = t_now; ++t_stage; } } while (0)
#else
#define GRID_BAR() xcd_barrier(bar)
#endif

    phase_mod(I, lds);
    conv_mixer(I, lds, 0);
    GRID_BAR();

    for (int l = 0; l < 2; ++l) {
        const int Mfull = (l == 0) ? MTOT : MLAT;
        phase_norm(I, l, 0, MTOT, l == 0);
        GRID_BAR();
        if (DBG_STOP != 11) {
            const KA ka = ka_fresh(); unsigned char* ws = KWS(ka);
            pg8::Gemm g{(const bf16*)(ws + WS_H), (const bf16*)(ws + WS_WIN), 1024, 1024, MTOT, NB1, 1024, 0};
            pg8::PanelOrder S; S.init(MTOT, NB1, G, bx); S.set_base(ws + WS_CTL); S.wait0 = -1; S.need0 = 0u; S.wait1 = -1; S.need1 = 0u; S.done_cnt = cnt_off(l, 3); S.tmo = CW_BAR + XB_TMO;
            pg8::EpiXbcDt E{(bf16*)(ws + WS_XBC), (bf16*)(ws + WS_Y), (float*)(ws + WS_DT), KIN(ka, 10) + l * 64};
            pg8::gemm_phase<pg8::EpiXbcDt, pg8::PanelOrder>(lds, xl, g, S, E);
        }
        phase_conv(I, lds, l);
        GRID_BAR();
        if (DBG_STOP == 2) { phase_dump(I, WS_XBC, 4096, true, false); return; }
#ifdef SSD_NAIVE
        phase_ssd(I, lds, l);
#elif defined(SSD_V2)
        phase_ssd_mfma(I, lds, l);
#else
        phase_ssd3(I, lds, l);
#ifdef REP_SSD
        phase_ssd_mfma(I, lds, l);
#endif
#endif
        GRID_BAR();
        if (DBG_STOP == 1) { phase_dump(I, WS_Y, 2048, true, false); return; }
        if (DBG_STOP == 9) { phase_dump(I, WS_H, 1024, true, false); phase_dump(I, WS_WIN, 1024, false, false, true); return; }
        {
            const KA ka = ka_fresh(); unsigned char* ws = KWS(ka);
            pg8::Gemm g{(const bf16*)(ws + WS_H), (const bf16*)(ws + WS_WIN) + (size_t)NB1 * 1024, 1024, 1024, Mfull, NB2, 1024, 0};
            pg8::PoolChainOrder S; S.init(Mfull, NB2, G, bx); S.set_base(ws + WS_CTL); S.wait0 = -1; S.need0 = 0u; S.wait1 = -1; S.need1 = 0u; S.done_cnt = cnt_off(l, 0); S.tmo = CW_BAR + XB_TMO;
            pg8::EpiZPG E{(bf16*)(ws + WS_Y), (bf16*)(ws + WS_XBC + XO_UPOOL), (bf16*)(ws + WS_XBC + XO_GATES)};
            pg8::gemm_phase<pg8::EpiZPG, pg8::PoolChainOrder>(lds, xl, g, S, E);
        }
        phase_pool(I, lds, l);
        GRID_BAR();
        if (DBG_STOP == 5) { phase_dump(I, WS_Y, 2048, true, false); phase_dump(I, WS_XBC + XO_GATES, 2048, true, false, true); phase_dump(I, WS_XBC + XO_UPOOL, 1024, true, false, true); return; }
        if (DBG_STOP == 8) { { const unsigned long long t0 = __builtin_amdgcn_s_memrealtime(); while (__builtin_amdgcn_s_memrealtime() - t0 < 50000ull) __builtin_amdgcn_s_sleep(32); } GRID_BAR(); phase_dump(I, WS_XBC + XO_GATES, 2048, true, false); phase_dump(I, WS_XBC + XO_UPOOL, 1024, true, false, true); return; }
        {
            const KA ka = ka_fresh(); unsigned char* ws = KWS(ka);
            pg8::Gemm g{(const bf16*)(ws + WS_Y), (const bf16*)(ws + WS_WSSD), 2048, 2048, Mfull, 1024, 2048, 0};
            pg8::ChainOrder S; S.init(Mfull, 1024, G, bx); S.set_base(ws + WS_CTL); S.wait0 = -1; S.need0 = 0u; S.wait1 = -1; S.need1 = 0u; S.done_cnt = cnt_off(l, 1); S.tmo = CW_BAR + XB_TMO;
            pg8::EpiGate<0> E{(bf16*)(ws + WS_XBC + XO_M1), (const bf16*)(ws + WS_XBC + XO_GATES)};
            pg8::gemm_phase<pg8::EpiGate<0>, pg8::ChainOrder>(lds, xl, g, S, E);
        }
        {
            const KA ka = ka_fresh(); unsigned char* ws = KWS(ka);
            pg8::Gemm g{(const bf16*)(ws + WS_XBC + XO_UPOOL), (const bf16*)(ws + WS_WPC), 1024, 1024, Mfull, 1024, 1024, 0};
            pg8::FOrder S; S.ctx_delta = (size_t)((long long)WS_DT - (long long)(WS_XBC + XO_UPOOL) - 64ll * 256 * 1024 * 2); S.init(Mfull, 1024, G, (bx + 16) % G); S.set_base(ws + WS_CTL); S.wait0 = cnt_off(l, 1); S.need0 = 32u; S.wait1 = -1; S.need1 = 0u; S.done_cnt = cnt_off(l, 2); S.tmo = CW_BAR + XB_TMO;
            pg8::EpiGate<1> E{(bf16*)(ws + WS_XBC + XO_M1), (const bf16*)(ws + WS_XBC + XO_GATES)};
            pg8::gemm_phase<pg8::EpiGate<1>, pg8::FOrder>(lds, xl, g, S, E);
        }
        {
            const KA ka = ka_fresh(); unsigned char* ws = KWS(ka);
            pg8::Gemm g{(const bf16*)(ws + WS_XBC + XO_M1), (const bf16*)(ws + WS_WOUT), 1024, 1024, Mfull, 1024, 1024, 0};
            pg8::RelChainOrder S; S.init(Mfull, 1024, G, (bx + 32) % G); S.set_base(ws + WS_CTL); S.wait0 = cnt_off(l, 2); S.need0 = 32u; S.wait1 = -1; S.need1 = 0u; S.done_cnt = cnt_off(l, 4); S.lds_word = (unsigned)(size_t)(lds + MISC_OFF + 46 * 4); S.tmo = CW_BAR + XB_TMO;
            if (l == 0) { pg8::EpiRes<false> E{KIN(ka, 0), (bf16*)KOUT(ka), KIN(ka, 2), (float*)(ws + WS_CX), (const float*)(ws + WS_MOD) + 2048};
                pg8::gemm_phase<pg8::EpiRes<false>, pg8::RelChainOrder>(lds, xl, g, S, E); }
            else { pg8::EpiRes<true> E{nullptr, (bf16*)KOUT(ka), (const float*)(ws + WS_CX), (float*)(ws + WS_CX), (const float*)(ws + WS_MOD) + (size_t)5 * 6144 + 2048};
                pg8::gemm_phase<pg8::EpiRes<true>, pg8::RelChainOrder>(lds, xl, g, S, E); }
        }
        if (l == 0) conv_win_dyn(I, lds, 1);
        phase_norm2_dyn(I, lds, l, Mfull);
        conv_ffn(I, lds, l);
        if (l == 0) conv_mixer(I, lds, 1, true);
        GRID_BAR();
        {
            const KA ka = ka_fresh(); unsigned char* ws = KWS(ka);
            pg8::Gemm g{(const bf16*)(ws + WS_H), (const bf16*)(ws + WS_XBC + XO_WGU), 1024, 1024, Mfull, 2 * FFH, 1024, 0}; pg8::StaticOrder S; S.init(Mfull, 2 * FFH, G, bx);
            pg8::EpiSwiglu E{(bf16*)(ws + WS_XBC + XO_ACT)};
            pg8::gemm_phase<pg8::EpiSwiglu, pg8::StaticOrder>(lds, xl, g, S, E);
        }
        GRID_BAR();
        if (DBG_STOP == 4) { phase_dump(I, WS_XBC + XO_ACT, 2048, false, false); return; }
        {
            const KA ka = ka_fresh(); unsigned char* ws = KWS(ka);
            pg8::Gemm g{(const bf16*)(ws + WS_XBC + XO_ACT), (const bf16*)(ws + WS_XBC + XO_WDN), FFH, FFH, MLAT, 1024, FFH, 0}; pg8::StaticOrder S; S.init(MLAT, 1024, G, bx);
            pg8::EpiRes<true> E{nullptr, (bf16*)KOUT(ka), (const float*)(ws + WS_CX), (float*)(ws + WS_CX), (const float*)(ws + WS_MOD) + (size_t)l * 5 * 6144 + 5120};
            pg8::gemm_phase<pg8::EpiRes<true>, pg8::StaticOrder>(lds, xl, g, S, E);
        }
        if (l == 0) {
            const KA ka = ka_fresh(); unsigned char* ws = KWS(ka);
            pg8::Gemm g{(const bf16*)(ws + WS_XBC + XO_ACT), (const bf16*)(ws + WS_XBC + XO_WDN), FFH, FFH, MTOT, 1024, 256, 0}; pg8::SplitKOrder S; S.G = G; S.c = bx;
            pg8::EpiPart E{(float*)(ws + WS_Y)};
            pg8::gemm_phase<pg8::EpiPart, pg8::SplitKOrder>(lds, xl, g, S, E);
        }
        GRID_BAR();
    }
#ifdef TSEL
    {
        gu32* tw = (gu32*)(KWS(ka_fresh()) + WS_CTL) + 8192;
        if (I.bx == 0 && I.tid == 0) __hip_atomic_store(tw, (unsigned)t_acc, __ATOMIC_RELAXED, __HIP_MEMORY_SCOPE_AGENT);
        xcd_barrier(bar);
        const unsigned long long dur = (unsigned long long)__hip_atomic_load(tw, __ATOMIC_RELAXED, __HIP_MEMORY_SCOPE_AGENT) * TMUL;
        const unsigned long long t0 = __builtin_amdgcn_s_memrealtime(); while (__builtin_amdgcn_s_memrealtime() - t0 < dur) __builtin_amdgcn_s_sleep(16);
    }
#endif
    phase_final(I);
}

extern "C" void kernel_launch(void* const* d_in, const int* in_sizes, int n_in, void* d_out, int out_size, void* d_ws, size_t ws_size, hipStream_t stream) {
    static int grid = 0;
    if (grid == 0) {
        if (n_in != 23 || in_sizes[0] != MLAT * D || out_size != MLAT * D || ws_size < WS_END) { fprintf(stderr, "kernel_launch: unexpected shapes / workspace (n_in %d, ws %zu, need %zu); nothing launched\n", n_in, ws_size, (size_t)WS_END); grid = -1; return; }
        int dev = 0, cus = 0, per_cu = 0;
        if (hipGetDevice(&dev) != hipSuccess || hipDeviceGetAttribute(&cus, hipDeviceAttributeMultiprocessorCount, dev) != hipSuccess) { grid = -1; return; }
        if (hipFuncSetAttribute((const void*)fwd_kernel, hipFuncAttributeMaxDynamicSharedMemorySize, LDS_BYTES) != hipSuccess) { fprintf(stderr, "kernel_launch: hipFuncSetAttribute failed\n"); grid = -1; return; }
        if (hipOccupancyMaxActiveBlocksPerMultiprocessor(&per_cu, (const void*)fwd_kernel, NWAVES * 64, LDS_BYTES) != hipSuccess || per_cu < 1) { fprintf(stderr, "kernel_launch: occupancy query says %d blocks per CU; nothing launched\n", per_cu); (void)hipGetLastError(); grid = -1; return; }
        grid = cus;
        if (grid != 256) { fprintf(stderr, "kernel_launch: built for a 256-CU device (got %d)\n", grid); grid = -1; return; }
    }
    if (grid < 0) return;
    if (hipMemsetAsync((char*)d_ws + WS_CTL, 0, CTL_ZERO_BYTES, stream) != hipSuccess) return;
    Args a{};
    for (int i = 0; i < 23; ++i) a.in[i] = (const float*)d_in[i];
    a.out = (float*)d_out; a.ws = (unsigned char*)d_ws;
    hipLaunchKernelGGL(fwd_kernel, dim3(grid), dim3(NWAVES * 64), LDS_BYTES, stream, a);
}
```

```cpp
#include <hip/hip_runtime.h>
#define SSD_V2 1
#define TSEL_OFF 0ull
#define TMUL 4ull
#include <cstdio>
#include <cstdint>

namespace pg8 {
#define PG8_LAS __attribute__((address_space(3)))
typedef unsigned short bf16_t;
typedef short bf16x8 __attribute__((ext_vector_type(8)));
typedef float f32x4 __attribute__((ext_vector_type(4)));
typedef float f32x2 __attribute__((ext_vector_type(2)));
typedef unsigned u32x4 __attribute__((ext_vector_type(4)));
typedef unsigned u32x2 __attribute__((ext_vector_type(2)));
constexpr int BM = 256, BK = 64, HALF = 128, HTB = HALF * BK * 2, STAGE_BYTES = 8 * HTB, NXCD = 8, WGM = 8;

__host__ __device__ __forceinline__ int lds_byte(int r, int c) { const int st = (r >> 4) * 2 + (c >> 5), rr = r & 15, cc = c & 31, ob = rr * 64 + cc * 2; return st * 1024 + (ob ^ (((ob >> 9) & 1) << 5)); }
__host__ __device__ __forceinline__ void stage_rc(int b, int& R, int& C) { const int st = b / 1024, sb = b % 1024, swz = sb ^ (((sb >> 9) & 1) << 5); R = (st >> 1) * 16 + swz / 64; C = (st & 1) * 32 + (swz % 64) / 2; }
__host__ __device__ __forceinline__ int perm32(int rho) { const int n = rho >> 4, i = rho & 15; return 8 * (i >> 2) + 4 * n + (i & 3); }

extern __shared__ __attribute__((aligned(16))) unsigned char lds_dyn[];
constexpr int WAVE_TAB_OFF = 159744 + 1024;
__device__ __forceinline__ int lane_now() { return (int)__builtin_amdgcn_mbcnt_hi(~0u, __builtin_amdgcn_mbcnt_lo(~0u, 0u)); }
__device__ __forceinline__ int hw_slot() { return (int)(__builtin_amdgcn_s_getreg(4 | (0 << 6) | (5 << 11)) & 63u); }
__device__ __forceinline__ int wave_now() { return __builtin_amdgcn_readfirstlane((int)((volatile PG8_LAS unsigned*)(lds_dyn + WAVE_TAB_OFF))[hw_slot()]); }
__device__ __forceinline__ int tid_now() { return wave_now() * 64 + lane_now(); }
struct Unit { int pm, pn; };
struct Gemm { const bf16_t* A; const bf16_t* Bt; int lda, ldb, M, N, K, a_pn_off; };

struct StaticOrder {
    int nM, nN, nwg, G, c;
    __host__ __device__ void init(int M, int N, int G_, int c_) { nM = M / BM; nN = N / BM; nwg = nM * nN; G = G_; c = c_; }
    __host__ __device__ bool next(int i, Unit& u) const {
        const long L = (long)i * G + c; if (L >= nwg) return false;
        int wgid = (int)L; { const int q = nwg / NXCD, r = nwg % NXCD, xcd = wgid % NXCD, off = wgid / NXCD; wgid = (xcd < r ? xcd * (q + 1) : r * (q + 1) + (xcd - r) * q) + off; }
        const int nig = WGM * nN, gid = wgid / nig, fm = gid * WGM, gsz = (nM - fm) < WGM ? (nM - fm) : WGM;
        u.pm = fm + ((wgid % nig) % gsz); u.pn = (wgid % nig) / gsz; return true;
    }
    __device__ __forceinline__ size_t a_off(const Unit& u, const Gemm& g, size_t tsA) const { return (size_t)u.pm * tsA + (size_t)u.pn * g.a_pn_off * 2; }
    __device__ __forceinline__ size_t b_off(const Unit& u, const Gemm&, size_t tsB) const { return (size_t)u.pn * tsB; }
    __device__ __forceinline__ void a_ready(const Unit&) const {}
    __device__ __forceinline__ void done(const Unit&) const {}
};
#define PG8_GAS __attribute__((address_space(1)))
typedef PG8_GAS unsigned pg8_gu32;
struct ChainOrder : StaticOrder {
    unsigned ctl_lo, ctl_hi;
    int wait0, wait1, done_cnt, tmo;
    unsigned need0, need1;
    __device__ __forceinline__ void set_base(const void* ctl) { const unsigned long long a = (unsigned long long)ctl; ctl_lo = (unsigned)__builtin_amdgcn_readfirstlane((int)(unsigned)a); ctl_hi = (unsigned)__builtin_amdgcn_readfirstlane((int)(unsigned)(a >> 32)); }
    __device__ __forceinline__ pg8_gu32* word(int off) const { return (pg8_gu32*)(((unsigned long long)ctl_hi << 32) | (unsigned long long)ctl_lo) + off; }
    __device__ __forceinline__ void a_ready(const Unit& u) const {
        if (wait0 >= 0) {
            if (wave_now() == 0) {
                unsigned sp = 0;
                for (;;) {
                    bool ok = (unsigned)__builtin_amdgcn_readfirstlane(__hip_atomic_load(word(wait0 + 64 * u.pm), __ATOMIC_RELAXED, __HIP_MEMORY_SCOPE_AGENT)) >= need0;
                    if (ok && wait1 >= 0) ok = (unsigned)__builtin_amdgcn_readfirstlane(__hip_atomic_load(word(wait1 + 64 * u.pm), __ATOMIC_RELAXED, __HIP_MEMORY_SCOPE_AGENT)) >= need1;
                    if (ok) break;
                    __builtin_amdgcn_s_sleep(2);
                    if ((++sp & 255u) == 0u) { if (__builtin_amdgcn_readfirstlane(__hip_atomic_load(word(tmo), __ATOMIC_RELAXED, __HIP_MEMORY_SCOPE_AGENT)) != 0u) break;
                        if (sp > (1u << 20)) { if (lane_now() == 0) __hip_atomic_fetch_add(word(tmo), 1u, __ATOMIC_RELAXED, __HIP_MEMORY_SCOPE_AGENT); break; } }
                }
                __builtin_amdgcn_fence(__ATOMIC_ACQUIRE, "agent");
                asm volatile("s_waitcnt vmcnt(0)" ::: "memory");
            }
            asm volatile("" ::: "memory"); __builtin_amdgcn_s_barrier(); asm volatile("" ::: "memory");
        }
    }
    __device__ __forceinline__ void done(const Unit& u) const {
        if (done_cnt >= 0) { asm volatile("s_waitcnt vmcnt(0)" ::: "memory");
            if (lane_now() == 0) __hip_atomic_fetch_add(word(done_cnt + 64 * u.pm), 1u, __ATOMIC_RELAXED, __HIP_MEMORY_SCOPE_AGENT); }
    }
};

struct PanelOrder : ChainOrder {
    __device__ __forceinline__ bool next(int i, Unit& u) const {
        const int x = c & 7, j = c >> 3, k0 = (nwg * x) >> 3, k1 = (nwg * (x + 1)) >> 3, k = k0 + j + (G >> 3) * i;
        if (k >= k1) return false;
        u.pm = k / nN; u.pn = k - u.pm * nN; return true;
    }
};
struct PoolChainOrder : PanelOrder {
    __device__ __forceinline__ void done(const Unit& u) const { if (u.pn >= 8 && u.pn < 12) ChainOrder::done(u); }
};
struct RelChainOrder : ChainOrder {
    unsigned lds_word;
    __device__ __forceinline__ void done(const Unit& u) const {
        asm volatile("s_waitcnt vmcnt(0)" ::: "memory");
        unsigned prev = 0u;
        if (lane_now() == 0) prev = __hip_atomic_fetch_add((PG8_LAS unsigned*)(size_t)lds_word, 1u, __ATOMIC_RELAXED, __HIP_MEMORY_SCOPE_WORKGROUP);
        prev = (unsigned)__builtin_amdgcn_readfirstlane((int)prev);
        if (prev == 7u) {
            if (lane_now() == 0) __hip_atomic_store((PG8_LAS unsigned*)(size_t)lds_word, 0u, __ATOMIC_RELAXED, __HIP_MEMORY_SCOPE_WORKGROUP);
            __builtin_amdgcn_fence(__ATOMIC_RELEASE, "agent"); asm volatile("s_waitcnt vmcnt(0)" ::: "memory");
            if (lane_now() == 0) __hip_atomic_fetch_add(word(done_cnt + 64 * u.pm), 8u, __ATOMIC_RELAXED, __HIP_MEMORY_SCOPE_AGENT);
        }
    }
};
struct FOrder : ChainOrder {
    size_t ctx_delta;
    __device__ __forceinline__ size_t a_off(const Unit& u, const Gemm& g, size_t tsA) const { return (size_t)u.pm * tsA + (u.pm >= 64 ? ctx_delta : (size_t)0); }
};
__device__ __forceinline__ int opaque_v(int x) { asm volatile("" : "+v"(x)); return x; }
__device__ __forceinline__ int opaque_s(int x) { asm volatile("" : "+s"(x)); return x; }
template <int O> __device__ __forceinline__ float lane_xor(float v) { static_assert(O < 32, "within a 32-lane half"); return __int_as_float(__builtin_amdgcn_ds_swizzle(__float_as_int(v), (O << 10) | 0x1f)); }
__device__ __forceinline__ float half_sum(float v) { const auto r = __builtin_amdgcn_permlane32_swap(__float_as_uint(v), __float_as_uint(v), false, false); return __uint_as_float(r[0]) + __uint_as_float(r[1]); }
__device__ __forceinline__ float softplus(float x) { if (x > 20.f) return x; const float e = __expf(x), u = 1.f + e; return u == 1.f ? e : __logf(u) * e * __builtin_amdgcn_rcpf(u - 1.f); }
typedef __bf16 bf16x2_t __attribute__((ext_vector_type(2)));
__device__ __forceinline__ unsigned cvt_pk_bf16(float lo, float hi) { const f32x2 v = {lo, hi}; return __builtin_bit_cast(unsigned, __builtin_convertvector(v, bf16x2_t)); }
__device__ __forceinline__ float bflo(unsigned u) { return __uint_as_float(u << 16); }
__device__ __forceinline__ float bfhi(unsigned u) { return __uint_as_float(u & 0xffff0000u); }
__device__ __forceinline__ float sigm(float v) { return __builtin_amdgcn_rcpf(1.f + __expf(-v)); }
__device__ __forceinline__ float silu(float v) { return v * sigm(v); }
__device__ __forceinline__ u32x4 pack8(const f32x4 a, const f32x4 b) { u32x4 w; w.x = cvt_pk_bf16(a[0], a[1]); w.y = cvt_pk_bf16(a[2], a[3]); w.z = cvt_pk_bf16(b[0], b[1]); w.w = cvt_pk_bf16(b[2], b[3]); return w; }

constexpr int SEGR = 68;
constexpr int MTOT_ROWS = 17408;

struct EpiPlain {
    static constexpr bool PERM = true;
    bf16_t* O; int ldc;
    __device__ __forceinline__ void operator()(f32x4 (&acc)[2][2][4][2], const Unit& u, int wr, int wc, int fr, int fq, PG8_LAS unsigned char*) const {
        const int row0 = u.pm * BM + wr * 64 + fr, col0 = u.pn * BM + wc * 32 + 8 * fq;
#pragma unroll
        for (int ai = 0; ai < 2; ++ai)
#pragma unroll
            for (int m = 0; m < 4; ++m) { bf16_t* rowp = O + (size_t)(row0 + ai * HALF + m * 16) * ldc + col0;
#pragma unroll
                for (int bj = 0; bj < 2; ++bj) *(u32x4*)(rowp + bj * HALF) = pack8(acc[ai][bj][m][0], acc[ai][bj][m][1]); }
    }
};

struct EpiXbcDt {
    static constexpr bool PERM = true;
    bf16_t* XBC; bf16_t* HALO; float* DT; const float* dt_bias;
    __device__ __forceinline__ void operator()(f32x4 (&acc)[2][2][4][2], const Unit& u, int wr, int wc, int fr, int fq, PG8_LAS unsigned char*) const {
        const int row0 = u.pm * BM + wr * 64 + fr;
        if (u.pn < 16) {
            const int col0 = u.pn * BM + wc * 32 + 8 * fq;
            const __amdgpu_buffer_rsrc_t rsx = __builtin_amdgcn_make_buffer_rsrc((void*)XBC, (short)0, 17408 * 4096 * 2, 0x00020000), rsh = __builtin_amdgcn_make_buffer_rsrc((void*)HALO, (short)0, 544 * 4 * 4096 * 2, 0x00020000);
#pragma unroll
            for (int ai = 0; ai < 2; ++ai)
#pragma unroll
                for (int m = 0; m < 4; ++m) { const int r = row0 + ai * HALF + m * 16; const unsigned ro = (unsigned)(((size_t)r * 4096 + col0) * 2);
                    const int seg = r >> 5, rs = r & 31; const int hs = rs < 2 ? rs : (rs >= 30 ? rs - 28 : -1);
#pragma unroll
                    for (int bj = 0; bj < 2; ++bj) { const u32x4 w = pack8(acc[ai][bj][m][0], acc[ai][bj][m][1]); __builtin_amdgcn_raw_buffer_store_b128(w, rsx, ro + bj * HALF * 2, 0, 16);
                        if (hs >= 0) __builtin_amdgcn_raw_buffer_store_b128(w, rsh, (unsigned)(((size_t)(seg * 4 + hs) * 4096 + col0 + bj * HALF) * 2), 0, 16); } }
        } else if (wc < 2) {
            const int c0 = wc * 32 + 8 * fq;
            const f32x4 b0 = *(const f32x4*)(dt_bias + c0), b1 = *(const f32x4*)(dt_bias + c0 + 4);
#pragma unroll
            for (int ai = 0; ai < 2; ++ai)
#pragma unroll
                for (int m = 0; m < 4; ++m) { const int r = row0 + ai * HALF + m * 16; float* colp = DT + (size_t)c0 * MTOT_ROWS + r;
                    f32x4 v0 = acc[ai][0][m][0] + b0, v1 = acc[ai][0][m][1] + b1;
#pragma unroll
                    for (int j = 0; j < 4; ++j) { colp[(size_t)j * MTOT_ROWS] = softplus(v0[j]); colp[(size_t)(4 + j) * MTOT_ROWS] = softplus(v1[j]); } }
        }
    }
};

struct EpiZPG {
    static constexpr bool PERM = true;
    bf16_t* Y; bf16_t* UPOOL; bf16_t* GATES;
    __device__ __forceinline__ void operator()(f32x4 (&acc)[2][2][4][2], const Unit& u, int wr, int wc, int fr, int fq, PG8_LAS unsigned char* xl) const {
        const int row0 = u.pm * BM + wr * 64 + fr;
#ifdef DBG_SKIPZ
        if (u.pn < 8) { return; }
#endif
        if (u.pn < 8) {
            const int col0 = u.pn * BM + wc * 32 + 8 * fq;
            PG8_LAS float* P = (PG8_LAS float*)xl;
            u32x4 yva[2][4][2];
#pragma unroll
            for (int ai = 0; ai < 2; ++ai)
#pragma unroll
                for (int m = 0; m < 4; ++m) { const bf16_t* yp = Y + (size_t)(row0 + ai * HALF + m * 16) * 2048 + col0; yva[ai][m][0] = *(const u32x4*)yp; yva[ai][m][1] = *(const u32x4*)(yp + HALF); }
#pragma unroll
            for (int ai = 0; ai < 2; ++ai) {
#pragma unroll
                for (int m = 0; m < 4; ++m) { float s = 0.f;
#pragma unroll
                    for (int bj = 0; bj < 2; ++bj) { const u32x4 yv = yva[ai][m][bj]; f32x4 v0 = acc[ai][bj][m][0], v1 = acc[ai][bj][m][1];
                        v0[0] = bflo(yv.x) * silu(v0[0]); v0[1] = bfhi(yv.x) * silu(v0[1]); v0[2] = bflo(yv.y) * silu(v0[2]); v0[3] = bfhi(yv.y) * silu(v0[3]);
                        v1[0] = bflo(yv.z) * silu(v1[0]); v1[1] = bfhi(yv.z) * silu(v1[1]); v1[2] = bflo(yv.w) * silu(v1[2]); v1[3] = bfhi(yv.w) * silu(v1[3]);
                        s += (v0[0] * v0[0] + v0[1] * v0[1]) + (v0[2] * v0[2] + v0[3] * v0[3]) + (v1[0] * v1[0] + v1[1] * v1[1]) + (v1[2] * v1[2] + v1[3] * v1[3]);
                        acc[ai][bj][m][0] = v0; acc[ai][bj][m][1] = v1; }
                    s += lane_xor<16>(s); s = half_sum(s);
                    if (fq == 0) P[(ai * HALF + wr * 64 + m * 16 + fr) * 4 + wc] = s; }
                asm volatile("" ::: "memory"); }
#ifndef DBG_NOZBAR
            asm volatile("s_waitcnt lgkmcnt(0)" ::: "memory"); __builtin_amdgcn_s_barrier(); asm volatile("" ::: "memory");
#else
            asm volatile("s_waitcnt lgkmcnt(0)" ::: "memory");
#endif
#pragma unroll
            for (int ai = 0; ai < 2; ++ai)
#pragma unroll
                for (int m = 0; m < 4; ++m) {
#ifndef DBG_NOZBAR
                    const f32x4 p = *(const PG8_LAS f32x4*)(P + (ai * HALF + wr * 64 + m * 16 + fr) * 4);
#else
                    const float pw_ = P[(ai * HALF + wr * 64 + m * 16 + fr) * 4 + wc]; const f32x4 p = {pw_, pw_, pw_, pw_};
#endif

                    const float rstd = rsqrtf(((p[0] + p[1]) + (p[2] + p[3])) * (1.0f / 256.0f) + 1e-6f);
                    bf16_t* yp = Y + (size_t)(row0 + ai * HALF + m * 16) * 2048 + col0;
#pragma unroll
                    for (int bj = 0; bj < 2; ++bj) *(u32x4*)(yp + bj * HALF) = pack8(acc[ai][bj][m][0] * rstd, acc[ai][bj][m][1] * rstd); }
        } else if (u.pn < 12) {
            const int col0 = (u.pn - 8) * BM + wc * 32 + 8 * fq;
            const __amdgpu_buffer_rsrc_t rsU = __builtin_amdgcn_make_buffer_rsrc((void*)UPOOL, (short)0, 17408 * 1024 * 2, 0x00020000);
#pragma unroll
            for (int ai = 0; ai < 2; ++ai)
#pragma unroll
                for (int m = 0; m < 4; ++m) { const unsigned ro = (unsigned)(((size_t)(row0 + ai * HALF + m * 16) * 1024 + col0) * 2);
#pragma unroll
                    for (int bj = 0; bj < 2; ++bj) __builtin_amdgcn_raw_buffer_store_b128(pack8(acc[ai][bj][m][0], acc[ai][bj][m][1]), rsU, ro + bj * HALF * 2, 0, 16); }
        } else {
            const int col0 = (u.pn - 12) * BM + wc * 32 + 8 * fq;
#pragma unroll
            for (int ai = 0; ai < 2; ++ai)
#pragma unroll
                for (int m = 0; m < 4; ++m) { bf16_t* rowp = GATES + (size_t)(row0 + ai * HALF + m * 16) * 2048 + col0;
#pragma unroll
                    for (int bj = 0; bj < 2; ++bj) { f32x4 v0 = acc[ai][bj][m][0], v1 = acc[ai][bj][m][1];
#pragma unroll
                        for (int j = 0; j < 4; ++j) { v0[j] = sigm(v0[j]); v1[j] = sigm(v1[j]); }
                        *(u32x4*)(rowp + bj * HALF) = pack8(v0, v1); } }
        }
    }
};

template <int MODE  > struct EpiGate {
    static constexpr bool PERM = true;
    bf16_t* M1; const bf16_t* GATES;
    __device__ __forceinline__ void operator()(f32x4 (&acc)[2][2][4][2], const Unit& u, int wr, int wc, int fr, int fq, PG8_LAS unsigned char*) const {
        const int row0 = u.pm * BM + wr * 64 + fr, col0 = u.pn * BM + wc * 32 + 8 * fq;
        const __amdgpu_buffer_rsrc_t rs = __builtin_amdgcn_make_buffer_rsrc((void*)M1, (short)0, 17408 * 1024 * 2, 0x00020000);
#pragma unroll
        for (int ai = 0; ai < 2; ++ai) {
            u32x4 gv[4][2], ov[4][2];
#pragma unroll
            for (int m = 0; m < 4; ++m) { const int r = row0 + ai * HALF + m * 16; const bf16_t* gp = GATES + (size_t)r * 2048 + MODE * 1024 + col0; const bf16_t* mp = M1 + (size_t)r * 1024 + col0;
                gv[m][0] = *(const u32x4*)gp; gv[m][1] = *(const u32x4*)(gp + HALF);
                if (MODE == 1) { ov[m][0] = *(const u32x4*)mp; ov[m][1] = *(const u32x4*)(mp + HALF); } }
#pragma unroll
            for (int m = 0; m < 4; ++m) { bf16_t* mp = M1 + (size_t)(row0 + ai * HALF + m * 16) * 1024 + col0;
#pragma unroll
                for (int bj = 0; bj < 2; ++bj) { const u32x4 g = gv[m][bj]; f32x4 v0 = acc[ai][bj][m][0], v1 = acc[ai][bj][m][1];
                    v0[0] *= bflo(g.x); v0[1] *= bfhi(g.x); v0[2] *= bflo(g.y); v0[3] *= bfhi(g.y); v1[0] *= bflo(g.z); v1[1] *= bfhi(g.z); v1[2] *= bflo(g.w); v1[3] *= bfhi(g.w);
                    if (MODE == 1) { const u32x4 o = ov[m][bj];
                        v0[0] += bflo(o.x); v0[1] += bfhi(o.x); v0[2] += bflo(o.y); v0[3] += bfhi(o.y); v1[0] += bflo(o.z); v1[1] += bfhi(o.z); v1[2] += bflo(o.w); v1[3] += bfhi(o.w); }
                    __builtin_amdgcn_raw_buffer_store_b128(pack8(v0, v1), rs, (unsigned)((size_t)((const char*)(mp + bj * HALF) - (const char*)M1)), 0,   16); } }
            asm volatile("" ::: "memory"); }
    }
};

template <bool LAT_BASE_BF16> struct EpiRes {
    static constexpr bool PERM = true;
    const float* base_lat_f32; bf16_t* xr; const float* base_ctx; float* out_ctx; const float* gate;
    __device__ __forceinline__ void operator()(f32x4 (&acc)[2][2][4][2], const Unit& u, int wr, int wc, int fr, int fq, PG8_LAS unsigned char*) const {
        const bool lat = u.pm < 64;
        const int row0 = (lat ? u.pm : u.pm - 64) * BM + wr * 64 + fr, col0 = u.pn * BM + wc * 32 + 8 * fq;
        const float* gp = gate + (lat ? (u.pm >> 4) : 4) * 6144 + col0;
        f32x4 gv[2][2];
#pragma unroll
        for (int bj = 0; bj < 2; ++bj)
#pragma unroll
            for (int n = 0; n < 2; ++n) gv[bj][n] = *(const f32x4*)(gp + bj * HALF + 4 * n);
        if (lat && LAT_BASE_BF16) {
#pragma unroll
            for (int ai = 0; ai < 2; ++ai) {
                u32x4 bb[4][2];
#pragma unroll
                for (int m = 0; m < 4; ++m)
#pragma unroll
                    for (int bj = 0; bj < 2; ++bj) bb[m][bj] = *(const u32x4*)(xr + (size_t)(row0 + ai * HALF + m * 16) * 2048 + col0 + bj * HALF);
#pragma unroll
                for (int m = 0; m < 4; ++m)
#pragma unroll
                    for (int bj = 0; bj < 2; ++bj) { const u32x4 o = bb[m][bj]; f32x4 v0 = gv[bj][0] * acc[ai][bj][m][0], v1 = gv[bj][1] * acc[ai][bj][m][1];
                        v0[0] += bflo(o.x); v0[1] += bfhi(o.x); v0[2] += bflo(o.y); v0[3] += bfhi(o.y); v1[0] += bflo(o.z); v1[1] += bfhi(o.z); v1[2] += bflo(o.w); v1[3] += bfhi(o.w);
                        *(u32x4*)(xr + (size_t)(row0 + ai * HALF + m * 16) * 2048 + col0 + bj * HALF) = pack8(v0, v1); }
                asm volatile("" ::: "memory"); }
        } else {
            const float* base = lat ? base_lat_f32 : base_ctx;
#pragma unroll
            for (int ai = 0; ai < 2; ++ai) {
                f32x4 bs[4][2][2];
#pragma unroll
                for (int m = 0; m < 4; ++m) { const size_t off = (size_t)(row0 + ai * HALF + m * 16) * 1024 + col0;
#pragma unroll
                    for (int bj = 0; bj < 2; ++bj)
#pragma unroll
                        for (int n = 0; n < 2; ++n) bs[m][bj][n] = *(const f32x4*)(base + off + bj * HALF + 4 * n); }
#pragma unroll
                for (int m = 0; m < 4; ++m) { const int r = row0 + ai * HALF + m * 16;
#pragma unroll
                    for (int bj = 0; bj < 2; ++bj) { const f32x4 v0 = bs[m][bj][0] + gv[bj][0] * acc[ai][bj][m][0], v1 = bs[m][bj][1] + gv[bj][1] * acc[ai][bj][m][1];
                        if (lat) *(u32x4*)(xr + (size_t)r * 2048 + col0 + bj * HALF) = pack8(v0, v1);
                        else { float* op = out_ctx + (size_t)r * 1024 + col0 + bj * HALF; *(f32x4*)op = v0; *(f32x4*)(op + 4) = v1; } } }
                asm volatile("" ::: "memory"); }
        }
    }
};

struct SplitKOrder {
    int G, c;
    __device__ __forceinline__ bool next(int i, Unit& u) const { const int L = i * G + c; if (L >= 176) return false; const int ks = L % 11, tile = L / 11; u.pm = 64 + (tile >> 2); u.pn = (tile & 3) + 4 * ks; return true; }
    __device__ __forceinline__ size_t a_off(const Unit& u, const Gemm&, size_t tsA) const { return (size_t)u.pm * tsA + (size_t)(u.pn >> 2) * 512; }
    __device__ __forceinline__ size_t b_off(const Unit& u, const Gemm&, size_t tsB) const { return (size_t)(u.pn & 3) * tsB + (size_t)(u.pn >> 2) * 512; }
    __device__ __forceinline__ void a_ready(const Unit&) const {}
    __device__ __forceinline__ void done(const Unit&) const {}
};
struct EpiPart {
    static constexpr bool PERM = true;
    float* P;
    __device__ __forceinline__ void operator()(f32x4 (&acc)[2][2][4][2], const Unit& u, int wr, int wc, int fr, int fq, PG8_LAS unsigned char*) const {
        const int ks = u.pn >> 2, row0 = (u.pm - 64) * BM + wr * 64 + fr, col0 = (u.pn & 3) * BM + wc * 32 + 8 * fq;
#pragma unroll
        for (int ai = 0; ai < 2; ++ai)
#pragma unroll
            for (int m = 0; m < 4; ++m) { float* op = P + ((size_t)ks * 1024 + row0 + ai * HALF + m * 16) * 1024 + col0;
#pragma unroll
                for (int bj = 0; bj < 2; ++bj) { *(f32x4*)(op + bj * HALF) = acc[ai][bj][m][0]; *(f32x4*)(op + bj * HALF + 4) = acc[ai][bj][m][1]; } }
    }
};

struct EpiSwiglu {
    static constexpr bool PERM = true;
    bf16_t* ACT;
    __device__ __forceinline__ void operator()(f32x4 (&acc)[2][2][4][2], const Unit& u, int wr, int wc, int fr, int fq, PG8_LAS unsigned char*) const {
        const int row0 = u.pm * BM + wr * 64 + fr, j0 = u.pn * 128 + wc * 32 + 8 * fq;
#pragma unroll
        for (int ai = 0; ai < 2; ++ai)
#pragma unroll
            for (int m = 0; m < 4; ++m) { bf16_t* rowp = ACT + (size_t)(row0 + ai * HALF + m * 16) * 2816 + j0;
                const f32x4 a0 = acc[ai][0][m][0], b0 = acc[ai][0][m][1], a1 = acc[ai][1][m][0], b1 = acc[ai][1][m][1];
                u32x4 w; w.x = cvt_pk_bf16(silu(a0[0]) * b0[0], silu(a0[1]) * b0[1]); w.y = cvt_pk_bf16(silu(a0[2]) * b0[2], silu(a0[3]) * b0[3]);
                w.z = cvt_pk_bf16(silu(a1[0]) * b1[0], silu(a1[1]) * b1[1]); w.w = cvt_pk_bf16(silu(a1[2]) * b1[2], silu(a1[3]) * b1[3]);
                *(u32x4*)rowp = w; }
    }
};

template <class Epi, class Sched, bool ALIGN_EPI = true, bool SP2 = true>
__device__ __forceinline__ void gemm_phase(PG8_LAS unsigned char* lds, PG8_LAS unsigned char* xl, const Gemm g, const Sched& S, const Epi& E) {
    const int tid = opaque_v(tid_now()), wid = __builtin_amdgcn_readfirstlane(tid >> 6), lane = tid & 63, wr = wid >> 2, wc = wid & 3, fr = lane & 15, fq = lane >> 4;
    const int K = g.K, nt = K / BK;
    unsigned voffA[2], voffB[2];
#pragma unroll
    for (int i = 0; i < 2; ++i) { int R, C; stage_rc(tid * 16 + i * 8192, R, C); const int Rb = Epi::PERM ? ((R & ~31) + perm32(R & 31)) : R;
        voffA[i] = (unsigned)(R * g.lda + C) * 2u; voffB[i] = (unsigned)(Rb * g.ldb + C) * 2u; }
    const size_t kstep = (size_t)(BK * 2);
    const size_t hsA = (size_t)HALF * g.lda * 2, hsB = (size_t)HALF * g.ldb * 2;
    const size_t tsA = 2 * hsA, tsB = 2 * hsB;
    const unsigned ldsw = (unsigned)wid * 1024u;
    const int aoff = lds_byte(wr * 64 + fr, fq * 8), boff = lds_byte(wc * 32 + fr, fq * 8);
#define PG8_SA(b, h) (((b) * 2 + (h)) * HTB)
#define PG8_SB(b, h) ((4 + (b) * 2 + (h)) * HTB)
#define PG8_STAGE(bufoff, gbase, voff) do { _Pragma("unroll") for (int _i = 0; _i < 2; ++_i) \
        __builtin_amdgcn_global_load_lds((const unsigned*)((const char*)(gbase) + (voff)[_i]), (PG8_LAS unsigned*)(lds + (bufoff) + ldsw + _i * 8192), 16, 0, 0); } while (0)
#define PG8_LDA(dst, b, h) do { _Pragma("unroll") for (int m = 0; m < 4; ++m) _Pragma("unroll") for (int k = 0; k < 2; ++k) dst[m][k] = *(const PG8_LAS bf16x8*)(lds + PG8_SA(b, h) + aoff + m * 2048 + k * 1024); } while (0)
#define PG8_LDB(dst, b, h) do { _Pragma("unroll") for (int n = 0; n < 2; ++n) _Pragma("unroll") for (int k = 0; k < 2; ++k) dst[n][k] = *(const PG8_LAS bf16x8*)(lds + PG8_SB(b, h) + boff + n * 2048 + k * 1024); } while (0)
#define PG8_MMA(ai, bj, At, Bt) do { __builtin_amdgcn_s_setprio(1); _Pragma("unroll") for (int m = 0; m < 4; ++m) _Pragma("unroll") for (int n = 0; n < 2; ++n) _Pragma("unroll") for (int k = 0; k < 2; ++k) \
        acc[ai][bj][m][n] = __builtin_amdgcn_mfma_f32_16x16x32_bf16(Bt[n][k], At[m][k], acc[ai][bj][m][n], 0, 0, 0); __builtin_amdgcn_s_setprio(0); } while (0)
#define PG8_WAIT_V(n) asm volatile("s_waitcnt vmcnt(" #n ")" ::: "memory")
#define PG8_WAIT_L(n) asm volatile("s_waitcnt lgkmcnt(" #n ")" ::: "memory")
#define PG8_BAR __builtin_amdgcn_s_barrier()
#define PG8_SCHED __builtin_amdgcn_sched_barrier(0)
    Unit cur, nxt; int ui = 0;
    if (!S.next(0, cur)) return;
    f32x4 acc[2][2][4][2];
#pragma unroll
    for (int a = 0; a < 2; ++a)
#pragma unroll
        for (int b = 0; b < 2; ++b)
#pragma unroll
            for (int m = 0; m < 4; ++m)
#pragma unroll
                for (int n = 0; n < 2; ++n) acc[a][b][m][n] = (f32x4){0.f, 0.f, 0.f, 0.f};
    bf16x8 At[4][2], B0[2][2], B1[2][2];
    const char* cA = (const char*)g.A + S.a_off(cur, g, tsA); const char* cB = (const char*)g.Bt + S.b_off(cur, g, tsB);
    S.a_ready(cur);
    if constexpr (SP2) {
        PG8_STAGE(PG8_SB(0, 0), cB, voffB); PG8_STAGE(PG8_SB(0, 1), cB + hsB, voffB); PG8_STAGE(PG8_SA(0, 0), cA, voffA); PG8_STAGE(PG8_SA(0, 1), cA + hsA, voffA);
        if (wr == 1) PG8_BAR;
        PG8_WAIT_V(2); PG8_BAR;
        PG8_STAGE(PG8_SB(1, 0), cB + kstep, voffB); PG8_STAGE(PG8_SA(1, 0), cA + kstep, voffA); PG8_STAGE(PG8_SB(1, 1), cB + hsB + kstep, voffB);
        PG8_WAIT_V(6); PG8_BAR;
    } else {
        PG8_STAGE(PG8_SB(0, 0), cB, voffB); PG8_STAGE(PG8_SA(0, 0), cA, voffA); PG8_STAGE(PG8_SB(0, 1), cB + hsB, voffB); PG8_STAGE(PG8_SA(0, 1), cA + hsA, voffA);
        if (wr == 1) PG8_BAR;
        PG8_WAIT_V(4); PG8_BAR;
        PG8_STAGE(PG8_SB(1, 0), cB + kstep, voffB); PG8_STAGE(PG8_SA(1, 0), cA + kstep, voffA); PG8_STAGE(PG8_SB(1, 1), cB + hsB + kstep, voffB);
        PG8_WAIT_V(6); PG8_BAR;
    }
    for (;;) {
        const bool has_next = S.next(ui + 1, nxt);
        const char* nA = has_next ? (const char*)g.A + S.a_off(nxt, g, tsA) : cA; const char* nB = has_next ? (const char*)g.Bt + S.b_off(nxt, g, tsB) : cB;
        for (int t = 0; t < nt; t += 2) {
            const bool last = (t == nt - 2);
            const char* a1 = cA + (size_t)(t + 1) * kstep;
            const char* a2 = last ? nA : cA + (size_t)(t + 2) * kstep; const char* b2 = last ? nB : cB + (size_t)(t + 2) * kstep;
            const char* a3 = a2 + kstep; const char* b3 = b2 + kstep;
            if (last && has_next) S.a_ready(nxt);
            if constexpr (SP2) {
            PG8_LDB(B0, 0, 0); PG8_LDB(B1, 0, 1); PG8_SCHED; PG8_LDA(At, 0, 0); PG8_STAGE(PG8_SA(1, 1), a1 + hsA, voffA);
            PG8_WAIT_V(8); PG8_WAIT_L(0); PG8_BAR; PG8_MMA(0, 0, At, B0); PG8_MMA(0, 1, At, B1); PG8_BAR; PG8_SCHED;
            PG8_LDA(At, 0, 1); PG8_STAGE(PG8_SB(0, 0), b2, voffB); PG8_STAGE(PG8_SB(0, 1), b2 + hsB, voffB); PG8_STAGE(PG8_SA(0, 0), a2, voffA);
            PG8_WAIT_V(8); PG8_WAIT_L(0); PG8_BAR; PG8_MMA(1, 0, At, B0); PG8_MMA(1, 1, At, B1); PG8_BAR; PG8_SCHED;
            PG8_LDB(B0, 1, 0); PG8_LDB(B1, 1, 1); PG8_SCHED; PG8_LDA(At, 1, 0); PG8_STAGE(PG8_SA(0, 1), a2 + hsA, voffA);
            PG8_WAIT_V(8); PG8_WAIT_L(0); PG8_BAR; PG8_MMA(0, 0, At, B0); PG8_MMA(0, 1, At, B1); PG8_BAR; PG8_SCHED;
            PG8_LDA(At, 1, 1); PG8_STAGE(PG8_SB(1, 0), b3, voffB); PG8_STAGE(PG8_SB(1, 1), b3 + hsB, voffB); PG8_STAGE(PG8_SA(1, 0), a3, voffA);
            PG8_WAIT_V(8); PG8_WAIT_L(0); PG8_BAR; PG8_MMA(1, 0, At, B0); PG8_MMA(1, 1, At, B1); PG8_BAR; PG8_SCHED;
            } else {
            PG8_LDB(B0, 0, 0); PG8_SCHED; PG8_LDA(At, 0, 0); PG8_STAGE(PG8_SA(1, 1), a1 + hsA, voffA);
            PG8_WAIT_L(8); PG8_BAR; PG8_WAIT_L(0); PG8_MMA(0, 0, At, B0); PG8_BAR; PG8_SCHED;
            PG8_LDB(B1, 0, 1); PG8_STAGE(PG8_SB(0, 0), b2, voffB);
            PG8_BAR; PG8_WAIT_L(0); PG8_MMA(0, 1, At, B1); PG8_BAR;
            PG8_LDA(At, 0, 1); PG8_STAGE(PG8_SA(0, 0), a2, voffA);
            PG8_BAR; PG8_WAIT_L(0); PG8_MMA(1, 0, At, B0); PG8_BAR; PG8_SCHED;
            PG8_STAGE(PG8_SB(0, 1), b2 + hsB, voffB);
            PG8_WAIT_V(6); PG8_BAR; PG8_MMA(1, 1, At, B1); PG8_BAR;
            PG8_LDB(B0, 1, 0); PG8_SCHED; PG8_LDA(At, 1, 0); PG8_STAGE(PG8_SA(0, 1), a2 + hsA, voffA);
            PG8_WAIT_L(8); PG8_BAR; PG8_WAIT_L(0); PG8_MMA(0, 0, At, B0); PG8_BAR; PG8_SCHED;
            PG8_LDB(B1, 1, 1); PG8_STAGE(PG8_SB(1, 0), b3, voffB);
            PG8_BAR; PG8_WAIT_L(0); PG8_MMA(0, 1, At, B1); PG8_BAR;
            PG8_LDA(At, 1, 1); PG8_STAGE(PG8_SA(1, 0), a3, voffA);
            PG8_BAR; PG8_WAIT_L(0); PG8_MMA(1, 0, At, B0); PG8_BAR; PG8_SCHED;
            PG8_STAGE(PG8_SB(1, 1), b3 + hsB, voffB);
            PG8_WAIT_V(6); PG8_BAR; PG8_MMA(1, 1, At, B1); PG8_BAR;
            }
        }
        if constexpr (ALIGN_EPI) { if (wr == 0) PG8_BAR; }
        E(acc, cur, wr, wc, fr, fq, xl); S.done(cur);
        if (!has_next) break;
#pragma unroll
        for (int a = 0; a < 2; ++a)
#pragma unroll
            for (int b = 0; b < 2; ++b)
#pragma unroll
                for (int m = 0; m < 4; ++m)
#pragma unroll
                    for (int n = 0; n < 2; ++n) acc[a][b][m][n] = (f32x4){0.f, 0.f, 0.f, 0.f};
        cur = nxt; cA = nA; cB = nB; ++ui;
        if constexpr (ALIGN_EPI) { if (wr == 1) PG8_BAR; }
    }
    PG8_WAIT_V(0);
    if constexpr (!ALIGN_EPI) { if (wr == 0) PG8_BAR; }
    PG8_BAR;
#undef PG8_SA
#undef PG8_SB
#undef PG8_STAGE
#undef PG8_LDA
#undef PG8_LDB
#undef PG8_MMA
#undef PG8_WAIT_V
#undef PG8_WAIT_L
#undef PG8_BAR
#undef PG8_SCHED
}
}

#define GAS __attribute__((address_space(1)))
#define LAS __attribute__((address_space(3)))
typedef unsigned short bf16;
typedef unsigned v4u __attribute__((ext_vector_type(4)));
typedef unsigned v2u __attribute__((ext_vector_type(2)));
typedef float f32x4 __attribute__((ext_vector_type(4)));
#define LDS_WAIT() asm volatile("s_waitcnt lgkmcnt(0)" ::: "memory")
#define VM_WAIT() asm volatile("s_waitcnt vmcnt(0)" ::: "memory")

constexpr int D = 1024, NB = 4, SEQ = 4096, CTXL = 256, MLAT = NB * SEQ, MCTX = NB * CTXL, MTOT = MLAT + MCTX;
constexpr int DI = 2048, XBCW = 4096, NHEAD = 32, FFH = 2816, INC = 9280;
constexpr int NB1 = 4352  , NB2 = 5120  ;
constexpr int NWAVES = 8;

constexpr size_t MiB = 1u << 20;
constexpr size_t WS_CTL = 0, CTL_ZERO_BYTES = 1 * MiB;
constexpr size_t WS_MOD = 1 * MiB;
constexpr size_t WS_WIN = 2 * MiB;
constexpr size_t WS_WSSD = WS_WIN + (size_t)(NB1 + NB2) * 1024 * 2;
constexpr size_t WS_WPC = WS_WSSD + (size_t)1024 * 2048 * 2;
constexpr size_t WS_WOUT = WS_WPC + (size_t)1024 * 1024 * 2;
constexpr size_t WS_CX = WS_WOUT + (size_t)1024 * 1024 * 2;
constexpr size_t WS_H = WS_CX + (size_t)MCTX * D * 4;
constexpr size_t WS_DT = WS_H + (size_t)MTOT * D * 2;
constexpr size_t WS_Y = WS_DT + (size_t)MTOT * 64 * 4;
constexpr size_t WS_XBC = WS_Y + (size_t)MTOT * DI * 2;
constexpr size_t WS_END = WS_XBC + (size_t)MTOT * XBCW * 2;
constexpr size_t XO_GATES = 0, XO_UPOOL = (size_t)MTOT * 2048 * 2, XO_M1 = XO_UPOOL + (size_t)MTOT * 1024 * 2;
constexpr size_t XO_ACT = 0, XO_WGU = (size_t)MTOT * FFH * 2, XO_WDN = XO_WGU + (size_t)2 * FFH * 1024 * 2;
static_assert(XO_M1 + (size_t)MTOT * 1024 * 2 <= (size_t)MTOT * XBCW * 2 && XO_WDN + (size_t)1024 * FFH * 2 <= (size_t)MTOT * XBCW * 2, "xbc overlay map");
constexpr int CW_BAR = 4096;
constexpr int CW_WORK = 12288;
constexpr int CW_CNT = 16384, CNT_ARR = 68 * 64;
__device__ __forceinline__ int cnt_off(int l, int kind) { return CW_CNT + (l * 8 + kind) * CNT_ARR; }
__device__ __forceinline__ pg8::pg8_gu32* cnt_arr(unsigned char* ws, int l, int kind) { return (pg8::pg8_gu32*)(ws + WS_CTL) + cnt_off(l, kind); }

constexpr int RING_BYTES = 131072, LDS_BYTES = 163840  , XL_OFF = 155648  , MISC_OFF = 159744  ;

__device__ __forceinline__ unsigned pk2(float lo, float hi) { return pg8::cvt_pk_bf16(lo, hi); }
__device__ __forceinline__ float bf_lo(unsigned u) { return __uint_as_float(u << 16); }
__device__ __forceinline__ float bf_hi(unsigned u) { return __uint_as_float(u & 0xffff0000u); }

#define XB_TMO      128
#define XB_XCNT(j)  (256  + 64 * (j))
#define XB_XSUB(j)  (1280 + 64 * (j))
#define XB_XGEN(j)  (2304 + 64 * (j))
#define XB_TOP      3328
#define XB_TOPGEN   3392
#define XCD_BAR_WORDS 3456
#define XB_SPIN_CAP (1u << 20)
typedef GAS unsigned gu32;
__device__ __forceinline__ unsigned xb_ld(gu32* p)              { return __hip_atomic_load(p, __ATOMIC_RELAXED, __HIP_MEMORY_SCOPE_AGENT); }
__device__ __forceinline__ unsigned xb_add(gu32* p, unsigned v) { return __hip_atomic_fetch_add(p, v, __ATOMIC_RELAXED, __HIP_MEMORY_SCOPE_AGENT); }
__device__ __forceinline__ unsigned xb_xcc_id() { return (unsigned)__builtin_amdgcn_s_getreg((3 << 11) | 20) & 0xFu; }
#define XB_SPIN(cond, bar) do { unsigned _sp = 0; while (cond) { __builtin_amdgcn_s_sleep(1); \
    if ((++_sp & 255u) == 0u) { if (xb_ld(&(bar)[XB_TMO])) break; if (_sp > XB_SPIN_CAP) { xb_add(&(bar)[XB_TMO], 1u); break; } } } } while (0)
struct XcdBarrier { gu32* bar; unsigned x; volatile LAS unsigned* st; };
__device__ __forceinline__ XcdBarrier xcd_barrier_post(gu32* bar, volatile LAS unsigned* st) {
    XcdBarrier b; b.bar = bar; b.x = xb_xcc_id(); b.st = st;
    if (pg8::tid_now() == 0) (void)xb_add(&bar[XB_XCNT(b.x)], 1u);
    return b;
}
__device__ __forceinline__ void xcd_barrier_complete(gu32* bar, unsigned x, unsigned& nloc, unsigned& nx) {
    const unsigned G = gridDim.x * gridDim.y * gridDim.z;
    unsigned sum, cnt, mine, sp = 0u;
    for (;;) {
        sum = 0u; cnt = 0u; mine = 0u;
#pragma unroll
        for (unsigned j = 0; j < 16; ++j) { const unsigned c = xb_ld(&bar[XB_XCNT(j)]); sum += c; cnt += (c > 0u) ? 1u : 0u; mine = (j == x) ? c : mine; }
        if (sum == G) break;
        __builtin_amdgcn_s_sleep(1);
        if ((++sp & 255u) == 0u) { if (xb_ld(&bar[XB_TMO])) break; if (sp > XB_SPIN_CAP) { xb_add(&bar[XB_TMO], 1u); break; } }
    }
    nloc = mine > 0u ? mine : 1u; nx = cnt > 0u ? cnt : 1u;
}
__device__ __forceinline__ void xcd_barrier(const XcdBarrier& b) {
    asm volatile("s_waitcnt vmcnt(0)" ::: "memory");
    __syncthreads();
    if (pg8::tid_now() == 0) {
        gu32* bar = b.bar; unsigned bx_ = b.x;
        asm volatile("" : "+s"(bar), "+s"(bx_));
        __builtin_amdgcn_s_waitcnt(0);
        unsigned nloc = b.st[0], nx = b.st[1];
        if (nloc == 0u) { xcd_barrier_complete(bar, bx_, nloc, nx); b.st[0] = nloc; b.st[1] = nx; }
        const unsigned old = xb_add(&bar[XB_XSUB(bx_)], 1u);
        const unsigned gen = old / nloc;
        if (old + 1u == (gen + 1u) * nloc) {
            __builtin_amdgcn_fence(__ATOMIC_RELEASE, "agent");
            asm volatile("s_waitcnt vmcnt(0)" ::: "memory");
            const unsigned og = xb_add(&bar[XB_TOP], 1u);
            const unsigned tg = og / nx;
            if (og + 1u == (tg + 1u) * nx) xb_add(&bar[XB_TOPGEN], 1u);
            else XB_SPIN(xb_ld(&bar[XB_TOPGEN]) == tg, bar);
            __builtin_amdgcn_fence(__ATOMIC_ACQUIRE, "agent");
            xb_add(&bar[XB_XGEN(bx_)], 1u);
            asm volatile("s_waitcnt vmcnt(0)" ::: "memory");
        } else {
            XB_SPIN(xb_ld(&bar[XB_XGEN(bx_)]) == gen, bar);
            __builtin_amdgcn_fence(__ATOMIC_ACQUIRE, "agent");
            asm volatile("s_waitcnt vmcnt(0)" ::: "memory");
        }
    }
    __syncthreads();
}

__device__ __forceinline__ float wave_sum(float v) {
    v += pg8::lane_xor<1>(v); v += pg8::lane_xor<2>(v); v += pg8::lane_xor<4>(v); v += pg8::lane_xor<8>(v); v += pg8::lane_xor<16>(v);
    return pg8::half_sum(v);
}

template <int MODE> __device__ __forceinline__ int srccol(int n) {
    if (MODE == 0) {
        if (n < 4096) return 2048 + n;
        if (n < 4160) return 6144 + (n - 4096);
        if (n < 4352) return -1;
        if (n < 6400) return n - 4352;
        if (n < 7424) return 6208 + (n - 6400);
        return 7232 + (n - 7424);
    }
    if (MODE == 2) { const int pn = n >> 8, c = n & 255, bj = c >> 7, wc = (c >> 5) & 3, fq = (c >> 3) & 3, sel = (c >> 2) & 1, j = pn * 128 + wc * 32 + 8 * fq + 4 * bj + (c & 3); return sel * FFH + j; }
    return n;
}
struct Args { const float* in[23]; float* out; unsigned char* ws; };
typedef const __attribute__((address_space(4))) unsigned long long* KA;
__device__ __forceinline__ KA ka_fresh() { KA p = (KA)__builtin_amdgcn_kernarg_segment_ptr(); asm volatile("" : "+s"(p)); return p; }
#define KIN(ka, k) ((const float*)(const GAS float*)(ka)[k])
#define KOUT(ka) ((float*)(GAS float*)(ka)[23])
#define KWS(ka) ((unsigned char*)(GAS unsigned char*)(ka)[24])

struct Ids { int tid, lane, wave, G, bx, vcu, gw, NGW; };
__device__ __forceinline__ Ids fresh(Ids I) { I.wave = pg8::opaque_s(pg8::wave_now()); I.tid = pg8::opaque_v(I.wave * 64 + pg8::lane_now()); I.lane = I.tid & 63; I.vcu = pg8::opaque_s(I.vcu); I.bx = pg8::opaque_s(I.bx); I.gw = I.vcu * NWAVES + I.wave; return I; }

struct ConvJob { const float* W; bf16* WT; const float* kscale; int K, Nsrc, Ndst, mode, item; };
__device__ __forceinline__ int srccol_rt(int mode, int n) { return mode == 0 ? srccol<0>(n) : (mode == 2 ? srccol<2>(n) : n); }
__device__ __forceinline__ void conv_load(const ConvJob& j, int lane, f32x4 (&v)[8]) {
    const int nblk = j.Ndst / 32, kb = j.item / nblk, nb = j.item % nblk, k0 = 64 * kb, n0 = 32 * nb;
    const int r8 = lane >> 3, c4 = lane & 7, sc = srccol_rt(j.mode, n0 + 4 * c4);
#pragma unroll
    for (int i = 0; i < 8; ++i) v[i] = sc >= 0 ? *(const f32x4*)(j.W + (size_t)(k0 + 8 * i + r8) * j.Nsrc + sc) : (f32x4){0.f, 0.f, 0.f, 0.f};
}
__device__ __forceinline__ void conv_store(const ConvJob& j, int lane, const f32x4 (&v)[8], LAS float* scr) {
    const int nblk = j.Ndst / 32, kb = j.item / nblk, nb = j.item % nblk, k0 = 64 * kb, n0 = 32 * nb;
    const int r8 = lane >> 3, c4 = lane & 7;
#pragma unroll
    for (int i = 0; i < 8; ++i) { const int kk = 8 * i + r8; f32x4 t = v[i]; if (j.kscale) t = t * j.kscale[k0 + kk];
        LAS float* d = scr + kk * 33 + 4 * c4; d[0] = t.x; d[1] = t.y; d[2] = t.z; d[3] = t.w; }
    LDS_WAIT(); asm volatile("" ::: "memory");
    const int c = lane & 7;
#pragma unroll
    for (int q = 0; q < 4; ++q) { const int n = (lane >> 3) + 8 * q; const LAS float* sp = scr + (8 * c) * 33 + n;
        v4u o; o.x = pk2(sp[0 * 33], sp[1 * 33]); o.y = pk2(sp[2 * 33], sp[3 * 33]); o.z = pk2(sp[4 * 33], sp[5 * 33]); o.w = pk2(sp[6 * 33], sp[7 * 33]);
        *(v4u*)(j.WT + (size_t)(n0 + n) * j.K + k0 + 8 * c) = o; }
    LDS_WAIT(); asm volatile("" ::: "memory");
}
__device__ __forceinline__ ConvJob conv_job(KA ka, unsigned char* ws, int which, int l, int it) {
    ConvJob j;
    if (which == 0) {
        constexpr int I_IN = 16 * ((NB1 + NB2) / 32), I_SSD = 32 * 32;
        if (it < I_IN) { j.W = KIN(ka, 7) + (size_t)l * D * INC; j.WT = (bf16*)(ws + WS_WIN); j.kscale = nullptr; j.K = D; j.Nsrc = INC; j.Ndst = NB1 + NB2; j.mode = 0; j.item = it; }
        else if (it < I_IN + I_SSD) { j.W = KIN(ka, 14) + (size_t)l * DI * D; j.WT = (bf16*)(ws + WS_WSSD); j.kscale = KIN(ka, 13) + (size_t)l * DI; j.K = DI; j.Nsrc = D; j.Ndst = D; j.mode = 1; j.item = it - I_IN; }
        else { j.W = KIN(ka, 18) + (size_t)l * D * D; j.WT = (bf16*)(ws + WS_WOUT); j.kscale = nullptr; j.K = D; j.Nsrc = D; j.Ndst = D; j.mode = 1; j.item = it - I_IN - I_SSD; }
    } else {
        constexpr int I_GU = 16 * (2 * FFH / 32);
        if (it < I_GU) { j.W = KIN(ka, 20) + (size_t)l * D * 2 * FFH; j.WT = (bf16*)(ws + WS_XBC + XO_WGU); j.kscale = nullptr; j.K = D; j.Nsrc = 2 * FFH; j.Ndst = 2 * FFH; j.mode = 2; j.item = it; }
        else { j.W = KIN(ka, 21) + (size_t)l * FFH * D; j.WT = (bf16*)(ws + WS_XBC + XO_WDN); j.kscale = nullptr; j.K = FFH; j.Nsrc = D; j.Ndst = D; j.mode = 1; j.item = it - I_GU; }
    }
    return j;
}
__device__ __forceinline__ void conv_pass(const Ids I, LAS unsigned char* lds, KA ka, unsigned char* ws, int which, int l, int it0, int nit, int gw, int ngw) {
    LAS float* scr = (LAS float*)(lds + I.wave * 8448);
    f32x4 va[8], vb[8], vc[8];
    for (int it = it0 + gw; it < nit; it += 3 * ngw) {
        const bool h1 = it + ngw < nit, h2 = it + 2 * ngw < nit;
        const ConvJob ja = conv_job(ka, ws, which, l, it); conv_load(ja, I.lane, va);
        ConvJob jb = ja, jc = ja;
        if (h1) { jb = conv_job(ka, ws, which, l, it + ngw); conv_load(jb, I.lane, vb); }
        if (h2) { jc = conv_job(ka, ws, which, l, it + 2 * ngw); conv_load(jc, I.lane, vc); }
        conv_store(ja, I.lane, va, scr);
        if (h1) conv_store(jb, I.lane, vb, scr);
        if (h2) conv_store(jc, I.lane, vc, scr);
    }
}

__device__ __forceinline__ void norm_row(const float* xrow, bf16* orow, const float* g, const float* sh, const float* sc, int lane) {
    const f32x4* xr = (const f32x4*)xrow + lane;
    f32x4 v[4]; float s = 0.f;
#pragma unroll
    for (int j = 0; j < 4; ++j) { v[j] = xr[64 * j]; s += (v[j].x * v[j].x + v[j].y * v[j].y) + (v[j].z * v[j].z + v[j].w * v[j].w); }
    const float rstd = rsqrtf(wave_sum(s) * (1.f / D) + 1e-6f);
    unsigned long long* o8 = (unsigned long long*)orow + lane;
#pragma unroll
    for (int j = 0; j < 4; ++j) { const f32x4 gg = ((const f32x4*)g)[lane + 64 * j], s1 = ((const f32x4*)sc)[lane + 64 * j], s0 = ((const f32x4*)sh)[lane + 64 * j];
        const f32x4 y = v[j] * rstd * gg * (s1 + 1.0f) + s0;
        o8[64 * j] = (unsigned long long)pk2(y.x, y.y) | ((unsigned long long)pk2(y.z, y.w) << 32); }
}

__device__ __forceinline__ void conv_mixer(const Ids I_, LAS unsigned char* lds, int l, bool skip_win = false) {
    const Ids I = fresh(I_);
    const KA ka = ka_fresh(); unsigned char* ws = KWS(ka);
    conv_pass(I, lds, ka, ws, 0, l, skip_win ? 16 * ((NB1 + NB2) / 32) : 0, 16 * ((NB1 + NB2) / 32) + 32 * 32 + 16 * 32, I.gw, I.NGW);
    const float* pw = KIN(ka, 15) + (size_t)l * 4 * 256 * 256; const float* psc = KIN(ka, 16) + (size_t)l * D; const float* wpo = KIN(ka, 17) + (size_t)l * D * D; bf16* WPC = (bf16*)(ws + WS_WPC);
    __syncthreads();
    for (int item = I.vcu; item < 256; item += I.G) {
        const int g = item >> 6, i0 = (item & 63) * 4, n = 2 * I.tid;
        LAS float* tab = (LAS float*)lds;
        for (int e = I.tid; e < 1024; e += NWAVES * 64) { const int q = e >> 8, o = e & 255; tab[o * 4 + q] = pw[((size_t)g * 256 + i0 + q) * 256 + o] * psc[g * 256 + o]; }
        __syncthreads();
        float a0[4] = {0.f, 0.f, 0.f, 0.f}, a1[4] = {0.f, 0.f, 0.f, 0.f};
        const float* wr_ = wpo + (size_t)g * 256 * D + n;
#pragma unroll 32
        for (int o = 0; o < 256; ++o) { const pg8::f32x2 wv = *(const pg8::f32x2*)(wr_ + (size_t)o * D); const f32x4 t = *(const LAS f32x4*)(tab + o * 4);
            a0[0] += t.x * wv.x; a0[1] += t.y * wv.x; a0[2] += t.z * wv.x; a0[3] += t.w * wv.x; a1[0] += t.x * wv.y; a1[1] += t.y * wv.y; a1[2] += t.z * wv.y; a1[3] += t.w * wv.y; }
        v2u o0, o1; o0.x = pk2(a0[0], a0[1]); o0.y = pk2(a0[2], a0[3]); o1.x = pk2(a1[0], a1[1]); o1.y = pk2(a1[2], a1[3]);
        *(v2u*)(WPC + (size_t)n * D + g * 256 + i0) = o0; *(v2u*)(WPC + (size_t)(n + 1) * D + g * 256 + i0) = o1;
        __syncthreads();
    }
}
__device__ __forceinline__ void conv_ffn(const Ids I_, LAS unsigned char* lds, int l) {
    const Ids I = fresh(I_);
    const KA ka = ka_fresh(); unsigned char* ws = KWS(ka);
    conv_pass(I, lds, ka, ws, 1, l, 0, 16 * (2 * FFH / 32) + (FFH / 64) * 32, I.gw, I.NGW);
}

__device__ __forceinline__ void conv_win_dyn(const Ids I_, LAS unsigned char* lds, int l) {
    const Ids I = fresh(I_);
    const KA ka = ka_fresh(); unsigned char* ws = KWS(ka);
    constexpr int NIT = 16 * ((NB1 + NB2) / 32), NCH = (NIT + 23) / 24;
    pg8::pg8_gu32* work = (pg8::pg8_gu32*)(ws + WS_CTL) + CW_WORK + 64 * 4;
    volatile LAS unsigned* slot = (volatile LAS unsigned*)(lds + MISC_OFF) + 48;
    if (I.tid == 0) slot[0] = __hip_atomic_fetch_add(work, 1u, __ATOMIC_RELAXED, __HIP_MEMORY_SCOPE_AGENT);
    __syncthreads();
    int ch = (int)slot[0], par = 0;
    while (ch < NCH) {
        unsigned nclaim = 0u;
        if (I.tid == 0) nclaim = __hip_atomic_fetch_add(work, 1u, __ATOMIC_RELAXED, __HIP_MEMORY_SCOPE_AGENT);
        { const int e = 24 * ch + 24; conv_pass(I, lds, ka, ws, 0, l, 24 * ch, e < NIT ? e : NIT, I.wave, NWAVES); }
        if (I.tid == 0) slot[par ^ 1] = nclaim;
        __syncthreads();
        par ^= 1; ch = (int)slot[par];
    }
}

__device__ __forceinline__ void phase_mod(const Ids I_, LAS unsigned char* lds) {
    const Ids I = fresh(I_);
    const KA ka = ka_fresh(); float* MOD = (float*)(KWS(ka) + WS_MOD);
    LAS float* sv = (LAS float*)lds;
    LAS float* red = (LAS float*)(lds + 20480);
    if (I.bx < 192) {
        const float* cvec = KIN(ka, 1); const float* cctx = KIN(ka, 3);
        for (int i = I.tid; i < 5 * 1024; i += NWAVES * 64) { const int c = i >> 10, k = i & 1023; const float v = c < 4 ? cvec[c * 1024 + k] : cctx[k]; sv[i] = v / (1.f + __expf(-v)); }
        __syncthreads();
        for (int item = I.bx; item < 192; item += I.G) {
            const int l = item / 96, c0 = (item % 96) * 64, kg = I.tid >> 4, cq = I.tid & 15;
            const float* w = KIN(ka, 4) + (size_t)l * D * 6144 + c0 + 4 * cq;
            f32x4 a[5];
#pragma unroll
            for (int c = 0; c < 5; ++c) a[c] = (f32x4){0.f, 0.f, 0.f, 0.f};
#pragma unroll 16
            for (int k = kg * 32; k < kg * 32 + 32; ++k) { const f32x4 wv = *(const f32x4*)(w + (size_t)k * 6144);
#pragma unroll
                for (int c = 0; c < 5; ++c) a[c] += wv * sv[c * 1024 + k]; }
#pragma unroll
            for (int c = 0; c < 5; ++c) *(LAS f32x4*)(red + (kg * 5 + c) * 64 + 4 * cq) = a[c];
            __syncthreads();
            if (I.tid < 320) { const int c = I.tid >> 6, col = I.tid & 63; float s = KIN(ka, 5)[l * 6144 + c0 + col];
#pragma unroll 8
                for (int q = 0; q < 32; ++q) s += red[(q * 5 + c) * 64 + col];
                MOD[((size_t)l * 5 + c) * 6144 + c0 + col] = s; }
            __syncthreads();
        }
    }
    __syncthreads();
}

__device__ __forceinline__ void phase_norm(const Ids I_, int l, int which  , int nrows, bool from_input) {
    const Ids I = fresh(I_);
    const KA ka = ka_fresh(); unsigned char* ws = KWS(ka);
    const float* modl = (const float*)(ws + WS_MOD) + (size_t)l * 5 * 6144 + which * 3072;
    const float* g = KIN(ka, which ? 19 : 6) + l * D;
    const float* xlat = from_input ? KIN(ka, 0) : KOUT(ka); const float* xctx = from_input ? KIN(ka, 2) : (const float*)(ws + WS_CX);
    bf16* H = (bf16*)(ws + WS_H);
    const bf16* xr = (const bf16*)KOUT(ka);
    const bool parts = (l == 1 && which == 0);
    const float* PP = (const float*)(ws + WS_Y); const float* gctx = (const float*)(ws + WS_MOD) + 5120 + 4 * 6144;
    f32x4 nxa[4], nxb[4];
#define NORM_LOAD(nx, mm) do { if ((mm) < MLAT && !from_input) { const v2u* q_ = (const v2u*)(xr + (size_t)(mm) * 2048) + I.lane; \
            _Pragma("unroll") for (int j = 0; j < 4; ++j) { const v2u t_ = q_[64 * j]; nx[j] = (f32x4){bf_lo(t_.x), bf_hi(t_.x), bf_lo(t_.y), bf_hi(t_.y)}; } } \
        else { const f32x4* q_ = (const f32x4*)((mm) < MLAT ? KIN(ka, 0) + (size_t)(mm) * D : xctx + (size_t)((mm) - MLAT) * D) + I.lane; \
            _Pragma("unroll") for (int j = 0; j < 4; ++j) nx[j] = q_[64 * j]; \
            if (parts && (mm) >= MLAT) { f32x4 s_[4]; _Pragma("unroll") for (int j = 0; j < 4; ++j) s_[j] = (f32x4){0.f, 0.f, 0.f, 0.f}; \
                _Pragma("unroll 4") for (int ks_ = 0; ks_ < 11; ++ks_) { const f32x4* p_ = (const f32x4*)(PP + ((size_t)ks_ * 1024 + ((mm) - MLAT)) * 1024) + I.lane; _Pragma("unroll") for (int j = 0; j < 4; ++j) s_[j] += p_[64 * j]; } \
                _Pragma("unroll") for (int j = 0; j < 4; ++j) nx[j] += ((const f32x4*)gctx)[I.lane + 64 * j] * s_[j]; } } } while (0)
#define NORM_ROW(nx, mm) do { f32x4 v[4]; float ss = 0.f; \
        _Pragma("unroll") for (int j = 0; j < 4; ++j) { v[j] = nx[j]; ss += (v[j].x * v[j].x + v[j].y * v[j].y) + (v[j].z * v[j].z + v[j].w * v[j].w); } \
        if ((mm) + 2 * I.NGW < nrows) NORM_LOAD(nx, (mm) + 2 * I.NGW); \
        const int cond = (mm) < MLAT ? (mm) / SEQ : 4; const float* sh = modl + cond * 6144; const float* sc = sh + 1024; \
        const float rstd = rsqrtf(wave_sum(ss) * (1.f / D) + 1e-6f); \
        unsigned long long* o8 = (unsigned long long*)(H + (size_t)(mm) * D) + I.lane; \
        _Pragma("unroll") for (int j = 0; j < 4; ++j) { const f32x4 gg = ((const f32x4*)g)[I.lane + 64 * j], s1 = ((const f32x4*)sc)[I.lane + 64 * j], s0 = ((const f32x4*)sh)[I.lane + 64 * j]; \
            const f32x4 y = v[j] * rstd * gg * (s1 + 1.0f) + s0; \
            o8[64 * j] = (unsigned long long)pk2(y.x, y.y) | ((unsigned long long)pk2(y.z, y.w) << 32); } } while (0)
    int m = I.gw;
    if (m < nrows) NORM_LOAD(nxa, m);
    if (m + I.NGW < nrows) NORM_LOAD(nxb, m + I.NGW);
    for (; m < nrows; m += 2 * I.NGW) {
        NORM_ROW(nxa, m);
        const int m1 = m + I.NGW; if (m1 >= nrows) break;
        NORM_ROW(nxb, m1);
    }
#undef NORM_ROW
#undef NORM_LOAD
}

__device__ __forceinline__ void phase_norm2_dyn(const Ids I_, LAS unsigned char* lds_base, int l, int nrows) {
    const Ids I = fresh(I_);
    const KA ka = ka_fresh(); unsigned char* ws = KWS(ka);
    const float* modl = (const float*)(ws + WS_MOD) + (size_t)l * 5 * 6144 + 3072;
    const float* g = KIN(ka, 19) + l * D;
    const float* xctx = (const float*)(ws + WS_CX); const bf16* xr = (const bf16*)KOUT(ka);
    bf16* H = (bf16*)(ws + WS_H);
    pg8::pg8_gu32* work = (pg8::pg8_gu32*)(ws + WS_CTL) + CW_WORK + 64 * (2 + l); pg8::pg8_gu32* cp_ = cnt_arr(ws, l, 4); pg8::pg8_gu32* tmo = (pg8::pg8_gu32*)(ws + WS_CTL) + CW_BAR + XB_TMO;
    const int nblk = nrows / 64;
#define N2_CLAIM_WAIT(claim_) do { const int b_ = (int)(claim_); \
        if (b_ < nblk) { unsigned sp_ = 0; \
            while (__hip_atomic_load(cp_ + 64 * (b_ >> 2), __ATOMIC_RELAXED, __HIP_MEMORY_SCOPE_AGENT) < 32u) { __builtin_amdgcn_s_sleep(2); \
                if ((++sp_ & 255u) == 0u) { if (__hip_atomic_load(tmo, __ATOMIC_RELAXED, __HIP_MEMORY_SCOPE_AGENT) != 0u) break; if (sp_ > (1u << 20)) { __hip_atomic_fetch_add(tmo, 1u, __ATOMIC_RELAXED, __HIP_MEMORY_SCOPE_AGENT); break; } } } \
            __builtin_amdgcn_fence(__ATOMIC_ACQUIRE, "agent"); asm volatile("s_waitcnt vmcnt(0)" ::: "memory"); } } while (0)
#define N2_LOAD(nx, mm) do { if ((mm) < MLAT) { const v2u* q_ = (const v2u*)(xr + (size_t)(mm) * 2048) + I.lane; \
            _Pragma("unroll") for (int j = 0; j < 4; ++j) { const v2u t_ = q_[64 * j]; nx[j] = (f32x4){bf_lo(t_.x), bf_hi(t_.x), bf_lo(t_.y), bf_hi(t_.y)}; } } \
        else { const f32x4* q_ = (const f32x4*)(xctx + (size_t)((mm) - MLAT) * D) + I.lane; _Pragma("unroll") for (int j = 0; j < 4; ++j) nx[j] = q_[64 * j]; } } while (0)
#define N2_ROW(nx, mm, mend) do { f32x4 v[4]; float ss = 0.f; \
        _Pragma("unroll") for (int j = 0; j < 4; ++j) { v[j] = nx[j]; ss += (v[j].x * v[j].x + v[j].y * v[j].y) + (v[j].z * v[j].z + v[j].w * v[j].w); } \
        if ((mm) + 16 < (mend)) N2_LOAD(nx, (mm) + 16); \
        const int cond = (mm) < MLAT ? (mm) / SEQ : 4; const float* sh = modl + cond * 6144; const float* sc = sh + 1024; \
        const float rstd = rsqrtf(wave_sum(ss) * (1.f / D) + 1e-6f); \
        unsigned long long* o8 = (unsigned long long*)(H + (size_t)(mm) * D) + I.lane; \
        _Pragma("unroll") for (int j = 0; j < 4; ++j) { const f32x4 gg = ((const f32x4*)g)[I.lane + 64 * j], s1 = ((const f32x4*)sc)[I.lane + 64 * j], s0 = ((const f32x4*)sh)[I.lane + 64 * j]; \
            const f32x4 y = v[j] * rstd * gg * (s1 + 1.0f) + s0; \
            o8[64 * j] = (unsigned long long)pk2(y.x, y.y) | ((unsigned long long)pk2(y.z, y.w) << 32); } } while (0)
    volatile LAS unsigned* slot = (volatile LAS unsigned*)(lds_base + MISC_OFF) + 44;
    if (I.tid == 0) { const unsigned c0 = __hip_atomic_fetch_add(work, 1u, __ATOMIC_RELAXED, __HIP_MEMORY_SCOPE_AGENT); N2_CLAIM_WAIT(c0); slot[0] = c0; }
    __syncthreads();
    int blk = (int)slot[0], par = 0;
    while (blk < nblk) {
        unsigned nclaim = 0u;
        if (I.tid == 0) nclaim = __hip_atomic_fetch_add(work, 1u, __ATOMIC_RELAXED, __HIP_MEMORY_SCOPE_AGENT);
        {
            const int mend = blk * 64 + 64; int m = blk * 64 + I.wave;
            f32x4 nxa[4], nxb[4];
            N2_LOAD(nxa, m); N2_LOAD(nxb, m + 8);
            for (; m < mend; m += 16) { N2_ROW(nxa, m, mend); N2_ROW(nxb, m + 8, mend); }
        }
        if (I.tid == 0) { N2_CLAIM_WAIT(nclaim); slot[par ^ 1] = nclaim; }
        __syncthreads();
        par ^= 1; blk = (int)slot[par];
    }
    if (I.tid < 64) {
        const int np = nrows / 256; unsigned sp = 0;
        for (;;) { bool ok = true; for (int p = I.lane; p < np; p += 64) ok = ok && __hip_atomic_load(cp_ + 64 * p, __ATOMIC_RELAXED, __HIP_MEMORY_SCOPE_AGENT) >= 32u;
            if (__builtin_amdgcn_ballot_w64(!ok) == 0ull) break;
            __builtin_amdgcn_s_sleep(127);
            if ((++sp & 15u) == 0u) { if (__hip_atomic_load(tmo, __ATOMIC_RELAXED, __HIP_MEMORY_SCOPE_AGENT) != 0u) break; if (sp > (1u << 14)) { if (I.tid == 0) __hip_atomic_fetch_add(tmo, 1u, __ATOMIC_RELAXED, __HIP_MEMORY_SCOPE_AGENT); break; } } }
    }
    __syncthreads();
#undef N2_ROW
#undef N2_LOAD
#undef N2_CLAIM_WAIT
}

__device__ const unsigned short CONV_PERM[544] = { 0, 1, 2, 3, 4, 5, 6, 73, 74, 75, 76, 77, 78, 137, 138, 139, 140, 141, 142, 209, 210, 211, 212, 213, 214, 273, 274, 275, 276, 277, 278, 345, 346, 347, 348, 349, 350, 409, 410, 411, 412, 413, 414, 481, 482, 483, 484, 485, 486, 7, 8, 9, 10, 11, 12, 13, 14, 15, 16, 17, 18, 19, 20, 21, 22, 79, 80, 81, 82, 83, 84, 85, 86, 87, 88, 89, 90, 91, 92, 93, 94, 143, 144, 145, 146, 147, 148, 149, 150, 151, 152, 153, 154, 155, 156, 157, 158, 215, 216, 217, 218, 219, 220, 221, 222, 223, 224, 225, 226, 227, 228, 229, 230, 279, 280, 281, 282, 283, 284, 285, 286, 287, 288, 289, 290, 291, 292, 293, 294, 351, 352, 353, 354, 355, 356, 357, 358, 359, 360, 361, 362, 363, 364, 365, 366, 415, 416, 417, 418, 419, 420, 421, 422, 423, 424, 425, 426, 427, 428, 429, 430, 487, 488, 489, 490, 491, 492, 493, 494, 495, 496, 497, 498, 499, 500, 501, 502, 23, 24, 25, 26, 27, 28, 29, 30, 31, 32, 33, 34, 35, 36, 37, 38, 95, 96, 97, 98, 99, 100, 101, 102, 103, 104, 105, 106, 107, 108, 109, 110, 159, 160, 161, 162, 163, 164, 165, 166, 167, 168, 169, 170, 171, 172, 173, 174, 231, 232, 233, 234, 235, 236, 237, 238, 239, 240, 241, 242, 243, 244, 245, 246, 295, 296, 297, 298, 299, 300, 301, 302, 303, 304, 305, 306, 307, 308, 309, 310, 367, 368, 369, 370, 371, 372, 373, 374, 375, 376, 377, 378, 379, 380, 381, 382, 431, 432, 433, 434, 435, 436, 437, 438, 439, 440, 441, 442, 443, 444, 445, 446, 503, 504, 505, 506, 507, 508, 509, 510, 511, 512, 513, 514, 515, 516, 517, 518, 39, 40, 41, 42, 43, 44, 45, 46, 47, 48, 49, 50, 51, 52, 53, 54, 111, 112, 113, 114, 115, 116, 117, 118, 119, 120, 121, 122, 123, 124, 125, 126, 175, 176, 177, 178, 179, 180, 181, 182, 183, 184, 185, 186, 187, 188, 189, 190, 247, 248, 249, 250, 251, 252, 253, 254, 255, 256, 257, 258, 259, 260, 261, 262, 311, 312, 313, 314, 315, 316, 317, 318, 319, 320, 321, 322, 323, 324, 325, 326, 383, 384, 385, 386, 387, 388, 389, 390, 391, 392, 393, 394, 395, 396, 397, 398, 447, 448, 449, 450, 451, 452, 453, 454, 455, 456, 457, 458, 459, 460, 461, 462, 519, 520, 521, 522, 523, 524, 525, 526, 527, 528, 529, 530, 531, 532, 533, 534, 55, 56, 57, 58, 59, 60, 61, 62, 63, 64, 65, 66, 67, 68, 69, 70, 71, 72, 127, 128, 129, 130, 131, 132, 133, 134, 135, 136, 191, 192, 193, 194, 195, 196, 197, 198, 199, 200, 201, 202, 203, 204, 205, 206, 207, 208, 263, 264, 265, 266, 267, 268, 269, 270, 271, 272, 327, 328, 329, 330, 331, 332, 333, 334, 335, 336, 337, 338, 339, 340, 341, 342, 343, 344, 399, 400, 401, 402, 403, 404, 405, 406, 407, 408, 463, 464, 465, 466, 467, 468, 469, 470, 471, 472, 473, 474, 475, 476, 477, 478, 479, 480, 535, 536, 537, 538, 539, 540, 541, 542, 543 };
__device__ __forceinline__ void phase_conv(const Ids I_, LAS unsigned char* lds_base, int l) {
    const Ids I = fresh(I_);
    const KA ka = ka_fresh(); unsigned char* ws = KWS(ka);
    bf16* XBC = (bf16*)(ws + WS_XBC); const bf16* HALO = (const bf16*)(ws + WS_Y);
    const int c0 = I.tid * 8;
    pg8::pg8_gu32* work = (pg8::pg8_gu32*)(ws + WS_CTL) + CW_WORK + 64 * (5 + l); const pg8::pg8_gu32* cb_ = cnt_arr(ws, l, 3); pg8::pg8_gu32* tmo = (pg8::pg8_gu32*)(ws + WS_CTL) + CW_BAR + XB_TMO;
#define CV_CLAIM_WAIT(claim_, out_) do { unsigned id_ = 0xffffu; \
        if ((claim_) < 544u) { id_ = CONV_PERM[claim_]; const int rb_ = 32 * (int)id_; const int p0_ = (rb_ - 2 < 0 ? 0 : rb_ - 2) >> 8, p1_ = (rb_ + 33 >= MTOT ? MTOT - 1 : rb_ + 33) >> 8; unsigned sp_ = 0; \
            for (;;) { bool ok_ = __hip_atomic_load(cb_ + 64 * p0_, __ATOMIC_RELAXED, __HIP_MEMORY_SCOPE_AGENT) >= 136u; if (ok_ && p1_ != p0_) ok_ = __hip_atomic_load(cb_ + 64 * p1_, __ATOMIC_RELAXED, __HIP_MEMORY_SCOPE_AGENT) >= 136u; \
                if (ok_) break; __builtin_amdgcn_s_sleep(2); \
                if ((++sp_ & 255u) == 0u) { if (__hip_atomic_load(tmo, __ATOMIC_RELAXED, __HIP_MEMORY_SCOPE_AGENT) != 0u) break; if (sp_ > (1u << 20)) { __hip_atomic_fetch_add(tmo, 1u, __ATOMIC_RELAXED, __HIP_MEMORY_SCOPE_AGENT); break; } } } \
            __builtin_amdgcn_fence(__ATOMIC_ACQUIRE, "agent"); asm volatile("s_waitcnt vmcnt(0)" ::: "memory"); } \
        out_ = id_; } while (0)
    volatile LAS unsigned* slot = (volatile LAS unsigned*)(lds_base + MISC_OFF) + 50;
    if (I.tid == 0) { const unsigned c0_ = __hip_atomic_fetch_add(work, 1u, __ATOMIC_RELAXED, __HIP_MEMORY_SCOPE_AGENT); unsigned id0; CV_CLAIM_WAIT(c0_, id0); slot[0] = id0; }
    __syncthreads();
    unsigned uid = slot[0]; int par = 0;
    const float* cw = KIN(ka, 8) + (size_t)l * 5 * XBCW + c0; const float* cb = KIN(ka, 9) + (size_t)l * XBCW + c0;
    float w[5][8], bias[8];
#pragma unroll
    for (int i = 0; i < 5; ++i) { const f32x4 a = *(const f32x4*)(cw + i * XBCW), b = *(const f32x4*)(cw + i * XBCW + 4); w[i][0] = a.x; w[i][1] = a.y; w[i][2] = a.z; w[i][3] = a.w; w[i][4] = b.x; w[i][5] = b.y; w[i][6] = b.z; w[i][7] = b.w; }
    { const f32x4 a = *(const f32x4*)cb, b = *(const f32x4*)(cb + 4); bias[0] = a.x; bias[1] = a.y; bias[2] = a.z; bias[3] = a.w; bias[4] = b.x; bias[5] = b.y; bias[6] = b.z; bias[7] = b.w; }
    const v4u zero4 = {0u, 0u, 0u, 0u};
    while (uid != 0xffffu) {
    unsigned nclaim = 0u;
    if (I.tid == 0) nclaim = __hip_atomic_fetch_add(work, 1u, __ATOMIC_RELAXED, __HIP_MEMORY_SCOPE_AGENT);
    const int u0 = (int)uid, rbase = 32 * u0;
#define LDROW(q_) ([&](int q) -> v4u { if (q < 0 || q >= MTOT) return zero4; \
        const bf16* p = q < rbase ? HALO + (size_t)((u0 - 1) * 4 + 2 + (q - (rbase - 2))) * XBCW : (q >= rbase + 32 ? HALO + (size_t)((u0 + 1) * 4 + (q - rbase - 32)) * XBCW : XBC + (size_t)q * XBCW); \
        return *(const v4u*)(p + c0); })(q_)
#define UNPK(dst, v_) do { dst[0] = bf_lo(v_.x); dst[1] = bf_hi(v_.x); dst[2] = bf_lo(v_.y); dst[3] = bf_hi(v_.y); dst[4] = bf_lo(v_.z); dst[5] = bf_hi(v_.z); dst[6] = bf_lo(v_.w); dst[7] = bf_hi(v_.w); } while (0)
    float f0[8], f1[8], f2[8], f3[8];
    { const v4u a0 = LDROW(rbase - 2), a1 = LDROW(rbase - 1), a2 = LDROW(rbase), a3 = LDROW(rbase + 1); UNPK(f0, a0); UNPK(f1, a1); UNPK(f2, a2); UNPK(f3, a3); }
    v4u q0 = LDROW(rbase + 2), q1 = LDROW(rbase + 3), q2 = LDROW(rbase + 4), q3 = LDROW(rbase + 5);
    for (int it = 0; it < 8; ++it) {
        const v4u c0v = q0, c1v = q1, c2v = q2, c3v = q3;
        const int nb = rbase + 2 + 4 * (it + 1);
        if (it + 1 < 8) { q0 = LDROW(nb); q1 = LDROW(nb + 1); q2 = LDROW(nb + 2); q3 = LDROW(nb + 3); }
#pragma unroll
        for (int k = 0; k < 4; ++k) {
            const v4u w4 = k == 0 ? c0v : (k == 1 ? c1v : (k == 2 ? c2v : c3v));
            float f4[8]; UNPK(f4, w4);
            const int r = rbase + 4 * it + k;
            const int s0 = r < MLAT ? (r & ~(SEQ - 1)) : (MLAT + ((r - MLAT) & ~(CTXL - 1))), e0 = s0 + (r < MLAT ? SEQ : CTXL);
            float o[8];
            if (r - 2 >= s0 && r + 2 < e0) {
#pragma unroll
                for (int j = 0; j < 8; ++j) o[j] = bias[j] + w[0][j] * f0[j] + w[1][j] * f1[j] + w[2][j] * f2[j] + w[3][j] * f3[j] + w[4][j] * f4[j];
            } else {
                const float m0 = (r - 2 >= s0) ? 1.f : 0.f, m1 = (r - 1 >= s0) ? 1.f : 0.f, m3 = (r + 1 < e0) ? 1.f : 0.f, m4 = (r + 2 < e0) ? 1.f : 0.f;
#pragma unroll
                for (int j = 0; j < 8; ++j) o[j] = bias[j] + m0 * w[0][j] * f0[j] + m1 * w[1][j] * f1[j] + w[2][j] * f2[j] + m3 * w[3][j] * f3[j] + m4 * w[4][j] * f4[j];
            }
#pragma unroll
            for (int j = 0; j < 8; ++j) o[j] = o[j] * __builtin_amdgcn_rcpf(1.f + __expf(-o[j]));
            v4u ov; ov.x = pk2(o[0], o[1]); ov.y = pk2(o[2], o[3]); ov.z = pk2(o[4], o[5]); ov.w = pk2(o[6], o[7]);
            *(v4u*)(XBC + (size_t)r * XBCW + c0) = ov;
#pragma unroll
            for (int j = 0; j < 8; ++j) { f0[j] = f1[j]; f1[j] = f2[j]; f2[j] = f3[j]; f3[j] = f4[j]; }
        }
    }
    if (I.tid == 0) { unsigned idn; CV_CLAIM_WAIT(nclaim, idn); slot[par ^ 1] = idn; }
    __syncthreads();
    par ^= 1; uid = slot[par];
    }
#undef UNPK
#undef LDROW
#undef CV_CLAIM_WAIT
}

__device__ __forceinline__ void phase_ssd(const Ids I_, LAS unsigned char* lds, int l) {
    const Ids I = fresh(I_);
    const KA ka = ka_fresh(); unsigned char* ws = KWS(ka);
    const bf16* XBC = (const bf16*)(ws + WS_XBC); const float* DT = (const float*)(ws + WS_DT); bf16* Y = (bf16*)(ws + WS_Y);
    const int tid = I.tid, id = I.vcu, b = id >> 6, h = (id >> 1) & 31, ph = id & 1, grp = h >> 2;
    const int pl = tid >> 4, nq = tid & 15;
    LAS float* XS = (LAS float*)lds;
    LAS unsigned char* BT = lds + 8192;
    LAS unsigned char* CT = lds + 24576;
    LAS float* DTT = (LAS float*)(lds + 40960);
    LAS float* YB = (LAS float*)(lds + 41216);
    const float Dsum = KIN(ka, 12)[l * 64 + h] + KIN(ka, 12)[l * 64 + 32 + h];
    for (int dir = 0; dir < 2; ++dir) {
        const float A = -__expf(KIN(ka, 11)[l * 64 + dir * 32 + h]);
        float S[8];
#pragma unroll
        for (int i = 0; i < 8; ++i) S[i] = 0.f;
        for (int part = 0; part < 2; ++part) {
            const int rows0 = part == 0 ? MLAT + b * CTXL : b * SEQ, ntile = (part == 0 ? CTXL : SEQ) / 64;
            for (int ti = 0; ti < ntile; ++ti) {
                const int tile = dir ? ntile - 1 - ti : ti, r0 = rows0 + tile * 64;
                __syncthreads();
#pragma unroll
                for (int q = 0; q < 2; ++q) { const int ch = tid + q * 512, row = ch >> 4, c16 = ch & 15;
                    *(LAS v4u*)(BT + ch * 16) = *(const v4u*)(XBC + (size_t)(r0 + row) * XBCW + 2048 + grp * 128 + c16 * 8);
                    *(LAS v4u*)(CT + ch * 16) = *(const v4u*)(XBC + (size_t)(r0 + row) * XBCW + 3072 + grp * 128 + c16 * 8); }
                if (tid < 256) { const int row = tid >> 2, c = tid & 3; const v4u xv = *(const v4u*)(XBC + (size_t)(r0 + row) * XBCW + h * 64 + ph * 32 + c * 8);
                    LAS float* d = XS + row * 32 + c * 8; d[0] = bf_lo(xv.x); d[1] = bf_hi(xv.x); d[2] = bf_lo(xv.y); d[3] = bf_hi(xv.y); d[4] = bf_lo(xv.z); d[5] = bf_hi(xv.z); d[6] = bf_lo(xv.w); d[7] = bf_hi(xv.w);
                    if (dir == 1) { const v4u yv = *(const v4u*)(Y + (size_t)(r0 + row) * DI + h * 64 + ph * 32 + c * 8);
                        LAS float* e = YB + row * 32 + c * 8; e[0] = bf_lo(yv.x); e[1] = bf_hi(yv.x); e[2] = bf_lo(yv.y); e[3] = bf_hi(yv.y); e[4] = bf_lo(yv.z); e[5] = bf_hi(yv.z); e[6] = bf_lo(yv.w); e[7] = bf_hi(yv.w); } }
                else if (tid < 320) DTT[tid - 256] = DT[(size_t)(dir * 32 + h) * MTOT + r0 + tid - 256];
                __syncthreads();
                for (int s = 0; s < 64; ++s) {
                    const int tt = dir ? 63 - s : s;
                    const float dtv = DTT[tt], a = __expf(dtv * A), xv = XS[tt * 32 + pl], xdt = xv * dtv;
                    const v4u bv = *(const LAS v4u*)(BT + tt * 256 + nq * 16), cv = *(const LAS v4u*)(CT + tt * 256 + nq * 16);
                    float yp;
                    S[0] = S[0] * a + xdt * bf_lo(bv.x); yp = bf_lo(cv.x) * S[0];
                    S[1] = S[1] * a + xdt * bf_hi(bv.x); yp += bf_hi(cv.x) * S[1];
                    S[2] = S[2] * a + xdt * bf_lo(bv.y); yp += bf_lo(cv.y) * S[2];
                    S[3] = S[3] * a + xdt * bf_hi(bv.y); yp += bf_hi(cv.y) * S[3];
                    S[4] = S[4] * a + xdt * bf_lo(bv.z); yp += bf_lo(cv.z) * S[4];
                    S[5] = S[5] * a + xdt * bf_hi(bv.z); yp += bf_hi(cv.z) * S[5];
                    S[6] = S[6] * a + xdt * bf_lo(bv.w); yp += bf_lo(cv.w) * S[6];
                    S[7] = S[7] * a + xdt * bf_hi(bv.w); yp += bf_hi(cv.w) * S[7];
                    yp += pg8::lane_xor<1>(yp); yp += pg8::lane_xor<2>(yp); yp += pg8::lane_xor<4>(yp); yp += pg8::lane_xor<8>(yp);
                    if (nq == 0) { if (dir == 0) YB[tt * 32 + pl] = yp + Dsum * xv; else YB[tt * 32 + pl] += yp; }
                }
                __syncthreads();
                if (tid < 256) { const int row = tid >> 2, c = tid & 3; const LAS float* e = YB + row * 32 + c * 8;
                    v4u o; o.x = pk2(e[0], e[1]); o.y = pk2(e[2], e[3]); o.z = pk2(e[4], e[5]); o.w = pk2(e[6], e[7]);
                    *(v4u*)(Y + (size_t)(r0 + row) * DI + h * 64 + ph * 32 + c * 8) = o; }
            }
        }
        VM_WAIT(); __syncthreads();
    }
}

namespace ssd {
typedef short bf16x8 __attribute__((ext_vector_type(8)));
typedef short s16x4 __attribute__((ext_vector_type(4)));
constexpr int ROW = 272;
constexpr int L_CS = 0, L_BS = 34816, L_XN = 69632  , L_XF = 79872, L_XB = 88576, L_XD = 97280, L_SS0 = 105984, L_SS1 = 114688;
constexpr int L_TAB = 123392;
constexpr int L_DT = L_TAB + 4096;
#define SSD_MFMA(a, b, c) __builtin_amdgcn_mfma_f32_16x16x32_bf16((a), (b), (c), 0, 0, 0)
template <int N> __device__ __forceinline__ float row_shr(float v) { return __int_as_float(__builtin_amdgcn_update_dpp(0, __float_as_int(v), 0x110 + N, 0xf, 0xf, false)); }
__device__ __forceinline__ void scan128(LAS float* dst, LAS float* ej, const LAS float* dt, float A, bool reverse, int lane) {
    const int e0 = reverse ? 127 - 2 * lane : 2 * lane, e1 = reverse ? 126 - 2 * lane : 2 * lane + 1;
    const float v0 = dt[e0] * A, v1 = dt[e1] * A; float sc = v0 + v1;
    sc += row_shr<1>(sc); sc += row_shr<2>(sc); sc += row_shr<4>(sc); sc += row_shr<8>(sc);
    const float t0 = __int_as_float(__builtin_amdgcn_readlane(__float_as_int(sc), 15)), t1 = __int_as_float(__builtin_amdgcn_readlane(__float_as_int(sc), 31)), t2 = __int_as_float(__builtin_amdgcn_readlane(__float_as_int(sc), 47));
    const int row = lane >> 4; sc += (row >= 1 ? t0 : 0.f) + (row >= 2 ? t1 : 0.f) + (row >= 3 ? t2 : 0.f);
    const float ex = sc - (v0 + v1), c0 = ex + v0, c1 = ex + v0 + v1; dst[e0] = c0; dst[e1] = c1;
    LDS_WAIT(); asm volatile("" ::: "memory");
    const float ref = dst[reverse ? (e0 & ~15) : (e0 | 15)];
    ej[e0] = __expf(ref - c0) * dt[e0]; ej[e1] = __expf(ref - c1) * dt[e1];
}
__device__ __forceinline__ bf16x8 pack8f(const float (&m)[8]) { v4u t; t.x = pk2(m[0], m[1]); t.y = pk2(m[2], m[3]); t.z = pk2(m[4], m[5]); t.w = pk2(m[6], m[7]); return __builtin_bit_cast(bf16x8, t); }
__device__ __forceinline__ bf16x8 ld2x8(const LAS unsigned char* p0, const LAS unsigned char* p1) { const v2u a = *(const LAS v2u*)p0, b = *(const LAS v2u*)p1; v4u t; t.x = a.x; t.y = a.y; t.z = b.x; t.w = b.y; return __builtin_bit_cast(bf16x8, t); }
__device__ __forceinline__ unsigned short bf1(float v) { return (unsigned short)(pk2(v, 0.f) & 0xffffu); }
}

template <int SWEEP> __device__ __forceinline__ void ssd_sweep(const Ids I_, LAS unsigned char* lds, int l) {
    constexpr int sweep = SWEEP, NSET = SWEEP ? 2 : 1;
    using namespace ssd;
    const Ids I = fresh(I_);
    const KA ka = ka_fresh(); unsigned char* ws = KWS(ka);
    const bf16* XBC = (const bf16*)(ws + WS_XBC); const float* DT = (const float*)(ws + WS_DT); bf16* Y = (bf16*)(ws + WS_Y);
    const int tid = I.tid, lane = I.lane, w = I.wave, li = lane & 15, lg = lane >> 4;
    const int id = I.vcu, b = id >> 6, h = (id >> 1) & 31, ph = id & 1, grp = h >> 2;
    const float Dsum = KIN(ka, 12)[l * 64 + h] + KIN(ka, 12)[l * 64 + 32 + h];
    const float A_f = -__expf(KIN(ka, 11)[l * 64 + h]), A_b = -__expf(KIN(ka, 11)[l * 64 + 32 + h]);
    const size_t xcol = (size_t)h * 64 + ph * 32;
    const int srow = tid >> 2, sc4 = tid & 3;

    {
        auto row_of = [&](int idx) -> int { const int c = idx < 2 ? (sweep ? 1 - idx : idx) : (sweep ? 31 - (idx - 2) : idx - 2); return idx < 2 ? MLAT + b * CTXL + 128 * c : b * SEQ + 128 * c; };
#define SSD_TAB(par) ((LAS float*)(lds + L_TAB + (par) * 2048))
#define SSD_DTP(par) ((LAS float*)(lds + L_DT + (par) * 1024))
#define SSD_LDDT(idx_) (DT[(size_t)((tid >> 7) * 32 + h) * MTOT + row_of(idx_) + (tid & 127)])
#define SSD_SCAN(par) do { if (sweep == 0) { if (w == 0) scan128(SSD_TAB(par), SSD_TAB(par) + 256, SSD_DTP(par), A_f, false, lane); else if (w == 1) scan128(SSD_TAB(par) + 128, SSD_TAB(par) + 384, SSD_DTP(par) + 128, A_b, true, lane); } \
        else { if (w == 0) scan128(SSD_TAB(par) + 128, SSD_TAB(par) + 384, SSD_DTP(par) + 128, A_b, true, lane); } } while (0)
        v4u pc[NSET][4], pb[NSET][4], px[NSET]; float pdt = 0.f;
#define SSD_ISSUE(idx_, u_) do { const int r0_ = row_of(idx_); \
        _Pragma("unroll") for (int q = 0; q < 4; ++q) { const int ch = tid + 512 * q, row = ch >> 4, c16 = ch & 15; \
            pc[u_][q] = *(const v4u*)(XBC + (size_t)(r0_ + row) * XBCW + 3072 + grp * 128 + c16 * 8); pb[u_][q] = *(const v4u*)(XBC + (size_t)(r0_ + row) * XBCW + 2048 + grp * 128 + c16 * 8); } \
        px[u_] = *(const v4u*)(XBC + (size_t)(r0_ + srow) * XBCW + xcol + sc4 * 8); } while (0)
        __syncthreads();
        for (int i = tid; i < (2 * 8704) / 4; i += NWAVES * 64) ((LAS unsigned*)(lds + L_SS0))[i] = 0u;
        f32x4 sacc[2] = {{0.f, 0.f, 0.f, 0.f}, {0.f, 0.f, 0.f, 0.f}};
        _Pragma("unroll") for (int u = 0; u < NSET; ++u) SSD_ISSUE(u, u);
        if (tid < 256) SSD_DTP(0)[tid] = SSD_LDDT(0);
        __syncthreads();
        SSD_SCAN(0);
        if (tid < 256) pdt = SSD_LDDT(1);
        for (int idx0 = 0; idx0 < 34; idx0 += NSET)
#pragma unroll
        for (int u = 0; u < NSET; ++u) {
            const int idx = idx0 + u;
            const int r0 = row_of(idx), par = idx & 1;
            const bool need_y = !(l == 1 && idx < 2);
            LAS unsigned char* SScur = lds + (par ? L_SS1 : L_SS0); LAS unsigned char* SSnxt = lds + (par ? L_SS0 : L_SS1);
            LAS float* AF = SSD_TAB(par); LAS float* RB = AF + 128; LAS float* EJF = AF + 256; LAS float* EJB = AF + 384; LAS float* DTF = SSD_DTP(par); LAS float* DTB = DTF + 128;
            __syncthreads();
#pragma unroll
            for (int q = 0; q < 4; ++q) { const int ch = tid + 512 * q, row = ch >> 4, c16 = ch & 15; *(LAS v4u*)(lds + L_CS + row * ROW + c16 * 16) = pc[u][q]; *(LAS v4u*)(lds + L_BS + row * ROW + c16 * 16) = pb[u][q]; }
            *(LAS v4u*)(lds + L_XN + srow * 80 + sc4 * 16) = px[u];
            {
                const v4u pxu = px[u]; const float xv[8] = {bf_lo(pxu.x), bf_hi(pxu.x), bf_lo(pxu.y), bf_hi(pxu.y), bf_lo(pxu.z), bf_hi(pxu.z), bf_lo(pxu.w), bf_hi(pxu.w)};
                LAS unsigned short* xf = (LAS unsigned short*)(lds + L_XF + (4 * sc4) * ROW) + srow; LAS unsigned short* xb = (LAS unsigned short*)(lds + L_XB + (4 * sc4) * ROW) + srow; LAS unsigned short* xd = (LAS unsigned short*)(lds + L_XD + (4 * sc4) * ROW) + srow;
                if (sweep == 0) { const float f = DTF[srow], gg = DTB[srow], e = f * __expf(AF[127] - AF[srow]);
#pragma unroll
                    for (int q = 0; q < 8; ++q) { const int ro = (16 * (q >> 2) + (q & 3)) * (ROW / 2); xf[ro] = bf1(xv[q]); xd[ro] = bf1(xv[q] * e); } (void)gg; (void)xb; }
                else { const float e = DTB[srow] * __expf(RB[0] - RB[srow]);
#pragma unroll
                    for (int q = 0; q < 8; ++q) xd[(16 * (q >> 2) + (q & 3)) * (ROW / 2)] = bf1(xv[q] * e); }
            }
            if (tid < 256 && idx + 1 < 34) SSD_DTP(par ^ 1)[tid] = pdt;
            __syncthreads();
            if (idx + NSET < 34) SSD_ISSUE(idx + NSET, u);
            if (idx + 1 < 34) SSD_SCAN(par ^ 1);
            if (tid < 256 && idx + 2 < 34) pdt = SSD_LDDT(idx + 2);
            v4u yold = {0u, 0u, 0u, 0u};
            if (sweep == 1 && need_y) yold = *(const v4u*)(Y + (size_t)(r0 + 16 * w + li) * DI + xcol + 8 * lg);
            bf16x8 cf[4];
#pragma unroll
            for (int ks = 0; ks < 4; ++ks) cf[ks] = *(const LAS bf16x8*)(lds + L_CS + (16 * w + li) * ROW + (32 * ks + 8 * lg) * 2);
            f32x4 yacc[2] = {{0.f, 0.f, 0.f, 0.f}, {0.f, 0.f, 0.f, 0.f}}, yi[2] = {{0.f, 0.f, 0.f, 0.f}, {0.f, 0.f, 0.f, 0.f}};
            if (need_y) {
            {
                bf16x8 sf[8];
#pragma unroll
                for (int ks = 0; ks < 4; ++ks)
#pragma unroll
                    for (int pt = 0; pt < 2; ++pt) sf[2 * ks + pt] = *(const LAS bf16x8*)(SScur + (16 * pt + li) * ROW + (32 * ks + 8 * lg) * 2);
                __builtin_amdgcn_sched_barrier(0);
#pragma unroll
                for (int ks = 0; ks < 4; ++ks)
#pragma unroll
                    for (int pt = 0; pt < 2; ++pt) yi[pt] = SSD_MFMA(sf[2 * ks + pt], cf[ks], yi[pt]);
            }
            float escale;
            if (sweep == 0) {
                const float af_i = AF[16 * w + li], rb_i = RB[16 * w + li];
                escale = __expf(af_i);
                f32x4 g[8];
                {
                    bf16x8 fa[8], fb[8];
#define SSD_GLOAD(dst, jp) do { _Pragma("unroll") for (int q_ = 0; q_ < 8; ++q_) dst[q_] = *(const LAS bf16x8*)(lds + L_BS + (16 * (2 * (jp) + (q_ >> 2)) + li) * ROW + (32 * (q_ & 3) + 8 * lg) * 2); } while (0)
#define SSD_GMMA(src, jp) do { g[2 * (jp)] = (f32x4){0.f, 0.f, 0.f, 0.f}; g[2 * (jp) + 1] = (f32x4){0.f, 0.f, 0.f, 0.f}; \
                        _Pragma("unroll") for (int q_ = 0; q_ < 8; ++q_) g[2 * (jp) + (q_ >> 2)] = SSD_MFMA(src[q_], cf[q_ & 3], g[2 * (jp) + (q_ >> 2)]); } while (0)
                    SSD_GLOAD(fa, 0); __builtin_amdgcn_sched_barrier(0);
                    SSD_GLOAD(fb, 1); __builtin_amdgcn_sched_barrier(0); SSD_GMMA(fa, 0); __builtin_amdgcn_sched_barrier(0);
                    SSD_GLOAD(fa, 2); __builtin_amdgcn_sched_barrier(0); SSD_GMMA(fb, 1); __builtin_amdgcn_sched_barrier(0);
                    SSD_GLOAD(fb, 3); __builtin_amdgcn_sched_barrier(0); SSD_GMMA(fa, 2); __builtin_amdgcn_sched_barrier(0);
                    SSD_GMMA(fb, 3); __builtin_amdgcn_sched_barrier(0);
#undef SSD_GLOAD
#undef SSD_GMMA
                }
#define SSD_TILE_F(t, mo) do { if ((t) < w) { const float ei = __expf(af_i - AF[16 * (t) + 15]); const f32x4 ejv = *(const LAS f32x4*)(EJF + 16 * (t) + 4 * lg); \
                        _Pragma("unroll") for (int r = 0; r < 4; ++r) m[(mo) + r] = g[t][r] * (ei * ejv[r]); } \
                    else if ((t) == w) { const f32x4 av = *(const LAS f32x4*)(AF + 16 * (t) + 4 * lg), dv = *(const LAS f32x4*)(DTF + 16 * (t) + 4 * lg); \
                        _Pragma("unroll") for (int r = 0; r < 4; ++r) m[(mo) + r] = (4 * lg + r <= li) ? g[t][r] * (dv[r] * __expf(fminf(af_i - av[r], 0.f))) : 0.f; } \
                    else { _Pragma("unroll") for (int r = 0; r < 4; ++r) m[(mo) + r] = 0.f; } } while (0)
#define SSD_TILE_B(t, mo) do { if ((t) > w) { const float ei = __expf(rb_i - RB[16 * (t)]); const f32x4 ejv = *(const LAS f32x4*)(EJB + 16 * (t) + 4 * lg); \
                        _Pragma("unroll") for (int r = 0; r < 4; ++r) m[(mo) + r] = g[t][r] * (ei * ejv[r]); } \
                    else if ((t) == w) { const f32x4 av = *(const LAS f32x4*)(RB + 16 * (t) + 4 * lg), dv = *(const LAS f32x4*)(DTB + 16 * (t) + 4 * lg); \
                        _Pragma("unroll") for (int r = 0; r < 4; ++r) m[(mo) + r] = (4 * lg + r >= li) ? g[t][r] * (dv[r] * __expf(fminf(rb_i - av[r], 0.f))) : 0.f; } \
                    else { _Pragma("unroll") for (int r = 0; r < 4; ++r) m[(mo) + r] = 0.f; } } while (0)
#pragma unroll
                for (int kk = 0; kk < 4; ++kk) {
                    const int t0 = 2 * kk, t1 = 2 * kk + 1;
                    if (t0 <= w) {
                        float m[8]; SSD_TILE_F(t0, 0); SSD_TILE_F(t1, 4);
                        const bf16x8 bfr = pack8f(m);
#pragma unroll
                        for (int pt = 0; pt < 2; ++pt) { const LAS unsigned char* rp = lds + L_XF + (16 * pt + li) * ROW; const bf16x8 a = ld2x8(rp + (32 * kk + 4 * lg) * 2, rp + (32 * kk + 16 + 4 * lg) * 2); yacc[pt] = SSD_MFMA(a, bfr, yacc[pt]); }
                    }
                    if (t1 >= w) {
                        float m[8]; SSD_TILE_B(t0, 0); SSD_TILE_B(t1, 4);
                        const bf16x8 bfr = pack8f(m);
#pragma unroll
                        for (int pt = 0; pt < 2; ++pt) { const LAS unsigned char* rp = lds + L_XF + (16 * pt + li) * ROW; const bf16x8 a = ld2x8(rp + (32 * kk + 4 * lg) * 2, rp + (32 * kk + 16 + 4 * lg) * 2); yacc[pt] = SSD_MFMA(a, bfr, yacc[pt]); }
                    }
                }
#undef SSD_TILE_F
#undef SSD_TILE_B
            } else escale = __expf(RB[16 * w + li]);
            {
                bf16* yp = Y + (size_t)(r0 + 16 * w + li) * DI + xcol + 8 * lg;
                float o[8];
                if (sweep == 0) { const v4u xv = *(const LAS v4u*)(lds + L_XN + (16 * w + li) * 80 + (8 * lg) * 2);
                    const float xs[8] = {bf_lo(xv.x), bf_hi(xv.x), bf_lo(xv.y), bf_hi(xv.y), bf_lo(xv.z), bf_hi(xv.z), bf_lo(xv.w), bf_hi(xv.w)};
#pragma unroll
                    for (int pt = 0; pt < 2; ++pt)
#pragma unroll
                        for (int r = 0; r < 4; ++r) o[4 * pt + r] = yacc[pt][r] + escale * yi[pt][r] + Dsum * xs[4 * pt + r]; }
                else { const float ys[8] = {bf_lo(yold.x), bf_hi(yold.x), bf_lo(yold.y), bf_hi(yold.y), bf_lo(yold.z), bf_hi(yold.z), bf_lo(yold.w), bf_hi(yold.w)};
#pragma unroll
                    for (int pt = 0; pt < 2; ++pt)
#pragma unroll
                        for (int r = 0; r < 4; ++r) o[4 * pt + r] = ys[4 * pt + r] + escale * yi[pt][r]; }
                v4u ov; ov.x = pk2(o[0], o[1]); ov.y = pk2(o[2], o[3]); ov.z = pk2(o[4], o[5]); ov.w = pk2(o[6], o[7]); *(v4u*)yp = ov;
            }
            }
            {
                const float atot = __expf(sweep == 0 ? AF[127] : RB[0]);
                sacc[0] = sacc[0] * atot; sacc[1] = sacc[1] * atot;
                const int q = li >> 2, pq = li & 3;
                bf16x8 ta[4], xd[8];
#pragma unroll
                for (int ks = 0; ks < 4; ++ks) {
                    const LAS unsigned char* tp = lds + L_BS + (32 * ks + 8 * lg + q) * ROW + (16 * w + 4 * pq) * 2;
                    const s16x4 lo = __builtin_amdgcn_ds_read_tr16_b64_v4i16((LAS s16x4*)tp), hi = __builtin_amdgcn_ds_read_tr16_b64_v4i16((LAS s16x4*)(tp + 4 * ROW));
                    ta[ks] = __builtin_shufflevector(lo, hi, 0, 1, 2, 3, 4, 5, 6, 7);
#pragma unroll
                    for (int pt = 0; pt < 2; ++pt) xd[2 * ks + pt] = *(const LAS bf16x8*)(lds + L_XD + (16 * pt + li) * ROW + (32 * ks + 8 * lg) * 2);
                }
                __builtin_amdgcn_sched_barrier(0);
#pragma unroll
                for (int ks = 0; ks < 4; ++ks)
#pragma unroll
                    for (int pt = 0; pt < 2; ++pt) sacc[pt] = SSD_MFMA(ta[ks], xd[2 * ks + pt], sacc[pt]);
#pragma unroll
                for (int pt = 0; pt < 2; ++pt) { v2u sv; sv.x = pk2(sacc[pt][0], sacc[pt][1]); sv.y = pk2(sacc[pt][2], sacc[pt][3]); *(LAS v2u*)(SSnxt + (16 * pt + li) * ROW + (16 * w + 4 * lg) * 2) = sv; }
            }
        }
#undef SSD_ISSUE
#undef SSD_SCAN
#undef SSD_LDDT
#undef SSD_TAB
#undef SSD_DTP
        VM_WAIT(); __syncthreads();
    }
}
__device__ __forceinline__ void phase_ssd_mfma(const Ids I, LAS unsigned char* lds, int l) { ssd_sweep<0>(I, lds, l); ssd_sweep<1>(I, lds, l); }
namespace ssdd {
constexpr int ROW = 272;
constexpr int L_CS = 0, L_BS = 34816, L_XF = 69632, L_XD = 87040, L_SS0 = 104448, L_SS1 = 121856, L_TAB = 139264  , L_DT = 141312  ;
constexpr int FLAG_OFF = 90112;
}
template <int DIR> __device__ __forceinline__ void ssd_dir(const Ids I_, LAS unsigned char* lds, int l) {
    using namespace ssdd;
    using ssd::scan128; using ssd::pack8f; using ssd::ld2x8; using ssd::bf1; using ssd::bf16x8; using ssd::s16x4;
    const Ids I = fresh(I_);
    const KA ka = ka_fresh(); unsigned char* ws = KWS(ka);
    const bf16* XBC = (const bf16*)(ws + WS_XBC); const float* DT = (const float*)(ws + WS_DT); bf16* Y = (bf16*)(ws + WS_Y);
    const int tid = I.tid, lane = I.lane, w = I.wave, li = lane & 15, lg = lane >> 4;
    const int wt = w < 4 ? w : 11 - w;
    const int id = I.vcu, b = id >> 6, h = (id >> 1) & 31, grp = h >> 2;
    const float Dsum = KIN(ka, 12)[l * 64 + h] + KIN(ka, 12)[l * 64 + 32 + h];
    const float A_d = -__expf(KIN(ka, 11)[l * 64 + DIR * 32 + h]);
    const size_t xcol = (size_t)h * 64;
    const int srow = tid >> 2, sc4 = tid & 3;
    pg8::pg8_gu32* flags = (pg8::pg8_gu32*)(ws + WS_CTL) + FLAG_OFF + (size_t)((l * 128 + b * 32 + h) * 34) * 8 + w;
    const __amdgpu_buffer_rsrc_t rsY = __builtin_amdgcn_make_buffer_rsrc((void*)Y, (short)0, 17408 * 2048 * 2, 0x00020000);
    auto chunk_of = [&](int idx) -> int { return idx < 2 ? (DIR ? 1 - idx : idx) : 2 + (DIR ? 31 - (idx - 2) : idx - 2); };
    auto row_of = [&](int idx) -> int { const int c = chunk_of(idx); return c < 2 ? MLAT + b * CTXL + 128 * c : b * SEQ + 128 * (c - 2); };
#define SD_TAB(par) ((LAS float*)(lds + L_TAB + (par) * 1024))
#define SD_DTP(par) ((LAS float*)(lds + L_DT + (par) * 512))
#define SD_LDDT(idx_) (DT[(size_t)(DIR * 32 + h) * MTOT + row_of(idx_) + tid])
#define SD_SCAN(par) do { if (w == 0) scan128(SD_TAB(par), SD_TAB(par) + 128, SD_DTP(par), A_d, DIR != 0, lane); } while (0)
    v4u pc[4], pb[4], px[2]; float pdt = 0.f;
#define SD_ISSUE(idx_) do { const int r0_ = row_of(idx_); \
        _Pragma("unroll") for (int q = 0; q < 4; ++q) { const int ch = tid + 512 * q, row = ch >> 4, c16 = ch & 15; \
            pc[q] = *(const v4u*)(XBC + (size_t)(r0_ + row) * XBCW + 3072 + grp * 128 + c16 * 8); pb[q] = *(const v4u*)(XBC + (size_t)(r0_ + row) * XBCW + 2048 + grp * 128 + c16 * 8); } \
        px[0] = *(const v4u*)(XBC + (size_t)(r0_ + srow) * XBCW + xcol + sc4 * 16); px[1] = *(const v4u*)(XBC + (size_t)(r0_ + srow) * XBCW + xcol + sc4 * 16 + 8); } while (0)
    __syncthreads();
    for (int i = tid; i < (2 * 17408) / 4; i += NWAVES * 64) ((LAS unsigned*)(lds + L_SS0))[i] = 0u;
    f32x4 sacc[4];
#pragma unroll
    for (int pt = 0; pt < 4; ++pt) sacc[pt] = (f32x4){0.f, 0.f, 0.f, 0.f};
    SD_ISSUE(0);
    if (tid < 128) SD_DTP(0)[tid] = SD_LDDT(0);
    __syncthreads();
    SD_SCAN(0);
    if (tid < 128) pdt = SD_LDDT(1);
    int pend = -1;
    for (int idx = 0; idx < 34; ++idx) {
        const int r0 = row_of(idx), par = idx & 1, cid = chunk_of(idx);
        const bool need_y = !(l == 1 && idx < 2);
        const bool first = idx < 2 ? (idx == 0) : (idx <= 17);
        LAS unsigned char* SScur = lds + (par ? L_SS1 : L_SS0); LAS unsigned char* SSnxt = lds + (par ? L_SS0 : L_SS1);
        LAS float* AC = SD_TAB(par); LAS float* EJ = AC + 128; LAS float* DTC = SD_DTP(par);
        __syncthreads();
#pragma unroll
        for (int q = 0; q < 4; ++q) { const int ch = tid + 512 * q, row = ch >> 4, c16 = ch & 15; *(LAS v4u*)(lds + L_CS + row * ROW + c16 * 16) = pc[q]; *(LAS v4u*)(lds + L_BS + row * ROW + c16 * 16) = pb[q]; }
        {
            const v4u p0 = px[0], p1 = px[1];
            const float xv[16] = {bf_lo(p0.x), bf_hi(p0.x), bf_lo(p0.y), bf_hi(p0.y), bf_lo(p0.z), bf_hi(p0.z), bf_lo(p0.w), bf_hi(p0.w), bf_lo(p1.x), bf_hi(p1.x), bf_lo(p1.y), bf_hi(p1.y), bf_lo(p1.z), bf_hi(p1.z), bf_lo(p1.w), bf_hi(p1.w)};
            LAS unsigned short* xf = (LAS unsigned short*)(lds + L_XF + (4 * sc4) * ROW) + srow; LAS unsigned short* xd = (LAS unsigned short*)(lds + L_XD + (4 * sc4) * ROW) + srow;
            const float e = DTC[srow] * __expf(AC[DIR ? 0 : 127] - AC[srow]);
#pragma unroll
            for (int q = 0; q < 16; ++q) { const int ro = (16 * (q >> 2) + (q & 3)) * (ROW / 2); xf[ro] = bf1(xv[q]); xd[ro] = bf1(xv[q] * e); }
        }
        if (tid < 128 && idx + 1 < 34) SD_DTP(par ^ 1)[tid] = pdt;
        if (pend >= 0) { asm volatile("s_waitcnt vmcnt(0)" ::: "memory"); if (lane == 0) __hip_atomic_store(flags + pend * 8, 1u, __ATOMIC_RELAXED, __HIP_MEMORY_SCOPE_AGENT); pend = -1; }
        __syncthreads();
        if (idx + 1 < 34) SD_ISSUE(idx + 1);
        if (idx + 1 < 34) SD_SCAN(par ^ 1);
        if (tid < 128 && idx + 2 < 34) pdt = SD_LDDT(idx + 2);
        const unsigned yoff = (unsigned)(((size_t)(r0 + 16 * wt + li) * DI + xcol + 16 * lg) * 2);
        v4u yo0 = {0u, 0u, 0u, 0u}, yo1 = {0u, 0u, 0u, 0u}, xs0 = {0u, 0u, 0u, 0u}, xs1 = {0u, 0u, 0u, 0u};
        if (need_y) {
            if (!first) {
                unsigned sp = 0;
                while (__builtin_amdgcn_readfirstlane(__hip_atomic_load(flags + cid * 8, __ATOMIC_RELAXED, __HIP_MEMORY_SCOPE_AGENT)) == 0u) { __builtin_amdgcn_s_sleep(2);
                    if ((++sp & 255u) == 0u) { pg8::pg8_gu32* tmo = (pg8::pg8_gu32*)(ws + WS_CTL) + CW_BAR + XB_TMO; if (__hip_atomic_load(tmo, __ATOMIC_RELAXED, __HIP_MEMORY_SCOPE_AGENT) != 0u) break; if (sp > (1u << 20)) { if (lane == 0) __hip_atomic_fetch_add(tmo, 1u, __ATOMIC_RELAXED, __HIP_MEMORY_SCOPE_AGENT); break; } } }
                asm volatile("" ::: "memory");
                yo0 = __builtin_amdgcn_raw_buffer_load_b128(rsY, yoff, 0, 17); yo1 = __builtin_amdgcn_raw_buffer_load_b128(rsY, yoff + 16, 0, 17);
            }
            if (DIR == 0) { const v4u* xp = (const v4u*)(XBC + (size_t)(r0 + 16 * wt + li) * XBCW + xcol + 16 * lg); xs0 = xp[0]; xs1 = xp[1]; }
        }
        bf16x8 cf[4];
#pragma unroll
        for (int ks = 0; ks < 4; ++ks) cf[ks] = *(const LAS bf16x8*)(lds + L_CS + (16 * wt + li) * ROW + (32 * ks + 8 * lg) * 2);
        f32x4 yacc[4], yi[4];
#pragma unroll
        for (int pt = 0; pt < 4; ++pt) { yacc[pt] = (f32x4){0.f, 0.f, 0.f, 0.f}; yi[pt] = (f32x4){0.f, 0.f, 0.f, 0.f}; }
        if (need_y) {
            {
#pragma unroll
                for (int ks = 0; ks < 4; ++ks) {
                    bf16x8 sf[4];
#pragma unroll
                    for (int pt = 0; pt < 4; ++pt) sf[pt] = *(const LAS bf16x8*)(SScur + (16 * pt + li) * ROW + (32 * ks + 8 * lg) * 2);
#pragma unroll
                    for (int pt = 0; pt < 4; ++pt) yi[pt] = SSD_MFMA(sf[pt], cf[ks], yi[pt]);
                }
            }
            const float a_i = AC[16 * wt + li];
            const float escale = __expf(a_i);
            f32x4 g[8];
            {
                bf16x8 fa[8], fb[8];
#define SD_GLOAD(dst, jp) do { _Pragma("unroll") for (int q_ = 0; q_ < 8; ++q_) dst[q_] = *(const LAS bf16x8*)(lds + L_BS + (16 * (2 * (jp) + (q_ >> 2)) + li) * ROW + (32 * (q_ & 3) + 8 * lg) * 2); } while (0)
#define SD_GMMA(src, jp) do { g[2 * (jp)] = (f32x4){0.f, 0.f, 0.f, 0.f}; g[2 * (jp) + 1] = (f32x4){0.f, 0.f, 0.f, 0.f}; \
                    _Pragma("unroll") for (int q_ = 0; q_ < 8; ++q_) g[2 * (jp) + (q_ >> 2)] = SSD_MFMA(src[q_], cf[q_ & 3], g[2 * (jp) + (q_ >> 2)]); } while (0)
                SD_GLOAD(fa, 0); __builtin_amdgcn_sched_barrier(0);
                SD_GLOAD(fb, 1); __builtin_amdgcn_sched_barrier(0); SD_GMMA(fa, 0); __builtin_amdgcn_sched_barrier(0);
                SD_GLOAD(fa, 2); __builtin_amdgcn_sched_barrier(0); SD_GMMA(fb, 1); __builtin_amdgcn_sched_barrier(0);
                SD_GLOAD(fb, 3); __builtin_amdgcn_sched_barrier(0); SD_GMMA(fa, 2); __builtin_amdgcn_sched_barrier(0);
                SD_GMMA(fb, 3); __builtin_amdgcn_sched_barrier(0);
#undef SD_GLOAD
#undef SD_GMMA
            }
#define SD_TILE(t, mo) do { if (DIR == 0 ? ((t) < wt) : ((t) > wt)) { const float ei = __expf(a_i - AC[DIR == 0 ? 16 * (t) + 15 : 16 * (t)]); const f32x4 ejv = *(const LAS f32x4*)(EJ + 16 * (t) + 4 * lg); \
                    _Pragma("unroll") for (int r = 0; r < 4; ++r) m[(mo) + r] = g[t][r] * (ei * ejv[r]); } \
                else if ((t) == wt) { const f32x4 av = *(const LAS f32x4*)(AC + 16 * (t) + 4 * lg), dv = *(const LAS f32x4*)(DTC + 16 * (t) + 4 * lg); \
                    _Pragma("unroll") for (int r = 0; r < 4; ++r) m[(mo) + r] = (DIR == 0 ? (4 * lg + r <= li) : (4 * lg + r >= li)) ? g[t][r] * (dv[r] * __expf(fminf(a_i - av[r], 0.f))) : 0.f; } \
                else { _Pragma("unroll") for (int r = 0; r < 4; ++r) m[(mo) + r] = 0.f; } } while (0)
#pragma unroll
            for (int kk = 0; kk < 4; ++kk) {
                const int t0 = 2 * kk, t1 = 2 * kk + 1;
                if (DIR == 0 ? (t0 <= wt) : (t1 >= wt)) {
                    float m[8]; SD_TILE(t0, 0); SD_TILE(t1, 4);
                    const bf16x8 bfr = pack8f(m);
#pragma unroll
                    for (int pt = 0; pt < 4; ++pt) { const LAS unsigned char* rp = lds + L_XF + (16 * pt + li) * ROW; const bf16x8 a = ld2x8(rp + (32 * kk + 4 * lg) * 2, rp + (32 * kk + 16 + 4 * lg) * 2); yacc[pt] = SSD_MFMA(a, bfr, yacc[pt]); }
                }
            }
#undef SD_TILE
            {
                float o[16];
#pragma unroll
                for (int pt = 0; pt < 4; ++pt)
#pragma unroll
                    for (int r = 0; r < 4; ++r) o[4 * pt + r] = yacc[pt][r] + escale * yi[pt][r];
                if (DIR == 0) { const float xs[16] = {bf_lo(xs0.x), bf_hi(xs0.x), bf_lo(xs0.y), bf_hi(xs0.y), bf_lo(xs0.z), bf_hi(xs0.z), bf_lo(xs0.w), bf_hi(xs0.w), bf_lo(xs1.x), bf_hi(xs1.x), bf_lo(xs1.y), bf_hi(xs1.y), bf_lo(xs1.z), bf_hi(xs1.z), bf_lo(xs1.w), bf_hi(xs1.w)};
#pragma unroll
                    for (int q = 0; q < 16; ++q) o[q] += Dsum * xs[q]; }
                if (!first) { const float ys[16] = {bf_lo(yo0.x), bf_hi(yo0.x), bf_lo(yo0.y), bf_hi(yo0.y), bf_lo(yo0.z), bf_hi(yo0.z), bf_lo(yo0.w), bf_hi(yo0.w), bf_lo(yo1.x), bf_hi(yo1.x), bf_lo(yo1.y), bf_hi(yo1.y), bf_lo(yo1.z), bf_hi(yo1.z), bf_lo(yo1.w), bf_hi(yo1.w)};
#pragma unroll
                    for (int q = 0; q < 16; ++q) o[q] += ys[q]; }
                v4u ov0, ov1; ov0.x = pk2(o[0], o[1]); ov0.y = pk2(o[2], o[3]); ov0.z = pk2(o[4], o[5]); ov0.w = pk2(o[6], o[7]); ov1.x = pk2(o[8], o[9]); ov1.y = pk2(o[10], o[11]); ov1.z = pk2(o[12], o[13]); ov1.w = pk2(o[14], o[15]);
                if (first) { __builtin_amdgcn_raw_buffer_store_b128(ov0, rsY, yoff, 0, 16); __builtin_amdgcn_raw_buffer_store_b128(ov1, rsY, yoff + 16, 0, 16); pend = cid; }
                else { __builtin_amdgcn_raw_buffer_store_b128(ov0, rsY, yoff, 0, 0); __builtin_amdgcn_raw_buffer_store_b128(ov1, rsY, yoff + 16, 0, 0); }
            }
        }
        {
            const float atot = __expf(AC[DIR ? 0 : 127]);
#pragma unroll
            for (int pt = 0; pt < 4; ++pt) sacc[pt] = sacc[pt] * atot;
            const int q = li >> 2, pq = li & 3;
#pragma unroll
            for (int ks = 0; ks < 4; ++ks) {
                const LAS unsigned char* tp = lds + L_BS + (32 * ks + 8 * lg + q) * ROW + (16 * w + 4 * pq) * 2;
                const s16x4 lo = __builtin_amdgcn_ds_read_tr16_b64_v4i16((LAS s16x4*)tp), hi = __builtin_amdgcn_ds_read_tr16_b64_v4i16((LAS s16x4*)(tp + 4 * ROW));
                const bf16x8 ta = __builtin_shufflevector(lo, hi, 0, 1, 2, 3, 4, 5, 6, 7);
                bf16x8 xdv[4];
#pragma unroll
                for (int pt = 0; pt < 4; ++pt) xdv[pt] = *(const LAS bf16x8*)(lds + L_XD + (16 * pt + li) * ROW + (32 * ks + 8 * lg) * 2);
#pragma unroll
                for (int pt = 0; pt < 4; ++pt) sacc[pt] = SSD_MFMA(ta, xdv[pt], sacc[pt]);
            }
#pragma unroll
            for (int pt = 0; pt < 4; ++pt) { v2u sv; sv.x = pk2(sacc[pt][0], sacc[pt][1]); sv.y = pk2(sacc[pt][2], sacc[pt][3]); *(LAS v2u*)(SSnxt + (16 * pt + li) * ROW + (16 * w + 4 * lg) * 2) = sv; }
        }
    }
    asm volatile("s_waitcnt vmcnt(0)" ::: "memory");
    if (pend >= 0 && lane == 0) __hip_atomic_store(flags + pend * 8, 1u, __ATOMIC_RELAXED, __HIP_MEMORY_SCOPE_AGENT);
#undef SD_ISSUE
#undef SD_SCAN
#undef SD_LDDT
#undef SD_TAB
#undef SD_DTP
    __syncthreads();
}
__device__ __forceinline__ void phase_ssd_dir(const Ids I, LAS unsigned char* lds, int l) { if (I.vcu & 1) ssd_dir<1>(I, lds, l); else ssd_dir<0>(I, lds, l); }

namespace ssd3 {
typedef short bf16x8 __attribute__((ext_vector_type(8)));
typedef short s16x4 __attribute__((ext_vector_type(4)));
constexpr int ROW = 272;
constexpr int L_BS = 0, L_XF = 69632, L_XB = L_XF + 17408, L_XD = L_XB + 17408, L_SS = L_XD + 17408, L_TAB = L_SS + 17408;
constexpr int T_AFL = 0, T_RBL = 128, T_EJF = 256, T_EJB = 384, T_TF = 512, T_TB = 520, T_FLOATS = 528;
#define SSD3_MFMA32(a, b, c) __builtin_amdgcn_mfma_f32_16x16x32_bf16((a), (b), (c), 0, 0, 0)
#define SSD3_MFMA16(a, b, c) __builtin_amdgcn_mfma_f32_16x16x16bf16_1k((a), (b), (c), 0, 0, 0)
template <int N> __device__ __forceinline__ float row_shr(float v) { return __int_as_float(__builtin_amdgcn_update_dpp(0, __float_as_int(v), 0x110 + N, 0xf, 0xf, false)); }
__device__ __forceinline__ float rdlane(float v, int l) { return __int_as_float(__builtin_amdgcn_readlane(__float_as_int(v), l)); }
__device__ __forceinline__ float scan16x4(float a, int lane, float& tot) {
    float s = a; s += row_shr<4>(s); s += row_shr<8>(s);
    const float t0 = rdlane(s, 15), t1 = rdlane(s, 31), t2 = rdlane(s, 47), t3 = rdlane(s, 63); const int dr = lane >> 4;
    s += (dr >= 1 ? t0 : 0.f) + (dr >= 2 ? t1 : 0.f) + (dr >= 3 ? t2 : 0.f); tot = (t0 + t1) + (t2 + t3); return s;
}
__device__ __forceinline__ bf16x8 pack8f(const float (&m)[8]) { v4u t; t.x = pk2(m[0], m[1]); t.y = pk2(m[2], m[3]); t.z = pk2(m[4], m[5]); t.w = pk2(m[6], m[7]); return __builtin_bit_cast(bf16x8, t); }
__device__ __forceinline__ bf16x8 ld2x8(const LAS unsigned char* p0, const LAS unsigned char* p1) { const v2u a = *(const LAS v2u*)p0, b = *(const LAS v2u*)p1; v4u t; t.x = a.x; t.y = a.y; t.z = b.x; t.w = b.y; return __builtin_bit_cast(bf16x8, t); }
__device__ __forceinline__ unsigned short bf1(float v) { return (unsigned short)(pk2(v, 0.f) & 0xffffu); }
}

template <int SWEEP> __device__ __forceinline__ void ssd3_sweep(const Ids I_, LAS unsigned char* lds, int l) {
    using namespace ssd3;
    constexpr int sweep = SWEEP;
    const Ids I = fresh(I_);
    const KA ka = ka_fresh(); unsigned char* ws = KWS(ka);
    const bf16* XBC = (const bf16*)(ws + WS_XBC); const float* DT = (const float*)(ws + WS_DT); bf16* Y = (bf16*)(ws + WS_Y);
    const int tid = I.tid, lane = I.lane, w = I.wave, li = lane & 15, lg = lane >> 4;
    const int id = I.vcu, b = id >> 6, h = (id >> 1) & 31, ph = id & 1, grp = h >> 2;
    const float Dsum = KIN(ka, 12)[l * 64 + h] + KIN(ka, 12)[l * 64 + 32 + h];
    const float A_f = -__expf(KIN(ka, 11)[l * 64 + h]), A_b = -__expf(KIN(ka, 11)[l * 64 + 32 + h]);
    const size_t xcol = (size_t)h * 64 + ph * 32;
    const int srow = tid >> 2, sc4 = tid & 3;
    auto row_of = [&](int idx) -> int { const int c = idx < 2 ? (sweep ? 1 - idx : idx) : (sweep ? 31 - (idx - 2) : idx - 2); return idx < 2 ? MLAT + b * CTXL + 128 * c : b * SEQ + 128 * c; };

    v4u pb[4], px; float pdf = 0.f, pdb = 0.f; v4u pcn[4]; v2u pxo[2];
#define SSD3_LOAD_S(idx_) do { const int r0_ = row_of(idx_); \
        _Pragma("unroll") for (int q = 0; q < 4; ++q) { const int ch = tid + 512 * q; pb[q] = *(const v4u*)(XBC + (size_t)(r0_ + (ch >> 4)) * XBCW + 2048 + grp * 128 + (ch & 15) * 8); } \
        px = *(const v4u*)(XBC + (size_t)(r0_ + srow) * XBCW + xcol + sc4 * 8); pdf = DT[(size_t)h * MTOT + r0_ + srow]; pdb = DT[(size_t)(32 + h) * MTOT + r0_ + srow]; } while (0)
#define SSD3_LOAD_C(idx_) do { const int r0_ = row_of(idx_); \
        _Pragma("unroll") for (int q = 0; q < 4; ++q) pcn[q] = *(const v4u*)(XBC + (size_t)(r0_ + 16 * w + li) * XBCW + 3072 + grp * 128 + (4 * q + lg) * 8); \
        if (sweep == 0) { _Pragma("unroll") for (int pt = 0; pt < 2; ++pt) pxo[pt] = *(const v2u*)(XBC + (size_t)(r0_ + 16 * w + li) * XBCW + xcol + 16 * pt + 4 * lg); } } while (0)
#define SSD3_STAGE(gen) do { \
        LAS float* T_ = (LAS float*)(lds + L_TAB) + (gen) * T_FLOATS; \
        float tf_, tb_; const float af_ = scan16x4(pdf * A_f, lane, tf_); const float bv_ = pdb * A_b; const float sb_ = scan16x4(bv_, lane, tb_); \
        const float rb_ = tb_ - sb_ + bv_, ejf_ = __expf(tf_ - af_), ejb_ = __expf(tb_ - rb_); \
        if (sc4 == 0) { T_[T_AFL + srow] = af_; T_[T_RBL + srow] = rb_; T_[T_EJF + srow] = ejf_; T_[T_EJB + srow] = ejb_; } \
        if (lane == 0) { T_[T_TF + w] = tf_; T_[T_TB + w] = tb_; } \
        _Pragma("unroll") for (int q = 0; q < 4; ++q) { const int ch = tid + 512 * q; *(LAS v4u*)(lds + L_BS + (gen) * 34816 + (ch >> 4) * ROW + (ch & 15) * 16) = pb[q]; } \
        const float xv_[8] = {bf_lo(px.x), bf_hi(px.x), bf_lo(px.y), bf_hi(px.y), bf_lo(px.z), bf_hi(px.z), bf_lo(px.w), bf_hi(px.w)}; \
        LAS unsigned short* xd_ = (LAS unsigned short*)(lds + L_XD + (gen) * 8704 + (8 * sc4) * ROW) + srow; \
        if (sweep == 0) { LAS unsigned short* xf_ = (LAS unsigned short*)(lds + L_XF + (gen) * 8704 + (8 * sc4) * ROW) + srow; LAS unsigned short* xb_ = (LAS unsigned short*)(lds + L_XB + (gen) * 8704 + (8 * sc4) * ROW) + srow; \
            const float e_ = pdf * ejf_; \
            _Pragma("unroll") for (int q = 0; q < 8; ++q) { xf_[q * (ROW / 2)] = bf1(xv_[q] * pdf); xb_[q * (ROW / 2)] = bf1(xv_[q] * pdb); xd_[q * (ROW / 2)] = bf1(xv_[q] * e_); } } \
        else { const float e_ = pdb * ejb_; _Pragma("unroll") for (int q = 0; q < 8; ++q) xd_[q * (ROW / 2)] = bf1(xv_[q] * e_); } } while (0)

    __syncthreads();
    for (int i = tid; i < 17408 / 4; i += NWAVES * 64) ((LAS unsigned*)(lds + L_SS))[i] = 0u;
    f32x4 sacc[2] = {{0.f, 0.f, 0.f, 0.f}, {0.f, 0.f, 0.f, 0.f}};
    SSD3_LOAD_S(0); SSD3_STAGE(0);
    SSD3_LOAD_S(1); SSD3_LOAD_C(0);
    for (int idx = 0; idx < 34; ++idx) {
        const int r0 = row_of(idx), par = idx & 1;
        const bool need_y = !(l == 1 && idx < 2);
        __syncthreads();
        if (idx + 1 < 34) SSD3_STAGE(par ^ 1);
        bf16x8 cf[4]; v2u xo[2] = {{0u, 0u}, {0u, 0u}};
#pragma unroll
        for (int ks = 0; ks < 4; ++ks) cf[ks] = __builtin_bit_cast(bf16x8, pcn[ks]);
        if (sweep == 0) { xo[0] = pxo[0]; xo[1] = pxo[1]; }
        if (idx + 2 < 34) SSD3_LOAD_S(idx + 2);
        if (idx + 1 < 34) SSD3_LOAD_C(idx + 1);
        const LAS unsigned char* BSc = lds + L_BS + par * 34816; const LAS unsigned char* XFc = lds + L_XF + par * 8704; const LAS unsigned char* XBc = lds + L_XB + par * 8704; const LAS unsigned char* XDc = lds + L_XD + par * 8704;
        const LAS unsigned char* SScur = lds + L_SS + par * 8704; LAS unsigned char* SSnxt = lds + L_SS + (par ^ 1) * 8704;
        const LAS float* T = (const LAS float*)(lds + L_TAB) + par * T_FLOATS;
        v2u yold[2] = {{0u, 0u}, {0u, 0u}};
        if (sweep == 1 && need_y) { _Pragma("unroll") for (int pt = 0; pt < 2; ++pt) yold[pt] = *(const v2u*)(Y + (size_t)(r0 + 16 * w + li) * DI + xcol + 16 * pt + 4 * lg); }
        float PF[9], SB[9], TFv[8], TBv[8];
#pragma unroll
        for (int t = 0; t < 8; ++t) { TFv[t] = T[T_TF + t]; TBv[t] = T[T_TB + t]; }
        PF[0] = 0.f; SB[8] = 0.f;
#pragma unroll
        for (int t = 0; t < 8; ++t) { PF[t + 1] = PF[t] + TFv[t]; SB[7 - t] = SB[8 - t] + TBv[7 - t]; }
        float PFw = 0.f, SBw1 = 0.f;
#pragma unroll
        for (int t = 0; t < 8; ++t) { PFw = (t == w) ? PF[t] : PFw; SBw1 = (t == w) ? SB[t + 1] : SBw1; }
        const float afl_i = T[T_AFL + 16 * w + li], rbl_i = T[T_RBL + 16 * w + li];
        const float af_i = PFw + afl_i, rb_i = SBw1 + rbl_i;
        if (need_y) {
        f32x4 yacc[2] = {{0.f, 0.f, 0.f, 0.f}, {0.f, 0.f, 0.f, 0.f}}, yi[2] = {{0.f, 0.f, 0.f, 0.f}, {0.f, 0.f, 0.f, 0.f}};
        {
            bf16x8 sf[8];
#pragma unroll
            for (int ks = 0; ks < 4; ++ks)
#pragma unroll
                for (int pt = 0; pt < 2; ++pt) sf[2 * ks + pt] = *(const LAS bf16x8*)(SScur + (16 * pt + li) * ROW + (32 * ks + 8 * lg) * 2);
            __builtin_amdgcn_sched_barrier(0);
#pragma unroll
            for (int ks = 0; ks < 4; ++ks)
#pragma unroll
                for (int pt = 0; pt < 2; ++pt) yi[pt] = SSD3_MFMA32(sf[2 * ks + pt], cf[ks], yi[pt]);
        }
        const float escale = __expf(sweep == 0 ? af_i : rb_i);
        if (sweep == 0) {
            f32x4 g[8];
            {
                bf16x8 fa[8], fb[8];
#define SSD3_GLOAD(dst, jp) do { _Pragma("unroll") for (int q_ = 0; q_ < 8; ++q_) dst[q_] = *(const LAS bf16x8*)(BSc + (16 * (2 * (jp) + (q_ >> 2)) + li) * ROW + (32 * (q_ & 3) + 8 * lg) * 2); } while (0)
#define SSD3_GMMA(src, jp) do { g[2 * (jp)] = (f32x4){0.f, 0.f, 0.f, 0.f}; g[2 * (jp) + 1] = (f32x4){0.f, 0.f, 0.f, 0.f}; \
                    _Pragma("unroll") for (int q_ = 0; q_ < 8; ++q_) g[2 * (jp) + (q_ >> 2)] = SSD3_MFMA32(src[q_], cf[q_ & 3], g[2 * (jp) + (q_ >> 2)]); } while (0)
                SSD3_GLOAD(fa, 0); __builtin_amdgcn_sched_barrier(0);
                SSD3_GLOAD(fb, 1); __builtin_amdgcn_sched_barrier(0); SSD3_GMMA(fa, 0); __builtin_amdgcn_sched_barrier(0);
                SSD3_GLOAD(fa, 2); __builtin_amdgcn_sched_barrier(0); SSD3_GMMA(fb, 1); __builtin_amdgcn_sched_barrier(0);
                SSD3_GLOAD(fb, 3); __builtin_amdgcn_sched_barrier(0); SSD3_GMMA(fa, 2); __builtin_amdgcn_sched_barrier(0);
                SSD3_GMMA(fb, 3); __builtin_amdgcn_sched_barrier(0);
#undef SSD3_GLOAD
#undef SSD3_GMMA
            }
#define SSD3_TILE_F(t, mo) do { if ((t) < w) { const float ei = __expf(af_i - PF[(t) + 1]); const f32x4 ejv = *(const LAS f32x4*)(T + T_EJF + 16 * (t) + 4 * lg); \
                    _Pragma("unroll") for (int r = 0; r < 4; ++r) m[(mo) + r] = g[t][r] * (ei * ejv[r]); } \
                else if ((t) == w) { const f32x4 av = *(const LAS f32x4*)(T + T_AFL + 16 * (t) + 4 * lg); \
                    _Pragma("unroll") for (int r = 0; r < 4; ++r) m[(mo) + r] = (4 * lg + r <= li) ? g[t][r] * __expf(fminf(afl_i - av[r], 0.f)) : 0.f; } \
                else { _Pragma("unroll") for (int r = 0; r < 4; ++r) m[(mo) + r] = 0.f; } } while (0)
#define SSD3_TILE_B(t, mo) do { if ((t) > w) { const float ei = __expf(rb_i - SB[t]); const f32x4 ejv = *(const LAS f32x4*)(T + T_EJB + 16 * (t) + 4 * lg); \
                    _Pragma("unroll") for (int r = 0; r < 4; ++r) m[(mo) + r] = g[t][r] * (ei * ejv[r]); } \
                else if ((t) == w) { const f32x4 av = *(const LAS f32x4*)(T + T_RBL + 16 * (t) + 4 * lg); \
                    _Pragma("unroll") for (int r = 0; r < 4; ++r) m[(mo) + r] = (4 * lg + r >= li) ? g[t][r] * __expf(fminf(rbl_i - av[r], 0.f)) : 0.f; } \
                else { _Pragma("unroll") for (int r = 0; r < 4; ++r) m[(mo) + r] = 0.f; } } while (0)
#pragma unroll
            for (int kk = 0; kk < 4; ++kk) {
                const int t0 = 2 * kk, t1 = 2 * kk + 1;
                if (t0 <= w) {
                    float m[8]; SSD3_TILE_F(t0, 0); SSD3_TILE_F(t1, 4);
                    const bf16x8 bfr = pack8f(m);
#pragma unroll
                    for (int pt = 0; pt < 2; ++pt) { const LAS unsigned char* rp = XFc + (16 * pt + li) * ROW; const bf16x8 a = ld2x8(rp + (32 * kk + 4 * lg) * 2, rp + (32 * kk + 16 + 4 * lg) * 2); yacc[pt] = SSD3_MFMA32(a, bfr, yacc[pt]); }
                }
                if (t1 >= w) {
                    float m[8]; SSD3_TILE_B(t0, 0); SSD3_TILE_B(t1, 4);
                    const bf16x8 bfr = pack8f(m);
#pragma unroll
                    for (int pt = 0; pt < 2; ++pt) { const LAS unsigned char* rp = XBc + (16 * pt + li) * ROW; const bf16x8 a = ld2x8(rp + (32 * kk + 4 * lg) * 2, rp + (32 * kk + 16 + 4 * lg) * 2); yacc[pt] = SSD3_MFMA32(a, bfr, yacc[pt]); }
                }
            }
#undef SSD3_TILE_F
#undef SSD3_TILE_B
        }
#pragma unroll
        for (int pt = 0; pt < 2; ++pt) {
            bf16* yp = Y + (size_t)(r0 + 16 * w + li) * DI + xcol + 16 * pt + 4 * lg;
            float o[4];
            if (sweep == 0) { const v2u xv = xo[pt];
                o[0] = yacc[pt][0] + escale * yi[pt][0] + Dsum * bf_lo(xv.x); o[1] = yacc[pt][1] + escale * yi[pt][1] + Dsum * bf_hi(xv.x);
                o[2] = yacc[pt][2] + escale * yi[pt][2] + Dsum * bf_lo(xv.y); o[3] = yacc[pt][3] + escale * yi[pt][3] + Dsum * bf_hi(xv.y); }
            else { const v2u yv = yold[pt];
                o[0] = bf_lo(yv.x) + escale * yi[pt][0]; o[1] = bf_hi(yv.x) + escale * yi[pt][1]; o[2] = bf_lo(yv.y) + escale * yi[pt][2]; o[3] = bf_hi(yv.y) + escale * yi[pt][3]; }
            v2u ov; ov.x = pk2(o[0], o[1]); ov.y = pk2(o[2], o[3]); *(v2u*)yp = ov;
        }
        }
        {
            const int q = li >> 2, pq = li & 3;
            s16x4 ta[8]; s16x4 xd[8][2];
#pragma unroll
            for (int t = 0; t < 8; ++t) { ta[t] = __builtin_amdgcn_ds_read_tr16_b64_v4i16((LAS s16x4*)(BSc + (16 * t + 4 * lg + q) * ROW + (16 * w + 4 * pq) * 2));
#pragma unroll
                for (int pt = 0; pt < 2; ++pt) xd[t][pt] = *(const LAS s16x4*)(XDc + (16 * pt + li) * ROW + (16 * t + 4 * lg) * 2); }
            __builtin_amdgcn_sched_barrier(0);
#pragma unroll
            for (int tt = 0; tt < 8; ++tt) { const int t = sweep == 0 ? tt : 7 - tt; const float dec = __expf(sweep == 0 ? TFv[t] : TBv[t]);
#pragma unroll
                for (int pt = 0; pt < 2; ++pt) { sacc[pt] = sacc[pt] * dec; sacc[pt] = SSD3_MFMA16(ta[t], xd[t][pt], sacc[pt]); } }
#pragma unroll
            for (int pt = 0; pt < 2; ++pt) { v2u sv; sv.x = pk2(sacc[pt][0], sacc[pt][1]); sv.y = pk2(sacc[pt][2], sacc[pt][3]); *(LAS v2u*)(SSnxt + (16 * pt + li) * ROW + (16 * w + 4 * lg) * 2) = sv; }
        }
    }
#undef SSD3_LOAD_S
#undef SSD3_LOAD_C
#undef SSD3_STAGE
    VM_WAIT(); __syncthreads();
}
__device__ __forceinline__ void phase_ssd3(const Ids I, LAS unsigned char* lds, int l) { ssd3_sweep<0>(I, lds, l); ssd3_sweep<1>(I, lds, l); }

__device__ __forceinline__ void phase_pool(const Ids I_, LAS unsigned char* lds_base, int l) {
    LAS unsigned char* lds_misc = lds_base + MISC_OFF;
    const Ids I = fresh(I_);
    const KA ka = ka_fresh(); unsigned char* ws = KWS(ka);
    const bf16* UPOOL = (const bf16*)(ws + WS_XBC + XO_UPOOL);
    bf16* PML = (bf16*)(ws + WS_XBC + XO_UPOOL); bf16* PMC = (bf16*)(ws + WS_DT);
    const int nitems = (l == 0) ? 1024 + 64 : 1024;
    pg8::pg8_gu32* work = (pg8::pg8_gu32*)(ws + WS_CTL) + CW_WORK + 64 * l; pg8::pg8_gu32* cp_ = cnt_arr(ws, l, 0); pg8::pg8_gu32* tmo = (pg8::pg8_gu32*)(ws + WS_CTL) + CW_BAR + XB_TMO;
#define POOL_GEOM(item_) int seqb, L, w0, gi; \
        if ((item_) < 1024) { seqb = ((item_) >> 2) * 64; L = 64; w0 = 0; gi = (item_) & 3; } \
        else { const int ci = (item_) - 1024; gi = ci & 3; w0 = 64 * ((ci >> 2) & 3); seqb = MLAT + 256 * (ci >> 4); L = 256; } \
        const int cp = I.tid & 127, rs = I.tid >> 7, t0 = w0 + 16 * rs, col = gi * 256 + 2 * cp;
#define POOL_OUT(HK) do { _Pragma("unroll") for (int i = 0; i < 16; ++i) { const int t = t0 + i; const float slo = plo[i + 8 + HK] - plo[i + 8 - HK], shi = phi[i + 8 + HK] - phi[i + 8 - HK]; \
            const int lo = t - HK < 0 ? 0 : t - HK, hi = t + HK > L ? L : t + HK; const float inv = __builtin_amdgcn_rcpf((float)(hi - lo)); \
            *(unsigned*)(pout + (size_t)t * 1024 + col) = pk2(slo * inv - bf_lo(r_[i + 8]), shi * inv - bf_hi(r_[i + 8])); } } while (0)
#define POOL_CLAIM_WAIT(claim_) do { const int it_ = 2 * (int)(claim_); \
        if (it_ < nitems) { const int pmi_ = it_ < 1024 ? (it_ >> 4) : 64 + ((it_ - 1024) >> 4); unsigned sp_ = 0; \
            while (__hip_atomic_load(cp_ + 64 * pmi_, __ATOMIC_RELAXED, __HIP_MEMORY_SCOPE_AGENT) < 32u) { __builtin_amdgcn_s_sleep(2); \
                if ((++sp_ & 255u) == 0u) { if (__hip_atomic_load(tmo, __ATOMIC_RELAXED, __HIP_MEMORY_SCOPE_AGENT) != 0u) break; if (sp_ > (1u << 20)) { __hip_atomic_fetch_add(tmo, 1u, __ATOMIC_RELAXED, __HIP_MEMORY_SCOPE_AGENT); break; } } } \
            __builtin_amdgcn_fence(__ATOMIC_ACQUIRE, "agent"); asm volatile("s_waitcnt vmcnt(0)" ::: "memory"); } } while (0)
#define POOL_LOAD(r_, item_) do { POOL_GEOM(item_) \
        _Pragma("unroll") for (int i = 0; i < 32; ++i) { const int t = t0 - 8 + i; unsigned v = 0u; if (t >= 0 && t < L) v = *(const unsigned*)(UPOOL + (size_t)(seqb + t) * 1024 + col); r_[i] = v; } } while (0)
#define POOL_COMP(rr_, item_) do { POOL_GEOM(item_) const unsigned (&r_)[32] = rr_; bf16* pout = (item_) < 1024 ? PML + (size_t)seqb * 1024 : PMC + (size_t)(seqb - MLAT) * 1024; \
        float plo[33], phi[33]; plo[0] = 0.f; phi[0] = 0.f; \
        _Pragma("unroll") for (int i = 0; i < 32; ++i) { plo[i + 1] = plo[i] + bf_lo(r_[i]); phi[i + 1] = phi[i] + bf_hi(r_[i]); } \
        if (gi == 0) POOL_OUT(1); else if (gi == 1) POOL_OUT(2); else if (gi == 2) POOL_OUT(4); else POOL_OUT(8); } while (0)
    volatile LAS unsigned* slot = (volatile LAS unsigned*)(lds_misc) + 40;
    if (I.tid == 0) { const unsigned c0 = __hip_atomic_fetch_add(work, 1u, __ATOMIC_RELAXED, __HIP_MEMORY_SCOPE_AGENT); POOL_CLAIM_WAIT(c0); slot[0] = c0; }
    __syncthreads();
    int item = 2 * (int)slot[0], par = 0;
    while (item < nitems) {
        unsigned nclaim = 0u;
        unsigned ra[32], rb[32];
        POOL_LOAD(ra, item); POOL_LOAD(rb, item + 1);
        asm volatile("s_waitcnt vmcnt(0)" ::: "memory"); __syncthreads();
        if (I.tid == 0) nclaim = __hip_atomic_fetch_add(work, 1u, __ATOMIC_RELAXED, __HIP_MEMORY_SCOPE_AGENT);
        POOL_COMP(ra, item); POOL_COMP(rb, item + 1);
        if (I.tid == 0) { POOL_CLAIM_WAIT(nclaim); slot[par ^ 1] = nclaim; }
        __syncthreads();
        par ^= 1; item = 2 * (int)slot[par];
    }
#undef POOL_COMP
#undef POOL_LOAD
#undef POOL_CLAIM_WAIT
#undef POOL_OUT
#undef POOL_GEOM
}

__device__ __forceinline__ void phase_final(const Ids I_) {
    const Ids I = fresh(I_);
    const KA ka = ka_fresh(); float* OUT = KOUT(ka); const float* g = KIN(ka, 22);
    const bool dead = xb_ld((gu32*)(KWS(ka) + WS_CTL) + CW_BAR + XB_TMO) != 0u;
    v2u ta[4], tb[4];
#define FIN_LOAD(t_, mm) do { const v2u* q_ = (const v2u*)((const bf16*)OUT + (size_t)(mm) * 2048) + I.lane; _Pragma("unroll") for (int j = 0; j < 4; ++j) t_[j] = q_[64 * j]; } while (0)
#define FIN_ROW(t_, mm) do { f32x4 v[4]; float s = 0.f; \
        _Pragma("unroll") for (int j = 0; j < 4; ++j) { const v2u t = t_[j]; v[j] = (f32x4){bf_lo(t.x), bf_hi(t.x), bf_lo(t.y), bf_hi(t.y)}; s += (v[j].x * v[j].x + v[j].y * v[j].y) + (v[j].z * v[j].z + v[j].w * v[j].w); } \
        if ((mm) + 2 * I.NGW < MLAT) FIN_LOAD(t_, (mm) + 2 * I.NGW); \
        const float rstd = rsqrtf(wave_sum(s) * (1.f / D) + 1e-6f); \
        f32x4* xr = (f32x4*)(OUT + (size_t)(mm) * D) + I.lane; \
        _Pragma("unroll") for (int j = 0; j < 4; ++j) { f32x4 o = v[j] * rstd * ((const f32x4*)g)[I.lane + 64 * j]; if (dead) { const float qn = __builtin_nanf(""); o = (f32x4){qn, qn, qn, qn}; } xr[64 * j] = o; } } while (0)
    int m = I.gw;
    if (m < MLAT) FIN_LOAD(ta, m);
    if (m + I.NGW < MLAT) FIN_LOAD(tb, m + I.NGW);
    for (; m < MLAT; m += 2 * I.NGW) {
        FIN_ROW(ta, m);
        const int m1 = m + I.NGW; if (m1 >= MLAT) break;
        FIN_ROW(tb, m1);
    }
#undef FIN_ROW
#undef FIN_LOAD
}

#ifndef DBG_STOP
#define DBG_STOP 0
#endif
__device__ __forceinline__ void phase_dump(const Ids I_, size_t ws_off, int cols, bool ctx_rows, bool isf32, bool accum = false) {
    const Ids I = fresh(I_);
    const KA ka = ka_fresh(); float* OUT = KOUT(ka); unsigned char* base = KWS(ka) + ws_off;
    for (int m = I.gw; m < MLAT; m += I.NGW) {
        for (int c = I.lane; c < 1024; c += 64) { float s = 0.f;
            for (int j = 0; j < cols / 1024; ++j) {
                if (isf32) { s += ((const float*)base)[(size_t)m * cols + c + 1024 * j]; }
                else {
#ifdef DBG_ATOMIC_DUMP
                    { const size_t e = (size_t)m * cols + c + 1024 * j; const unsigned w = __hip_atomic_fetch_or((unsigned*)base + (e >> 1), 0u, __ATOMIC_RELAXED, __HIP_MEMORY_SCOPE_AGENT); s += (e & 1) ? bf_hi(w) : bf_lo(w); }
                    if (ctx_rows) { const size_t e = (size_t)(MLAT + (m & 1023)) * cols + c + 1024 * j; const unsigned w = __hip_atomic_fetch_or((unsigned*)base + (e >> 1), 0u, __ATOMIC_RELAXED, __HIP_MEMORY_SCOPE_AGENT); s += (e & 1) ? bf_hi(w) : bf_lo(w); }
#else
                    s += bf_lo(((const bf16*)base)[(size_t)m * cols + c + 1024 * j]); if (ctx_rows) s += bf_lo(((const bf16*)base)[(size_t)(MLAT + (m & 1023)) * cols + c + 1024 * j]);
#endif
                } }
            if (accum) s += OUT[(size_t)m * D + c]; OUT[(size_t)m * D + c] = s; } }
}

__global__ void __launch_bounds__(NWAVES * 64, 2) fwd_kernel(Args args) {
    LAS unsigned char* lds = (LAS unsigned char*)pg8::lds_dyn;
    volatile LAS unsigned* MISC = (volatile LAS unsigned*)(lds + MISC_OFF);
    LAS unsigned char* xl = lds + XL_OFF;
    if ((threadIdx.x & 63u) == 0u) ((volatile LAS unsigned*)(lds + pg8::WAVE_TAB_OFF))[pg8::hw_slot()] = threadIdx.x >> 6;
    __syncthreads();
    Ids I; I.wave = pg8::wave_now(); I.tid = I.wave * 64 + pg8::lane_now(); I.lane = I.tid & 63;
    I.G = gridDim.x; I.bx = blockIdx.x; I.vcu = (I.G % 8 == 0) ? (I.bx % 8) * (I.G / 8) + I.bx / 8 : I.bx;
    I.gw = I.vcu * NWAVES + I.wave; I.NGW = I.G * NWAVES;
    const int G = I.G, bx = I.bx;

    for (int u = I.tid; u < 64; u += NWAVES * 64) MISC[u] = 0u;
    __syncthreads();
    XcdBarrier bar = xcd_barrier_post((gu32*)(KWS(ka_fresh()) + WS_CTL) + CW_BAR, MISC + 8);
#ifdef TSEL
    unsigned long long t_prev = __builtin_amdgcn_s_memrealtime(), t_acc = 0ull; int t_stage = 0;
#define GRID_BAR() do { xcd_barrier(bar); { const unsigned long long t_now = __builtin_amdgcn_s_memrealtime(); if ((TSEL >> t_stage) & 1ull) t_acc += t_now - t_prev; t_prev = t_now; ++t_stage; } } while (0)
#else
#define GRID_BAR() xcd_barrier(bar)
#endif

    phase_mod(I, lds);
    conv_mixer(I, lds, 0);
    GRID_BAR();

    for (int l = 0; l < 2; ++l) {
        const int Mfull = (l == 0) ? MTOT : MLAT;
        phase_norm(I, l, 0, MTOT, l == 0);
        GRID_BAR();
        if (DBG_STOP != 11) {
            const KA ka = ka_fresh(); unsigned char* ws = KWS(ka);
            pg8::Gemm g{(const bf16*)(ws + WS_H), (const bf16*)(ws + WS_WIN), 1024, 1024, MTOT, NB1, 1024, 0};
            pg8::PanelOrder S; S.init(MTOT, NB1, G, bx); S.set_base(ws + WS_CTL); S.wait0 = -1; S.need0 = 0u; S.wait1 = -1; S.need1 = 0u; S.done_cnt = cnt_off(l, 3); S.tmo = CW_BAR + XB_TMO;
            pg8::EpiXbcDt E{(bf16*)(ws + WS_XBC), (bf16*)(ws + WS_Y), (float*)(ws + WS_DT), KIN(ka, 10) + l * 64};
            pg8::gemm_phase<pg8::EpiXbcDt, pg8::PanelOrder>(lds, xl, g, S, E);
        }
        phase_conv(I, lds, l);
        GRID_BAR();
        if (DBG_STOP == 2) { phase_dump(I, WS_XBC, 4096, true, false); return; }
#ifdef SSD_NAIVE
        phase_ssd(I, lds, l);
#elif defined(SSD_V2)
        phase_ssd_dir(I, lds, l);
#else
        phase_ssd3(I, lds, l);
#ifdef REP_SSD
        phase_ssd_mfma(I, lds, l);
#endif
#endif
        GRID_BAR();
        if (DBG_STOP == 1) { phase_dump(I, WS_Y, 2048, true, false); return; }
        if (DBG_STOP == 9) { phase_dump(I, WS_H, 1024, true, false); phase_dump(I, WS_WIN, 1024, false, false, true); return; }
        {
            const KA ka = ka_fresh(); unsigned char* ws = KWS(ka);
            pg8::Gemm g{(const bf16*)(ws + WS_H), (const bf16*)(ws + WS_WIN) + (size_t)NB1 * 1024, 1024, 1024, Mfull, NB2, 1024, 0};
            pg8::PoolChainOrder S; S.init(Mfull, NB2, G, bx); S.set_base(ws + WS_CTL); S.wait0 = -1; S.need0 = 0u; S.wait1 = -1; S.need1 = 0u; S.done_cnt = cnt_off(l, 0); S.tmo = CW_BAR + XB_TMO;
            pg8::EpiZPG E{(bf16*)(ws + WS_Y), (bf16*)(ws + WS_XBC + XO_UPOOL), (bf16*)(ws + WS_XBC + XO_GATES)};
            pg8::gemm_phase<pg8::EpiZPG, pg8::PoolChainOrder>(lds, xl, g, S, E);
        }
        phase_pool(I, lds, l);
        GRID_BAR();
        if (DBG_STOP == 5) { phase_dump(I, WS_Y, 2048, true, false); phase_dump(I, WS_XBC + XO_GATES, 2048, true, false, true); phase_dump(I, WS_XBC + XO_UPOOL, 1024, true, false, true); return; }
        if (DBG_STOP == 8) { { const unsigned long long t0 = __builtin_amdgcn_s_memrealtime(); while (__builtin_amdgcn_s_memrealtime() - t0 < 50000ull) __builtin_amdgcn_s_sleep(32); } GRID_BAR(); phase_dump(I, WS_XBC + XO_GATES, 2048, true, false); phase_dump(I, WS_XBC + XO_UPOOL, 1024, true, false, true); return; }
        {
            const KA ka = ka_fresh(); unsigned char* ws = KWS(ka);
            pg8::Gemm g{(const bf16*)(ws + WS_Y), (const bf16*)(ws + WS_WSSD), 2048, 2048, Mfull, 1024, 2048, 0};
            pg8::ChainOrder S; S.init(Mfull, 1024, G, bx); S.set_base(ws + WS_CTL); S.wait0 = -1; S.need0 = 0u; S.wait1 = -1; S.need1 = 0u; S.done_cnt = cnt_off(l, 1); S.tmo = CW_BAR + XB_TMO;
            pg8::EpiGate<0> E{(bf16*)(ws + WS_XBC + XO_M1), (const bf16*)(ws + WS_XBC + XO_GATES)};
            pg8::gemm_phase<pg8::EpiGate<0>, pg8::ChainOrder>(lds, xl, g, S, E);
        }
        {
            const KA ka = ka_fresh(); unsigned char* ws = KWS(ka);
            pg8::Gemm g{(const bf16*)(ws + WS_XBC + XO_UPOOL), (const bf16*)(ws + WS_WPC), 1024, 1024, Mfull, 1024, 1024, 0};
            pg8::FOrder S; S.ctx_delta = (size_t)((long long)WS_DT - (long long)(WS_XBC + XO_UPOOL) - 64ll * 256 * 1024 * 2); S.init(Mfull, 1024, G, (bx + 16) % G); S.set_base(ws + WS_CTL); S.wait0 = cnt_off(l, 1); S.need0 = 32u; S.wait1 = -1; S.need1 = 0u; S.done_cnt = cnt_off(l, 2); S.tmo = CW_BAR + XB_TMO;
            pg8::EpiGate<1> E{(bf16*)(ws + WS_XBC + XO_M1), (const bf16*)(ws + WS_XBC + XO_GATES)};
            pg8::gemm_phase<pg8::EpiGate<1>, pg8::FOrder>(lds, xl, g, S, E);
        }
        {
            const KA ka = ka_fresh(); unsigned char* ws = KWS(ka);
            pg8::Gemm g{(const bf16*)(ws + WS_XBC + XO_M1), (const bf16*)(ws + WS_WOUT), 1024, 1024, Mfull, 1024, 1024, 0};
            pg8::RelChainOrder S; S.init(Mfull, 1024, G, (bx + 32) % G); S.set_base(ws + WS_CTL); S.wait0 = cnt_off(l, 2); S.need0 = 32u; S.wait1 = -1; S.need1 = 0u; S.done_cnt = cnt_off(l, 4); S.lds_word = (unsigned)(size_t)(lds + MISC_OFF + 46 * 4); S.tmo = CW_BAR + XB_TMO;
            if (l == 0) { pg8::EpiRes<false> E{KIN(ka, 0), (bf16*)KOUT(ka), KIN(ka, 2), (float*)(ws + WS_CX), (const float*)(ws + WS_MOD) + 2048};
                pg8::gemm_phase<pg8::EpiRes<false>, pg8::RelChainOrder>(lds, xl, g, S, E); }
            else { pg8::EpiRes<true> E{nullptr, (bf16*)KOUT(ka), (const float*)(ws + WS_CX), (float*)(ws + WS_CX), (const float*)(ws + WS_MOD) + (size_t)5 * 6144 + 2048};
                pg8::gemm_phase<pg8::EpiRes<true>, pg8::RelChainOrder>(lds, xl, g, S, E); }
        }
        if (l == 0) conv_win_dyn(I, lds, 1);
        phase_norm2_dyn(I, lds, l, Mfull);
        conv_ffn(I, lds, l);
        if (l == 0) conv_mixer(I, lds, 1, true);
        GRID_BAR();
        {
            const KA ka = ka_fresh(); unsigned char* ws = KWS(ka);
            pg8::Gemm g{(const bf16*)(ws + WS_H), (const bf16*)(ws + WS_XBC + XO_WGU), 1024, 1024, Mfull, 2 * FFH, 1024, 0}; pg8::StaticOrder S; S.init(Mfull, 2 * FFH, G, bx);
            pg8::EpiSwiglu E{(bf16*)(ws + WS_XBC + XO_ACT)};
            pg8::gemm_phase<pg8::EpiSwiglu, pg8::StaticOrder>(lds, xl, g, S, E);
        }
        GRID_BAR();
        if (DBG_STOP == 4) { phase_dump(I, WS_XBC + XO_ACT, 2048, false, false); return; }
        {
            const KA ka = ka_fresh(); unsigned char* ws = KWS(ka);
            pg8::Gemm g{(const bf16*)(ws + WS_XBC + XO_ACT), (const bf16*)(ws + WS_XBC + XO_WDN), FFH, FFH, MLAT, 1024, FFH, 0}; pg8::StaticOrder S; S.init(MLAT, 1024, G, bx);
            pg8::EpiRes<true> E{nullptr, (bf16*)KOUT(ka), (const float*)(ws + WS_CX), (float*)(ws + WS_CX), (const float*)(ws + WS_MOD) + (size_t)l * 5 * 6144 + 5120};
            pg8::gemm_phase<pg8::EpiRes<true>, pg8::StaticOrder>(lds, xl, g, S, E);
        }
        if (l == 0) {
            const KA ka = ka_fresh(); unsigned char* ws = KWS(ka);
            pg8::Gemm g{(const bf16*)(ws + WS_XBC + XO_ACT), (const bf16*)(ws + WS_XBC + XO_WDN), FFH, FFH, MTOT, 1024, 256, 0}; pg8::SplitKOrder S; S.G = G; S.c = bx;
            pg8::EpiPart E{(float*)(ws + WS_Y)};
            pg8::gemm_phase<pg8::EpiPart, pg8::SplitKOrder>(lds, xl, g, S, E);
        }
        GRID_BAR();
    }
#ifdef TSEL
    {
        gu32* tw = (gu32*)(KWS(ka_fresh()) + WS_CTL) + 8192;
        if (I.bx == 0 && I.tid == 0) __hip_atomic_store(tw, (unsigned)t_acc, __ATOMIC_RELAXED, __HIP_MEMORY_SCOPE_AGENT);
        xcd_barrier(bar);
        const unsigned long long dur = (unsigned long long)__hip_atomic_load(tw, __ATOMIC_RELAXED, __HIP_MEMORY_SCOPE_AGENT) * TMUL;
        const unsigned long long t0 = __builtin_amdgcn_s_memrealtime(); while (__builtin_amdgcn_s_memrealtime() - t0 < dur) __builtin_amdgcn_s_sleep(16);
    }
#endif
    phase_final(I);
}

extern "C" void kernel_launch(void* const* d_in, const int* in_sizes, int n_in, void* d_out, int out_size, void* d_ws, size_t ws_size, hipStream_t stream) {
    static int grid = 0;
    if (grid == 0) {
        if (n_in != 23 || in_sizes[0] != MLAT * D || out_size != MLAT * D || ws_size < WS_END) { fprintf(stderr, "kernel_launch: unexpected shapes / workspace (n_in %d, ws %zu, need %zu); nothing launched\n", n_in, ws_size, (size_t)WS_END); grid = -1; return; }
        int dev = 0, cus = 0, per_cu = 0;
        if (hipGetDevice(&dev) != hipSuccess || hipDeviceGetAttribute(&cus, hipDeviceAttributeMultiprocessorCount, dev) != hipSuccess) { grid = -1; return; }
        if (hipFuncSetAttribute((const void*)fwd_kernel, hipFuncAttributeMaxDynamicSharedMemorySize, LDS_BYTES) != hipSuccess) { fprintf(stderr, "kernel_launch: hipFuncSetAttribute failed\n"); grid = -1; return; }
        if (hipOccupancyMaxActiveBlocksPerMultiprocessor(&per_cu, (const void*)fwd_kernel, NWAVES * 64, LDS_BYTES) != hipSuccess || per_cu < 1) { fprintf(stderr, "kernel_launch: occupancy query says %d blocks per CU; nothing launched\n", per_cu); (void)hipGetLastError(); grid = -1; return; }
        grid = cus;
        if (grid != 256) { fprintf(stderr, "kernel_launch: built for a 256-CU device (got %d)\n", grid); grid = -1; return; }
    }
    if (grid < 0) return;
    if (hipMemsetAsync((char*)d_ws + WS_CTL, 0, CTL_ZERO_BYTES, stream) != hipSuccess) return;
    Args a{};
    for (int i = 0; i < 23; ++i) a.in[i] = (const float*)d_in[i];
    a.out = (float*)d_out; a.ws = (unsigned char*)d_ws;
    hipLaunchKernelGGL(fwd_kernel, dim3(grid), dim3(NWAVES * 64), LDS_BYTES, stream, a);
}
```

```cpp
#include <hip/hip_runtime.h>
#define SSD_V2 1
#define TSEL_OFF 0ull
#define TMUL 4ull
#include <cstdio>
#include <cstdint>

namespace pg8 {
#define PG8_LAS __attribute__((address_space(3)))
typedef unsigned short bf16_t;
typedef short bf16x8 __attribute__((ext_vector_type(8)));
typedef float f32x4 __attribute__((ext_vector_type(4)));
typedef float f32x2 __attribute__((ext_vector_type(2)));
typedef unsigned u32x4 __attribute__((ext_vector_type(4)));
typedef unsigned u32x2 __attribute__((ext_vector_type(2)));
constexpr int BM = 256, BK = 64, HALF = 128, HTB = HALF * BK * 2, STAGE_BYTES = 8 * HTB, NXCD = 8, WGM = 8;

__host__ __device__ __forceinline__ int lds_byte(int r, int c) { const int st = (r >> 4) * 2 + (c >> 5), rr = r & 15, cc = c & 31, ob = rr * 64 + cc * 2; return st * 1024 + (ob ^ (((ob >> 9) & 1) << 5)); }
__host__ __device__ __forceinline__ void stage_rc(int b, int& R, int& C) { const int st = b / 1024, sb = b % 1024, swz = sb ^ (((sb >> 9) & 1) << 5); R = (st >> 1) * 16 + swz / 64; C = (st & 1) * 32 + (swz % 64) / 2; }
__host__ __device__ __forceinline__ int perm32(int rho) { const int n = rho >> 4, i = rho & 15; return 8 * (i >> 2) + 4 * n + (i & 3); }

extern __shared__ __attribute__((aligned(16))) unsigned char lds_dyn[];
constexpr int WAVE_TAB_OFF = 159744 + 1024;
__device__ __forceinline__ int lane_now() { return (int)__builtin_amdgcn_mbcnt_hi(~0u, __builtin_amdgcn_mbcnt_lo(~0u, 0u)); }
__device__ __forceinline__ int hw_slot() { return (int)(__builtin_amdgcn_s_getreg(4 | (0 << 6) | (5 << 11)) & 63u); }
__device__ __forceinline__ int wave_now() { return __builtin_amdgcn_readfirstlane((int)((volatile PG8_LAS unsigned*)(lds_dyn + WAVE_TAB_OFF))[hw_slot()]); }
__device__ __forceinline__ int tid_now() { return wave_now() * 64 + lane_now(); }
struct Unit { int pm, pn; };
struct Gemm { const bf16_t* A; const bf16_t* Bt; int lda, ldb, M, N, K, a_pn_off; };

struct StaticOrder {
    int nM, nN, nwg, G, c;
    __host__ __device__ void init(int M, int N, int G_, int c_) { nM = M / BM; nN = N / BM; nwg = nM * nN; G = G_; c = c_; }
    __host__ __device__ bool next(int i, Unit& u) const {
        const long L = (long)i * G + c; if (L >= nwg) return false;
        int wgid = (int)L; { const int q = nwg / NXCD, r = nwg % NXCD, xcd = wgid % NXCD, off = wgid / NXCD; wgid = (xcd < r ? xcd * (q + 1) : r * (q + 1) + (xcd - r) * q) + off; }
        const int nig = WGM * nN, gid = wgid / nig, fm = gid * WGM, gsz = (nM - fm) < WGM ? (nM - fm) : WGM;
        u.pm = fm + ((wgid % nig) % gsz); u.pn = (wgid % nig) / gsz; return true;
    }
    __device__ __forceinline__ size_t a_off(const Unit& u, const Gemm& g, size_t tsA) const { return (size_t)u.pm * tsA + (size_t)u.pn * g.a_pn_off * 2; }
    __device__ __forceinline__ size_t b_off(const Unit& u, const Gemm&, size_t tsB) const { return (size_t)u.pn * tsB; }
    __device__ __forceinline__ void a_ready(const Unit&) const {}
    __device__ __forceinline__ void done(const Unit&) const {}
};
#define PG8_GAS __attribute__((address_space(1)))
typedef PG8_GAS unsigned pg8_gu32;
struct ChainOrder : StaticOrder {
    unsigned ctl_lo, ctl_hi;
    int wait0, wait1, done_cnt, tmo;
    unsigned need0, need1;
    __device__ __forceinline__ void set_base(const void* ctl) { const unsigned long long a = (unsigned long long)ctl; ctl_lo = (unsigned)__builtin_amdgcn_readfirstlane((int)(unsigned)a); ctl_hi = (unsigned)__builtin_amdgcn_readfirstlane((int)(unsigned)(a >> 32)); }
    __device__ __forceinline__ pg8_gu32* word(int off) const { return (pg8_gu32*)(((unsigned long long)ctl_hi << 32) | (unsigned long long)ctl_lo) + off; }
    __device__ __forceinline__ void a_ready(const Unit& u) const {
        if (wait0 >= 0) {
            if (wave_now() == 0) {
                unsigned sp = 0;
                for (;;) {
                    bool ok = (unsigned)__builtin_amdgcn_readfirstlane(__hip_atomic_load(word(wait0 + 64 * u.pm), __ATOMIC_RELAXED, __HIP_MEMORY_SCOPE_AGENT)) >= need0;
                    if (ok && wait1 >= 0) ok = (unsigned)__builtin_amdgcn_readfirstlane(__hip_atomic_load(word(wait1 + 64 * u.pm), __ATOMIC_RELAXED, __HIP_MEMORY_SCOPE_AGENT)) >= need1;
                    if (ok) break;
                    __builtin_amdgcn_s_sleep(2);
                    if ((++sp & 255u) == 0u) { if (__builtin_amdgcn_readfirstlane(__hip_atomic_load(word(tmo), __ATOMIC_RELAXED, __HIP_MEMORY_SCOPE_AGENT)) != 0u) break;
                        if (sp > (1u << 20)) { if (lane_now() == 0) __hip_atomic_fetch_add(word(tmo), 1u, __ATOMIC_RELAXED, __HIP_MEMORY_SCOPE_AGENT); break; } }
                }
                __builtin_amdgcn_fence(__ATOMIC_ACQUIRE, "agent");
                asm volatile("s_waitcnt vmcnt(0)" ::: "memory");
            }
            asm volatile("" ::: "memory"); __builtin_amdgcn_s_barrier(); asm volatile("" ::: "memory");
        }
    }
    __device__ __forceinline__ void done(const Unit& u) const {
        if (done_cnt >= 0) { asm volatile("s_waitcnt vmcnt(0)" ::: "memory");
            if (lane_now() == 0) __hip_atomic_fetch_add(word(done_cnt + 64 * u.pm), 1u, __ATOMIC_RELAXED, __HIP_MEMORY_SCOPE_AGENT); }
    }
};

struct PanelOrder : ChainOrder {
    __device__ __forceinline__ bool next(int i, Unit& u) const {
        const int x = c & 7, j = c >> 3, k0 = (nwg * x) >> 3, k1 = (nwg * (x + 1)) >> 3, k = k0 + j + (G >> 3) * i;
        if (k >= k1) return false;
        u.pm = k / nN; u.pn = k - u.pm * nN; return true;
    }
};
struct PoolChainOrder : PanelOrder {
    __device__ __forceinline__ void done(const Unit& u) const { if (u.pn >= 8 && u.pn < 12) ChainOrder::done(u); }
};
struct RelChainOrder : ChainOrder {
    unsigned lds_word;
    __device__ __forceinline__ void done(const Unit& u) const {
        asm volatile("s_waitcnt vmcnt(0)" ::: "memory");
        unsigned prev = 0u;
        if (lane_now() == 0) prev = __hip_atomic_fetch_add((PG8_LAS unsigned*)(size_t)lds_word, 1u, __ATOMIC_RELAXED, __HIP_MEMORY_SCOPE_WORKGROUP);
        prev = (unsigned)__builtin_amdgcn_readfirstlane((int)prev);
        if (prev == 7u) {
            if (lane_now() == 0) __hip_atomic_store((PG8_LAS unsigned*)(size_t)lds_word, 0u, __ATOMIC_RELAXED, __HIP_MEMORY_SCOPE_WORKGROUP);
            __builtin_amdgcn_fence(__ATOMIC_RELEASE, "agent"); asm volatile("s_waitcnt vmcnt(0)" ::: "memory");
            if (lane_now() == 0) __hip_atomic_fetch_add(word(done_cnt + 64 * u.pm), 8u, __ATOMIC_RELAXED, __HIP_MEMORY_SCOPE_AGENT);
        }
    }
};
struct FOrder : ChainOrder {
    size_t ctx_delta;
    __device__ __forceinline__ size_t a_off(const Unit& u, const Gemm& g, size_t tsA) const { return (size_t)u.pm * tsA + (u.pm >= 64 ? ctx_delta : (size_t)0); }
};
__device__ __forceinline__ int opaque_v(int x) { asm volatile("" : "+v"(x)); return x; }
__device__ __forceinline__ int opaque_s(int x) { asm volatile("" : "+s"(x)); return x; }
template <int O> __device__ __forceinline__ float lane_xor(float v) { static_assert(O < 32, "within a 32-lane half"); return __int_as_float(__builtin_amdgcn_ds_swizzle(__float_as_int(v), (O << 10) | 0x1f)); }
__device__ __forceinline__ float half_sum(float v) { const auto r = __builtin_amdgcn_permlane32_swap(__float_as_uint(v), __float_as_uint(v), false, false); return __uint_as_float(r[0]) + __uint_as_float(r[1]); }
__device__ __forceinline__ float softplus(float x) { if (x > 20.f) return x; const float e = __expf(x), u = 1.f + e; return u == 1.f ? e : __logf(u) * e * __builtin_amdgcn_rcpf(u - 1.f); }
typedef __bf16 bf16x2_t __attribute__((ext_vector_type(2)));
__device__ __forceinline__ unsigned cvt_pk_bf16(float lo, float hi) { const f32x2 v = {lo, hi}; return __builtin_bit_cast(unsigned, __builtin_convertvector(v, bf16x2_t)); }
__device__ __forceinline__ float bflo(unsigned u) { return __uint_as_float(u << 16); }
__device__ __forceinline__ float bfhi(unsigned u) { return __uint_as_float(u & 0xffff0000u); }
__device__ __forceinline__ float sigm(float v) { return __builtin_amdgcn_rcpf(1.f + __expf(-v)); }
__device__ __forceinline__ float silu(float v) { return v * sigm(v); }
__device__ __forceinline__ u32x4 pack8(const f32x4 a, const f32x4 b) { u32x4 w; w.x = cvt_pk_bf16(a[0], a[1]); w.y = cvt_pk_bf16(a[2], a[3]); w.z = cvt_pk_bf16(b[0], b[1]); w.w = cvt_pk_bf16(b[2], b[3]); return w; }

constexpr int SEGR = 68;
constexpr int MTOT_ROWS = 17408;

struct EpiPlain {
    static constexpr bool PERM = true;
    bf16_t* O; int ldc;
    __device__ __forceinline__ void operator()(f32x4 (&acc)[2][2][4][2], const Unit& u, int wr, int wc, int fr, int fq, PG8_LAS unsigned char*) const {
        const int row0 = u.pm * BM + wr * 64 + fr, col0 = u.pn * BM + wc * 32 + 8 * fq;
#pragma unroll
        for (int ai = 0; ai < 2; ++ai)
#pragma unroll
            for (int m = 0; m < 4; ++m) { bf16_t* rowp = O + (size_t)(row0 + ai * HALF + m * 16) * ldc + col0;
#pragma unroll
                for (int bj = 0; bj < 2; ++bj) *(u32x4*)(rowp + bj * HALF) = pack8(acc[ai][bj][m][0], acc[ai][bj][m][1]); }
    }
};

struct EpiXbcDt {
    static constexpr bool PERM = true;
    bf16_t* XBC; bf16_t* HALO; float* DT; const float* dt_bias;
    __device__ __forceinline__ void operator()(f32x4 (&acc)[2][2][4][2], const Unit& u, int wr, int wc, int fr, int fq, PG8_LAS unsigned char*) const {
        const int row0 = u.pm * BM + wr * 64 + fr;
        if (u.pn < 16) {
            const int col0 = u.pn * BM + wc * 32 + 8 * fq;
            const __amdgpu_buffer_rsrc_t rsx = __builtin_amdgcn_make_buffer_rsrc((void*)XBC, (short)0, 17408 * 4096 * 2, 0x00020000), rsh = __builtin_amdgcn_make_buffer_rsrc((void*)HALO, (short)0, 544 * 4 * 4096 * 2, 0x00020000);
#pragma unroll
            for (int ai = 0; ai < 2; ++ai)
#pragma unroll
                for (int m = 0; m < 4; ++m) { const int r = row0 + ai * HALF + m * 16; const unsigned ro = (unsigned)(((size_t)r * 4096 + col0) * 2);
                    const int seg = r >> 5, rs = r & 31; const int hs = rs < 2 ? rs : (rs >= 30 ? rs - 28 : -1);
#pragma unroll
                    for (int bj = 0; bj < 2; ++bj) { const u32x4 w = pack8(acc[ai][bj][m][0], acc[ai][bj][m][1]); __builtin_amdgcn_raw_buffer_store_b128(w, rsx, ro + bj * HALF * 2, 0, 16);
                        if (hs >= 0) __builtin_amdgcn_raw_buffer_store_b128(w, rsh, (unsigned)(((size_t)(seg * 4 + hs) * 4096 + col0 + bj * HALF) * 2), 0, 16); } }
        } else if (wc < 2) {
            const int c0 = wc * 32 + 8 * fq;
            const f32x4 b0 = *(const f32x4*)(dt_bias + c0), b1 = *(const f32x4*)(dt_bias + c0 + 4);
#pragma unroll
            for (int ai = 0; ai < 2; ++ai)
#pragma unroll
                for (int m = 0; m < 4; ++m) { const int r = row0 + ai * HALF + m * 16; float* colp = DT + (size_t)c0 * MTOT_ROWS + r;
                    f32x4 v0 = acc[ai][0][m][0] + b0, v1 = acc[ai][0][m][1] + b1;
#pragma unroll
                    for (int j = 0; j < 4; ++j) { colp[(size_t)j * MTOT_ROWS] = softplus(v0[j]); colp[(size_t)(4 + j) * MTOT_ROWS] = softplus(v1[j]); } }
        }
    }
};

struct EpiZPG {
    static constexpr bool PERM = true;
    bf16_t* Y; bf16_t* UPOOL; bf16_t* GATES;
    __device__ __forceinline__ void operator()(f32x4 (&acc)[2][2][4][2], const Unit& u, int wr, int wc, int fr, int fq, PG8_LAS unsigned char* xl) const {
        const int row0 = u.pm * BM + wr * 64 + fr;
#ifdef DBG_SKIPZ
        if (u.pn < 8) { return; }
#endif
        if (u.pn < 8) {
            const int col0 = u.pn * BM + wc * 32 + 8 * fq;
            PG8_LAS float* P = (PG8_LAS float*)xl;
            u32x4 yva[2][4][2];
#pragma unroll
            for (int ai = 0; ai < 2; ++ai)
#pragma unroll
                for (int m = 0; m < 4; ++m) { const bf16_t* yp = Y + (size_t)(row0 + ai * HALF + m * 16) * 2048 + col0; yva[ai][m][0] = *(const u32x4*)yp; yva[ai][m][1] = *(const u32x4*)(yp + HALF); }
#pragma unroll
            for (int ai = 0; ai < 2; ++ai) {
#pragma unroll
                for (int m = 0; m < 4; ++m) { float s = 0.f;
#pragma unroll
                    for (int bj = 0; bj < 2; ++bj) { const u32x4 yv = yva[ai][m][bj]; f32x4 v0 = acc[ai][bj][m][0], v1 = acc[ai][bj][m][1];
                        v0[0] = bflo(yv.x) * silu(v0[0]); v0[1] = bfhi(yv.x) * silu(v0[1]); v0[2] = bflo(yv.y) * silu(v0[2]); v0[3] = bfhi(yv.y) * silu(v0[3]);
                        v1[0] = bflo(yv.z) * silu(v1[0]); v1[1] = bfhi(yv.z) * silu(v1[1]); v1[2] = bflo(yv.w) * silu(v1[2]); v1[3] = bfhi(yv.w) * silu(v1[3]);
                        s += (v0[0] * v0[0] + v0[1] * v0[1]) + (v0[2] * v0[2] + v0[3] * v0[3]) + (v1[0] * v1[0] + v1[1] * v1[1]) + (v1[2] * v1[2] + v1[3] * v1[3]);
                        acc[ai][bj][m][0] = v0; acc[ai][bj][m][1] = v1; }
                    s += lane_xor<16>(s); s = half_sum(s);
                    if (fq == 0) P[(ai * HALF + wr * 64 + m * 16 + fr) * 4 + wc] = s; }
                asm volatile("" ::: "memory"); }
#ifndef DBG_NOZBAR
            asm volatile("s_waitcnt lgkmcnt(0)" ::: "memory"); __builtin_amdgcn_s_barrier(); asm volatile("" ::: "memory");
#else
            asm volatile("s_waitcnt lgkmcnt(0)" ::: "memory");
#endif
#pragma unroll
            for (int ai = 0; ai < 2; ++ai)
#pragma unroll
                for (int m = 0; m < 4; ++m) {
#ifndef DBG_NOZBAR
                    const f32x4 p = *(const PG8_LAS f32x4*)(P + (ai * HALF + wr * 64 + m * 16 + fr) * 4);
#else
                    const float pw_ = P[(ai * HALF + wr * 64 + m * 16 + fr) * 4 + wc]; const f32x4 p = {pw_, pw_, pw_, pw_};
#endif

                    const float rstd = rsqrtf(((p[0] + p[1]) + (p[2] + p[3])) * (1.0f / 256.0f) + 1e-6f);
                    bf16_t* yp = Y + (size_t)(row0 + ai * HALF + m * 16) * 2048 + col0;
#pragma unroll
                    for (int bj = 0; bj < 2; ++bj) *(u32x4*)(yp + bj * HALF) = pack8(acc[ai][bj][m][0] * rstd, acc[ai][bj][m][1] * rstd); }
        } else if (u.pn < 12) {
            const int col0 = (u.pn - 8) * BM + wc * 32 + 8 * fq;
            const __amdgpu_buffer_rsrc_t rsU = __builtin_amdgcn_make_buffer_rsrc((void*)UPOOL, (short)0, 17408 * 1024 * 2, 0x00020000);
#pragma unroll
            for (int ai = 0; ai < 2; ++ai)
#pragma unroll
                for (int m = 0; m < 4; ++m) { const unsigned ro = (unsigned)(((size_t)(row0 + ai * HALF + m * 16) * 1024 + col0) * 2);
#pragma unroll
                    for (int bj = 0; bj < 2; ++bj) __builtin_amdgcn_raw_buffer_store_b128(pack8(acc[ai][bj][m][0], acc[ai][bj][m][1]), rsU, ro + bj * HALF * 2, 0, 16); }
        } else {
            const int col0 = (u.pn - 12) * BM + wc * 32 + 8 * fq;
#pragma unroll
            for (int ai = 0; ai < 2; ++ai)
#pragma unroll
                for (int m = 0; m < 4; ++m) { bf16_t* rowp = GATES + (size_t)(row0 + ai * HALF + m * 16) * 2048 + col0;
#pragma unroll
                    for (int bj = 0; bj < 2; ++bj) { f32x4 v0 = acc[ai][bj][m][0], v1 = acc[ai][bj][m][1];
#pragma unroll
                        for (int j = 0; j < 4; ++j) { v0[j] = sigm(v0[j]); v1[j] = sigm(v1[j]); }
                        *(u32x4*)(rowp + bj * HALF) = pack8(v0, v1); } }
        }
    }
};

template <int MODE  > struct EpiGate {
    static constexpr bool PERM = true;
    bf16_t* M1; const bf16_t* GATES;
    __device__ __forceinline__ void operator()(f32x4 (&acc)[2][2][4][2], const Unit& u, int wr, int wc, int fr, int fq, PG8_LAS unsigned char*) const {
        const int row0 = u.pm * BM + wr * 64 + fr, col0 = u.pn * BM + wc * 32 + 8 * fq;
        const __amdgpu_buffer_rsrc_t rs = __builtin_amdgcn_make_buffer_rsrc((void*)M1, (short)0, 17408 * 1024 * 2, 0x00020000);
#pragma unroll
        for (int ai = 0; ai < 2; ++ai) {
            u32x4 gv[4][2], ov[4][2];
#pragma unroll
            for (int m = 0; m < 4; ++m) { const int r = row0 + ai * HALF + m * 16; const bf16_t* gp = GATES + (size_t)r * 2048 + MODE * 1024 + col0; const bf16_t* mp = M1 + (size_t)r * 1024 + col0;
                gv[m][0] = *(const u32x4*)gp; gv[m][1] = *(const u32x4*)(gp + HALF);
                if (MODE == 1) { ov[m][0] = *(const u32x4*)mp; ov[m][1] = *(const u32x4*)(mp + HALF); } }
#pragma unroll
            for (int m = 0; m < 4; ++m) { bf16_t* mp = M1 + (size_t)(row0 + ai * HALF + m * 16) * 1024 + col0;
#pragma unroll
                for (int bj = 0; bj < 2; ++bj) { const u32x4 g = gv[m][bj]; f32x4 v0 = acc[ai][bj][m][0], v1 = acc[ai][bj][m][1];
                    v0[0] *= bflo(g.x); v0[1] *= bfhi(g.x); v0[2] *= bflo(g.y); v0[3] *= bfhi(g.y); v1[0] *= bflo(g.z); v1[1] *= bfhi(g.z); v1[2] *= bflo(g.w); v1[3] *= bfhi(g.w);
                    if (MODE == 1) { const u32x4 o = ov[m][bj];
                        v0[0] += bflo(o.x); v0[1] += bfhi(o.x); v0[2] += bflo(o.y); v0[3] += bfhi(o.y); v1[0] += bflo(o.z); v1[1] += bfhi(o.z); v1[2] += bflo(o.w); v1[3] += bfhi(o.w); }
                    __builtin_amdgcn_raw_buffer_store_b128(pack8(v0, v1), rs, (unsigned)((size_t)((const char*)(mp + bj * HALF) - (const char*)M1)), 0,   16); } }
            asm volatile("" ::: "memory"); }
    }
};

template <bool LAT_BASE_BF16> struct EpiRes {
    static constexpr bool PERM = true;
    const float* base_lat_f32; bf16_t* xr; const float* base_ctx; float* out_ctx; const float* gate;
    __device__ __forceinline__ void operator()(f32x4 (&acc)[2][2][4][2], const Unit& u, int wr, int wc, int fr, int fq, PG8_LAS unsigned char*) const {
        const bool lat = u.pm < 64;
        const int row0 = (lat ? u.pm : u.pm - 64) * BM + wr * 64 + fr, col0 = u.pn * BM + wc * 32 + 8 * fq;
        const float* gp = gate + (lat ? (u.pm >> 4) : 4) * 6144 + col0;
        f32x4 gv[2][2];
#pragma unroll
        for (int bj = 0; bj < 2; ++bj)
#pragma unroll
            for (int n = 0; n < 2; ++n) gv[bj][n] = *(const f32x4*)(gp + bj * HALF + 4 * n);
        if (lat && LAT_BASE_BF16) {
#pragma unroll
            for (int ai = 0; ai < 2; ++ai) {
                u32x4 bb[4][2];
#pragma unroll
                for (int m = 0; m < 4; ++m)
#pragma unroll
                    for (int bj = 0; bj < 2; ++bj) bb[m][bj] = *(const u32x4*)(xr + (size_t)(row0 + ai * HALF + m * 16) * 2048 + col0 + bj * HALF);
#pragma unroll
                for (int m = 0; m < 4; ++m)
#pragma unroll
                    for (int bj = 0; bj < 2; ++bj) { const u32x4 o = bb[m][bj]; f32x4 v0 = gv[bj][0] * acc[ai][bj][m][0], v1 = gv[bj][1] * acc[ai][bj][m][1];
                        v0[0] += bflo(o.x); v0[1] += bfhi(o.x); v0[2] += bflo(o.y); v0[3] += bfhi(o.y); v1[0] += bflo(o.z); v1[1] += bfhi(o.z); v1[2] += bflo(o.w); v1[3] += bfhi(o.w);
                        *(u32x4*)(xr + (size_t)(row0 + ai * HALF + m * 16) * 2048 + col0 + bj * HALF) = pack8(v0, v1); }
                asm volatile("" ::: "memory"); }
        } else {
            const float* base = lat ? base_lat_f32 : base_ctx;
#pragma unroll
            for (int ai = 0; ai < 2; ++ai) {
                f32x4 bs[4][2][2];
#pragma unroll
                for (int m = 0; m < 4; ++m) { const size_t off = (size_t)(row0 + ai * HALF + m * 16) * 1024 + col0;
#pragma unroll
                    for (int bj = 0; bj < 2; ++bj)
#pragma unroll
                        for (int n = 0; n < 2; ++n) bs[m][bj][n] = *(const f32x4*)(base + off + bj * HALF + 4 * n); }
#pragma unroll
                for (int m = 0; m < 4; ++m) { const int r = row0 + ai * HALF + m * 16;
#pragma unroll
                    for (int bj = 0; bj < 2; ++bj) { const f32x4 v0 = bs[m][bj][0] + gv[bj][0] * acc[ai][bj][m][0], v1 = bs[m][bj][1] + gv[bj][1] * acc[ai][bj][m][1];
                        if (lat) *(u32x4*)(xr + (size_t)r * 2048 + col0 + bj * HALF) = pack8(v0, v1);
                        else { float* op = out_ctx + (size_t)r * 1024 + col0 + bj * HALF; *(f32x4*)op = v0; *(f32x4*)(op + 4) = v1; } } }
                asm volatile("" ::: "memory"); }
        }
    }
};

struct SplitKOrder {
    int G, c;
    __device__ __forceinline__ bool next(int i, Unit& u) const { const int L = i * G + c; if (L >= 176) return false; const int ks = L % 11, tile = L / 11; u.pm = 64 + (tile >> 2); u.pn = (tile & 3) + 4 * ks; return true; }
    __device__ __forceinline__ size_t a_off(const Unit& u, const Gemm&, size_t tsA) const { return (size_t)u.pm * tsA + (size_t)(u.pn >> 2) * 512; }
    __device__ __forceinline__ size_t b_off(const Unit& u, const Gemm&, size_t tsB) const { return (size_t)(u.pn & 3) * tsB + (size_t)(u.pn >> 2) * 512; }
    __device__ __forceinline__ void a_ready(const Unit&) const {}
    __device__ __forceinline__ void done(const Unit&) const {}
};
struct EpiPart {
    static constexpr bool PERM = true;
    float* P;
    __device__ __forceinline__ void operator()(f32x4 (&acc)[2][2][4][2], const Unit& u, int wr, int wc, int fr, int fq, PG8_LAS unsigned char*) const {
        const int ks = u.pn >> 2, row0 = (u.pm - 64) * BM + wr * 64 + fr, col0 = (u.pn & 3) * BM + wc * 32 + 8 * fq;
#pragma unroll
        for (int ai = 0; ai < 2; ++ai)
#pragma unroll
            for (int m = 0; m < 4; ++m) { float* op = P + ((size_t)ks * 1024 + row0 + ai * HALF + m * 16) * 1024 + col0;
#pragma unroll
                for (int bj = 0; bj < 2; ++bj) { *(f32x4*)(op + bj * HALF) = acc[ai][bj][m][0]; *(f32x4*)(op + bj * HALF + 4) = acc[ai][bj][m][1]; } }
    }
};

struct EpiSwiglu {
    static constexpr bool PERM = true;
    bf16_t* ACT;
    __device__ __forceinline__ void operator()(f32x4 (&acc)[2][2][4][2], const Unit& u, int wr, int wc, int fr, int fq, PG8_LAS unsigned char*) const {
        const int row0 = u.pm * BM + wr * 64 + fr, j0 = u.pn * 128 + wc * 32 + 8 * fq;
#pragma unroll
        for (int ai = 0; ai < 2; ++ai)
#pragma unroll
            for (int m = 0; m < 4; ++m) { bf16_t* rowp = ACT + (size_t)(row0 + ai * HALF + m * 16) * 2816 + j0;
                const f32x4 a0 = acc[ai][0][m][0], b0 = acc[ai][0][m][1], a1 = acc[ai][1][m][0], b1 = acc[ai][1][m][1];
                u32x4 w; w.x = cvt_pk_bf16(silu(a0[0]) * b0[0], silu(a0[1]) * b0[1]); w.y = cvt_pk_bf16(silu(a0[2]) * b0[2], silu(a0[3]) * b0[3]);
                w.z = cvt_pk_bf16(silu(a1[0]) * b1[0], silu(a1[1]) * b1[1]); w.w = cvt_pk_bf16(silu(a1[2]) * b1[2], silu(a1[3]) * b1[3]);
                *(u32x4*)rowp = w; }
    }
};

template <class Epi, class Sched, bool ALIGN_EPI = true, bool SP2 = true>
__device__ __forceinline__ void gemm_phase(PG8_LAS unsigned char* lds, PG8_LAS unsigned char* xl, const Gemm g, const Sched& S, const Epi& E) {
    const int tid = opaque_v(tid_now()), wid = __builtin_amdgcn_readfirstlane(tid >> 6), lane = tid & 63, wr = wid >> 2, wc = wid & 3, fr = lane & 15, fq = lane >> 4;
    const int K = g.K, nt = K / BK;
    unsigned voffA[2], voffB[2];
#pragma unroll
    for (int i = 0; i < 2; ++i) { int R, C; stage_rc(tid * 16 + i * 8192, R, C); const int Rb = Epi::PERM ? ((R & ~31) + perm32(R & 31)) : R;
        voffA[i] = (unsigned)(R * g.lda + C) * 2u; voffB[i] = (unsigned)(Rb * g.ldb + C) * 2u; }
    const size_t kstep = (size_t)(BK * 2);
    const size_t hsA = (size_t)HALF * g.lda * 2, hsB = (size_t)HALF * g.ldb * 2;
    const size_t tsA = 2 * hsA, tsB = 2 * hsB;
    const unsigned ldsw = (unsigned)wid * 1024u;
    const int aoff = lds_byte(wr * 64 + fr, fq * 8), boff = lds_byte(wc * 32 + fr, fq * 8);
#define PG8_SA(b, h) (((b) * 2 + (h)) * HTB)
#define PG8_SB(b, h) ((4 + (b) * 2 + (h)) * HTB)
#define PG8_STAGE(bufoff, gbase, voff) do { _Pragma("unroll") for (int _i = 0; _i < 2; ++_i) \
        __builtin_amdgcn_global_load_lds((const unsigned*)((const char*)(gbase) + (voff)[_i]), (PG8_LAS unsigned*)(lds + (bufoff) + ldsw + _i * 8192), 16, 0, 0); } while (0)
#define PG8_LDA(dst, b, h) do { _Pragma("unroll") for (int m = 0; m < 4; ++m) _Pragma("unroll") for (int k = 0; k < 2; ++k) dst[m][k] = *(const PG8_LAS bf16x8*)(lds + PG8_SA(b, h) + aoff + m * 2048 + k * 1024); } while (0)
#define PG8_LDB(dst, b, h) do { _Pragma("unroll") for (int n = 0; n < 2; ++n) _Pragma("unroll") for (int k = 0; k < 2; ++k) dst[n][k] = *(const PG8_LAS bf16x8*)(lds + PG8_SB(b, h) + boff + n * 2048 + k * 1024); } while (0)
#define PG8_MMA(ai, bj, At, Bt) do { __builtin_amdgcn_s_setprio(1); _Pragma("unroll") for (int m = 0; m < 4; ++m) _Pragma("unroll") for (int n = 0; n < 2; ++n) _Pragma("unroll") for (int k = 0; k < 2; ++k) \
        acc[ai][bj][m][n] = __builtin_amdgcn_mfma_f32_16x16x32_bf16(Bt[n][k], At[m][k], acc[ai][bj][m][n], 0, 0, 0); __builtin_amdgcn_s_setprio(0); } while (0)
#define PG8_WAIT_V(n) asm volatile("s_waitcnt vmcnt(" #n ")" ::: "memory")
#define PG8_WAIT_L(n) asm volatile("s_waitcnt lgkmcnt(" #n ")" ::: "memory")
#define PG8_BAR __builtin_amdgcn_s_barrier()
#define PG8_SCHED __builtin_amdgcn_sched_barrier(0)
    Unit cur, nxt; int ui = 0;
    if (!S.next(0, cur)) return;
    f32x4 acc[2][2][4][2];
#pragma unroll
    for (int a = 0; a < 2; ++a)
#pragma unroll
        for (int b = 0; b < 2; ++b)
#pragma unroll
            for (int m = 0; m < 4; ++m)
#pragma unroll
                for (int n = 0; n < 2; ++n) acc[a][b][m][n] = (f32x4){0.f, 0.f, 0.f, 0.f};
    bf16x8 At[4][2], B0[2][2], B1[2][2];
    const char* cA = (const char*)g.A + S.a_off(cur, g, tsA); const char* cB = (const char*)g.Bt + S.b_off(cur, g, tsB);
    S.a_ready(cur);
    if constexpr (SP2) {
        PG8_STAGE(PG8_SB(0, 0), cB, voffB); PG8_STAGE(PG8_SB(0, 1), cB + hsB, voffB); PG8_STAGE(PG8_SA(0, 0), cA, voffA); PG8_STAGE(PG8_SA(0, 1), cA + hsA, voffA);
        if (wr == 1) PG8_BAR;
        PG8_WAIT_V(2); PG8_BAR;
        PG8_STAGE(PG8_SB(1, 0), cB + kstep, voffB); PG8_STAGE(PG8_SA(1, 0), cA + kstep, voffA); PG8_STAGE(PG8_SB(1, 1), cB + hsB + kstep, voffB);
        PG8_WAIT_V(6); PG8_BAR;
    } else {
        PG8_STAGE(PG8_SB(0, 0), cB, voffB); PG8_STAGE(PG8_SA(0, 0), cA, voffA); PG8_STAGE(PG8_SB(0, 1), cB + hsB, voffB); PG8_STAGE(PG8_SA(0, 1), cA + hsA, voffA);
        if (wr == 1) PG8_BAR;
        PG8_WAIT_V(4); PG8_BAR;
        PG8_STAGE(PG8_SB(1, 0), cB + kstep, voffB); PG8_STAGE(PG8_SA(1, 0), cA + kstep, voffA); PG8_STAGE(PG8_SB(1, 1), cB + hsB + kstep, voffB);
        PG8_WAIT_V(6); PG8_BAR;
    }
    for (;;) {
        const bool has_next = S.next(ui + 1, nxt);
        const char* nA = has_next ? (const char*)g.A + S.a_off(nxt, g, tsA) : cA; const char* nB = has_next ? (const char*)g.Bt + S.b_off(nxt, g, tsB) : cB;
        for (int t = 0; t < nt; t += 2) {
            const bool last = (t == nt - 2);
            const char* a1 = cA + (size_t)(t + 1) * kstep;
            const char* a2 = last ? nA : cA + (size_t)(t + 2) * kstep; const char* b2 = last ? nB : cB + (size_t)(t + 2) * kstep;
            const char* a3 = a2 + kstep; const char* b3 = b2 + kstep;
            if (last && has_next) S.a_ready(nxt);
            if constexpr (SP2) {
            PG8_LDB(B0, 0, 0); PG8_LDB(B1, 0, 1); PG8_SCHED; PG8_LDA(At, 0, 0); PG8_STAGE(PG8_SA(1, 1), a1 + hsA, voffA);
            PG8_WAIT_V(8); PG8_WAIT_L(0); PG8_BAR; PG8_MMA(0, 0, At, B0); PG8_MMA(0, 1, At, B1); PG8_BAR; PG8_SCHED;
            PG8_LDA(At, 0, 1); PG8_STAGE(PG8_SB(0, 0), b2, voffB); PG8_STAGE(PG8_SB(0, 1), b2 + hsB, voffB); PG8_STAGE(PG8_SA(0, 0), a2, voffA);
            PG8_WAIT_V(8); PG8_WAIT_L(0); PG8_BAR; PG8_MMA(1, 0, At, B0); PG8_MMA(1, 1, At, B1); PG8_BAR; PG8_SCHED;
            PG8_LDB(B0, 1, 0); PG8_LDB(B1, 1, 1); PG8_SCHED; PG8_LDA(At, 1, 0); PG8_STAGE(PG8_SA(0, 1), a2 + hsA, voffA);
            PG8_WAIT_V(8); PG8_WAIT_L(0); PG8_BAR; PG8_MMA(0, 0, At, B0); PG8_MMA(0, 1, At, B1); PG8_BAR; PG8_SCHED;
            PG8_LDA(At, 1, 1); PG8_STAGE(PG8_SB(1, 0), b3, voffB); PG8_STAGE(PG8_SB(1, 1), b3 + hsB, voffB); PG8_STAGE(PG8_SA(1, 0), a3, voffA);
            PG8_WAIT_V(8); PG8_WAIT_L(0); PG8_BAR; PG8_MMA(1, 0, At, B0); PG8_MMA(1, 1, At, B1); PG8_BAR; PG8_SCHED;
            } else {
            PG8_LDB(B0, 0, 0); PG8_SCHED; PG8_LDA(At, 0, 0); PG8_STAGE(PG8_SA(1, 1), a1 + hsA, voffA);
            PG8_WAIT_L(8); PG8_BAR; PG8_WAIT_L(0); PG8_MMA(0, 0, At, B0); PG8_BAR; PG8_SCHED;
            PG8_LDB(B1, 0, 1); PG8_STAGE(PG8_SB(0, 0), b2, voffB);
            PG8_BAR; PG8_WAIT_L(0); PG8_MMA(0, 1, At, B1); PG8_BAR;
            PG8_LDA(At, 0, 1); PG8_STAGE(PG8_SA(0, 0), a2, voffA);
            PG8_BAR; PG8_WAIT_L(0); PG8_MMA(1, 0, At, B0); PG8_BAR; PG8_SCHED;
            PG8_STAGE(PG8_SB(0, 1), b2 + hsB, voffB);
            PG8_WAIT_V(6); PG8_BAR; PG8_MMA(1, 1, At, B1); PG8_BAR;
            PG8_LDB(B0, 1, 0); PG8_SCHED; PG8_LDA(At, 1, 0); PG8_STAGE(PG8_SA(0, 1), a2 + hsA, voffA);
            PG8_WAIT_L(8); PG8_BAR; PG8_WAIT_L(0); PG8_MMA(0, 0, At, B0); PG8_BAR; PG8_SCHED;
            PG8_LDB(B1, 1, 1); PG8_STAGE(PG8_SB(1, 0), b3, voffB);
            PG8_BAR; PG8_WAIT_L(0); PG8_MMA(0, 1, At, B1); PG8_BAR;
            PG8_LDA(At, 1, 1); PG8_STAGE(PG8_SA(1, 0), a3, voffA);
            PG8_BAR; PG8_WAIT_L(0); PG8_MMA(1, 0, At, B0); PG8_BAR; PG8_SCHED;
            PG8_STAGE(PG8_SB(1, 1), b3 + hsB, voffB);
            PG8_WAIT_V(6); PG8_BAR; PG8_MMA(1, 1, At, B1); PG8_BAR;
            }
        }
        if constexpr (ALIGN_EPI) { if (wr == 0) PG8_BAR; }
        E(acc, cur, wr, wc, fr, fq, xl); S.done(cur);
        if (!has_next) break;
#pragma unroll
        for (int a = 0; a < 2; ++a)
#pragma unroll
            for (int b = 0; b < 2; ++b)
#pragma unroll
                for (int m = 0; m < 4; ++m)
#pragma unroll
                    for (int n = 0; n < 2; ++n) acc[a][b][m][n] = (f32x4){0.f, 0.f, 0.f, 0.f};
        cur = nxt; cA = nA; cB = nB; ++ui;
        if constexpr (ALIGN_EPI) { if (wr == 1) PG8_BAR; }
    }
    PG8_WAIT_V(0);
    if constexpr (!ALIGN_EPI) { if (wr == 0) PG8_BAR; }
    PG8_BAR;
#undef PG8_SA
#undef PG8_SB
#undef PG8_STAGE
#undef PG8_LDA
#undef PG8_LDB
#undef PG8_MMA
#undef PG8_WAIT_V
#undef PG8_WAIT_L
#undef PG8_BAR
#undef PG8_SCHED
}
}

#define GAS __attribute__((address_space(1)))
#define LAS __attribute__((address_space(3)))
typedef unsigned short bf16;
typedef unsigned v4u __attribute__((ext_vector_type(4)));
typedef unsigned v2u __attribute__((ext_vector_type(2)));
typedef float f32x4 __attribute__((ext_vector_type(4)));
#define LDS_WAIT() asm volatile("s_waitcnt lgkmcnt(0)" ::: "memory")
#define VM_WAIT() asm volatile("s_waitcnt vmcnt(0)" ::: "memory")

constexpr int D = 1024, NB = 4, SEQ = 4096, CTXL = 256, MLAT = NB * SEQ, MCTX = NB * CTXL, MTOT = MLAT + MCTX;
constexpr int DI = 2048, XBCW = 4096, NHEAD = 32, FFH = 2816, INC = 9280;
constexpr int NB1 = 4352  , NB2 = 5120  ;
constexpr int NWAVES = 8;

constexpr size_t MiB = 1u << 20;
constexpr size_t WS_CTL = 0, CTL_ZERO_BYTES = 1 * MiB;
constexpr size_t WS_MOD = 1 * MiB;
constexpr size_t WS_WIN = 2 * MiB;
constexpr size_t WS_WSSD = WS_WIN + (size_t)(NB1 + NB2) * 1024 * 2;
constexpr size_t WS_WPC = WS_WSSD + (size_t)1024 * 2048 * 2;
constexpr size_t WS_WOUT = WS_WPC + (size_t)1024 * 1024 * 2;
constexpr size_t WS_CX = WS_WOUT + (size_t)1024 * 1024 * 2;
constexpr size_t WS_H = WS_CX + (size_t)MCTX * D * 4;
constexpr size_t WS_DT = WS_H + (size_t)MTOT * D * 2;
constexpr size_t WS_Y = WS_DT + (size_t)MTOT * 64 * 4;
constexpr size_t WS_XBC = WS_Y + (size_t)MTOT * DI * 2;
constexpr size_t WS_END = WS_XBC + (size_t)MTOT * XBCW * 2;
constexpr size_t XO_GATES = 0, XO_UPOOL = (size_t)MTOT * 2048 * 2, XO_M1 = XO_UPOOL + (size_t)MTOT * 1024 * 2;
constexpr size_t XO_ACT = 0, XO_WGU = (size_t)MTOT * FFH * 2, XO_WDN = XO_WGU + (size_t)2 * FFH * 1024 * 2;
static_assert(XO_M1 + (size_t)MTOT * 1024 * 2 <= (size_t)MTOT * XBCW * 2 && XO_WDN + (size_t)1024 * FFH * 2 <= (size_t)MTOT * XBCW * 2, "xbc overlay map");
constexpr int CW_BAR = 4096;
constexpr int CW_WORK = 12288;
constexpr int CW_CNT = 16384, CNT_ARR = 68 * 64;
__device__ __forceinline__ int cnt_off(int l, int kind) { return CW_CNT + (l * 8 + kind) * CNT_ARR; }
__device__ __forceinline__ pg8::pg8_gu32* cnt_arr(unsigned char* ws, int l, int kind) { return (pg8::pg8_gu32*)(ws + WS_CTL) + cnt_off(l, kind); }

constexpr int RING_BYTES = 131072, LDS_BYTES = 163840  , XL_OFF = 155648  , MISC_OFF = 159744  ;

__device__ __forceinline__ unsigned pk2(float lo, float hi) { return pg8::cvt_pk_bf16(lo, hi); }
__device__ __forceinline__ float bf_lo(unsigned u) { return __uint_as_float(u << 16); }
__device__ __forceinline__ float bf_hi(unsigned u) { return __uint_as_float(u & 0xffff0000u); }

#define XB_TMO      128
#define XB_XCNT(j)  (256  + 64 * (j))
#define XB_XSUB(j)  (1280 + 64 * (j))
#define XB_XGEN(j)  (2304 + 64 * (j))
#define XB_TOP      3328
#define XB_TOPGEN   3392
#define XCD_BAR_WORDS 3456
#define XB_SPIN_CAP (1u << 20)
typedef GAS unsigned gu32;
__device__ __forceinline__ unsigned xb_ld(gu32* p)              { return __hip_atomic_load(p, __ATOMIC_RELAXED, __HIP_MEMORY_SCOPE_AGENT); }
__device__ __forceinline__ unsigned xb_add(gu32* p, unsigned v) { return __hip_atomic_fetch_add(p, v, __ATOMIC_RELAXED, __HIP_MEMORY_SCOPE_AGENT); }
__device__ __forceinline__ unsigned xb_xcc_id() { return (unsigned)__builtin_amdgcn_s_getreg((3 << 11) | 20) & 0xFu; }
#define XB_SPIN(cond, bar) do { unsigned _sp = 0; while (cond) { __builtin_amdgcn_s_sleep(1); \
    if ((++_sp & 255u) == 0u) { if (xb_ld(&(bar)[XB_TMO])) break; if (_sp > XB_SPIN_CAP) { xb_add(&(bar)[XB_TMO], 1u); break; } } } } while (0)
struct XcdBarrier { gu32* bar; unsigned x; volatile LAS unsigned* st; };
__device__ __forceinline__ XcdBarrier xcd_barrier_post(gu32* bar, volatile LAS unsigned* st) {
    XcdBarrier b; b.bar = bar; b.x = xb_xcc_id(); b.st = st;
    if (pg8::tid_now() == 0) (void)xb_add(&bar[XB_XCNT(b.x)], 1u);
    return b;
}
__device__ __forceinline__ void xcd_barrier_complete(gu32* bar, unsigned x, unsigned& nloc, unsigned& nx) {
    const unsigned G = gridDim.x * gridDim.y * gridDim.z;
    unsigned sum, cnt, mine, sp = 0u;
    for (;;) {
        sum = 0u; cnt = 0u; mine = 0u;
#pragma unroll
        for (unsigned j = 0; j < 16; ++j) { const unsigned c = xb_ld(&bar[XB_XCNT(j)]); sum += c; cnt += (c > 0u) ? 1u : 0u; mine = (j == x) ? c : mine; }
        if (sum == G) break;
        __builtin_amdgcn_s_sleep(1);
        if ((++sp & 255u) == 0u) { if (xb_ld(&bar[XB_TMO])) break; if (sp > XB_SPIN_CAP) { xb_add(&bar[XB_TMO], 1u); break; } }
    }
    nloc = mine > 0u ? mine : 1u; nx = cnt > 0u ? cnt : 1u;
}
__device__ __forceinline__ void xcd_barrier(const XcdBarrier& b) {
    asm volatile("s_waitcnt vmcnt(0)" ::: "memory");
    __syncthreads();
    if (pg8::tid_now() == 0) {
        gu32* bar = b.bar; unsigned bx_ = b.x;
        asm volatile("" : "+s"(bar), "+s"(bx_));
        __builtin_amdgcn_s_waitcnt(0);
        unsigned nloc = b.st[0], nx = b.st[1];
        if (nloc == 0u) { xcd_barrier_complete(bar, bx_, nloc, nx); b.st[0] = nloc; b.st[1] = nx; }
        const unsigned old = xb_add(&bar[XB_XSUB(bx_)], 1u);
        const unsigned gen = old / nloc;
        if (old + 1u == (gen + 1u) * nloc) {
            __builtin_amdgcn_fence(__ATOMIC_RELEASE, "agent");
            asm volatile("s_waitcnt vmcnt(0)" ::: "memory");
            const unsigned og = xb_add(&bar[XB_TOP], 1u);
            const unsigned tg = og / nx;
            if (og + 1u == (tg + 1u) * nx) xb_add(&bar[XB_TOPGEN], 1u);
            else XB_SPIN(xb_ld(&bar[XB_TOPGEN]) == tg, bar);
            __builtin_amdgcn_fence(__ATOMIC_ACQUIRE, "agent");
            xb_add(&bar[XB_XGEN(bx_)], 1u);
            asm volatile("s_waitcnt vmcnt(0)" ::: "memory");
        } else {
            XB_SPIN(xb_ld(&bar[XB_XGEN(bx_)]) == gen, bar);
            __builtin_amdgcn_fence(__ATOMIC_ACQUIRE, "agent");
            asm volatile("s_waitcnt vmcnt(0)" ::: "memory");
        }
    }
    __syncthreads();
}

__device__ __forceinline__ float wave_sum(float v) {
    v += pg8::lane_xor<1>(v); v += pg8::lane_xor<2>(v); v += pg8::lane_xor<4>(v); v += pg8::lane_xor<8>(v); v += pg8::lane_xor<16>(v);
    return pg8::half_sum(v);
}

template <int MODE> __device__ __forceinline__ int srccol(int n) {
    if (MODE == 0) {
        if (n < 4096) return 2048 + n;
        if (n < 4160) return 6144 + (n - 4096);
        if (n < 4352) return -1;
        if (n < 6400) return n - 4352;
        if (n < 7424) return 6208 + (n - 6400);
        return 7232 + (n - 7424);
    }
    if (MODE == 2) { const int pn = n >> 8, c = n & 255, bj = c >> 7, wc = (c >> 5) & 3, fq = (c >> 3) & 3, sel = (c >> 2) & 1, j = pn * 128 + wc * 32 + 8 * fq + 4 * bj + (c & 3); return sel * FFH + j; }
    return n;
}
struct Args { const float* in[23]; float* out; unsigned char* ws; };
typedef const __attribute__((address_space(4))) unsigned long long* KA;
__device__ __forceinline__ KA ka_fresh() { KA p = (KA)__builtin_amdgcn_kernarg_segment_ptr(); asm volatile("" : "+s"(p)); return p; }
#define KIN(ka, k) ((const float*)(const GAS float*)(ka)[k])
#define KOUT(ka) ((float*)(GAS float*)(ka)[23])
#define KWS(ka) ((unsigned char*)(GAS unsigned char*)(ka)[24])

struct Ids { int tid, lane, wave, G, bx, vcu, gw, NGW; };
__device__ __forceinline__ Ids fresh(Ids I) { I.wave = pg8::opaque_s(pg8::wave_now()); I.tid = pg8::opaque_v(I.wave * 64 + pg8::lane_now()); I.lane = I.tid & 63; I.vcu = pg8::opaque_s(I.vcu); I.bx = pg8::opaque_s(I.bx); I.gw = I.vcu * NWAVES + I.wave; return I; }

struct ConvJob { const float* W; bf16* WT; const float* kscale; int K, Nsrc, Ndst, mode, item; };
__device__ __forceinline__ int srccol_rt(int mode, int n) { return mode == 0 ? srccol<0>(n) : (mode == 2 ? srccol<2>(n) : n); }
__device__ __forceinline__ void conv_load(const ConvJob& j, int lane, f32x4 (&v)[8]) {
    const int nblk = j.Ndst / 32, kb = j.item / nblk, nb = j.item % nblk, k0 = 64 * kb, n0 = 32 * nb;
    const int r8 = lane >> 3, c4 = lane & 7, sc = srccol_rt(j.mode, n0 + 4 * c4);
#pragma unroll
    for (int i = 0; i < 8; ++i) v[i] = sc >= 0 ? *(const f32x4*)(j.W + (size_t)(k0 + 8 * i + r8) * j.Nsrc + sc) : (f32x4){0.f, 0.f, 0.f, 0.f};
}
__device__ __forceinline__ void conv_store(const ConvJob& j, int lane, const f32x4 (&v)[8], LAS float* scr) {
    const int nblk = j.Ndst / 32, kb = j.item / nblk, nb = j.item % nblk, k0 = 64 * kb, n0 = 32 * nb;
    const int r8 = lane >> 3, c4 = lane & 7;
#pragma unroll
    for (int i = 0; i < 8; ++i) { const int kk = 8 * i + r8; f32x4 t = v[i]; if (j.kscale) t = t * j.kscale[k0 + kk];
        LAS float* d = scr + kk * 33 + 4 * c4; d[0] = t.x; d[1] = t.y; d[2] = t.z; d[3] = t.w; }
    LDS_WAIT(); asm volatile("" ::: "memory");
    const int c = lane & 7;
#pragma unroll
    for (int q = 0; q < 4; ++q) { const int n = (lane >> 3) + 8 * q; const LAS float* sp = scr + (8 * c) * 33 + n;
        v4u o; o.x = pk2(sp[0 * 33], sp[1 * 33]); o.y = pk2(sp[2 * 33], sp[3 * 33]); o.z = pk2(sp[4 * 33], sp[5 * 33]); o.w = pk2(sp[6 * 33], sp[7 * 33]);
        *(v4u*)(j.WT + (size_t)(n0 + n) * j.K + k0 + 8 * c) = o; }
    LDS_WAIT(); asm volatile("" ::: "memory");
}
__device__ __forceinline__ ConvJob conv_job(KA ka, unsigned char* ws, int which, int l, int it) {
    ConvJob j;
    if (which == 0) {
        constexpr int I_IN = 16 * ((NB1 + NB2) / 32), I_SSD = 32 * 32;
        if (it < I_IN) { j.W = KIN(ka, 7) + (size_t)l * D * INC; j.WT = (bf16*)(ws + WS_WIN); j.kscale = nullptr; j.K = D; j.Nsrc = INC; j.Ndst = NB1 + NB2; j.mode = 0; j.item = it; }
        else if (it < I_IN + I_SSD) { j.W = KIN(ka, 14) + (size_t)l * DI * D; j.WT = (bf16*)(ws + WS_WSSD); j.kscale = KIN(ka, 13) + (size_t)l * DI; j.K = DI; j.Nsrc = D; j.Ndst = D; j.mode = 1; j.item = it - I_IN; }
        else { j.W = KIN(ka, 18) + (size_t)l * D * D; j.WT = (bf16*)(ws + WS_WOUT); j.kscale = nullptr; j.K = D; j.Nsrc = D; j.Ndst = D; j.mode = 1; j.item = it - I_IN - I_SSD; }
    } else {
        constexpr int I_GU = 16 * (2 * FFH / 32);
        if (it < I_GU) { j.W = KIN(ka, 20) + (size_t)l * D * 2 * FFH; j.WT = (bf16*)(ws + WS_XBC + XO_WGU); j.kscale = nullptr; j.K = D; j.Nsrc = 2 * FFH; j.Ndst = 2 * FFH; j.mode = 2; j.item = it; }
        else { j.W = KIN(ka, 21) + (size_t)l * FFH * D; j.WT = (bf16*)(ws + WS_XBC + XO_WDN); j.kscale = nullptr; j.K = FFH; j.Nsrc = D; j.Ndst = D; j.mode = 1; j.item = it - I_GU; }
    }
    return j;
}
__device__ __forceinline__ void conv_pass(const Ids I, LAS unsigned char* lds, KA ka, unsigned char* ws, int which, int l, int it0, int nit, int gw, int ngw) {
    LAS float* scr = (LAS float*)(lds + I.wave * 8448);
    f32x4 va[8], vb[8], vc[8];
    for (int it = it0 + gw; it < nit; it += 3 * ngw) {
        const bool h1 = it + ngw < nit, h2 = it + 2 * ngw < nit;
        const ConvJob ja = conv_job(ka, ws, which, l, it); conv_load(ja, I.lane, va);
        ConvJob jb = ja, jc = ja;
        if (h1) { jb = conv_job(ka, ws, which, l, it + ngw); conv_load(jb, I.lane, vb); }
        if (h2) { jc = conv_job(ka, ws, which, l, it + 2 * ngw); conv_load(jc, I.lane, vc); }
        conv_store(ja, I.lane, va, scr);
        if (h1) conv_store(jb, I.lane, vb, scr);
        if (h2) conv_store(jc, I.lane, vc, scr);
    }
}

__device__ __forceinline__ void norm_row(const float* xrow, bf16* orow, const float* g, const float* sh, const float* sc, int lane) {
    const f32x4* xr = (const f32x4*)xrow + lane;
    f32x4 v[4]; float s = 0.f;
#pragma unroll
    for (int j = 0; j < 4; ++j) { v[j] = xr[64 * j]; s += (v[j].x * v[j].x + v[j].y * v[j].y) + (v[j].z * v[j].z + v[j].w * v[j].w); }
    const float rstd = rsqrtf(wave_sum(s) * (1.f / D) + 1e-6f);
    unsigned long long* o8 = (unsigned long long*)orow + lane;
#pragma unroll
    for (int j = 0; j < 4; ++j) { const f32x4 gg = ((const f32x4*)g)[lane + 64 * j], s1 = ((const f32x4*)sc)[lane + 64 * j], s0 = ((const f32x4*)sh)[lane + 64 * j];
        const f32x4 y = v[j] * rstd * gg * (s1 + 1.0f) + s0;
        o8[64 * j] = (unsigned long long)pk2(y.x, y.y) | ((unsigned long long)pk2(y.z, y.w) << 32); }
}

__device__ __forceinline__ void conv_mixer(const Ids I_, LAS unsigned char* lds, int l, bool skip_win = false) {
    const Ids I = fresh(I_);
    const KA ka = ka_fresh(); unsigned char* ws = KWS(ka);
    conv_pass(I, lds, ka, ws, 0, l, skip_win ? 16 * ((NB1 + NB2) / 32) : 0, 16 * ((NB1 + NB2) / 32) + 32 * 32 + 16 * 32, I.gw, I.NGW);
    const float* pw = KIN(ka, 15) + (size_t)l * 4 * 256 * 256; const float* psc = KIN(ka, 16) + (size_t)l * D; const float* wpo = KIN(ka, 17) + (size_t)l * D * D; bf16* WPC = (bf16*)(ws + WS_WPC);
    __syncthreads();
    for (int item = I.vcu; item < 256; item += I.G) {
        const int g = item >> 6, i0 = (item & 63) * 4, n = 2 * I.tid;
        LAS float* tab = (LAS float*)lds;
        for (int e = I.tid; e < 1024; e += NWAVES * 64) { const int q = e >> 8, o = e & 255; tab[o * 4 + q] = pw[((size_t)g * 256 + i0 + q) * 256 + o] * psc[g * 256 + o]; }
        __syncthreads();
        float a0[4] = {0.f, 0.f, 0.f, 0.f}, a1[4] = {0.f, 0.f, 0.f, 0.f};
        const float* wr_ = wpo + (size_t)g * 256 * D + n;
#pragma unroll 32
        for (int o = 0; o < 256; ++o) { const pg8::f32x2 wv = *(const pg8::f32x2*)(wr_ + (size_t)o * D); const f32x4 t = *(const LAS f32x4*)(tab + o * 4);
            a0[0] += t.x * wv.x; a0[1] += t.y * wv.x; a0[2] += t.z * wv.x; a0[3] += t.w * wv.x; a1[0] += t.x * wv.y; a1[1] += t.y * wv.y; a1[2] += t.z * wv.y; a1[3] += t.w * wv.y; }
        v2u o0, o1; o0.x = pk2(a0[0], a0[1]); o0.y = pk2(a0[2], a0[3]); o1.x = pk2(a1[0], a1[1]); o1.y = pk2(a1[2], a1[3]);
        *(v2u*)(WPC + (size_t)n * D + g * 256 + i0) = o0; *(v2u*)(WPC + (size_t)(n + 1) * D + g * 256 + i0) = o1;
        __syncthreads();
    }
}
__device__ __forceinline__ void conv_ffn(const Ids I_, LAS unsigned char* lds, int l) {
    const Ids I = fresh(I_);
    const KA ka = ka_fresh(); unsigned char* ws = KWS(ka);
    conv_pass(I, lds, ka, ws, 1, l, 0, 16 * (2 * FFH / 32) + (FFH / 64) * 32, I.gw, I.NGW);
}

__device__ __forceinline__ void conv_win_dyn(const Ids I_, LAS unsigned char* lds, int l) {
    const Ids I = fresh(I_);
    const KA ka = ka_fresh(); unsigned char* ws = KWS(ka);
    constexpr int NIT = 16 * ((NB1 + NB2) / 32), NCH = (NIT + 23) / 24;
    pg8::pg8_gu32* work = (pg8::pg8_gu32*)(ws + WS_CTL) + CW_WORK + 64 * 4;
    volatile LAS unsigned* slot = (volatile LAS unsigned*)(lds + MISC_OFF) + 48;
    if (I.tid == 0) slot[0] = __hip_atomic_fetch_add(work, 1u, __ATOMIC_RELAXED, __HIP_MEMORY_SCOPE_AGENT);
    __syncthreads();
    int ch = (int)slot[0], par = 0;
    while (ch < NCH) {
        unsigned nclaim = 0u;
        if (I.tid == 0) nclaim = __hip_atomic_fetch_add(work, 1u, __ATOMIC_RELAXED, __HIP_MEMORY_SCOPE_AGENT);
        { const int e = 24 * ch + 24; conv_pass(I, lds, ka, ws, 0, l, 24 * ch, e < NIT ? e : NIT, I.wave, NWAVES); }
        if (I.tid == 0) slot[par ^ 1] = nclaim;
        __syncthreads();
        par ^= 1; ch = (int)slot[par];
    }
}

__device__ __forceinline__ void phase_mod(const Ids I_, LAS unsigned char* lds) {
    const Ids I = fresh(I_);
    const KA ka = ka_fresh(); float* MOD = (float*)(KWS(ka) + WS_MOD);
    LAS float* sv = (LAS float*)lds;
    LAS float* red = (LAS float*)(lds + 20480);
    if (I.bx < 192) {
        const float* cvec = KIN(ka, 1); const float* cctx = KIN(ka, 3);
        for (int i = I.tid; i < 5 * 1024; i += NWAVES * 64) { const int c = i >> 10, k = i & 1023; const float v = c < 4 ? cvec[c * 1024 + k] : cctx[k]; sv[i] = v / (1.f + __expf(-v)); }
        __syncthreads();
        for (int item = I.bx; item < 192; item += I.G) {
            const int l = item / 96, c0 = (item % 96) * 64, kg = I.tid >> 4, cq = I.tid & 15;
            const float* w = KIN(ka, 4) + (size_t)l * D * 6144 + c0 + 4 * cq;
            f32x4 a[5];
#pragma unroll
            for (int c = 0; c < 5; ++c) a[c] = (f32x4){0.f, 0.f, 0.f, 0.f};
#pragma unroll 16
            for (int k = kg * 32; k < kg * 32 + 32; ++k) { const f32x4 wv = *(const f32x4*)(w + (size_t)k * 6144);
#pragma unroll
                for (int c = 0; c < 5; ++c) a[c] += wv * sv[c * 1024 + k]; }
#pragma unroll
            for (int c = 0; c < 5; ++c) *(LAS f32x4*)(red + (kg * 5 + c) * 64 + 4 * cq) = a[c];
            __syncthreads();
            if (I.tid < 320) { const int c = I.tid >> 6, col = I.tid & 63; float s = KIN(ka, 5)[l * 6144 + c0 + col];
#pragma unroll 8
                for (int q = 0; q < 32; ++q) s += red[(q * 5 + c) * 64 + col];
                MOD[((size_t)l * 5 + c) * 6144 + c0 + col] = s; }
            __syncthreads();
        }
    }
    __syncthreads();
}

__device__ __forceinline__ void phase_norm(const Ids I_, int l, int which  , int nrows, bool from_input) {
    const Ids I = fresh(I_);
    const KA ka = ka_fresh(); unsigned char* ws = KWS(ka);
    const float* modl = (const float*)(ws + WS_MOD) + (size_t)l * 5 * 6144 + which * 3072;
    const float* g = KIN(ka, which ? 19 : 6) + l * D;
    const float* xlat = from_input ? KIN(ka, 0) : KOUT(ka); const float* xctx = from_input ? KIN(ka, 2) : (const float*)(ws + WS_CX);
    bf16* H = (bf16*)(ws + WS_H);
    const bf16* xr = (const bf16*)KOUT(ka);
    const bool parts = (l == 1 && which == 0);
    const float* PP = (const float*)(ws + WS_Y); const float* gctx = (const float*)(ws + WS_MOD) + 5120 + 4 * 6144;
    f32x4 nxa[4], nxb[4];
#define NORM_LOAD(nx, mm) do { if ((mm) < MLAT && !from_input) { const v2u* q_ = (const v2u*)(xr + (size_t)(mm) * 2048) + I.lane; \
            _Pragma("unroll") for (int j = 0; j < 4; ++j) { const v2u t_ = q_[64 * j]; nx[j] = (f32x4){bf_lo(t_.x), bf_hi(t_.x), bf_lo(t_.y), bf_hi(t_.y)}; } } \
        else { const f32x4* q_ = (const f32x4*)((mm) < MLAT ? KIN(ka, 0) + (size_t)(mm) * D : xctx + (size_t)((mm) - MLAT) * D) + I.lane; \
            _Pragma("unroll") for (int j = 0; j < 4; ++j) nx[j] = q_[64 * j]; \
            if (parts && (mm) >= MLAT) { f32x4 s_[4]; _Pragma("unroll") for (int j = 0; j < 4; ++j) s_[j] = (f32x4){0.f, 0.f, 0.f, 0.f}; \
                _Pragma("unroll 4") for (int ks_ = 0; ks_ < 11; ++ks_) { const f32x4* p_ = (const f32x4*)(PP + ((size_t)ks_ * 1024 + ((mm) - MLAT)) * 1024) + I.lane; _Pragma("unroll") for (int j = 0; j < 4; ++j) s_[j] += p_[64 * j]; } \
                _Pragma("unroll") for (int j = 0; j < 4; ++j) nx[j] += ((const f32x4*)gctx)[I.lane + 64 * j] * s_[j]; } } } while (0)
#define NORM_ROW(nx, mm) do { f32x4 v[4]; float ss = 0.f; \
        _Pragma("unroll") for (int j = 0; j < 4; ++j) { v[j] = nx[j]; ss += (v[j].x * v[j].x + v[j].y * v[j].y) + (v[j].z * v[j].z + v[j].w * v[j].w); } \
        if ((mm) + 2 * I.NGW < nrows) NORM_LOAD(nx, (mm) + 2 * I.NGW); \
        const int cond = (mm) < MLAT ? (mm) / SEQ : 4; const float* sh = modl + cond * 6144; const float* sc = sh + 1024; \
        const float rstd = rsqrtf(wave_sum(ss) * (1.f / D) + 1e-6f); \
        unsigned long long* o8 = (unsigned long long*)(H + (size_t)(mm) * D) + I.lane; \
        _Pragma("unroll") for (int j = 0; j < 4; ++j) { const f32x4 gg = ((const f32x4*)g)[I.lane + 64 * j], s1 = ((const f32x4*)sc)[I.lane + 64 * j], s0 = ((const f32x4*)sh)[I.lane + 64 * j]; \
            const f32x4 y = v[j] * rstd * gg * (s1 + 1.0f) + s0; \
            o8[64 * j] = (unsigned long long)pk2(y.x, y.y) | ((unsigned long long)pk2(y.z, y.w) << 32); } } while (0)
    int m = I.gw;
    if (m < nrows) NORM_LOAD(nxa, m);
    if (m + I.NGW < nrows) NORM_LOAD(nxb, m + I.NGW);
    for (; m < nrows; m += 2 * I.NGW) {
        NORM_ROW(nxa, m);
        const int m1 = m + I.NGW; if (m1 >= nrows) break;
        NORM_ROW(nxb, m1);
    }
#undef NORM_ROW
#undef NORM_LOAD
}

__device__ __forceinline__ void phase_norm2_dyn(const Ids I_, LAS unsigned char* lds_base, int l, int nrows) {
    const Ids I = fresh(I_);
    const KA ka = ka_fresh(); unsigned char* ws = KWS(ka);
    const float* modl = (const float*)(ws + WS_MOD) + (size_t)l * 5 * 6144 + 3072;
    const float* g = KIN(ka, 19) + l * D;
    const float* xctx = (const float*)(ws + WS_CX); const bf16* xr = (const bf16*)KOUT(ka);
    bf16* H = (bf16*)(ws + WS_H);
    pg8::pg8_gu32* work = (pg8::pg8_gu32*)(ws + WS_CTL) + CW_WORK + 64 * (2 + l); pg8::pg8_gu32* cp_ = cnt_arr(ws, l, 4); pg8::pg8_gu32* tmo = (pg8::pg8_gu32*)(ws + WS_CTL) + CW_BAR + XB_TMO;
    const int nblk = nrows / 64;
#define N2_CLAIM_WAIT(claim_) do { const int b_ = (int)(claim_); \
        if (b_ < nblk) { unsigned sp_ = 0; \
            while (__hip_atomic_load(cp_ + 64 * (b_ >> 2), __ATOMIC_RELAXED, __HIP_MEMORY_SCOPE_AGENT) < 32u) { __builtin_amdgcn_s_sleep(2); \
                if ((++sp_ & 255u) == 0u) { if (__hip_atomic_load(tmo, __ATOMIC_RELAXED, __HIP_MEMORY_SCOPE_AGENT) != 0u) break; if (sp_ > (1u << 20)) { __hip_atomic_fetch_add(tmo, 1u, __ATOMIC_RELAXED, __HIP_MEMORY_SCOPE_AGENT); break; } } } \
            __builtin_amdgcn_fence(__ATOMIC_ACQUIRE, "agent"); asm volatile("s_waitcnt vmcnt(0)" ::: "memory"); } } while (0)
#define N2_LOAD(nx, mm) do { if ((mm) < MLAT) { const v2u* q_ = (const v2u*)(xr + (size_t)(mm) * 2048) + I.lane; \
            _Pragma("unroll") for (int j = 0; j < 4; ++j) { const v2u t_ = q_[64 * j]; nx[j] = (f32x4){bf_lo(t_.x), bf_hi(t_.x), bf_lo(t_.y), bf_hi(t_.y)}; } } \
        else { const f32x4* q_ = (const f32x4*)(xctx + (size_t)((mm) - MLAT) * D) + I.lane; _Pragma("unroll") for (int j = 0; j < 4; ++j) nx[j] = q_[64 * j]; } } while (0)
#define N2_ROW(nx, mm, mend) do { f32x4 v[4]; float ss = 0.f; \
        _Pragma("unroll") for (int j = 0; j < 4; ++j) { v[j] = nx[j]; ss += (v[j].x * v[j].x + v[j].y * v[j].y) + (v[j].z * v[j].z + v[j].w * v[j].w); } \
        if ((mm) + 16 < (mend)) N2_LOAD(nx, (mm) + 16); \
        const int cond = (mm) < MLAT ? (mm) / SEQ : 4; const float* sh = modl + cond * 6144; const float* sc = sh + 1024; \
        const float rstd = rsqrtf(wave_sum(ss) * (1.f / D) + 1e-6f); \
        unsigned long long* o8 = (unsigned long long*)(H + (size_t)(mm) * D) + I.lane; \
        _Pragma("unroll") for (int j = 0; j < 4; ++j) { const f32x4 gg = ((const f32x4*)g)[I.lane + 64 * j], s1 = ((const f32x4*)sc)[I.lane + 64 * j], s0 = ((const f32x4*)sh)[I.lane + 64 * j]; \
            const f32x4 y = v[j] * rstd * gg * (s1 + 1.0f) + s0; \
            o8[64 * j] = (unsigned long long)pk2(y.x, y.y) | ((unsigned long long)pk2(y.z, y.w) << 32); } } while (0)
    volatile LAS unsigned* slot = (volatile LAS unsigned*)(lds_base + MISC_OFF) + 44;
    if (I.tid == 0) { const unsigned c0 = __hip_atomic_fetch_add(work, 1u, __ATOMIC_RELAXED, __HIP_MEMORY_SCOPE_AGENT); N2_CLAIM_WAIT(c0); slot[0] = c0; }
    __syncthreads();
    int blk = (int)slot[0], par = 0;
    while (blk < nblk) {
        unsigned nclaim = 0u;
        if (I.tid == 0) nclaim = __hip_atomic_fetch_add(work, 1u, __ATOMIC_RELAXED, __HIP_MEMORY_SCOPE_AGENT);
        {
            const int mend = blk * 64 + 64; int m = blk * 64 + I.wave;
            f32x4 nxa[4], nxb[4];
            N2_LOAD(nxa, m); N2_LOAD(nxb, m + 8);
            for (; m < mend; m += 16) { N2_ROW(nxa, m, mend); N2_ROW(nxb, m + 8, mend); }
        }
        if (I.tid == 0) { N2_CLAIM_WAIT(nclaim); slot[par ^ 1] = nclaim; }
        __syncthreads();
        par ^= 1; blk = (int)slot[par];
    }
    if (I.tid < 64) {
        const int np = nrows / 256; unsigned sp = 0;
        for (;;) { bool ok = true; for (int p = I.lane; p < np; p += 64) ok = ok && __hip_atomic_load(cp_ + 64 * p, __ATOMIC_RELAXED, __HIP_MEMORY_SCOPE_AGENT) >= 32u;
            if (__builtin_amdgcn_ballot_w64(!ok) == 0ull) break;
            __builtin_amdgcn_s_sleep(127);
            if ((++sp & 15u) == 0u) { if (__hip_atomic_load(tmo, __ATOMIC_RELAXED, __HIP_MEMORY_SCOPE_AGENT) != 0u) break; if (sp > (1u << 14)) { if (I.tid == 0) __hip_atomic_fetch_add(tmo, 1u, __ATOMIC_RELAXED, __HIP_MEMORY_SCOPE_AGENT); break; } } }
    }
    __syncthreads();
#undef N2_ROW
#undef N2_LOAD
#undef N2_CLAIM_WAIT
}

__device__ const unsigned short CONV_PERM[544] = { 0, 1, 2, 3, 4, 5, 6, 73, 74, 75, 76, 77, 78, 137, 138, 139, 140, 141, 142, 209, 210, 211, 212, 213, 214, 273, 274, 275, 276, 277, 278, 345, 346, 347, 348, 349, 350, 409, 410, 411, 412, 413, 414, 481, 482, 483, 484, 485, 486, 7, 8, 9, 10, 11, 12, 13, 14, 15, 16, 17, 18, 19, 20, 21, 22, 79, 80, 81, 82, 83, 84, 85, 86, 87, 88, 89, 90, 91, 92, 93, 94, 143, 144, 145, 146, 147, 148, 149, 150, 151, 152, 153, 154, 155, 156, 157, 158, 215, 216, 217, 218, 219, 220, 221, 222, 223, 224, 225, 226, 227, 228, 229, 230, 279, 280, 281, 282, 283, 284, 285, 286, 287, 288, 289, 290, 291, 292, 293, 294, 351, 352, 353, 354, 355, 356, 357, 358, 359, 360, 361, 362, 363, 364, 365, 366, 415, 416, 417, 418, 419, 420, 421, 422, 423, 424, 425, 426, 427, 428, 429, 430, 487, 488, 489, 490, 491, 492, 493, 494, 495, 496, 497, 498, 499, 500, 501, 502, 23, 24, 25, 26, 27, 28, 29, 30, 31, 32, 33, 34, 35, 36, 37, 38, 95, 96, 97, 98, 99, 100, 101, 102, 103, 104, 105, 106, 107, 108, 109, 110, 159, 160, 161, 162, 163, 164, 165, 166, 167, 168, 169, 170, 171, 172, 173, 174, 231, 232, 233, 234, 235, 236, 237, 238, 239, 240, 241, 242, 243, 244, 245, 246, 295, 296, 297, 298, 299, 300, 301, 302, 303, 304, 305, 306, 307, 308, 309, 310, 367, 368, 369, 370, 371, 372, 373, 374, 375, 376, 377, 378, 379, 380, 381, 382, 431, 432, 433, 434, 435, 436, 437, 438, 439, 440, 441, 442, 443, 444, 445, 446, 503, 504, 505, 506, 507, 508, 509, 510, 511, 512, 513, 514, 515, 516, 517, 518, 39, 40, 41, 42, 43, 44, 45, 46, 47, 48, 49, 50, 51, 52, 53, 54, 111, 112, 113, 114, 115, 116, 117, 118, 119, 120, 121, 122, 123, 124, 125, 126, 175, 176, 177, 178, 179, 180, 181, 182, 183, 184, 185, 186, 187, 188, 189, 190, 247, 248, 249, 250, 251, 252, 253, 254, 255, 256, 257, 258, 259, 260, 261, 262, 311, 312, 313, 314, 315, 316, 317, 318, 319, 320, 321, 322, 323, 324, 325, 326, 383, 384, 385, 386, 387, 388, 389, 390, 391, 392, 393, 394, 395, 396, 397, 398, 447, 448, 449, 450, 451, 452, 453, 454, 455, 456, 457, 458, 459, 460, 461, 462, 519, 520, 521, 522, 523, 524, 525, 526, 527, 528, 529, 530, 531, 532, 533, 534, 55, 56, 57, 58, 59, 60, 61, 62, 63, 64, 65, 66, 67, 68, 69, 70, 71, 72, 127, 128, 129, 130, 131, 132, 133, 134, 135, 136, 191, 192, 193, 194, 195, 196, 197, 198, 199, 200, 201, 202, 203, 204, 205, 206, 207, 208, 263, 264, 265, 266, 267, 268, 269, 270, 271, 272, 327, 328, 329, 330, 331, 332, 333, 334, 335, 336, 337, 338, 339, 340, 341, 342, 343, 344, 399, 400, 401, 402, 403, 404, 405, 406, 407, 408, 463, 464, 465, 466, 467, 468, 469, 470, 471, 472, 473, 474, 475, 476, 477, 478, 479, 480, 535, 536, 537, 538, 539, 540, 541, 542, 543 };
__device__ __forceinline__ void phase_conv(const Ids I_, LAS unsigned char* lds_base, int l) {
    const Ids I = fresh(I_);
    const KA ka = ka_fresh(); unsigned char* ws = KWS(ka);
    bf16* XBC = (bf16*)(ws + WS_XBC); const bf16* HALO = (const bf16*)(ws + WS_Y);
    const int c0 = I.tid * 8;
    pg8::pg8_gu32* work = (pg8::pg8_gu32*)(ws + WS_CTL) + CW_WORK + 64 * (5 + l); const pg8::pg8_gu32* cb_ = cnt_arr(ws, l, 3); pg8::pg8_gu32* tmo = (pg8::pg8_gu32*)(ws + WS_CTL) + CW_BAR + XB_TMO;
#define CV_CLAIM_WAIT(claim_, out_) do { unsigned id_ = 0xffffu; \
        if ((claim_) < 544u) { id_ = CONV_PERM[claim_]; const int rb_ = 32 * (int)id_; const int p0_ = (rb_ - 2 < 0 ? 0 : rb_ - 2) >> 8, p1_ = (rb_ + 33 >= MTOT ? MTOT - 1 : rb_ + 33) >> 8; unsigned sp_ = 0; \
            for (;;) { bool ok_ = __hip_atomic_load(cb_ + 64 * p0_, __ATOMIC_RELAXED, __HIP_MEMORY_SCOPE_AGENT) >= 136u; if (ok_ && p1_ != p0_) ok_ = __hip_atomic_load(cb_ + 64 * p1_, __ATOMIC_RELAXED, __HIP_MEMORY_SCOPE_AGENT) >= 136u; \
                if (ok_) break; __builtin_amdgcn_s_sleep(2); \
                if ((++sp_ & 255u) == 0u) { if (__hip_atomic_load(tmo, __ATOMIC_RELAXED, __HIP_MEMORY_SCOPE_AGENT) != 0u) break; if (sp_ > (1u << 20)) { __hip_atomic_fetch_add(tmo, 1u, __ATOMIC_RELAXED, __HIP_MEMORY_SCOPE_AGENT); break; } } } \
            __builtin_amdgcn_fence(__ATOMIC_ACQUIRE, "agent"); asm volatile("s_waitcnt vmcnt(0)" ::: "memory"); } \
        out_ = id_; } while (0)
    volatile LAS unsigned* slot = (volatile LAS unsigned*)(lds_base + MISC_OFF) + 50;
    if (I.tid == 0) { const unsigned c0_ = __hip_atomic_fetch_add(work, 1u, __ATOMIC_RELAXED, __HIP_MEMORY_SCOPE_AGENT); unsigned id0; CV_CLAIM_WAIT(c0_, id0); slot[0] = id0; }
    __syncthreads();
    unsigned uid = slot[0]; int par = 0;
    const float* cw = KIN(ka, 8) + (size_t)l * 5 * XBCW + c0; const float* cb = KIN(ka, 9) + (size_t)l * XBCW + c0;
    float w[5][8], bias[8];
#pragma unroll
    for (int i = 0; i < 5; ++i) { const f32x4 a = *(const f32x4*)(cw + i * XBCW), b = *(const f32x4*)(cw + i * XBCW + 4); w[i][0] = a.x; w[i][1] = a.y; w[i][2] = a.z; w[i][3] = a.w; w[i][4] = b.x; w[i][5] = b.y; w[i][6] = b.z; w[i][7] = b.w; }
    { const f32x4 a = *(const f32x4*)cb, b = *(const f32x4*)(cb + 4); bias[0] = a.x; bias[1] = a.y; bias[2] = a.z; bias[3] = a.w; bias[4] = b.x; bias[5] = b.y; bias[6] = b.z; bias[7] = b.w; }
    const v4u zero4 = {0u, 0u, 0u, 0u};
    while (uid != 0xffffu) {
    unsigned nclaim = 0u;
    if (I.tid == 0) nclaim = __hip_atomic_fetch_add(work, 1u, __ATOMIC_RELAXED, __HIP_MEMORY_SCOPE_AGENT);
    const int u0 = (int)uid, rbase = 32 * u0;
#define LDROW(q_) ([&](int q) -> v4u { if (q < 0 || q >= MTOT) return zero4; \
        const bf16* p = q < rbase ? HALO + (size_t)((u0 - 1) * 4 + 2 + (q - (rbase - 2))) * XBCW : (q >= rbase + 32 ? HALO + (size_t)((u0 + 1) * 4 + (q - rbase - 32)) * XBCW : XBC + (size_t)q * XBCW); \
        return *(const v4u*)(p + c0); })(q_)
#define UNPK(dst, v_) do { dst[0] = bf_lo(v_.x); dst[1] = bf_hi(v_.x); dst[2] = bf_lo(v_.y); dst[3] = bf_hi(v_.y); dst[4] = bf_lo(v_.z); dst[5] = bf_hi(v_.z); dst[6] = bf_lo(v_.w); dst[7] = bf_hi(v_.w); } while (0)
    float f0[8], f1[8], f2[8], f3[8];
    { const v4u a0 = LDROW(rbase - 2), a1 = LDROW(rbase - 1), a2 = LDROW(rbase), a3 = LDROW(rbase + 1); UNPK(f0, a0); UNPK(f1, a1); UNPK(f2, a2); UNPK(f3, a3); }
    v4u q0 = LDROW(rbase + 2), q1 = LDROW(rbase + 3), q2 = LDROW(rbase + 4), q3 = LDROW(rbase + 5);
    for (int it = 0; it < 8; ++it) {
        const v4u c0v = q0, c1v = q1, c2v = q2, c3v = q3;
        const int nb = rbase + 2 + 4 * (it + 1);
        if (it + 1 < 8) { q0 = LDROW(nb); q1 = LDROW(nb + 1); q2 = LDROW(nb + 2); q3 = LDROW(nb + 3); }
#pragma unroll
        for (int k = 0; k < 4; ++k) {
            const v4u w4 = k == 0 ? c0v : (k == 1 ? c1v : (k == 2 ? c2v : c3v));
            float f4[8]; UNPK(f4, w4);
            const int r = rbase + 4 * it + k;
            const int s0 = r < MLAT ? (r & ~(SEQ - 1)) : (MLAT + ((r - MLAT) & ~(CTXL - 1))), e0 = s0 + (r < MLAT ? SEQ : CTXL);
            float o[8];
            if (r - 2 >= s0 && r + 2 < e0) {
#pragma unroll
                for (int j = 0; j < 8; ++j) o[j] = bias[j] + w[0][j] * f0[j] + w[1][j] * f1[j] + w[2][j] * f2[j] + w[3][j] * f3[j] + w[4][j] * f4[j];
            } else {
                const float m0 = (r - 2 >= s0) ? 1.f : 0.f, m1 = (r - 1 >= s0) ? 1.f : 0.f, m3 = (r + 1 < e0) ? 1.f : 0.f, m4 = (r + 2 < e0) ? 1.f : 0.f;
#pragma unroll
                for (int j = 0; j < 8; ++j) o[j] = bias[j] + m0 * w[0][j] * f0[j] + m1 * w[1][j] * f1[j] + w[2][j] * f2[j] + m3 * w[3][j] * f3[j] + m4 * w[4][j] * f4[j];
            }
#pragma unroll
            for (int j = 0; j < 8; ++j) o[j] = o[j] * __builtin_amdgcn_rcpf(1.f + __expf(-o[j]));
            v4u ov; ov.x = pk2(o[0], o[1]); ov.y = pk2(o[2], o[3]); ov.z = pk2(o[4], o[5]); ov.w = pk2(o[6], o[7]);
            *(v4u*)(XBC + (size_t)r * XBCW + c0) = ov;
#pragma unroll
            for (int j = 0; j < 8; ++j) { f0[j] = f1[j]; f1[j] = f2[j]; f2[j] = f3[j]; f3[j] = f4[j]; }
        }
    }
    if (I.tid == 0) { unsigned idn; CV_CLAIM_WAIT(nclaim, idn); slot[par ^ 1] = idn; }
    __syncthreads();
    par ^= 1; uid = slot[par];
    }
#undef UNPK
#undef LDROW
#undef CV_CLAIM_WAIT
}

__device__ __forceinline__ void phase_ssd(const Ids I_, LAS unsigned char* lds, int l) {
    const Ids I = fresh(I_);
    const KA ka = ka_fresh(); unsigned char* ws = KWS(ka);
    const bf16* XBC = (const bf16*)(ws + WS_XBC); const float* DT = (const float*)(ws + WS_DT); bf16* Y = (bf16*)(ws + WS_Y);
    const int tid = I.tid, id = I.vcu, b = id >> 6, h = (id >> 1) & 31, ph = id & 1, grp = h >> 2;
    const int pl = tid >> 4, nq = tid & 15;
    LAS float* XS = (LAS float*)lds;
    LAS unsigned char* BT = lds + 8192;
    LAS unsigned char* CT = lds + 24576;
    LAS float* DTT = (LAS float*)(lds + 40960);
    LAS float* YB = (LAS float*)(lds + 41216);
    const float Dsum = KIN(ka, 12)[l * 64 + h] + KIN(ka, 12)[l * 64 + 32 + h];
    for (int dir = 0; dir < 2; ++dir) {
        const float A = -__expf(KIN(ka, 11)[l * 64 + dir * 32 + h]);
        float S[8];
#pragma unroll
        for (int i = 0; i < 8; ++i) S[i] = 0.f;
        for (int part = 0; part < 2; ++part) {
            const int rows0 = part == 0 ? MLAT + b * CTXL : b * SEQ, ntile = (part == 0 ? CTXL : SEQ) / 64;
            for (int ti = 0; ti < ntile; ++ti) {
                const int tile = dir ? ntile - 1 - ti : ti, r0 = rows0 + tile * 64;
                __syncthreads();
#pragma unroll
                for (int q = 0; q < 2; ++q) { const int ch = tid + q * 512, row = ch >> 4, c16 = ch & 15;
                    *(LAS v4u*)(BT + ch * 16) = *(const v4u*)(XBC + (size_t)(r0 + row) * XBCW + 2048 + grp * 128 + c16 * 8);
                    *(LAS v4u*)(CT + ch * 16) = *(const v4u*)(XBC + (size_t)(r0 + row) * XBCW + 3072 + grp * 128 + c16 * 8); }
                if (tid < 256) { const int row = tid >> 2, c = tid & 3; const v4u xv = *(const v4u*)(XBC + (size_t)(r0 + row) * XBCW + h * 64 + ph * 32 + c * 8);
                    LAS float* d = XS + row * 32 + c * 8; d[0] = bf_lo(xv.x); d[1] = bf_hi(xv.x); d[2] = bf_lo(xv.y); d[3] = bf_hi(xv.y); d[4] = bf_lo(xv.z); d[5] = bf_hi(xv.z); d[6] = bf_lo(xv.w); d[7] = bf_hi(xv.w);
                    if (dir == 1) { const v4u yv = *(const v4u*)(Y + (size_t)(r0 + row) * DI + h * 64 + ph * 32 + c * 8);
                        LAS float* e = YB + row * 32 + c * 8; e[0] = bf_lo(yv.x); e[1] = bf_hi(yv.x); e[2] = bf_lo(yv.y); e[3] = bf_hi(yv.y); e[4] = bf_lo(yv.z); e[5] = bf_hi(yv.z); e[6] = bf_lo(yv.w); e[7] = bf_hi(yv.w); } }
                else if (tid < 320) DTT[tid - 256] = DT[(size_t)(dir * 32 + h) * MTOT + r0 + tid - 256];
                __syncthreads();
                for (int s = 0; s < 64; ++s) {
                    const int tt = dir ? 63 - s : s;
                    const float dtv = DTT[tt], a = __expf(dtv * A), xv = XS[tt * 32 + pl], xdt = xv * dtv;
                    const v4u bv = *(const LAS v4u*)(BT + tt * 256 + nq * 16), cv = *(const LAS v4u*)(CT + tt * 256 + nq * 16);
                    float yp;
                    S[0] = S[0] * a + xdt * bf_lo(bv.x); yp = bf_lo(cv.x) * S[0];
                    S[1] = S[1] * a + xdt * bf_hi(bv.x); yp += bf_hi(cv.x) * S[1];
                    S[2] = S[2] * a + xdt * bf_lo(bv.y); yp += bf_lo(cv.y) * S[2];
                    S[3] = S[3] * a + xdt * bf_hi(bv.y); yp += bf_hi(cv.y) * S[3];
                    S[4] = S[4] * a + xdt * bf_lo(bv.z); yp += bf_lo(cv.z) * S[4];
                    S[5] = S[5] * a + xdt * bf_hi(bv.z); yp += bf_hi(cv.z) * S[5];
                    S[6] = S[6] * a + xdt * bf_lo(bv.w); yp += bf_lo(cv.w) * S[6];
                    S[7] = S[7] * a + xdt * bf_hi(bv.w); yp += bf_hi(cv.w) * S[7];
                    yp += pg8::lane_xor<1>(yp); yp += pg8::lane_xor<2>(yp); yp += pg8::lane_xor<4>(yp); yp += pg8::lane_xor<8>(yp);
                    if (nq == 0) { if (dir == 0) YB[tt * 32 + pl] = yp + Dsum * xv; else YB[tt * 32 + pl] += yp; }
                }
                __syncthreads();
                if (tid < 256) { const int row = tid >> 2, c = tid & 3; const LAS float* e = YB + row * 32 + c * 8;
                    v4u o; o.x = pk2(e[0], e[1]); o.y = pk2(e[2], e[3]); o.z = pk2(e[4], e[5]); o.w = pk2(e[6], e[7]);
                    *(v4u*)(Y + (size_t)(r0 + row) * DI + h * 64 + ph * 32 + c * 8) = o; }
            }
        }
        VM_WAIT(); __syncthreads();
    }
}

namespace ssd {
typedef short bf16x8 __attribute__((ext_vector_type(8)));
typedef short s16x4 __attribute__((ext_vector_type(4)));
constexpr int ROW = 272;
constexpr int L_CS = 0, L_BS = 34816, L_XN = 69632  , L_XF = 79872, L_XB = 88576, L_XD = 97280, L_SS0 = 105984, L_SS1 = 114688;
constexpr int L_TAB = 123392;
constexpr int L_DT = L_TAB + 4096;
#define SSD_MFMA(a, b, c) __builtin_amdgcn_mfma_f32_16x16x32_bf16((a), (b), (c), 0, 0, 0)
template <int N> __device__ __forceinline__ float row_shr(float v) { return __int_as_float(__builtin_amdgcn_update_dpp(0, __float_as_int(v), 0x110 + N, 0xf, 0xf, false)); }
__device__ __forceinline__ void scan128(LAS float* dst, LAS float* ej, const LAS float* dt, float A, bool reverse, int lane) {
    const int e0 = reverse ? 127 - 2 * lane : 2 * lane, e1 = reverse ? 126 - 2 * lane : 2 * lane + 1;
    const float v0 = dt[e0] * A, v1 = dt[e1] * A; float sc = v0 + v1;
    sc += row_shr<1>(sc); sc += row_shr<2>(sc); sc += row_shr<4>(sc); sc += row_shr<8>(sc);
    const float t0 = __int_as_float(__builtin_amdgcn_readlane(__float_as_int(sc), 15)), t1 = __int_as_float(__builtin_amdgcn_readlane(__float_as_int(sc), 31)), t2 = __int_as_float(__builtin_amdgcn_readlane(__float_as_int(sc), 47));
    const int row = lane >> 4; sc += (row >= 1 ? t0 : 0.f) + (row >= 2 ? t1 : 0.f) + (row >= 3 ? t2 : 0.f);
    const float ex = sc - (v0 + v1), c0 = ex + v0, c1 = ex + v0 + v1; dst[e0] = c0; dst[e1] = c1;
    LDS_WAIT(); asm volatile("" ::: "memory");
    const float ref = dst[reverse ? (e0 & ~15) : (e0 | 15)];
    ej[e0] = __expf(ref - c0) * dt[e0]; ej[e1] = __expf(ref - c1) * dt[e1];
}
__device__ __forceinline__ bf16x8 pack8f(const float (&m)[8]) { v4u t; t.x = pk2(m[0], m[1]); t.y = pk2(m[2], m[3]); t.z = pk2(m[4], m[5]); t.w = pk2(m[6], m[7]); return __builtin_bit_cast(bf16x8, t); }
__device__ __forceinline__ bf16x8 ld2x8(const LAS unsigned char* p0, const LAS unsigned char* p1) { const v2u a = *(const LAS v2u*)p0, b = *(const LAS v2u*)p1; v4u t; t.x = a.x; t.y = a.y; t.z = b.x; t.w = b.y; return __builtin_bit_cast(bf16x8, t); }
__device__ __forceinline__ unsigned short bf1(float v) { return (unsigned short)(pk2(v, 0.f) & 0xffffu); }
}

template <int SWEEP> __device__ __forceinline__ void ssd_sweep(const Ids I_, LAS unsigned char* lds, int l) {
    constexpr int sweep = SWEEP, NSET = SWEEP ? 2 : 1;
    using namespace ssd;
    const Ids I = fresh(I_);
    const KA ka = ka_fresh(); unsigned char* ws = KWS(ka);
    const bf16* XBC = (const bf16*)(ws + WS_XBC); const float* DT = (const float*)(ws + WS_DT); bf16* Y = (bf16*)(ws + WS_Y);
    const int tid = I.tid, lane = I.lane, w = I.wave, li = lane & 15, lg = lane >> 4;
    const int id = I.vcu, b = id >> 6, h = (id >> 1) & 31, ph = id & 1, grp = h >> 2;
    const float Dsum = KIN(ka, 12)[l * 64 + h] + KIN(ka, 12)[l * 64 + 32 + h];
    const float A_f = -__expf(KIN(ka, 11)[l * 64 + h]), A_b = -__expf(KIN(ka, 11)[l * 64 + 32 + h]);
    const size_t xcol = (size_t)h * 64 + ph * 32;
    const int srow = tid >> 2, sc4 = tid & 3;

    {
        auto row_of = [&](int idx) -> int { const int c = idx < 2 ? (sweep ? 1 - idx : idx) : (sweep ? 31 - (idx - 2) : idx - 2); return idx < 2 ? MLAT + b * CTXL + 128 * c : b * SEQ + 128 * c; };
#define SSD_TAB(par) ((LAS float*)(lds + L_TAB + (par) * 2048))
#define SSD_DTP(par) ((LAS float*)(lds + L_DT + (par) * 1024))
#define SSD_LDDT(idx_) (DT[(size_t)((tid >> 7) * 32 + h) * MTOT + row_of(idx_) + (tid & 127)])
#define SSD_SCAN(par) do { if (sweep == 0) { if (w == 0) scan128(SSD_TAB(par), SSD_TAB(par) + 256, SSD_DTP(par), A_f, false, lane); else if (w == 1) scan128(SSD_TAB(par) + 128, SSD_TAB(par) + 384, SSD_DTP(par) + 128, A_b, true, lane); } \
        else { if (w == 0) scan128(SSD_TAB(par) + 128, SSD_TAB(par) + 384, SSD_DTP(par) + 128, A_b, true, lane); } } while (0)
        v4u pc[NSET][4], pb[NSET][4], px[NSET]; float pdt = 0.f;
#define SSD_ISSUE(idx_, u_) do { const int r0_ = row_of(idx_); \
        _Pragma("unroll") for (int q = 0; q < 4; ++q) { const int ch = tid + 512 * q, row = ch >> 4, c16 = ch & 15; \
            pc[u_][q] = *(const v4u*)(XBC + (size_t)(r0_ + row) * XBCW + 3072 + grp * 128 + c16 * 8); pb[u_][q] = *(const v4u*)(XBC + (size_t)(r0_ + row) * XBCW + 2048 + grp * 128 + c16 * 8); } \
        px[u_] = *(const v4u*)(XBC + (size_t)(r0_ + srow) * XBCW + xcol + sc4 * 8); } while (0)
        __syncthreads();
        for (int i = tid; i < (2 * 8704) / 4; i += NWAVES * 64) ((LAS unsigned*)(lds + L_SS0))[i] = 0u;
        f32x4 sacc[2] = {{0.f, 0.f, 0.f, 0.f}, {0.f, 0.f, 0.f, 0.f}};
        _Pragma("unroll") for (int u = 0; u < NSET; ++u) SSD_ISSUE(u, u);
        if (tid < 256) SSD_DTP(0)[tid] = SSD_LDDT(0);
        __syncthreads();
        SSD_SCAN(0);
        if (tid < 256) pdt = SSD_LDDT(1);
        for (int idx0 = 0; idx0 < 34; idx0 += NSET)
#pragma unroll
        for (int u = 0; u < NSET; ++u) {
            const int idx = idx0 + u;
            const int r0 = row_of(idx), par = idx & 1;
            const bool need_y = !(l == 1 && idx < 2);
            LAS unsigned char* SScur = lds + (par ? L_SS1 : L_SS0); LAS unsigned char* SSnxt = lds + (par ? L_SS0 : L_SS1);
            LAS float* AF = SSD_TAB(par); LAS float* RB = AF + 128; LAS float* EJF = AF + 256; LAS float* EJB = AF + 384; LAS float* DTF = SSD_DTP(par); LAS float* DTB = DTF + 128;
            __syncthreads();
#pragma unroll
            for (int q = 0; q < 4; ++q) { const int ch = tid + 512 * q, row = ch >> 4, c16 = ch & 15; *(LAS v4u*)(lds + L_CS + row * ROW + c16 * 16) = pc[u][q]; *(LAS v4u*)(lds + L_BS + row * ROW + c16 * 16) = pb[u][q]; }
            *(LAS v4u*)(lds + L_XN + srow * 80 + sc4 * 16) = px[u];
            {
                const v4u pxu = px[u]; const float xv[8] = {bf_lo(pxu.x), bf_hi(pxu.x), bf_lo(pxu.y), bf_hi(pxu.y), bf_lo(pxu.z), bf_hi(pxu.z), bf_lo(pxu.w), bf_hi(pxu.w)};
                LAS unsigned short* xf = (LAS unsigned short*)(lds + L_XF + (4 * sc4) * ROW) + srow; LAS unsigned short* xb = (LAS unsigned short*)(lds + L_XB + (4 * sc4) * ROW) + srow; LAS unsigned short* xd = (LAS unsigned short*)(lds + L_XD + (4 * sc4) * ROW) + srow;
                if (sweep == 0) { const float f = DTF[srow], gg = DTB[srow], e = f * __expf(AF[127] - AF[srow]);
#pragma unroll
                    for (int q = 0; q < 8; ++q) { const int ro = (16 * (q >> 2) + (q & 3)) * (ROW / 2); xf[ro] = bf1(xv[q]); xd[ro] = bf1(xv[q] * e); } (void)gg; (void)xb; }
                else { const float e = DTB[srow] * __expf(RB[0] - RB[srow]);
#pragma unroll
                    for (int q = 0; q < 8; ++q) xd[(16 * (q >> 2) + (q & 3)) * (ROW / 2)] = bf1(xv[q] * e); }
            }
            if (tid < 256 && idx + 1 < 34) SSD_DTP(par ^ 1)[tid] = pdt;
            __syncthreads();
            if (idx + NSET < 34) SSD_ISSUE(idx + NSET, u);
            if (idx + 1 < 34) SSD_SCAN(par ^ 1);
            if (tid < 256 && idx + 2 < 34) pdt = SSD_LDDT(idx + 2);
            v4u yold = {0u, 0u, 0u, 0u};
            if (sweep == 1 && need_y) yold = *(const v4u*)(Y + (size_t)(r0 + 16 * w + li) * DI + xcol + 8 * lg);
            bf16x8 cf[4];
#pragma unroll
            for (int ks = 0; ks < 4; ++ks) cf[ks] = *(const LAS bf16x8*)(lds + L_CS + (16 * w + li) * ROW + (32 * ks + 8 * lg) * 2);
            f32x4 yacc[2] = {{0.f, 0.f, 0.f, 0.f}, {0.f, 0.f, 0.f, 0.f}}, yi[2] = {{0.f, 0.f, 0.f, 0.f}, {0.f, 0.f, 0.f, 0.f}};
            if (need_y) {
            {
                bf16x8 sf[8];
#pragma unroll
                for (int ks = 0; ks < 4; ++ks)
#pragma unroll
                    for (int pt = 0; pt < 2; ++pt) sf[2 * ks + pt] = *(const LAS bf16x8*)(SScur + (16 * pt + li) * ROW + (32 * ks + 8 * lg) * 2);
                __builtin_amdgcn_sched_barrier(0);
#pragma unroll
                for (int ks = 0; ks < 4; ++ks)
#pragma unroll
                    for (int pt = 0; pt < 2; ++pt) yi[pt] = SSD_MFMA(sf[2 * ks + pt], cf[ks], yi[pt]);
            }
            float escale;
            if (sweep == 0) {
                const float af_i = AF[16 * w + li], rb_i = RB[16 * w + li];
                escale = __expf(af_i);
                f32x4 g[8];
                {
                    bf16x8 fa[8], fb[8];
#define SSD_GLOAD(dst, jp) do { _Pragma("unroll") for (int q_ = 0; q_ < 8; ++q_) dst[q_] = *(const LAS bf16x8*)(lds + L_BS + (16 * (2 * (jp) + (q_ >> 2)) + li) * ROW + (32 * (q_ & 3) + 8 * lg) * 2); } while (0)
#define SSD_GMMA(src, jp) do { g[2 * (jp)] = (f32x4){0.f, 0.f, 0.f, 0.f}; g[2 * (jp) + 1] = (f32x4){0.f, 0.f, 0.f, 0.f}; \
                        _Pragma("unroll") for (int q_ = 0; q_ < 8; ++q_) g[2 * (jp) + (q_ >> 2)] = SSD_MFMA(src[q_], cf[q_ & 3], g[2 * (jp) + (q_ >> 2)]); } while (0)
                    SSD_GLOAD(fa, 0); __builtin_amdgcn_sched_barrier(0);
                    SSD_GLOAD(fb, 1); __builtin_amdgcn_sched_barrier(0); SSD_GMMA(fa, 0); __builtin_amdgcn_sched_barrier(0);
                    SSD_GLOAD(fa, 2); __builtin_amdgcn_sched_barrier(0); SSD_GMMA(fb, 1); __builtin_amdgcn_sched_barrier(0);
                    SSD_GLOAD(fb, 3); __builtin_amdgcn_sched_barrier(0); SSD_GMMA(fa, 2); __builtin_amdgcn_sched_barrier(0);
                    SSD_GMMA(fb, 3); __builtin_amdgcn_sched_barrier(0);
#undef SSD_GLOAD
#undef SSD_GMMA
                }
#define SSD_TILE_F(t, mo) do { if ((t) < w) { const float ei = __expf(af_i - AF[16 * (t) + 15]); const f32x4 ejv = *(const LAS f32x4*)(EJF + 16 * (t) + 4 * lg); \
                        _Pragma("unroll") for (int r = 0; r < 4; ++r) m[(mo) + r] = g[t][r] * (ei * ejv[r]); } \
                    else if ((t) == w) { const f32x4 av = *(const LAS f32x4*)(AF + 16 * (t) + 4 * lg), dv = *(const LAS f32x4*)(DTF + 16 * (t) + 4 * lg); \
                        _Pragma("unroll") for (int r = 0; r < 4; ++r) m[(mo) + r] = (4 * lg + r <= li) ? g[t][r] * (dv[r] * __expf(fminf(af_i - av[r], 0.f))) : 0.f; } \
                    else { _Pragma("unroll") for (int r = 0; r < 4; ++r) m[(mo) + r] = 0.f; } } while (0)
#define SSD_TILE_B(t, mo) do { if ((t) > w) { const float ei = __expf(rb_i - RB[16 * (t)]); const f32x4 ejv = *(const LAS f32x4*)(EJB + 16 * (t) + 4 * lg); \
                        _Pragma("unroll") for (int r = 0; r < 4; ++r) m[(mo) + r] = g[t][r] * (ei * ejv[r]); } \
                    else if ((t) == w) { const f32x4 av = *(const LAS f32x4*)(RB + 16 * (t) + 4 * lg), dv = *(const LAS f32x4*)(DTB + 16 * (t) + 4 * lg); \
                        _Pragma("unroll") for (int r = 0; r < 4; ++r) m[(mo) + r] = (4 * lg + r >= li) ? g[t][r] * (dv[r] * __expf(fminf(rb_i - av[r], 0.f))) : 0.f; } \
                    else { _Pragma("unroll") for (int r = 0; r < 4; ++r) m[(mo) + r] = 0.f; } } while (0)
#pragma unroll
                for (int kk = 0; kk < 4; ++kk) {
                    const int t0 = 2 * kk, t1 = 2 * kk + 1;
                    if (t0 <= w) {
                        float m[8]; SSD_TILE_F(t0, 0); SSD_TILE_F(t1, 4);
                        const bf16x8 bfr = pack8f(m);
#pragma unroll
                        for (int pt = 0; pt < 2; ++pt) { const LAS unsigned char* rp = lds + L_XF + (16 * pt + li) * ROW; const bf16x8 a = ld2x8(rp + (32 * kk + 4 * lg) * 2, rp + (32 * kk + 16 + 4 * lg) * 2); yacc[pt] = SSD_MFMA(a, bfr, yacc[pt]); }
                    }
                    if (t1 >= w) {
                        float m[8]; SSD_TILE_B(t0, 0); SSD_TILE_B(t1, 4);
                        const bf16x8 bfr = pack8f(m);
#pragma unroll
                        for (int pt = 0; pt < 2; ++pt) { const LAS unsigned char* rp = lds + L_XF + (16 * pt + li) * ROW; const bf16x8 a = ld2x8(rp + (32 * kk + 4 * lg) * 2, rp + (32 * kk + 16 + 4 * lg) * 2); yacc[pt] = SSD_MFMA(a, bfr, yacc[pt]); }
                    }
                }
#undef SSD_TILE_F
#undef SSD_TILE_B
            } else escale = __expf(RB[16 * w + li]);
            {
                bf16* yp = Y + (size_t)(r0 + 16 * w + li) * DI + xcol + 8 * lg;
                float o[8];
                if (sweep == 0) { const v4u xv = *(const LAS v4u*)(lds + L_XN + (16 * w + li) * 80 + (8 * lg) * 2);
                    const float xs[8] = {bf_lo(xv.x), bf_hi(xv.x), bf_lo(xv.y), bf_hi(xv.y), bf_lo(xv.z), bf_hi(xv.z), bf_lo(xv.w), bf_hi(xv.w)};
#pragma unroll
                    for (int pt = 0; pt < 2; ++pt)
#pragma unroll
                        for (int r = 0; r < 4; ++r) o[4 * pt + r] = yacc[pt][r] + escale * yi[pt][r] + Dsum * xs[4 * pt + r]; }
                else { const float ys[8] = {bf_lo(yold.x), bf_hi(yold.x), bf_lo(yold.y), bf_hi(yold.y), bf_lo(yold.z), bf_hi(yold.z), bf_lo(yold.w), bf_hi(yold.w)};
#pragma unroll
                    for (int pt = 0; pt < 2; ++pt)
#pragma unroll
                        for (int r = 0; r < 4; ++r) o[4 * pt + r] = ys[4 * pt + r] + escale * yi[pt][r]; }
                v4u ov; ov.x = pk2(o[0], o[1]); ov.y = pk2(o[2], o[3]); ov.z = pk2(o[4], o[5]); ov.w = pk2(o[6], o[7]); *(v4u*)yp = ov;
            }
            }
            {
                const float atot = __expf(sweep == 0 ? AF[127] : RB[0]);
                sacc[0] = sacc[0] * atot; sacc[1] = sacc[1] * atot;
                const int q = li >> 2, pq = li & 3;
                bf16x8 ta[4], xd[8];
#pragma unroll
                for (int ks = 0; ks < 4; ++ks) {
                    const LAS unsigned char* tp = lds + L_BS + (32 * ks + 8 * lg + q) * ROW + (16 * w + 4 * pq) * 2;
                    const s16x4 lo = __builtin_amdgcn_ds_read_tr16_b64_v4i16((LAS s16x4*)tp), hi = __builtin_amdgcn_ds_read_tr16_b64_v4i16((LAS s16x4*)(tp + 4 * ROW));
                    ta[ks] = __builtin_shufflevector(lo, hi, 0, 1, 2, 3, 4, 5, 6, 7);
#pragma unroll
                    for (int pt = 0; pt < 2; ++pt) xd[2 * ks + pt] = *(const LAS bf16x8*)(lds + L_XD + (16 * pt + li) * ROW + (32 * ks + 8 * lg) * 2);
                }
                __builtin_amdgcn_sched_barrier(0);
#pragma unroll
                for (int ks = 0; ks < 4; ++ks)
#pragma unroll
                    for (int pt = 0; pt < 2; ++pt) sacc[pt] = SSD_MFMA(ta[ks], xd[2 * ks + pt], sacc[pt]);
#pragma unroll
                for (int pt = 0; pt < 2; ++pt) { v2u sv; sv.x = pk2(sacc[pt][0], sacc[pt][1]); sv.y = pk2(sacc[pt][2], sacc[pt][3]); *(LAS v2u*)(SSnxt + (16 * pt + li) * ROW + (16 * w + 4 * lg) * 2) = sv; }
            }
        }
#undef SSD_ISSUE
#undef SSD_SCAN
#undef SSD_LDDT
#undef SSD_TAB
#undef SSD_DTP
        VM_WAIT(); __syncthreads();
    }
}
__device__ __forceinline__ void phase_ssd_mfma(const Ids I, LAS unsigned char* lds, int l) { ssd_sweep<0>(I, lds, l); ssd_sweep<1>(I, lds, l); }
namespace ssdd {
constexpr int ROW = 272;
constexpr int L_CS = 0, L_BS = 34816, L_XF = 69632, L_XD = 87040, L_SS0 = 104448, L_SS1 = 121856, L_TAB = 139264  , L_DT = 141312  ;
constexpr int FLAG_OFF = 90112;
}
template <int DIR> __device__ __forceinline__ void ssd_dir(const Ids I_, LAS unsigned char* lds, int l) {
    using namespace ssdd;
    using ssd::scan128; using ssd::pack8f; using ssd::ld2x8; using ssd::bf1; using ssd::bf16x8; using ssd::s16x4;
    const Ids I = fresh(I_);
    const KA ka = ka_fresh(); unsigned char* ws = KWS(ka);
    const bf16* XBC = (const bf16*)(ws + WS_XBC); const float* DT = (const float*)(ws + WS_DT); bf16* Y = (bf16*)(ws + WS_Y);
    const int tid = I.tid, lane = I.lane, w = I.wave, li = lane & 15, lg = lane >> 4;
    const int wt = w < 4 ? w : 11 - w;
    const int id = I.vcu, b = id >> 6, h = (id >> 1) & 31, grp = h >> 2;
    const float Dsum = KIN(ka, 12)[l * 64 + h] + KIN(ka, 12)[l * 64 + 32 + h];
    const float A_d = -__expf(KIN(ka, 11)[l * 64 + DIR * 32 + h]);
    const size_t xcol = (size_t)h * 64;
    const int srow = tid >> 2, sc4 = tid & 3;
    pg8::pg8_gu32* flags = (pg8::pg8_gu32*)(ws + WS_CTL) + FLAG_OFF + (size_t)((l * 128 + b * 32 + h) * 34) * 8 + w;
    const __amdgpu_buffer_rsrc_t rsY = __builtin_amdgcn_make_buffer_rsrc((void*)Y, (short)0, 17408 * 2048 * 2, 0x00020000);
    auto chunk_of = [&](int idx) -> int { return idx < 2 ? (DIR ? 1 - idx : idx) : 2 + (DIR ? 31 - (idx - 2) : idx - 2); };
    auto row_of = [&](int idx) -> int { const int c = chunk_of(idx); return c < 2 ? MLAT + b * CTXL + 128 * c : b * SEQ + 128 * (c - 2); };
#define SD_TAB(par) ((LAS float*)(lds + L_TAB + (par) * 1024))
#define SD_DTP(par) ((LAS float*)(lds + L_DT + (par) * 512))
#define SD_LDDT(idx_) (DT[(size_t)(DIR * 32 + h) * MTOT + row_of(idx_) + tid])
#define SD_SCAN(par) do { if (w == 0) scan128(SD_TAB(par), SD_TAB(par) + 128, SD_DTP(par), A_d, DIR != 0, lane); } while (0)
    v4u pc[4], pb[4], px[2]; float pdt = 0.f;
#define SD_ISSUE(idx_) do { const int r0_ = row_of(idx_); \
        _Pragma("unroll") for (int q = 0; q < 4; ++q) { const int ch = tid + 512 * q, row = ch >> 4, c16 = ch & 15; \
            pc[q] = *(const v4u*)(XBC + (size_t)(r0_ + row) * XBCW + 3072 + grp * 128 + c16 * 8); pb[q] = *(const v4u*)(XBC + (size_t)(r0_ + row) * XBCW + 2048 + grp * 128 + c16 * 8); } \
        px[0] = *(const v4u*)(XBC + (size_t)(r0_ + srow) * XBCW + xcol + sc4 * 16); px[1] = *(const v4u*)(XBC + (size_t)(r0_ + srow) * XBCW + xcol + sc4 * 16 + 8); } while (0)
    __syncthreads();
    for (int i = tid; i < (2 * 17408) / 4; i += NWAVES * 64) ((LAS unsigned*)(lds + L_SS0))[i] = 0u;
    f32x4 sacc[4];
#pragma unroll
    for (int pt = 0; pt < 4; ++pt) sacc[pt] = (f32x4){0.f, 0.f, 0.f, 0.f};
    SD_ISSUE(0);
    if (tid < 128) SD_DTP(0)[tid] = SD_LDDT(0);
    __syncthreads();
    SD_SCAN(0);
    if (tid < 128) pdt = SD_LDDT(1);
    int pend = -1;
    for (int idx = 0; idx < 34; ++idx) {
        const int r0 = row_of(idx), par = idx & 1, cid = chunk_of(idx);
        const bool need_y = !(l == 1 && idx < 2);
        const bool first = idx < 2 ? (idx == 0) : (idx <= 17);
        LAS unsigned char* SScur = lds + (par ? L_SS1 : L_SS0); LAS unsigned char* SSnxt = lds + (par ? L_SS0 : L_SS1);
        LAS float* AC = SD_TAB(par); LAS float* EJ = AC + 128; LAS float* DTC = SD_DTP(par);
        __syncthreads();
#pragma unroll
        for (int q = 0; q < 4; ++q) { const int ch = tid + 512 * q, row = ch >> 4, c16 = ch & 15; *(LAS v4u*)(lds + L_CS + row * ROW + c16 * 16) = pc[q]; *(LAS v4u*)(lds + L_BS + row * ROW + c16 * 16) = pb[q]; }
        {
            const v4u p0 = px[0], p1 = px[1];
            const float xv[16] = {bf_lo(p0.x), bf_hi(p0.x), bf_lo(p0.y), bf_hi(p0.y), bf_lo(p0.z), bf_hi(p0.z), bf_lo(p0.w), bf_hi(p0.w), bf_lo(p1.x), bf_hi(p1.x), bf_lo(p1.y), bf_hi(p1.y), bf_lo(p1.z), bf_hi(p1.z), bf_lo(p1.w), bf_hi(p1.w)};
            LAS unsigned short* xf = (LAS unsigned short*)(lds + L_XF + (4 * sc4) * ROW) + srow; LAS unsigned short* xd = (LAS unsigned short*)(lds + L_XD + (4 * sc4) * ROW) + srow;
            const float e = DTC[srow] * __expf(AC[DIR ? 0 : 127] - AC[srow]);
#pragma unroll
            for (int q = 0; q < 16; ++q) { const int ro = (16 * (q >> 2) + (q & 3)) * (ROW / 2); xf[ro] = bf1(xv[q]); xd[ro] = bf1(xv[q] * e); }
        }
        if (tid < 128 && idx + 1 < 34) SD_DTP(par ^ 1)[tid] = pdt;
        if (pend >= 0) { asm volatile("s_waitcnt vmcnt(0)" ::: "memory"); if (lane == 0) __hip_atomic_store(flags + pend * 8, 1u, __ATOMIC_RELAXED, __HIP_MEMORY_SCOPE_AGENT); pend = -1; }
        __syncthreads();
        if (idx + 1 < 34) SD_ISSUE(idx + 1);
        if (idx + 1 < 34) SD_SCAN(par ^ 1);
        if (tid < 128 && idx + 2 < 34) pdt = SD_LDDT(idx + 2);
        const unsigned yoff = (unsigned)(((size_t)(r0 + 16 * wt + li) * DI + xcol + 16 * lg) * 2);
        v4u yo0 = {0u, 0u, 0u, 0u}, yo1 = {0u, 0u, 0u, 0u}, xs0 = {0u, 0u, 0u, 0u}, xs1 = {0u, 0u, 0u, 0u};
        if (need_y) {
            if (!first) {
                unsigned sp = 0;
                while (__builtin_amdgcn_readfirstlane(__hip_atomic_load(flags + cid * 8, __ATOMIC_RELAXED, __HIP_MEMORY_SCOPE_AGENT)) == 0u) { __builtin_amdgcn_s_sleep(2);
                    if ((++sp & 255u) == 0u) { pg8::pg8_gu32* tmo = (pg8::pg8_gu32*)(ws + WS_CTL) + CW_BAR + XB_TMO; if (__hip_atomic_load(tmo, __ATOMIC_RELAXED, __HIP_MEMORY_SCOPE_AGENT) != 0u) break; if (sp > (1u << 20)) { if (lane == 0) __hip_atomic_fetch_add(tmo, 1u, __ATOMIC_RELAXED, __HIP_MEMORY_SCOPE_AGENT); break; } } }
                asm volatile("" ::: "memory");
                yo0 = __builtin_amdgcn_raw_buffer_load_b128(rsY, yoff, 0, 17); yo1 = __builtin_amdgcn_raw_buffer_load_b128(rsY, yoff + 16, 0, 17);
            }
            if (DIR == 0) { const v4u* xp = (const v4u*)(XBC + (size_t)(r0 + 16 * wt + li) * XBCW + xcol + 16 * lg); xs0 = xp[0]; xs1 = xp[1]; }
        }
        bf16x8 cf[4];
#pragma unroll
        for (int ks = 0; ks < 4; ++ks) cf[ks] = *(const LAS bf16x8*)(lds + L_CS + (16 * wt + li) * ROW + (32 * ks + 8 * lg) * 2);
        f32x4 yacc[4], yi[4];
#pragma unroll
        for (int pt = 0; pt < 4; ++pt) { yacc[pt] = (f32x4){0.f, 0.f, 0.f, 0.f}; yi[pt] = (f32x4){0.f, 0.f, 0.f, 0.f}; }
        if (need_y) {
            {
#pragma unroll
                for (int ks = 0; ks < 4; ++ks) {
                    bf16x8 sf[4];
#pragma unroll
                    for (int pt = 0; pt < 4; ++pt) sf[pt] = *(const LAS bf16x8*)(SScur + (16 * pt + li) * ROW + (32 * ks + 8 * lg) * 2);
#pragma unroll
                    for (int pt = 0; pt < 4; ++pt) yi[pt] = SSD_MFMA(sf[pt], cf[ks], yi[pt]);
                }
            }
            const float a_i = AC[16 * wt + li];
            const float escale = __expf(a_i);
            f32x4 g[8];
            {
                bf16x8 fa[8], fb[8];
#define SD_GLOAD(dst, jp) do { _Pragma("unroll") for (int q_ = 0; q_ < 8; ++q_) dst[q_] = *(const LAS bf16x8*)(lds + L_BS + (16 * (2 * (jp) + (q_ >> 2)) + li) * ROW + (32 * (q_ & 3) + 8 * lg) * 2); } while (0)
#define SD_GMMA(src, jp) do { g[2 * (jp)] = (f32x4){0.f, 0.f, 0.f, 0.f}; g[2 * (jp) + 1] = (f32x4){0.f, 0.f, 0.f, 0.f}; \
                    _Pragma("unroll") for (int q_ = 0; q_ < 8; ++q_) g[2 * (jp) + (q_ >> 2)] = SSD_MFMA(src[q_], cf[q_ & 3], g[2 * (jp) + (q_ >> 2)]); } while (0)
#define SD_NEED(jp) (DIR == 0 ? (2 * (jp) <= wt) : (2 * (jp) + 1 >= wt))
                if (DIR == 0 ? (wt >= 6) : (wt <= 1)) {
                    SD_GLOAD(fa, 0); __builtin_amdgcn_sched_barrier(0);
                    SD_GLOAD(fb, 1); __builtin_amdgcn_sched_barrier(0); SD_GMMA(fa, 0); __builtin_amdgcn_sched_barrier(0);
                    SD_GLOAD(fa, 2); __builtin_amdgcn_sched_barrier(0); SD_GMMA(fb, 1); __builtin_amdgcn_sched_barrier(0);
                    SD_GLOAD(fb, 3); __builtin_amdgcn_sched_barrier(0); SD_GMMA(fa, 2); __builtin_amdgcn_sched_barrier(0);
                    SD_GMMA(fb, 3); __builtin_amdgcn_sched_barrier(0);
                } else {
#pragma unroll
                    for (int jp = 0; jp < 4; ++jp) {
                        if (SD_NEED(jp)) { SD_GLOAD(fa, jp); __builtin_amdgcn_sched_barrier(0); SD_GMMA(fa, jp); __builtin_amdgcn_sched_barrier(0); }
                        else { g[2 * jp] = (f32x4){0.f, 0.f, 0.f, 0.f}; g[2 * jp + 1] = (f32x4){0.f, 0.f, 0.f, 0.f}; }
                    }
                    (void)fb;
                }
#undef SD_NEED
#undef SD_GLOAD
#undef SD_GMMA
            }
#define SD_TILE(t, mo) do { if (DIR == 0 ? ((t) < wt) : ((t) > wt)) { const float ei = __expf(a_i - AC[DIR == 0 ? 16 * (t) + 15 : 16 * (t)]); const f32x4 ejv = *(const LAS f32x4*)(EJ + 16 * (t) + 4 * lg); \
                    _Pragma("unroll") for (int r = 0; r < 4; ++r) m[(mo) + r] = g[t][r] * (ei * ejv[r]); } \
                else if ((t) == wt) { const f32x4 av = *(const LAS f32x4*)(AC + 16 * (t) + 4 * lg), dv = *(const LAS f32x4*)(DTC + 16 * (t) + 4 * lg); \
                    _Pragma("unroll") for (int r = 0; r < 4; ++r) m[(mo) + r] = (DIR == 0 ? (4 * lg + r <= li) : (4 * lg + r >= li)) ? g[t][r] * (dv[r] * __expf(fminf(a_i - av[r], 0.f))) : 0.f; } \
                else { _Pragma("unroll") for (int r = 0; r < 4; ++r) m[(mo) + r] = 0.f; } } while (0)
#pragma unroll
            for (int kk = 0; kk < 4; ++kk) {
                const int t0 = 2 * kk, t1 = 2 * kk + 1;
                if (DIR == 0 ? (t0 <= wt) : (t1 >= wt)) {
                    float m[8]; SD_TILE(t0, 0); SD_TILE(t1, 4);
                    const bf16x8 bfr = pack8f(m);
#pragma unroll
                    for (int pt = 0; pt < 4; ++pt) { const LAS unsigned char* rp = lds + L_XF + (16 * pt + li) * ROW; const bf16x8 a = ld2x8(rp + (32 * kk + 4 * lg) * 2, rp + (32 * kk + 16 + 4 * lg) * 2); yacc[pt] = SSD_MFMA(a, bfr, yacc[pt]); }
                }
            }
#undef SD_TILE
            {
                float o[16];
#pragma unroll
                for (int pt = 0; pt < 4; ++pt)
#pragma unroll
                    for (int r = 0; r < 4; ++r) o[4 * pt + r] = yacc[pt][r] + escale * yi[pt][r];
                if (DIR == 0) { const float xs[16] = {bf_lo(xs0.x), bf_hi(xs0.x), bf_lo(xs0.y), bf_hi(xs0.y), bf_lo(xs0.z), bf_hi(xs0.z), bf_lo(xs0.w), bf_hi(xs0.w), bf_lo(xs1.x), bf_hi(xs1.x), bf_lo(xs1.y), bf_hi(xs1.y), bf_lo(xs1.z), bf_hi(xs1.z), bf_lo(xs1.w), bf_hi(xs1.w)};
#pragma unroll
                    for (int q = 0; q < 16; ++q) o[q] += Dsum * xs[q]; }
                if (!first) { const float ys[16] = {bf_lo(yo0.x), bf_hi(yo0.x), bf_lo(yo0.y), bf_hi(yo0.y), bf_lo(yo0.z), bf_hi(yo0.z), bf_lo(yo0.w), bf_hi(yo0.w), bf_lo(yo1.x), bf_hi(yo1.x), bf_lo(yo1.y), bf_hi(yo1.y), bf_lo(yo1.z), bf_hi(yo1.z), bf_lo(yo1.w), bf_hi(yo1.w)};
#pragma unroll
                    for (int q = 0; q < 16; ++q) o[q] += ys[q]; }
                v4u ov0, ov1; ov0.x = pk2(o[0], o[1]); ov0.y = pk2(o[2], o[3]); ov0.z = pk2(o[4], o[5]); ov0.w = pk2(o[6], o[7]); ov1.x = pk2(o[8], o[9]); ov1.y = pk2(o[10], o[11]); ov1.z = pk2(o[12], o[13]); ov1.w = pk2(o[14], o[15]);
                if (first) { __builtin_amdgcn_raw_buffer_store_b128(ov0, rsY, yoff, 0, 16); __builtin_amdgcn_raw_buffer_store_b128(ov1, rsY, yoff + 16, 0, 16); pend = cid; }
                else { __builtin_amdgcn_raw_buffer_store_b128(ov0, rsY, yoff, 0, 0); __builtin_amdgcn_raw_buffer_store_b128(ov1, rsY, yoff + 16, 0, 0); }
            }
        }
        {
            const float atot = __expf(AC[DIR ? 0 : 127]);
#pragma unroll
            for (int pt = 0; pt < 4; ++pt) sacc[pt] = sacc[pt] * atot;
            const int q = li >> 2, pq = li & 3;
#pragma unroll
            for (int ks = 0; ks < 4; ++ks) {
                const LAS unsigned char* tp = lds + L_BS + (32 * ks + 8 * lg + q) * ROW + (16 * w + 4 * pq) * 2;
                const s16x4 lo = __builtin_amdgcn_ds_read_tr16_b64_v4i16((LAS s16x4*)tp), hi = __builtin_amdgcn_ds_read_tr16_b64_v4i16((LAS s16x4*)(tp + 4 * ROW));
                const bf16x8 ta = __builtin_shufflevector(lo, hi, 0, 1, 2, 3, 4, 5, 6, 7);
                bf16x8 xdv[4];
#pragma unroll
                for (int pt = 0; pt < 4; ++pt) xdv[pt] = *(const LAS bf16x8*)(lds + L_XD + (16 * pt + li) * ROW + (32 * ks + 8 * lg) * 2);
#pragma unroll
                for (int pt = 0; pt < 4; ++pt) sacc[pt] = SSD_MFMA(ta, xdv[pt], sacc[pt]);
            }
#pragma unroll
            for (int pt = 0; pt < 4; ++pt) { v2u sv; sv.x = pk2(sacc[pt][0], sacc[pt][1]); sv.y = pk2(sacc[pt][2], sacc[pt][3]); *(LAS v2u*)(SSnxt + (16 * pt + li) * ROW + (16 * w + 4 * lg) * 2) = sv; }
        }
    }
    asm volatile("s_waitcnt vmcnt(0)" ::: "memory");
    if (pend >= 0 && lane == 0) __hip_atomic_store(flags + pend * 8, 1u, __ATOMIC_RELAXED, __HIP_MEMORY_SCOPE_AGENT);
#undef SD_ISSUE
#undef SD_SCAN
#undef SD_LDDT
#undef SD_TAB
#undef SD_DTP
    __syncthreads();
}
__device__ __forceinline__ void phase_ssd_dir(const Ids I, LAS unsigned char* lds, int l) { if (I.vcu & 1) ssd_dir<1>(I, lds, l); else ssd_dir<0>(I, lds, l); }

namespace ssd3 {
typedef short bf16x8 __attribute__((ext_vector_type(8)));
typedef short s16x4 __attribute__((ext_vector_type(4)));
constexpr int ROW = 272;
constexpr int L_BS = 0, L_XF = 69632, L_XB = L_XF + 17408, L_XD = L_XB + 17408, L_SS = L_XD + 17408, L_TAB = L_SS + 17408;
constexpr int T_AFL = 0, T_RBL = 128, T_EJF = 256, T_EJB = 384, T_TF = 512, T_TB = 520, T_FLOATS = 528;
#define SSD3_MFMA32(a, b, c) __builtin_amdgcn_mfma_f32_16x16x32_bf16((a), (b), (c), 0, 0, 0)
#define SSD3_MFMA16(a, b, c) __builtin_amdgcn_mfma_f32_16x16x16bf16_1k((a), (b), (c), 0, 0, 0)
template <int N> __device__ __forceinline__ float row_shr(float v) { return __int_as_float(__builtin_amdgcn_update_dpp(0, __float_as_int(v), 0x110 + N, 0xf, 0xf, false)); }
__device__ __forceinline__ float rdlane(float v, int l) { return __int_as_float(__builtin_amdgcn_readlane(__float_as_int(v), l)); }
__device__ __forceinline__ float scan16x4(float a, int lane, float& tot) {
    float s = a; s += row_shr<4>(s); s += row_shr<8>(s);
    const float t0 = rdlane(s, 15), t1 = rdlane(s, 31), t2 = rdlane(s, 47), t3 = rdlane(s, 63); const int dr = lane >> 4;
    s += (dr >= 1 ? t0 : 0.f) + (dr >= 2 ? t1 : 0.f) + (dr >= 3 ? t2 : 0.f); tot = (t0 + t1) + (t2 + t3); return s;
}
__device__ __forceinline__ bf16x8 pack8f(const float (&m)[8]) { v4u t; t.x = pk2(m[0], m[1]); t.y = pk2(m[2], m[3]); t.z = pk2(m[4], m[5]); t.w = pk2(m[6], m[7]); return __builtin_bit_cast(bf16x8, t); }
__device__ __forceinline__ bf16x8 ld2x8(const LAS unsigned char* p0, const LAS unsigned char* p1) { const v2u a = *(const LAS v2u*)p0, b = *(const LAS v2u*)p1; v4u t; t.x = a.x; t.y = a.y; t.z = b.x; t.w = b.y; return __builtin_bit_cast(bf16x8, t); }
__device__ __forceinline__ unsigned short bf1(float v) { return (unsigned short)(pk2(v, 0.f) & 0xffffu); }
}

template <int SWEEP> __device__ __forceinline__ void ssd3_sweep(const Ids I_, LAS unsigned char* lds, int l) {
    using namespace ssd3;
    constexpr int sweep = SWEEP;
    const Ids I = fresh(I_);
    const KA ka = ka_fresh(); unsigned char* ws = KWS(ka);
    const bf16* XBC = (const bf16*)(ws + WS_XBC); const float* DT = (const float*)(ws + WS_DT); bf16* Y = (bf16*)(ws + WS_Y);
    const int tid = I.tid, lane = I.lane, w = I.wave, li = lane & 15, lg = lane >> 4;
    const int id = I.vcu, b = id >> 6, h = (id >> 1) & 31, ph = id & 1, grp = h >> 2;
    const float Dsum = KIN(ka, 12)[l * 64 + h] + KIN(ka, 12)[l * 64 + 32 + h];
    const float A_f = -__expf(KIN(ka, 11)[l * 64 + h]), A_b = -__expf(KIN(ka, 11)[l * 64 + 32 + h]);
    const size_t xcol = (size_t)h * 64 + ph * 32;
    const int srow = tid >> 2, sc4 = tid & 3;
    auto row_of = [&](int idx) -> int { const int c = idx < 2 ? (sweep ? 1 - idx : idx) : (sweep ? 31 - (idx - 2) : idx - 2); return idx < 2 ? MLAT + b * CTXL + 128 * c : b * SEQ + 128 * c; };

    v4u pb[4], px; float pdf = 0.f, pdb = 0.f; v4u pcn[4]; v2u pxo[2];
#define SSD3_LOAD_S(idx_) do { const int r0_ = row_of(idx_); \
        _Pragma("unroll") for (int q = 0; q < 4; ++q) { const int ch = tid + 512 * q; pb[q] = *(const v4u*)(XBC + (size_t)(r0_ + (ch >> 4)) * XBCW + 2048 + grp * 128 + (ch & 15) * 8); } \
        px = *(const v4u*)(XBC + (size_t)(r0_ + srow) * XBCW + xcol + sc4 * 8); pdf = DT[(size_t)h * MTOT + r0_ + srow]; pdb = DT[(size_t)(32 + h) * MTOT + r0_ + srow]; } while (0)
#define SSD3_LOAD_C(idx_) do { const int r0_ = row_of(idx_); \
        _Pragma("unroll") for (int q = 0; q < 4; ++q) pcn[q] = *(const v4u*)(XBC + (size_t)(r0_ + 16 * w + li) * XBCW + 3072 + grp * 128 + (4 * q + lg) * 8); \
        if (sweep == 0) { _Pragma("unroll") for (int pt = 0; pt < 2; ++pt) pxo[pt] = *(const v2u*)(XBC + (size_t)(r0_ + 16 * w + li) * XBCW + xcol + 16 * pt + 4 * lg); } } while (0)
#define SSD3_STAGE(gen) do { \
        LAS float* T_ = (LAS float*)(lds + L_TAB) + (gen) * T_FLOATS; \
        float tf_, tb_; const float af_ = scan16x4(pdf * A_f, lane, tf_); const float bv_ = pdb * A_b; const float sb_ = scan16x4(bv_, lane, tb_); \
        const float rb_ = tb_ - sb_ + bv_, ejf_ = __expf(tf_ - af_), ejb_ = __expf(tb_ - rb_); \
        if (sc4 == 0) { T_[T_AFL + srow] = af_; T_[T_RBL + srow] = rb_; T_[T_EJF + srow] = ejf_; T_[T_EJB + srow] = ejb_; } \
        if (lane == 0) { T_[T_TF + w] = tf_; T_[T_TB + w] = tb_; } \
        _Pragma("unroll") for (int q = 0; q < 4; ++q) { const int ch = tid + 512 * q; *(LAS v4u*)(lds + L_BS + (gen) * 34816 + (ch >> 4) * ROW + (ch & 15) * 16) = pb[q]; } \
        const float xv_[8] = {bf_lo(px.x), bf_hi(px.x), bf_lo(px.y), bf_hi(px.y), bf_lo(px.z), bf_hi(px.z), bf_lo(px.w), bf_hi(px.w)}; \
        LAS unsigned short* xd_ = (LAS unsigned short*)(lds + L_XD + (gen) * 8704 + (8 * sc4) * ROW) + srow; \
        if (sweep == 0) { LAS unsigned short* xf_ = (LAS unsigned short*)(lds + L_XF + (gen) * 8704 + (8 * sc4) * ROW) + srow; LAS unsigned short* xb_ = (LAS unsigned short*)(lds + L_XB + (gen) * 8704 + (8 * sc4) * ROW) + srow; \
            const float e_ = pdf * ejf_; \
            _Pragma("unroll") for (int q = 0; q < 8; ++q) { xf_[q * (ROW / 2)] = bf1(xv_[q] * pdf); xb_[q * (ROW / 2)] = bf1(xv_[q] * pdb); xd_[q * (ROW / 2)] = bf1(xv_[q] * e_); } } \
        else { const float e_ = pdb * ejb_; _Pragma("unroll") for (int q = 0; q < 8; ++q) xd_[q * (ROW / 2)] = bf1(xv_[q] * e_); } } while (0)

    __syncthreads();
    for (int i = tid; i < 17408 / 4; i += NWAVES * 64) ((LAS unsigned*)(lds + L_SS))[i] = 0u;
    f32x4 sacc[2] = {{0.f, 0.f, 0.f, 0.f}, {0.f, 0.f, 0.f, 0.f}};
    SSD3_LOAD_S(0); SSD3_STAGE(0);
    SSD3_LOAD_S(1); SSD3_LOAD_C(0);
    for (int idx = 0; idx < 34; ++idx) {
        const int r0 = row_of(idx), par = idx & 1;
        const bool need_y = !(l == 1 && idx < 2);
        __syncthreads();
        if (idx + 1 < 34) SSD3_STAGE(par ^ 1);
        bf16x8 cf[4]; v2u xo[2] = {{0u, 0u}, {0u, 0u}};
#pragma unroll
        for (int ks = 0; ks < 4; ++ks) cf[ks] = __builtin_bit_cast(bf16x8, pcn[ks]);
        if (sweep == 0) { xo[0] = pxo[0]; xo[1] = pxo[1]; }
        if (idx + 2 < 34) SSD3_LOAD_S(idx + 2);
        if (idx + 1 < 34) SSD3_LOAD_C(idx + 1);
        const LAS unsigned char* BSc = lds + L_BS + par * 34816; const LAS unsigned char* XFc = lds + L_XF + par * 8704; const LAS unsigned char* XBc = lds + L_XB + par * 8704; const LAS unsigned char* XDc = lds + L_XD + par * 8704;
        const LAS unsigned char* SScur = lds + L_SS + par * 8704; LAS unsigned char* SSnxt = lds + L_SS + (par ^ 1) * 8704;
        const LAS float* T = (const LAS float*)(lds + L_TAB) + par * T_FLOATS;
        v2u yold[2] = {{0u, 0u}, {0u, 0u}};
        if (sweep == 1 && need_y) { _Pragma("unroll") for (int pt = 0; pt < 2; ++pt) yold[pt] = *(const v2u*)(Y + (size_t)(r0 + 16 * w + li) * DI + xcol + 16 * pt + 4 * lg); }
        float PF[9], SB[9], TFv[8], TBv[8];
#pragma unroll
        for (int t = 0; t < 8; ++t) { TFv[t] = T[T_TF + t]; TBv[t] = T[T_TB + t]; }
        PF[0] = 0.f; SB[8] = 0.f;
#pragma unroll
        for (int t = 0; t < 8; ++t) { PF[t + 1] = PF[t] + TFv[t]; SB[7 - t] = SB[8 - t] + TBv[7 - t]; }
        float PFw = 0.f, SBw1 = 0.f;
#pragma unroll
        for (int t = 0; t < 8; ++t) { PFw = (t == w) ? PF[t] : PFw; SBw1 = (t == w) ? SB[t + 1] : SBw1; }
        const float afl_i = T[T_AFL + 16 * w + li], rbl_i = T[T_RBL + 16 * w + li];
        const float af_i = PFw + afl_i, rb_i = SBw1 + rbl_i;
        if (need_y) {
        f32x4 yacc[2] = {{0.f, 0.f, 0.f, 0.f}, {0.f, 0.f, 0.f, 0.f}}, yi[2] = {{0.f, 0.f, 0.f, 0.f}, {0.f, 0.f, 0.f, 0.f}};
        {
            bf16x8 sf[8];
#pragma unroll
            for (int ks = 0; ks < 4; ++ks)
#pragma unroll
                for (int pt = 0; pt < 2; ++pt) sf[2 * ks + pt] = *(const LAS bf16x8*)(SScur + (16 * pt + li) * ROW + (32 * ks + 8 * lg) * 2);
            __builtin_amdgcn_sched_barrier(0);
#pragma unroll
            for (int ks = 0; ks < 4; ++ks)
#pragma unroll
                for (int pt = 0; pt < 2; ++pt) yi[pt] = SSD3_MFMA32(sf[2 * ks + pt], cf[ks], yi[pt]);
        }
        const float escale = __expf(sweep == 0 ? af_i : rb_i);
        if (sweep == 0) {
            f32x4 g[8];
            {
                bf16x8 fa[8], fb[8];
#define SSD3_GLOAD(dst, jp) do { _Pragma("unroll") for (int q_ = 0; q_ < 8; ++q_) dst[q_] = *(const LAS bf16x8*)(BSc + (16 * (2 * (jp) + (q_ >> 2)) + li) * ROW + (32 * (q_ & 3) + 8 * lg) * 2); } while (0)
#define SSD3_GMMA(src, jp) do { g[2 * (jp)] = (f32x4){0.f, 0.f, 0.f, 0.f}; g[2 * (jp) + 1] = (f32x4){0.f, 0.f, 0.f, 0.f}; \
                    _Pragma("unroll") for (int q_ = 0; q_ < 8; ++q_) g[2 * (jp) + (q_ >> 2)] = SSD3_MFMA32(src[q_], cf[q_ & 3], g[2 * (jp) + (q_ >> 2)]); } while (0)
                SSD3_GLOAD(fa, 0); __builtin_amdgcn_sched_barrier(0);
                SSD3_GLOAD(fb, 1); __builtin_amdgcn_sched_barrier(0); SSD3_GMMA(fa, 0); __builtin_amdgcn_sched_barrier(0);
                SSD3_GLOAD(fa, 2); __builtin_amdgcn_sched_barrier(0); SSD3_GMMA(fb, 1); __builtin_amdgcn_sched_barrier(0);
                SSD3_GLOAD(fb, 3); __builtin_amdgcn_sched_barrier(0); SSD3_GMMA(fa, 2); __builtin_amdgcn_sched_barrier(0);
                SSD3_GMMA(fb, 3); __builtin_amdgcn_sched_barrier(0);
#undef SSD3_GLOAD
#undef SSD3_GMMA
            }
#define SSD3_TILE_F(t, mo) do { if ((t) < w) { const float ei = __expf(af_i - PF[(t) + 1]); const f32x4 ejv = *(const LAS f32x4*)(T + T_EJF + 16 * (t) + 4 * lg); \
                    _Pragma("unroll") for (int r = 0; r < 4; ++r) m[(mo) + r] = g[t][r] * (ei * ejv[r]); } \
                else if ((t) == w) { const f32x4 av = *(const LAS f32x4*)(T + T_AFL + 16 * (t) + 4 * lg); \
                    _Pragma("unroll") for (int r = 0; r < 4; ++r) m[(mo) + r] = (4 * lg + r <= li) ? g[t][r] * __expf(fminf(afl_i - av[r], 0.f)) : 0.f; } \
                else { _Pragma("unroll") for (int r = 0; r < 4; ++r) m[(mo) + r] = 0.f; } } while (0)
#define SSD3_TILE_B(t, mo) do { if ((t) > w) { const float ei = __expf(rb_i - SB[t]); const f32x4 ejv = *(const LAS f32x4*)(T + T_EJB + 16 * (t) + 4 * lg); \
                    _Pragma("unroll") for (int r = 0; r < 4; ++r) m[(mo) + r] = g[t][r] * (ei * ejv[r]); } \
                else if ((t) == w) { const f32x4 av = *(const LAS f32x4*)(T + T_RBL + 16 * (t) + 4 * lg); \
                    _Pragma("unroll") for (int r = 0; r < 4; ++r) m[(mo) + r] = (4 * lg + r >= li) ? g[t][r] * __expf(fminf(rbl_i - av[r], 0.f)) : 0.f; } \
                else { _Pragma("unroll") for (int r = 0; r < 4; ++r) m[(mo) + r] = 0.f; } } while (0)
#pragma unroll
            for (int kk = 0; kk < 4; ++kk) {
                const int t0 = 2 * kk, t1 = 2 * kk + 1;
                if (t0 <= w) {
                    float m[8]; SSD3_TILE_F(t0, 0); SSD3_TILE_F(t1, 4);
                    const bf16x8 bfr = pack8f(m);
#pragma unroll
                    for (int pt = 0; pt < 2; ++pt) { const LAS unsigned char* rp = XFc + (16 * pt + li) * ROW; const bf16x8 a = ld2x8(rp + (32 * kk + 4 * lg) * 2, rp + (32 * kk + 16 + 4 * lg) * 2); yacc[pt] = SSD3_MFMA32(a, bfr, yacc[pt]); }
                }
                if (t1 >= w) {
                    float m[8]; SSD3_TILE_B(t0, 0); SSD3_TILE_B(t1, 4);
                    const bf16x8 bfr = pack8f(m);
#pragma unroll
                    for (int pt = 0; pt < 2; ++pt) { const LAS unsigned char* rp = XBc + (16 * pt + li) * ROW; const bf16x8 a = ld2x8(rp + (32 * kk + 4 * lg) * 2, rp + (32 * kk + 16 + 4 * lg) * 2); yacc[pt] = SSD3_MFMA32(a, bfr, yacc[pt]); }
                }
            }
#undef SSD3_TILE_F
#undef SSD3_TILE_B
        }
#pragma unroll
        for (int pt = 0; pt < 2; ++pt) {
            bf16* yp = Y + (size_t)(r0 + 16 * w + li) * DI + xcol + 16 * pt + 4 * lg;
            float o[4];
            if (sweep == 0) { const v2u xv = xo[pt];
                o[0] = yacc[pt][0] + escale * yi[pt][0] + Dsum * bf_lo(xv.x); o[1] = yacc[pt][1] + escale * yi[pt][1] + Dsum * bf_hi(xv.x);
                o[2] = yacc[pt][2] + escale * yi[pt][2] + Dsum * bf_lo(xv.y); o[3] = yacc[pt][3] + escale * yi[pt][3] + Dsum * bf_hi(xv.y); }
            else { const v2u yv = yold[pt];
                o[0] = bf_lo(yv.x) + escale * yi[pt][0]; o[1] = bf_hi(yv.x) + escale * yi[pt][1]; o[2] = bf_lo(yv.y) + escale * yi[pt][2]; o[3] = bf_hi(yv.y) + escale * yi[pt][3]; }
            v2u ov; ov.x = pk2(o[0], o[1]); ov.y = pk2(o[2], o[3]); *(v2u*)yp = ov;
        }
        }
        {
            const int q = li >> 2, pq = li & 3;
            s16x4 ta[8]; s16x4 xd[8][2];
#pragma unroll
            for (int t = 0; t < 8; ++t) { ta[t] = __builtin_amdgcn_ds_read_tr16_b64_v4i16((LAS s16x4*)(BSc + (16 * t + 4 * lg + q) * ROW + (16 * w + 4 * pq) * 2));
#pragma unroll
                for (int pt = 0; pt < 2; ++pt) xd[t][pt] = *(const LAS s16x4*)(XDc + (16 * pt + li) * ROW + (16 * t + 4 * lg) * 2); }
            __builtin_amdgcn_sched_barrier(0);
#pragma unroll
            for (int tt = 0; tt < 8; ++tt) { const int t = sweep == 0 ? tt : 7 - tt; const float dec = __expf(sweep == 0 ? TFv[t] : TBv[t]);
#pragma unroll
                for (int pt = 0; pt < 2; ++pt) { sacc[pt] = sacc[pt] * dec; sacc[pt] = SSD3_MFMA16(ta[t], xd[t][pt], sacc[pt]); } }
#pragma unroll
            for (int pt = 0; pt < 2; ++pt) { v2u sv; sv.x = pk2(sacc[pt][0], sacc[pt][1]); sv.y = pk2(sacc[pt][2], sacc[pt][3]); *(LAS v2u*)(SSnxt + (16 * pt + li) * ROW + (16 * w + 4 * lg) * 2) = sv; }
        }
    }
#undef SSD3_LOAD_S
#undef SSD3_LOAD_C
#undef SSD3_STAGE
    VM_WAIT(); __syncthreads();
}
__device__ __forceinline__ void phase_ssd3(const Ids I, LAS unsigned char* lds, int l) { ssd3_sweep<0>(I, lds, l); ssd3_sweep<1>(I, lds, l); }

__device__ __forceinline__ void phase_pool(const Ids I_, LAS unsigned char* lds_base, int l) {
    LAS unsigned char* lds_misc = lds_base + MISC_OFF;
    const Ids I = fresh(I_);
    const KA ka = ka_fresh(); unsigned char* ws = KWS(ka);
    const bf16* UPOOL = (const bf16*)(ws + WS_XBC + XO_UPOOL);
    bf16* PML = (bf16*)(ws + WS_XBC + XO_UPOOL); bf16* PMC = (bf16*)(ws + WS_DT);
    const int nitems = (l == 0) ? 1024 + 64 : 1024;
    pg8::pg8_gu32* work = (pg8::pg8_gu32*)(ws + WS_CTL) + CW_WORK + 64 * l; pg8::pg8_gu32* cp_ = cnt_arr(ws, l, 0); pg8::pg8_gu32* tmo = (pg8::pg8_gu32*)(ws + WS_CTL) + CW_BAR + XB_TMO;
#define POOL_GEOM(item_) int seqb, L, w0, gi; \
        if ((item_) < 1024) { seqb = ((item_) >> 2) * 64; L = 64; w0 = 0; gi = (item_) & 3; } \
        else { const int ci = (item_) - 1024; gi = ci & 3; w0 = 64 * ((ci >> 2) & 3); seqb = MLAT + 256 * (ci >> 4); L = 256; } \
        const int cp = I.tid & 127, rs = I.tid >> 7, t0 = w0 + 16 * rs, col = gi * 256 + 2 * cp;
#define POOL_OUT(HK) do { _Pragma("unroll") for (int i = 0; i < 16; ++i) { const int t = t0 + i; const float slo = plo[i + 8 + HK] - plo[i + 8 - HK], shi = phi[i + 8 + HK] - phi[i + 8 - HK]; \
            const int lo = t - HK < 0 ? 0 : t - HK, hi = t + HK > L ? L : t + HK; const float inv = __builtin_amdgcn_rcpf((float)(hi - lo)); \
            *(unsigned*)(pout + (size_t)t * 1024 + col) = pk2(slo * inv - bf_lo(r_[i + 8]), shi * inv - bf_hi(r_[i + 8])); } } while (0)
#define POOL_CLAIM_WAIT(claim_) do { const int it_ = 2 * (int)(claim_); \
        if (it_ < nitems) { const int pmi_ = it_ < 1024 ? (it_ >> 4) : 64 + ((it_ - 1024) >> 4); unsigned sp_ = 0; \
            while (__hip_atomic_load(cp_ + 64 * pmi_, __ATOMIC_RELAXED, __HIP_MEMORY_SCOPE_AGENT) < 32u) { __builtin_amdgcn_s_sleep(2); \
                if ((++sp_ & 255u) == 0u) { if (__hip_atomic_load(tmo, __ATOMIC_RELAXED, __HIP_MEMORY_SCOPE_AGENT) != 0u) break; if (sp_ > (1u << 20)) { __hip_atomic_fetch_add(tmo, 1u, __ATOMIC_RELAXED, __HIP_MEMORY_SCOPE_AGENT); break; } } } \
            __builtin_amdgcn_fence(__ATOMIC_ACQUIRE, "agent"); asm volatile("s_waitcnt vmcnt(0)" ::: "memory"); } } while (0)
#define POOL_LOAD(r_, item_) do { POOL_GEOM(item_) \
        _Pragma("unroll") for (int i = 0; i < 32; ++i) { const int t = t0 - 8 + i; unsigned v = 0u; if (t >= 0 && t < L) v = *(const unsigned*)(UPOOL + (size_t)(seqb + t) * 1024 + col); r_[i] = v; } } while (0)
#define POOL_COMP(rr_, item_) do { POOL_GEOM(item_) const unsigned (&r_)[32] = rr_; bf16* pout = (item_) < 1024 ? PML + (size_t)seqb * 1024 : PMC + (size_t)(seqb - MLAT) * 1024; \
        float plo[33], phi[33]; plo[0] = 0.f; phi[0] = 0.f; \
        _Pragma("unroll") for (int i = 0; i < 32; ++i) { plo[i + 1] = plo[i] + bf_lo(r_[i]); phi[i + 1] = phi[i] + bf_hi(r_[i]); } \
        if (gi == 0) POOL_OUT(1); else if (gi == 1) POOL_OUT(2); else if (gi == 2) POOL_OUT(4); else POOL_OUT(8); } while (0)
    volatile LAS unsigned* slot = (volatile LAS unsigned*)(lds_misc) + 40;
    if (I.tid == 0) { const unsigned c0 = __hip_atomic_fetch_add(work, 1u, __ATOMIC_RELAXED, __HIP_MEMORY_SCOPE_AGENT); POOL_CLAIM_WAIT(c0); slot[0] = c0; }
    __syncthreads();
    int item = 2 * (int)slot[0], par = 0;
    while (item < nitems) {
        unsigned nclaim = 0u;
        unsigned ra[32], rb[32];
        POOL_LOAD(ra, item); POOL_LOAD(rb, item + 1);
        asm volatile("s_waitcnt vmcnt(0)" ::: "memory"); __syncthreads();
        if (I.tid == 0) nclaim = __hip_atomic_fetch_add(work, 1u, __ATOMIC_RELAXED, __HIP_MEMORY_SCOPE_AGENT);
        POOL_COMP(ra, item); POOL_COMP(rb, item + 1);
        if (I.tid == 0) { POOL_CLAIM_WAIT(nclaim); slot[par ^ 1] = nclaim; }
        __syncthreads();
        par ^= 1; item = 2 * (int)slot[par];
    }
#undef POOL_COMP
#undef POOL_LOAD
#undef POOL_CLAIM_WAIT
#undef POOL_OUT
#undef POOL_GEOM
}

__device__ __forceinline__ void phase_final(const Ids I_) {
    const Ids I = fresh(I_);
    const KA ka = ka_fresh(); float* OUT = KOUT(ka); const float* g = KIN(ka, 22);
    const bool dead = xb_ld((gu32*)(KWS(ka) + WS_CTL) + CW_BAR + XB_TMO) != 0u;
    v2u ta[4], tb[4];
#define FIN_LOAD(t_, mm) do { const v2u* q_ = (const v2u*)((const bf16*)OUT + (size_t)(mm) * 2048) + I.lane; _Pragma("unroll") for (int j = 0; j < 4; ++j) t_[j] = q_[64 * j]; } while (0)
#define FIN_ROW(t_, mm) do { f32x4 v[4]; float s = 0.f; \
        _Pragma("unroll") for (int j = 0; j < 4; ++j) { const v2u t = t_[j]; v[j] = (f32x4){bf_lo(t.x), bf_hi(t.x), bf_lo(t.y), bf_hi(t.y)}; s += (v[j].x * v[j].x + v[j].y * v[j].y) + (v[j].z * v[j].z + v[j].w * v[j].w); } \
        if ((mm) + 2 * I.NGW < MLAT) FIN_LOAD(t_, (mm) + 2 * I.NGW); \
        const float rstd = rsqrtf(wave_sum(s) * (1.f / D) + 1e-6f); \
        f32x4* xr = (f32x4*)(OUT + (size_t)(mm) * D) + I.lane; \
        _Pragma("unroll") for (int j = 0; j < 4; ++j) { f32x4 o = v[j] * rstd * ((const f32x4*)g)[I.lane + 64 * j]; if (dead) { const float qn = __builtin_nanf(""); o = (f32x4){qn, qn, qn, qn}; } xr[64 * j] = o; } } while (0)
    int m = I.gw;
    if (m < MLAT) FIN_LOAD(ta, m);
    if (m + I.NGW < MLAT) FIN_LOAD(tb, m + I.NGW);
    for (; m < MLAT; m += 2 * I.NGW) {
        FIN_ROW(ta, m);
        const int m1 = m + I.NGW; if (m1 >= MLAT) break;
        FIN_ROW(tb, m1);
    }
#undef FIN_ROW
#undef FIN_LOAD
}

#ifndef DBG_STOP
#define DBG_STOP 0
#endif
__device__ __forceinline__ void phase_dump(const Ids I_, size_t ws_off, int cols, bool ctx_rows, bool isf32, bool accum = false) {
    const Ids I = fresh(I_);
    const KA ka = ka_fresh(); float* OUT = KOUT(ka); unsigned char* base = KWS(ka) + ws_off;
    for (int m = I.gw; m < MLAT; m += I.NGW) {
        for (int c = I.lane; c < 1024; c += 64) { float s = 0.f;
            for (int j = 0; j < cols / 1024; ++j) {
                if (isf32) { s += ((const float*)base)[(size_t)m * cols + c + 1024 * j]; }
                else {
#ifdef DBG_ATOMIC_DUMP
                    { const size_t e = (size_t)m * cols + c + 1024 * j; const unsigned w = __hip_atomic_fetch_or((unsigned*)base + (e >> 1), 0u, __ATOMIC_RELAXED, __HIP_MEMORY_SCOPE_AGENT); s += (e & 1) ? bf_hi(w) : bf_lo(w); }
                    if (ctx_rows) { const size_t e = (size_t)(MLAT + (m & 1023)) * cols + c + 1024 * j; const unsigned w = __hip_atomic_fetch_or((unsigned*)base + (e >> 1), 0u, __ATOMIC_RELAXED, __HIP_MEMORY_SCOPE_AGENT); s += (e & 1) ? bf_hi(w) : bf_lo(w); }
#else
                    s += bf_lo(((const bf16*)base)[(size_t)m * cols + c + 1024 * j]); if (ctx_rows) s += bf_lo(((const bf16*)base)[(size_t)(MLAT + (m & 1023)) * cols + c + 1024 * j]);
#endif
                } }
            if (accum) s += OUT[(size_t)m * D + c]; OUT[(size_t)m * D + c] = s; } }
}

__global__ void __launch_bounds__(NWAVES * 64, 2) fwd_kernel(Args args) {
    LAS unsigned char* lds = (LAS unsigned char*)pg8::lds_dyn;
    volatile LAS unsigned* MISC = (volatile LAS unsigned*)(lds + MISC_OFF);
    LAS unsigned char* xl = lds + XL_OFF;
    if ((threadIdx.x & 63u) == 0u) ((volatile LAS unsigned*)(lds + pg8::WAVE_TAB_OFF))[pg8::hw_slot()] = threadIdx.x >> 6;
    __syncthreads();
    Ids I; I.wave = pg8::wave_now(); I.tid = I.wave * 64 + pg8::lane_now(); I.lane = I.tid & 63;
    I.G = gridDim.x; I.bx = blockIdx.x; I.vcu = (I.G % 8 == 0) ? (I.bx % 8) * (I.G / 8) + I.bx / 8 : I.bx;
    I.gw = I.vcu * NWAVES + I.wave; I.NGW = I.G * NWAVES;
    const int G = I.G, bx = I.bx;

    for (int u = I.tid; u < 64; u += NWAVES * 64) MISC[u] = 0u;
    __syncthreads();
    XcdBarrier bar = xcd_barrier_post((gu32*)(KWS(ka_fresh()) + WS_CTL) + CW_BAR, MISC + 8);
#ifdef TSEL
    unsigned long long t_prev = __builtin_amdgcn_s_memrealtime(), t_acc = 0ull; int t_stage = 0;
#define GRID_BAR() do { xcd_barrier(bar); { const unsigned long long t_now = __builtin_amdgcn_s_memrealtime(); if ((TSEL >> t_stage) & 1ull) t_acc += t_now - t_prev; t_prev = t_now; ++t_stage; } } while (0)
#else
#define GRID_BAR() xcd_barrier(bar)
#endif

    phase_mod(I, lds);
    conv_mixer(I, lds, 0);
    GRID_BAR();

    for (int l = 0; l < 2; ++l) {
        const int Mfull = (l == 0) ? MTOT : MLAT;
        phase_norm(I, l, 0, MTOT, l == 0);
        GRID_BAR();
        if (DBG_STOP != 11) {
            const KA ka = ka_fresh(); unsigned char* ws = KWS(ka);
            pg8::Gemm g{(const bf16*)(ws + WS_H), (const bf16*)(ws + WS_WIN), 1024, 1024, MTOT, NB1, 1024, 0};
            pg8::PanelOrder S; S.init(MTOT, NB1, G, bx); S.set_base(ws + WS_CTL); S.wait0 = -1; S.need0 = 0u; S.wait1 = -1; S.need1 = 0u; S.done_cnt = cnt_off(l, 3); S.tmo = CW_BAR + XB_TMO;
            pg8::EpiXbcDt E{(bf16*)(ws + WS_XBC), (bf16*)(ws + WS_Y), (float*)(ws + WS_DT), KIN(ka, 10) + l * 64};
            pg8::gemm_phase<pg8::EpiXbcDt, pg8::PanelOrder>(lds, xl, g, S, E);
        }
        phase_conv(I, lds, l);
        GRID_BAR();
        if (DBG_STOP == 2) { phase_dump(I, WS_XBC, 4096, true, false); return; }
#ifdef SSD_NAIVE
        phase_ssd(I, lds, l);
#elif defined(SSD_V2)
        phase_ssd_dir(I, lds, l);
#else
        phase_ssd3(I, lds, l);
#ifdef REP_SSD
        phase_ssd_mfma(I, lds, l);
#endif
#endif
        GRID_BAR();
        if (DBG_STOP == 1) { phase_dump(I, WS_Y, 2048, true, false); return; }
        if (DBG_STOP == 9) { phase_dump(I, WS_H, 1024, true, false); phase_dump(I, WS_WIN, 1024, false, false, true); return; }
        {
            const KA ka = ka_fresh(); unsigned char* ws = KWS(ka);
            pg8::Gemm g{(const bf16*)(ws + WS_H), (const bf16*)(ws + WS_WIN) + (size_t)NB1 * 1024, 1024, 1024, Mfull, NB2, 1024, 0};
            pg8::PoolChainOrder S; S.init(Mfull, NB2, G, bx); S.set_base(ws + WS_CTL); S.wait0 = -1; S.need0 = 0u; S.wait1 = -1; S.need1 = 0u; S.done_cnt = cnt_off(l, 0); S.tmo = CW_BAR + XB_TMO;
            pg8::EpiZPG E{(bf16*)(ws + WS_Y), (bf16*)(ws + WS_XBC + XO_UPOOL), (bf16*)(ws + WS_XBC + XO_GATES)};
            pg8::gemm_phase<pg8::EpiZPG, pg8::PoolChainOrder>(lds, xl, g, S, E);
        }
        phase_pool(I, lds, l);
        GRID_BAR();
        if (DBG_STOP == 5) { phase_dump(I, WS_Y, 2048, true, false); phase_dump(I, WS_XBC + XO_GATES, 2048, true, false, true); phase_dump(I, WS_XBC + XO_UPOOL, 1024, true, false, true); return; }
        if (DBG_STOP == 8) { { const unsigned long long t0 = __builtin_amdgcn_s_memrealtime(); while (__builtin_amdgcn_s_memrealtime() - t0 < 50000ull) __builtin_amdgcn_s_sleep(32); } GRID_BAR(); phase_dump(I, WS_XBC + XO_GATES, 2048, true, false); phase_dump(I, WS_XBC + XO_UPOOL, 1024, true, false, true); return; }
        {
            const KA ka = ka_fresh(); unsigned char* ws = KWS(ka);
            pg8::Gemm g{(const bf16*)(ws + WS_Y), (const bf16*)(ws + WS_WSSD), 2048, 2048, Mfull, 1024, 2048, 0};
            pg8::ChainOrder S; S.init(Mfull, 1024, G, bx); S.set_base(ws + WS_CTL); S.wait0 = -1; S.need0 = 0u; S.wait1 = -1; S.need1 = 0u; S.done_cnt = cnt_off(l, 1); S.tmo = CW_BAR + XB_TMO;
            pg8::EpiGate<0> E{(bf16*)(ws + WS_XBC + XO_M1), (const bf16*)(ws + WS_XBC + XO_GATES)};
            pg8::gemm_phase<pg8::EpiGate<0>, pg8::ChainOrder>(lds, xl, g, S, E);
        }
        {
            const KA ka = ka_fresh(); unsigned char* ws = KWS(ka);
            pg8::Gemm g{(const bf16*)(ws + WS_XBC + XO_UPOOL), (const bf16*)(ws + WS_WPC), 1024, 1024, Mfull, 1024, 1024, 0};
            pg8::FOrder S; S.ctx_delta = (size_t)((long long)WS_DT - (long long)(WS_XBC + XO_UPOOL) - 64ll * 256 * 1024 * 2); S.init(Mfull, 1024, G, (bx + 16) % G); S.set_base(ws + WS_CTL); S.wait0 = cnt_off(l, 1); S.need0 = 32u; S.wait1 = -1; S.need1 = 0u; S.done_cnt = cnt_off(l, 2); S.tmo = CW_BAR + XB_TMO;
            pg8::EpiGate<1> E{(bf16*)(ws + WS_XBC + XO_M1), (const bf16*)(ws + WS_XBC + XO_GATES)};
            pg8::gemm_phase<pg8::EpiGate<1>, pg8::FOrder>(lds, xl, g, S, E);
        }
        {
            const KA ka = ka_fresh(); unsigned char* ws = KWS(ka);
            pg8::Gemm g{(const bf16*)(ws + WS_XBC + XO_M1), (const bf16*)(ws + WS_WOUT), 1024, 1024, Mfull, 1024, 1024, 0};
            pg8::RelChainOrder S; S.init(Mfull, 1024, G, (bx + 32) % G); S.set_base(ws + WS_CTL); S.wait0 = cnt_off(l, 2); S.need0 = 32u; S.wait1 = -1; S.need1 = 0u; S.done_cnt = cnt_off(l, 4); S.lds_word = (unsigned)(size_t)(lds + MISC_OFF + 46 * 4); S.tmo = CW_BAR + XB_TMO;
            if (l == 0) { pg8::EpiRes<false> E{KIN(ka, 0), (bf16*)KOUT(ka), KIN(ka, 2), (float*)(ws + WS_CX), (const float*)(ws + WS_MOD) + 2048};
                pg8::gemm_phase<pg8::EpiRes<false>, pg8::RelChainOrder>(lds, xl, g, S, E); }
            else { pg8::EpiRes<true> E{nullptr, (bf16*)KOUT(ka), (const float*)(ws + WS_CX), (float*)(ws + WS_CX), (const float*)(ws + WS_MOD) + (size_t)5 * 6144 + 2048};
                pg8::gemm_phase<pg8::EpiRes<true>, pg8::RelChainOrder>(lds, xl, g, S, E); }
        }
        if (l == 0) conv_win_dyn(I, lds, 1);
        phase_norm2_dyn(I, lds, l, Mfull);
        conv_ffn(I, lds, l);
        if (l == 0) conv_mixer(I, lds, 1, true);
        GRID_BAR();
        {
            const KA ka = ka_fresh(); unsigned char* ws = KWS(ka);
            pg8::Gemm g{(const bf16*)(ws + WS_H), (const bf16*)(ws + WS_XBC + XO_WGU), 1024, 1024, Mfull, 2 * FFH, 1024, 0}; pg8::StaticOrder S; S.init(Mfull, 2 * FFH, G, bx);
            pg8::EpiSwiglu E{(bf16*)(ws + WS_XBC + XO_ACT)};
            pg8::gemm_phase<pg8::EpiSwiglu, pg8::StaticOrder>(lds, xl, g, S, E);
        }
        GRID_BAR();
        if (DBG_STOP == 4) { phase_dump(I, WS_XBC + XO_ACT, 2048, false, false); return; }
        {
            const KA ka = ka_fresh(); unsigned char* ws = KWS(ka);
            pg8::Gemm g{(const bf16*)(ws + WS_XBC + XO_ACT), (const bf16*)(ws + WS_XBC + XO_WDN), FFH, FFH, MLAT, 1024, FFH, 0}; pg8::StaticOrder S; S.init(MLAT, 1024, G, bx);
            pg8::EpiRes<true> E{nullptr, (bf16*)KOUT(ka), (const float*)(ws + WS_CX), (float*)(ws + WS_CX), (const float*)(ws + WS_MOD) + (size_t)l * 5 * 6144 + 5120};
            pg8::gemm_phase<pg8::EpiRes<true>, pg8::StaticOrder>(lds, xl, g, S, E);
        }
        if (l == 0) {
            const KA ka = ka_fresh(); unsigned char* ws = KWS(ka);
            pg8::Gemm g{(const bf16*)(ws + WS_XBC + XO_ACT), (const bf16*)(ws + WS_XBC + XO_WDN), FFH, FFH, MTOT, 1024, 256, 0}; pg8::SplitKOrder S; S.G = G; S.c = bx;
            pg8::EpiPart E{(float*)(ws + WS_Y)};
            pg8::gemm_phase<pg8::EpiPart, pg8::SplitKOrder>(lds, xl, g, S, E);
        }
        GRID_BAR();
    }
#ifdef TSEL
    {
        gu32* tw = (gu32*)(KWS(ka_fresh()) + WS_CTL) + 8192;
        if (I.bx == 0 && I.tid == 0) __hip_atomic_store(tw, (unsigned)t_acc, __ATOMIC_RELAXED, __HIP_MEMORY_SCOPE_AGENT);
        xcd_barrier(bar);
        const unsigned long long dur = (unsigned long long)__hip_atomic_load(tw, __ATOMIC_RELAXED, __HIP_MEMORY_SCOPE_AGENT) * TMUL;
        const unsigned long long t0 = __builtin_amdgcn_s_memrealtime(); while (__builtin_amdgcn_s_memrealtime() - t0 < dur) __builtin_amdgcn_s_sleep(16);
    }
#endif
    phase_final(I);
}

extern "C" void kernel_launch(void* const* d_in, const int* in_sizes, int n_in, void* d_out, int out_size, void* d_ws, size_t ws_size, hipStream_t stream) {
    static int grid = 0;
    if (grid == 0) {
        if (n_in != 23 || in_sizes[0] != MLAT * D || out_size != MLAT * D || ws_size < WS_END) { fprintf(stderr, "kernel_launch: unexpected shapes / workspace (n_in %d, ws %zu, need %zu); nothing launched\n", n_in, ws_size, (size_t)WS_END); grid = -1; return; }
        int dev = 0, cus = 0, per_cu = 0;
        if (hipGetDevice(&dev) != hipSuccess || hipDeviceGetAttribute(&cus, hipDeviceAttributeMultiprocessorCount, dev) != hipSuccess) { grid = -1; return; }
        if (hipFuncSetAttribute((const void*)fwd_kernel, hipFuncAttributeMaxDynamicSharedMemorySize, LDS_BYTES) != hipSuccess) { fprintf(stderr, "kernel_launch: hipFuncSetAttribute failed\n"); grid = -1; return; }
        if (hipOccupancyMaxActiveBlocksPerMultiprocessor(&per_cu, (const void*)fwd_kernel, NWAVES * 64, LDS_BYTES) != hipSuccess || per_cu < 1) { fprintf(stderr, "kernel_launch: occupancy query says %d blocks per CU; nothing launched\n", per_cu); (void)hipGetLastError(); grid = -1; return; }
        grid = cus;
        if (grid != 256) { fprintf(stderr, "kernel_launch: built for a 256-CU device (got %d)\n", grid); grid = -1; return; }
    }
    if (grid < 0) return;
    if (hipMemsetAsync((char*)d_ws + WS_CTL, 0, CTL_ZERO_BYTES, stream) != hipSuccess) return;
    Args a{};
    for (int i = 0; i < 23; ++i) a.in[i] = (const float*)d_in[i];
    a.out = (float*)d_out; a.ws = (unsigned char*)d_ws;
    hipLaunchKernelGGL(fwd_kernel, dim3(grid), dim3(NWAVES * 64), LDS_BYTES, stream, a);
}
```

```cpp
#include <hip/hip_runtime.h>
#define SSD_V2 1
#define TSEL_OFF 0ull
#define TMUL 4ull
#include <cstdio>
#include <cstdint>

namespace pg8 {
#define PG8_LAS __attribute__((address_space(3)))
typedef unsigned short bf16_t;
typedef short bf16x8 __attribute__((ext_vector_type(8)));
typedef float f32x4 __attribute__((ext_vector_type(4)));
typedef float f32x2 __attribute__((ext_vector_type(2)));
typedef unsigned u32x4 __attribute__((ext_vector_type(4)));
typedef unsigned u32x2 __attribute__((ext_vector_type(2)));
constexpr int BM = 256, BK = 64, HALF = 128, HTB = HALF * BK * 2, STAGE_BYTES = 8 * HTB, NXCD = 8, WGM = 8;

__host__ __device__ __forceinline__ int lds_byte(int r, int c) { const int st = (r >> 4) * 2 + (c >> 5), rr = r & 15, cc = c & 31, ob = rr * 64 + cc * 2; return st * 1024 + (ob ^ (((ob >> 9) & 1) << 5)); }
__host__ __device__ __forceinline__ void stage_rc(int b, int& R, int& C) { const int st = b / 1024, sb = b % 1024, swz = sb ^ (((sb >> 9) & 1) << 5); R = (st >> 1) * 16 + swz / 64; C = (st & 1) * 32 + (swz % 64) / 2; }
__host__ __device__ __forceinline__ int perm32(int rho) { const int n = rho >> 4, i = rho & 15; return 8 * (i >> 2) + 4 * n + (i & 3); }

extern __shared__ __attribute__((aligned(16))) unsigned char lds_dyn[];
constexpr int WAVE_TAB_OFF = 159744 + 1024;
__device__ __forceinline__ int lane_now() { return (int)__builtin_amdgcn_mbcnt_hi(~0u, __builtin_amdgcn_mbcnt_lo(~0u, 0u)); }
__device__ __forceinline__ int hw_slot() { return (int)(__builtin_amdgcn_s_getreg(4 | (0 << 6) | (5 << 11)) & 63u); }
__device__ __forceinline__ int wave_now() { return __builtin_amdgcn_readfirstlane((int)((volatile PG8_LAS unsigned*)(lds_dyn + WAVE_TAB_OFF))[hw_slot()]); }
__device__ __forceinline__ int tid_now() { return wave_now() * 64 + lane_now(); }
struct Unit { int pm, pn; };
struct Gemm { const bf16_t* A; const bf16_t* Bt; int lda, ldb, M, N, K, a_pn_off; };

struct StaticOrder {
    int nM, nN, nwg, G, c;
    __host__ __device__ void init(int M, int N, int G_, int c_) { nM = M / BM; nN = N / BM; nwg = nM * nN; G = G_; c = c_; }
    __host__ __device__ bool next(int i, Unit& u) const {
        const long L = (long)i * G + c; if (L >= nwg) return false;
        int wgid = (int)L; { const int q = nwg / NXCD, r = nwg % NXCD, xcd = wgid % NXCD, off = wgid / NXCD; wgid = (xcd < r ? xcd * (q + 1) : r * (q + 1) + (xcd - r) * q) + off; }
        const int nig = WGM * nN, gid = wgid / nig, fm = gid * WGM, gsz = (nM - fm) < WGM ? (nM - fm) : WGM;
        u.pm = fm + ((wgid % nig) % gsz); u.pn = (wgid % nig) / gsz; return true;
    }
    __device__ __forceinline__ size_t a_off(const Unit& u, const Gemm& g, size_t tsA) const { return (size_t)u.pm * tsA + (size_t)u.pn * g.a_pn_off * 2; }
    __device__ __forceinline__ size_t b_off(const Unit& u, const Gemm&, size_t tsB) const { return (size_t)u.pn * tsB; }
    __device__ __forceinline__ void a_ready(const Unit&) const {}
    __device__ __forceinline__ void done(const Unit&) const {}
};
#define PG8_GAS __attribute__((address_space(1)))
typedef PG8_GAS unsigned pg8_gu32;
struct ChainOrder : StaticOrder {
    unsigned ctl_lo, ctl_hi;
    int wait0, wait1, done_cnt, tmo;
    unsigned need0, need1;
    __device__ __forceinline__ void set_base(const void* ctl) { const unsigned long long a = (unsigned long long)ctl; ctl_lo = (unsigned)__builtin_amdgcn_readfirstlane((int)(unsigned)a); ctl_hi = (unsigned)__builtin_amdgcn_readfirstlane((int)(unsigned)(a >> 32)); }
    __device__ __forceinline__ pg8_gu32* word(int off) const { return (pg8_gu32*)(((unsigned long long)ctl_hi << 32) | (unsigned long long)ctl_lo) + off; }
    __device__ __forceinline__ void a_ready(const Unit& u) const {
        if (wait0 >= 0) {
            if (wave_now() == 0) {
                unsigned sp = 0;
                for (;;) {
                    bool ok = (unsigned)__builtin_amdgcn_readfirstlane(__hip_atomic_load(word(wait0 + 64 * u.pm), __ATOMIC_RELAXED, __HIP_MEMORY_SCOPE_AGENT)) >= need0;
                    if (ok && wait1 >= 0) ok = (unsigned)__builtin_amdgcn_readfirstlane(__hip_atomic_load(word(wait1 + 64 * u.pm), __ATOMIC_RELAXED, __HIP_MEMORY_SCOPE_AGENT)) >= need1;
                    if (ok) break;
                    __builtin_amdgcn_s_sleep(2);
                    if ((++sp & 255u) == 0u) { if (__builtin_amdgcn_readfirstlane(__hip_atomic_load(word(tmo), __ATOMIC_RELAXED, __HIP_MEMORY_SCOPE_AGENT)) != 0u) break;
                        if (sp > (1u << 20)) { if (lane_now() == 0) __hip_atomic_fetch_add(word(tmo), 1u, __ATOMIC_RELAXED, __HIP_MEMORY_SCOPE_AGENT); break; } }
                }
                __builtin_amdgcn_fence(__ATOMIC_ACQUIRE, "agent");
                asm volatile("s_waitcnt vmcnt(0)" ::: "memory");
            }
            asm volatile("" ::: "memory"); __builtin_amdgcn_s_barrier(); asm volatile("" ::: "memory");
        }
    }
    __device__ __forceinline__ void done(const Unit& u) const {
        if (done_cnt >= 0) { asm volatile("s_waitcnt vmcnt(0)" ::: "memory");
            if (lane_now() == 0) __hip_atomic_fetch_add(word(done_cnt + 64 * u.pm), 1u, __ATOMIC_RELAXED, __HIP_MEMORY_SCOPE_AGENT); }
    }
};

struct PanelOrder : ChainOrder {
    __device__ __forceinline__ bool next(int i, Unit& u) const {
        const int x = c & 7, j = c >> 3, k0 = (nwg * x) >> 3, k1 = (nwg * (x + 1)) >> 3, k = k0 + j + (G >> 3) * i;
        if (k >= k1) return false;
        u.pm = k / nN; u.pn = k - u.pm * nN; return true;
    }
};
struct PoolChainOrder : PanelOrder {
    __device__ __forceinline__ void done(const Unit& u) const { if (u.pn >= 8 && u.pn < 12) ChainOrder::done(u); }
};
struct RelChainOrder : ChainOrder {
    unsigned lds_word;
    __device__ __forceinline__ void done(const Unit& u) const {
        asm volatile("s_waitcnt vmcnt(0)" ::: "memory");
        unsigned prev = 0u;
        if (lane_now() == 0) prev = __hip_atomic_fetch_add((PG8_LAS unsigned*)(size_t)lds_word, 1u, __ATOMIC_RELAXED, __HIP_MEMORY_SCOPE_WORKGROUP);
        prev = (unsigned)__builtin_amdgcn_readfirstlane((int)prev);
        if (prev == 7u) {
            if (lane_now() == 0) __hip_atomic_store((PG8_LAS unsigned*)(size_t)lds_word, 0u, __ATOMIC_RELAXED, __HIP_MEMORY_SCOPE_WORKGROUP);
            __builtin_amdgcn_fence(__ATOMIC_RELEASE, "agent"); asm volatile("s_waitcnt vmcnt(0)" ::: "memory");
            if (lane_now() == 0) __hip_atomic_fetch_add(word(done_cnt + 64 * u.pm), 8u, __ATOMIC_RELAXED, __HIP_MEMORY_SCOPE_AGENT);
        }
    }
};
struct FOrder : ChainOrder {
    size_t ctx_delta;
    __device__ __forceinline__ size_t a_off(const Unit& u, const Gemm& g, size_t tsA) const { return (size_t)u.pm * tsA + (u.pm >= 64 ? ctx_delta : (size_t)0); }
};
__device__ __forceinline__ int opaque_v(int x) { asm volatile("" : "+v"(x)); return x; }
__device__ __forceinline__ int opaque_s(int x) { asm volatile("" : "+s"(x)); return x; }
template <int O> __device__ __forceinline__ float lane_xor(float v) { static_assert(O < 32, "within a 32-lane half"); return __int_as_float(__builtin_amdgcn_ds_swizzle(__float_as_int(v), (O << 10) | 0x1f)); }
__device__ __forceinline__ float half_sum(float v) { const auto r = __builtin_amdgcn_permlane32_swap(__float_as_uint(v), __float_as_uint(v), false, false); return __uint_as_float(r[0]) + __uint_as_float(r[1]); }
__device__ __forceinline__ float softplus(float x) { if (x > 20.f) return x; const float e = __expf(x), u = 1.f + e; return u == 1.f ? e : __logf(u) * e * __builtin_amdgcn_rcpf(u - 1.f); }
typedef __bf16 bf16x2_t __attribute__((ext_vector_type(2)));
__device__ __forceinline__ unsigned cvt_pk_bf16(float lo, float hi) { const f32x2 v = {lo, hi}; return __builtin_bit_cast(unsigned, __builtin_convertvector(v, bf16x2_t)); }
__device__ __forceinline__ float bflo(unsigned u) { return __uint_as_float(u << 16); }
__device__ __forceinline__ float bfhi(unsigned u) { return __uint_as_float(u & 0xffff0000u); }
__device__ __forceinline__ float sigm(float v) { return __builtin_amdgcn_rcpf(1.f + __expf(-v)); }
__device__ __forceinline__ float silu(float v) { return v * sigm(v); }
__device__ __forceinline__ u32x4 pack8(const f32x4 a, const f32x4 b) { u32x4 w; w.x = cvt_pk_bf16(a[0], a[1]); w.y = cvt_pk_bf16(a[2], a[3]); w.z = cvt_pk_bf16(b[0], b[1]); w.w = cvt_pk_bf16(b[2], b[3]); return w; }

constexpr int SEGR = 68;
constexpr int MTOT_ROWS = 17408;

struct EpiPlain {
    static constexpr bool PERM = true;
    bf16_t* O; int ldc;
    __device__ __forceinline__ void operator()(f32x4 (&acc)[2][2][4][2], const Unit& u, int wr, int wc, int fr, int fq, PG8_LAS unsigned char*) const {
        const int row0 = u.pm * BM + wr * 64 + fr, col0 = u.pn * BM + wc * 32 + 8 * fq;
#pragma unroll
        for (int ai = 0; ai < 2; ++ai)
#pragma unroll
            for (int m = 0; m < 4; ++m) { bf16_t* rowp = O + (size_t)(row0 + ai * HALF + m * 16) * ldc + col0;
#pragma unroll
                for (int bj = 0; bj < 2; ++bj) *(u32x4*)(rowp + bj * HALF) = pack8(acc[ai][bj][m][0], acc[ai][bj][m][1]); }
    }
};

struct EpiXbcDt {
    static constexpr bool PERM = true;
    bf16_t* XBC; bf16_t* HALO; float* DT; const float* dt_bias;
    __device__ __forceinline__ void operator()(f32x4 (&acc)[2][2][4][2], const Unit& u, int wr, int wc, int fr, int fq, PG8_LAS unsigned char*) const {
        const int row0 = u.pm * BM + wr * 64 + fr;
        if (u.pn < 16) {
            const int col0 = u.pn * BM + wc * 32 + 8 * fq;
            const __amdgpu_buffer_rsrc_t rsx = __builtin_amdgcn_make_buffer_rsrc((void*)XBC, (short)0, 17408 * 4096 * 2, 0x00020000), rsh = __builtin_amdgcn_make_buffer_rsrc((void*)HALO, (short)0, 544 * 4 * 4096 * 2, 0x00020000);
#pragma unroll
            for (int ai = 0; ai < 2; ++ai)
#pragma unroll
                for (int m = 0; m < 4; ++m) { const int r = row0 + ai * HALF + m * 16; const unsigned ro = (unsigned)(((size_t)r * 4096 + col0) * 2);
                    const int seg = r >> 5, rs = r & 31; const int hs = rs < 2 ? rs : (rs >= 30 ? rs - 28 : -1);
#pragma unroll
                    for (int bj = 0; bj < 2; ++bj) { const u32x4 w = pack8(acc[ai][bj][m][0], acc[ai][bj][m][1]); __builtin_amdgcn_raw_buffer_store_b128(w, rsx, ro + bj * HALF * 2, 0, 16);
                        if (hs >= 0) __builtin_amdgcn_raw_buffer_store_b128(w, rsh, (unsigned)(((size_t)(seg * 4 + hs) * 4096 + col0 + bj * HALF) * 2), 0, 16); } }
        } else if (wc < 2) {
            const int c0 = wc * 32 + 8 * fq;
            const f32x4 b0 = *(const f32x4*)(dt_bias + c0), b1 = *(const f32x4*)(dt_bias + c0 + 4);
#pragma unroll
            for (int ai = 0; ai < 2; ++ai)
#pragma unroll
                for (int m = 0; m < 4; ++m) { const int r = row0 + ai * HALF + m * 16; float* colp = DT + (size_t)c0 * MTOT_ROWS + r;
                    f32x4 v0 = acc[ai][0][m][0] + b0, v1 = acc[ai][0][m][1] + b1;
#pragma unroll
                    for (int j = 0; j < 4; ++j) { colp[(size_t)j * MTOT_ROWS] = softplus(v0[j]); colp[(size_t)(4 + j) * MTOT_ROWS] = softplus(v1[j]); } }
        }
    }
};

struct EpiZPG {
    static constexpr bool PERM = true;
    bf16_t* Y; bf16_t* UPOOL; bf16_t* GATES;
    __device__ __forceinline__ void operator()(f32x4 (&acc)[2][2][4][2], const Unit& u, int wr, int wc, int fr, int fq, PG8_LAS unsigned char* xl) const {
        const int row0 = u.pm * BM + wr * 64 + fr;
#ifdef DBG_SKIPZ
        if (u.pn < 8) { return; }
#endif
        if (u.pn < 8) {
            const int col0 = u.pn * BM + wc * 32 + 8 * fq;
            PG8_LAS float* P = (PG8_LAS float*)xl;
            u32x4 yva[2][4][2];
#pragma unroll
            for (int ai = 0; ai < 2; ++ai)
#pragma unroll
                for (int m = 0; m < 4; ++m) { const bf16_t* yp = Y + (size_t)(row0 + ai * HALF + m * 16) * 2048 + col0; yva[ai][m][0] = *(const u32x4*)yp; yva[ai][m][1] = *(const u32x4*)(yp + HALF); }
#pragma unroll
            for (int ai = 0; ai < 2; ++ai) {
#pragma unroll
                for (int m = 0; m < 4; ++m) { float s = 0.f;
#pragma unroll
                    for (int bj = 0; bj < 2; ++bj) { const u32x4 yv = yva[ai][m][bj]; f32x4 v0 = acc[ai][bj][m][0], v1 = acc[ai][bj][m][1];
                        v0[0] = bflo(yv.x) * silu(v0[0]); v0[1] = bfhi(yv.x) * silu(v0[1]); v0[2] = bflo(yv.y) * silu(v0[2]); v0[3] = bfhi(yv.y) * silu(v0[3]);
                        v1[0] = bflo(yv.z) * silu(v1[0]); v1[1] = bfhi(yv.z) * silu(v1[1]); v1[2] = bflo(yv.w) * silu(v1[2]); v1[3] = bfhi(yv.w) * silu(v1[3]);
                        s += (v0[0] * v0[0] + v0[1] * v0[1]) + (v0[2] * v0[2] + v0[3] * v0[3]) + (v1[0] * v1[0] + v1[1] * v1[1]) + (v1[2] * v1[2] + v1[3] * v1[3]);
                        acc[ai][bj][m][0] = v0; acc[ai][bj][m][1] = v1; }
                    s += lane_xor<16>(s); s = half_sum(s);
                    if (fq == 0) P[(ai * HALF + wr * 64 + m * 16 + fr) * 4 + wc] = s; }
                asm volatile("" ::: "memory"); }
#ifndef DBG_NOZBAR
            asm volatile("s_waitcnt lgkmcnt(0)" ::: "memory"); __builtin_amdgcn_s_barrier(); asm volatile("" ::: "memory");
#else
            asm volatile("s_waitcnt lgkmcnt(0)" ::: "memory");
#endif
#pragma unroll
            for (int ai = 0; ai < 2; ++ai)
#pragma unroll
                for (int m = 0; m < 4; ++m) {
#ifndef DBG_NOZBAR
                    const f32x4 p = *(const PG8_LAS f32x4*)(P + (ai * HALF + wr * 64 + m * 16 + fr) * 4);
#else
                    const float pw_ = P[(ai * HALF + wr * 64 + m * 16 + fr) * 4 + wc]; const f32x4 p = {pw_, pw_, pw_, pw_};
#endif

                    const float rstd = rsqrtf(((p[0] + p[1]) + (p[2] + p[3])) * (1.0f / 256.0f) + 1e-6f);
                    bf16_t* yp = Y + (size_t)(row0 + ai * HALF + m * 16) * 2048 + col0;
#pragma unroll
                    for (int bj = 0; bj < 2; ++bj) *(u32x4*)(yp + bj * HALF) = pack8(acc[ai][bj][m][0] * rstd, acc[ai][bj][m][1] * rstd); }
        } else if (u.pn < 12) {
            const int col0 = (u.pn - 8) * BM + wc * 32 + 8 * fq;
            const __amdgpu_buffer_rsrc_t rsU = __builtin_amdgcn_make_buffer_rsrc((void*)UPOOL, (short)0, 17408 * 1024 * 2, 0x00020000);
#pragma unroll
            for (int ai = 0; ai < 2; ++ai)
#pragma unroll
                for (int m = 0; m < 4; ++m) { const unsigned ro = (unsigned)(((size_t)(row0 + ai * HALF + m * 16) * 1024 + col0) * 2);
#pragma unroll
                    for (int bj = 0; bj < 2; ++bj) __builtin_amdgcn_raw_buffer_store_b128(pack8(acc[ai][bj][m][0], acc[ai][bj][m][1]), rsU, ro + bj * HALF * 2, 0, 16); }
        } else {
            const int col0 = (u.pn - 12) * BM + wc * 32 + 8 * fq;
#pragma unroll
            for (int ai = 0; ai < 2; ++ai)
#pragma unroll
                for (int m = 0; m < 4; ++m) { bf16_t* rowp = GATES + (size_t)(row0 + ai * HALF + m * 16) * 2048 + col0;
#pragma unroll
                    for (int bj = 0; bj < 2; ++bj) { f32x4 v0 = acc[ai][bj][m][0], v1 = acc[ai][bj][m][1];
#pragma unroll
                        for (int j = 0; j < 4; ++j) { v0[j] = sigm(v0[j]); v1[j] = sigm(v1[j]); }
                        *(u32x4*)(rowp + bj * HALF) = pack8(v0, v1); } }
        }
    }
};

template <int MODE  > struct EpiGate {
    static constexpr bool PERM = true;
    bf16_t* M1; const bf16_t* GATES;
    __device__ __forceinline__ void operator()(f32x4 (&acc)[2][2][4][2], const Unit& u, int wr, int wc, int fr, int fq, PG8_LAS unsigned char*) const {
        const int row0 = u.pm * BM + wr * 64 + fr, col0 = u.pn * BM + wc * 32 + 8 * fq;
        const __amdgpu_buffer_rsrc_t rs = __builtin_amdgcn_make_buffer_rsrc((void*)M1, (short)0, 17408 * 1024 * 2, 0x00020000);
#pragma unroll
        for (int ai = 0; ai < 2; ++ai) {
            u32x4 gv[4][2], ov[4][2];
#pragma unroll
            for (int m = 0; m < 4; ++m) { const int r = row0 + ai * HALF + m * 16; const bf16_t* gp = GATES + (size_t)r * 2048 + MODE * 1024 + col0; const bf16_t* mp = M1 + (size_t)r * 1024 + col0;
                gv[m][0] = *(const u32x4*)gp; gv[m][1] = *(const u32x4*)(gp + HALF);
                if (MODE == 1) { ov[m][0] = *(const u32x4*)mp; ov[m][1] = *(const u32x4*)(mp + HALF); } }
#pragma unroll
            for (int m = 0; m < 4; ++m) { bf16_t* mp = M1 + (size_t)(row0 + ai * HALF + m * 16) * 1024 + col0;
#pragma unroll
                for (int bj = 0; bj < 2; ++bj) { const u32x4 g = gv[m][bj]; f32x4 v0 = acc[ai][bj][m][0], v1 = acc[ai][bj][m][1];
                    v0[0] *= bflo(g.x); v0[1] *= bfhi(g.x); v0[2] *= bflo(g.y); v0[3] *= bfhi(g.y); v1[0] *= bflo(g.z); v1[1] *= bfhi(g.z); v1[2] *= bflo(g.w); v1[3] *= bfhi(g.w);
                    if (MODE == 1) { const u32x4 o = ov[m][bj];
                        v0[0] += bflo(o.x); v0[1] += bfhi(o.x); v0[2] += bflo(o.y); v0[3] += bfhi(o.y); v1[0] += bflo(o.z); v1[1] += bfhi(o.z); v1[2] += bflo(o.w); v1[3] += bfhi(o.w); }
                    __builtin_amdgcn_raw_buffer_store_b128(pack8(v0, v1), rs, (unsigned)((size_t)((const char*)(mp + bj * HALF) - (const char*)M1)), 0,   16); } }
            asm volatile("" ::: "memory"); }
    }
};

template <bool LAT_BASE_BF16> struct EpiRes {
    static constexpr bool PERM = true;
    const float* base_lat_f32; bf16_t* xr; const float* base_ctx; float* out_ctx; const float* gate;
    __device__ __forceinline__ void operator()(f32x4 (&acc)[2][2][4][2], const Unit& u, int wr, int wc, int fr, int fq, PG8_LAS unsigned char*) const {
        const bool lat = u.pm < 64;
        const int row0 = (lat ? u.pm : u.pm - 64) * BM + wr * 64 + fr, col0 = u.pn * BM + wc * 32 + 8 * fq;
        const float* gp = gate + (lat ? (u.pm >> 4) : 4) * 6144 + col0;
        f32x4 gv[2][2];
#pragma unroll
        for (int bj = 0; bj < 2; ++bj)
#pragma unroll
            for (int n = 0; n < 2; ++n) gv[bj][n] = *(const f32x4*)(gp + bj * HALF + 4 * n);
        if (lat && LAT_BASE_BF16) {
#pragma unroll
            for (int ai = 0; ai < 2; ++ai) {
                u32x4 bb[4][2];
#pragma unroll
                for (int m = 0; m < 4; ++m)
#pragma unroll
                    for (int bj = 0; bj < 2; ++bj) bb[m][bj] = *(const u32x4*)(xr + (size_t)(row0 + ai * HALF + m * 16) * 2048 + col0 + bj * HALF);
#pragma unroll
                for (int m = 0; m < 4; ++m)
#pragma unroll
                    for (int bj = 0; bj < 2; ++bj) { const u32x4 o = bb[m][bj]; f32x4 v0 = gv[bj][0] * acc[ai][bj][m][0], v1 = gv[bj][1] * acc[ai][bj][m][1];
                        v0[0] += bflo(o.x); v0[1] += bfhi(o.x); v0[2] += bflo(o.y); v0[3] += bfhi(o.y); v1[0] += bflo(o.z); v1[1] += bfhi(o.z); v1[2] += bflo(o.w); v1[3] += bfhi(o.w);
                        *(u32x4*)(xr + (size_t)(row0 + ai * HALF + m * 16) * 2048 + col0 + bj * HALF) = pack8(v0, v1); }
                asm volatile("" ::: "memory"); }
        } else {
            const float* base = lat ? base_lat_f32 : base_ctx;
#pragma unroll
            for (int ai = 0; ai < 2; ++ai) {
                f32x4 bs[4][2][2];
#pragma unroll
                for (int m = 0; m < 4; ++m) { const size_t off = (size_t)(row0 + ai * HALF + m * 16) * 1024 + col0;
#pragma unroll
                    for (int bj = 0; bj < 2; ++bj)
#pragma unroll
                        for (int n = 0; n < 2; ++n) bs[m][bj][n] = *(const f32x4*)(base + off + bj * HALF + 4 * n); }
#pragma unroll
                for (int m = 0; m < 4; ++m) { const int r = row0 + ai * HALF + m * 16;
#pragma unroll
                    for (int bj = 0; bj < 2; ++bj) { const f32x4 v0 = bs[m][bj][0] + gv[bj][0] * acc[ai][bj][m][0], v1 = bs[m][bj][1] + gv[bj][1] * acc[ai][bj][m][1];
                        if (lat) *(u32x4*)(xr + (size_t)r * 2048 + col0 + bj * HALF) = pack8(v0, v1);
                        else { float* op = out_ctx + (size_t)r * 1024 + col0 + bj * HALF; *(f32x4*)op = v0; *(f32x4*)(op + 4) = v1; } } }
                asm volatile("" ::: "memory"); }
        }
    }
};

struct SplitKOrder {
    int G, c;
    __device__ __forceinline__ bool next(int i, Unit& u) const { const int L = i * G + c; if (L >= 176) return false; const int ks = L % 11, tile = L / 11; u.pm = 64 + (tile >> 2); u.pn = (tile & 3) + 4 * ks; return true; }
    __device__ __forceinline__ size_t a_off(const Unit& u, const Gemm&, size_t tsA) const { return (size_t)u.pm * tsA + (size_t)(u.pn >> 2) * 512; }
    __device__ __forceinline__ size_t b_off(const Unit& u, const Gemm&, size_t tsB) const { return (size_t)(u.pn & 3) * tsB + (size_t)(u.pn >> 2) * 512; }
    __device__ __forceinline__ void a_ready(const Unit&) const {}
    __device__ __forceinline__ void done(const Unit&) const {}
};
struct EpiPart {
    static constexpr bool PERM = true;
    float* P;
    __device__ __forceinline__ void operator()(f32x4 (&acc)[2][2][4][2], const Unit& u, int wr, int wc, int fr, int fq, PG8_LAS unsigned char*) const {
        const int ks = u.pn >> 2, row0 = (u.pm - 64) * BM + wr * 64 + fr, col0 = (u.pn & 3) * BM + wc * 32 + 8 * fq;
#pragma unroll
        for (int ai = 0; ai < 2; ++ai)
#pragma unroll
            for (int m = 0; m < 4; ++m) { float* op = P + ((size_t)ks * 1024 + row0 + ai * HALF + m * 16) * 1024 + col0;
#pragma unroll
                for (int bj = 0; bj < 2; ++bj) { *(f32x4*)(op + bj * HALF) = acc[ai][bj][m][0]; *(f32x4*)(op + bj * HALF + 4) = acc[ai][bj][m][1]; } }
    }
};

struct EpiSwiglu {
    static constexpr bool PERM = true;
    bf16_t* ACT;
    __device__ __forceinline__ void operator()(f32x4 (&acc)[2][2][4][2], const Unit& u, int wr, int wc, int fr, int fq, PG8_LAS unsigned char*) const {
        const int row0 = u.pm * BM + wr * 64 + fr, j0 = u.pn * 128 + wc * 32 + 8 * fq;
#pragma unroll
        for (int ai = 0; ai < 2; ++ai)
#pragma unroll
            for (int m = 0; m < 4; ++m) { bf16_t* rowp = ACT + (size_t)(row0 + ai * HALF + m * 16) * 2816 + j0;
                const f32x4 a0 = acc[ai][0][m][0], b0 = acc[ai][0][m][1], a1 = acc[ai][1][m][0], b1 = acc[ai][1][m][1];
                u32x4 w; w.x = cvt_pk_bf16(silu(a0[0]) * b0[0], silu(a0[1]) * b0[1]); w.y = cvt_pk_bf16(silu(a0[2]) * b0[2], silu(a0[3]) * b0[3]);
                w.z = cvt_pk_bf16(silu(a1[0]) * b1[0], silu(a1[1]) * b1[1]); w.w = cvt_pk_bf16(silu(a1[2]) * b1[2], silu(a1[3]) * b1[3]);
                *(u32x4*)rowp = w; }
    }
};

template <class Epi, class Sched, bool ALIGN_EPI = true, bool SP2 = true>
__device__ __forceinline__ void gemm_phase(PG8_LAS unsigned char* lds, PG8_LAS unsigned char* xl, const Gemm g, const Sched& S, const Epi& E) {
    const int tid = opaque_v(tid_now()), wid = __builtin_amdgcn_readfirstlane(tid >> 6), lane = tid & 63, wr = wid >> 2, wc = wid & 3, fr = lane & 15, fq = lane >> 4;
    const int K = g.K, nt = K / BK;
    unsigned voffA[2], voffB[2];
#pragma unroll
    for (int i = 0; i < 2; ++i) { int R, C; stage_rc(tid * 16 + i * 8192, R, C); const int Rb = Epi::PERM ? ((R & ~31) + perm32(R & 31)) : R;
        voffA[i] = (unsigned)(R * g.lda + C) * 2u; voffB[i] = (unsigned)(Rb * g.ldb + C) * 2u; }
    const size_t kstep = (size_t)(BK * 2);
    const size_t hsA = (size_t)HALF * g.lda * 2, hsB = (size_t)HALF * g.ldb * 2;
    const size_t tsA = 2 * hsA, tsB = 2 * hsB;
    const unsigned ldsw = (unsigned)wid * 1024u;
    const int aoff = lds_byte(wr * 64 + fr, fq * 8), boff = lds_byte(wc * 32 + fr, fq * 8);
#define PG8_SA(b, h) (((b) * 2 + (h)) * HTB)
#define PG8_SB(b, h) ((4 + (b) * 2 + (h)) * HTB)
#define PG8_STAGE(bufoff, gbase, voff) do { _Pragma("unroll") for (int _i = 0; _i < 2; ++_i) \
        __builtin_amdgcn_global_load_lds((const unsigned*)((const char*)(gbase) + (voff)[_i]), (PG8_LAS unsigned*)(lds + (bufoff) + ldsw + _i * 8192), 16, 0, 0); } while (0)
#define PG8_LDA(dst, b, h) do { _Pragma("unroll") for (int m = 0; m < 4; ++m) _Pragma("unroll") for (int k = 0; k < 2; ++k) dst[m][k] = *(const PG8_LAS bf16x8*)(lds + PG8_SA(b, h) + aoff + m * 2048 + k * 1024); } while (0)
#define PG8_LDB(dst, b, h) do { _Pragma("unroll") for (int n = 0; n < 2; ++n) _Pragma("unroll") for (int k = 0; k < 2; ++k) dst[n][k] = *(const PG8_LAS bf16x8*)(lds + PG8_SB(b, h) + boff + n * 2048 + k * 1024); } while (0)
#define PG8_MMA(ai, bj, At, Bt) do { __builtin_amdgcn_s_setprio(1); _Pragma("unroll") for (int m = 0; m < 4; ++m) _Pragma("unroll") for (int n = 0; n < 2; ++n) _Pragma("unroll") for (int k = 0; k < 2; ++k) \
        acc[ai][bj][m][n] = __builtin_amdgcn_mfma_f32_16x16x32_bf16(Bt[n][k], At[m][k], acc[ai][bj][m][n], 0, 0, 0); __builtin_amdgcn_s_setprio(0); } while (0)
#define PG8_WAIT_V(n) asm volatile("s_waitcnt vmcnt(" #n ")" ::: "memory")
#define PG8_WAIT_L(n) asm volatile("s_waitcnt lgkmcnt(" #n ")" ::: "memory")
#define PG8_BAR __builtin_amdgcn_s_barrier()
#define PG8_SCHED __builtin_amdgcn_sched_barrier(0)
    Unit cur, nxt; int ui = 0;
    if (!S.next(0, cur)) return;
    f32x4 acc[2][2][4][2];
#pragma unroll
    for (int a = 0; a < 2; ++a)
#pragma unroll
        for (int b = 0; b < 2; ++b)
#pragma unroll
            for (int m = 0; m < 4; ++m)
#pragma unroll
                for (int n = 0; n < 2; ++n) acc[a][b][m][n] = (f32x4){0.f, 0.f, 0.f, 0.f};
    bf16x8 At[4][2], B0[2][2], B1[2][2];
    const char* cA = (const char*)g.A + S.a_off(cur, g, tsA); const char* cB = (const char*)g.Bt + S.b_off(cur, g, tsB);
    S.a_ready(cur);
    if constexpr (SP2) {
        PG8_STAGE(PG8_SB(0, 0), cB, voffB); PG8_STAGE(PG8_SB(0, 1), cB + hsB, voffB); PG8_STAGE(PG8_SA(0, 0), cA, voffA); PG8_STAGE(PG8_SA(0, 1), cA + hsA, voffA);
        if (wr == 1) PG8_BAR;
        PG8_WAIT_V(2); PG8_BAR;
        PG8_STAGE(PG8_SB(1, 0), cB + kstep, voffB); PG8_STAGE(PG8_SA(1, 0), cA + kstep, voffA); PG8_STAGE(PG8_SB(1, 1), cB + hsB + kstep, voffB);
        PG8_WAIT_V(6); PG8_BAR;
    } else {
        PG8_STAGE(PG8_SB(0, 0), cB, voffB); PG8_STAGE(PG8_SA(0, 0), cA, voffA); PG8_STAGE(PG8_SB(0, 1), cB + hsB, voffB); PG8_STAGE(PG8_SA(0, 1), cA + hsA, voffA);
        if (wr == 1) PG8_BAR;
        PG8_WAIT_V(4); PG8_BAR;
        PG8_STAGE(PG8_SB(1, 0), cB + kstep, voffB); PG8_STAGE(PG8_SA(1, 0), cA + kstep, voffA); PG8_STAGE(PG8_SB(1, 1), cB + hsB + kstep, voffB);
        PG8_WAIT_V(6); PG8_BAR;
    }
    for (;;) {
        const bool has_next = S.next(ui + 1, nxt);
        const char* nA = has_next ? (const char*)g.A + S.a_off(nxt, g, tsA) : cA; const char* nB = has_next ? (const char*)g.Bt + S.b_off(nxt, g, tsB) : cB;
        for (int t = 0; t < nt; t += 2) {
            const bool last = (t == nt - 2);
            const char* a1 = cA + (size_t)(t + 1) * kstep;
            const char* a2 = last ? nA : cA + (size_t)(t + 2) * kstep; const char* b2 = last ? nB : cB + (size_t)(t + 2) * kstep;
            const char* a3 = a2 + kstep; const char* b3 = b2 + kstep;
            if (last && has_next) S.a_ready(nxt);
            if constexpr (SP2) {
            PG8_LDB(B0, 0, 0); PG8_LDB(B1, 0, 1); PG8_SCHED; PG8_LDA(At, 0, 0); PG8_STAGE(PG8_SA(1, 1), a1 + hsA, voffA);
            PG8_WAIT_V(8); PG8_WAIT_L(0); PG8_BAR; PG8_MMA(0, 0, At, B0); PG8_MMA(0, 1, At, B1); PG8_BAR; PG8_SCHED;
            PG8_LDA(At, 0, 1); PG8_STAGE(PG8_SB(0, 0), b2, voffB); PG8_STAGE(PG8_SB(0, 1), b2 + hsB, voffB); PG8_STAGE(PG8_SA(0, 0), a2, voffA);
            PG8_WAIT_V(8); PG8_WAIT_L(0); PG8_BAR; PG8_MMA(1, 0, At, B0); PG8_MMA(1, 1, At, B1); PG8_BAR; PG8_SCHED;
            PG8_LDB(B0, 1, 0); PG8_LDB(B1, 1, 1); PG8_SCHED; PG8_LDA(At, 1, 0); PG8_STAGE(PG8_SA(0, 1), a2 + hsA, voffA);
            PG8_WAIT_V(8); PG8_WAIT_L(0); PG8_BAR; PG8_MMA(0, 0, At, B0); PG8_MMA(0, 1, At, B1); PG8_BAR; PG8_SCHED;
            PG8_LDA(At, 1, 1); PG8_STAGE(PG8_SB(1, 0), b3, voffB); PG8_STAGE(PG8_SB(1, 1), b3 + hsB, voffB); PG8_STAGE(PG8_SA(1, 0), a3, voffA);
            PG8_WAIT_V(8); PG8_WAIT_L(0); PG8_BAR; PG8_MMA(1, 0, At, B0); PG8_MMA(1, 1, At, B1); PG8_BAR; PG8_SCHED;
            } else {
            PG8_LDB(B0, 0, 0); PG8_SCHED; PG8_LDA(At, 0, 0); PG8_STAGE(PG8_SA(1, 1), a1 + hsA, voffA);
            PG8_WAIT_L(8); PG8_BAR; PG8_WAIT_L(0); PG8_MMA(0, 0, At, B0); PG8_BAR; PG8_SCHED;
            PG8_LDB(B1, 0, 1); PG8_STAGE(PG8_SB(0, 0), b2, voffB);
            PG8_BAR; PG8_WAIT_L(0); PG8_MMA(0, 1, At, B1); PG8_BAR;
            PG8_LDA(At, 0, 1); PG8_STAGE(PG8_SA(0, 0), a2, voffA);
            PG8_BAR; PG8_WAIT_L(0); PG8_MMA(1, 0, At, B0); PG8_BAR; PG8_SCHED;
            PG8_STAGE(PG8_SB(0, 1), b2 + hsB, voffB);
            PG8_WAIT_V(6); PG8_BAR; PG8_MMA(1, 1, At, B1); PG8_BAR;
            PG8_LDB(B0, 1, 0); PG8_SCHED; PG8_LDA(At, 1, 0); PG8_STAGE(PG8_SA(0, 1), a2 + hsA, voffA);
            PG8_WAIT_L(8); PG8_BAR; PG8_WAIT_L(0); PG8_MMA(0, 0, At, B0); PG8_BAR; PG8_SCHED;
            PG8_LDB(B1, 1, 1); PG8_STAGE(PG8_SB(1, 0), b3, voffB);
            PG8_BAR; PG8_WAIT_L(0); PG8_MMA(0, 1, At, B1); PG8_BAR;
            PG8_LDA(At, 1, 1); PG8_STAGE(PG8_SA(1, 0), a3, voffA);
            PG8_BAR; PG8_WAIT_L(0); PG8_MMA(1, 0, At, B0); PG8_BAR; PG8_SCHED;
            PG8_STAGE(PG8_SB(1, 1), b3 + hsB, voffB);
            PG8_WAIT_V(6); PG8_BAR; PG8_MMA(1, 1, At, B1); PG8_BAR;
            }
        }
        if constexpr (ALIGN_EPI) { if (wr == 0) PG8_BAR; }
        E(acc, cur, wr, wc, fr, fq, xl); S.done(cur);
        if (!has_next) break;
#pragma unroll
        for (int a = 0; a < 2; ++a)
#pragma unroll
            for (int b = 0; b < 2; ++b)
#pragma unroll
                for (int m = 0; m < 4; ++m)
#pragma unroll
                    for (int n = 0; n < 2; ++n) acc[a][b][m][n] = (f32x4){0.f, 0.f, 0.f, 0.f};
        cur = nxt; cA = nA; cB = nB; ++ui;
        if constexpr (ALIGN_EPI) { if (wr == 1) PG8_BAR; }
    }
    PG8_WAIT_V(0);
    if constexpr (!ALIGN_EPI) { if (wr == 0) PG8_BAR; }
    PG8_BAR;
#undef PG8_SA
#undef PG8_SB
#undef PG8_STAGE
#undef PG8_LDA
#undef PG8_LDB
#undef PG8_MMA
#undef PG8_WAIT_V
#undef PG8_WAIT_L
#undef PG8_BAR
#undef PG8_SCHED
}
}

#define GAS __attribute__((address_space(1)))
#define LAS __attribute__((address_space(3)))
typedef unsigned short bf16;
typedef unsigned v4u __attribute__((ext_vector_type(4)));
typedef unsigned v2u __attribute__((ext_vector_type(2)));
typedef float f32x4 __attribute__((ext_vector_type(4)));
#define LDS_WAIT() asm volatile("s_waitcnt lgkmcnt(0)" ::: "memory")
#define VM_WAIT() asm volatile("s_waitcnt vmcnt(0)" ::: "memory")

constexpr int D = 1024, NB = 4, SEQ = 4096, CTXL = 256, MLAT = NB * SEQ, MCTX = NB * CTXL, MTOT = MLAT + MCTX;
constexpr int DI = 2048, XBCW = 4096, NHEAD = 32, FFH = 2816, INC = 9280;
constexpr int NB1 = 4352  , NB2 = 5120  ;
constexpr int NWAVES = 8;

constexpr size_t MiB = 1u << 20;
constexpr size_t WS_CTL = 0, CTL_ZERO_BYTES = 1 * MiB;
constexpr size_t WS_MOD = 1 * MiB;
constexpr size_t WS_WIN = 2 * MiB;
constexpr size_t WS_WSSD = WS_WIN + (size_t)(NB1 + NB2) * 1024 * 2;
constexpr size_t WS_WPC = WS_WSSD + (size_t)1024 * 2048 * 2;
constexpr size_t WS_WOUT = WS_WPC + (size_t)1024 * 1024 * 2;
constexpr size_t WS_CX = WS_WOUT + (size_t)1024 * 1024 * 2;
constexpr size_t WS_H = WS_CX + (size_t)MCTX * D * 4;
constexpr size_t WS_DT = WS_H + (size_t)MTOT * D * 2;
constexpr size_t WS_Y = WS_DT + (size_t)MTOT * 64 * 4;
constexpr size_t WS_XBC = WS_Y + (size_t)MTOT * DI * 2;
constexpr size_t WS_END = WS_XBC + (size_t)MTOT * XBCW * 2;
constexpr size_t XO_GATES = 0, XO_UPOOL = (size_t)MTOT * 2048 * 2, XO_M1 = XO_UPOOL + (size_t)MTOT * 1024 * 2;
constexpr size_t XO_ACT = 0, XO_WGU = (size_t)MTOT * FFH * 2, XO_WDN = XO_WGU + (size_t)2 * FFH * 1024 * 2;
static_assert(XO_M1 + (size_t)MTOT * 1024 * 2 <= (size_t)MTOT * XBCW * 2 && XO_WDN + (size_t)1024 * FFH * 2 <= (size_t)MTOT * XBCW * 2, "xbc overlay map");
constexpr int CW_BAR = 4096;
constexpr int CW_WORK = 12288;
constexpr int CW_CNT = 16384, CNT_ARR = 68 * 64;
__device__ __forceinline__ int cnt_off(int l, int kind) { return CW_CNT + (l * 8 + kind) * CNT_ARR; }
__device__ __forceinline__ pg8::pg8_gu32* cnt_arr(unsigned char* ws, int l, int kind) { return (pg8::pg8_gu32*)(ws + WS_CTL) + cnt_off(l, kind); }

constexpr int RING_BYTES = 131072, LDS_BYTES = 163840  , XL_OFF = 155648  , MISC_OFF = 159744  ;

__device__ __forceinline__ unsigned pk2(float lo, float hi) { return pg8::cvt_pk_bf16(lo, hi); }
__device__ __forceinline__ float bf_lo(unsigned u) { return __uint_as_float(u << 16); }
__device__ __forceinline__ float bf_hi(unsigned u) { return __uint_as_float(u & 0xffff0000u); }

#define XB_TMO      128
#define XB_XCNT(j)  (256  + 64 * (j))
#define XB_XSUB(j)  (1280 + 64 * (j))
#define XB_XGEN(j)  (2304 + 64 * (j))
#define XB_TOP      3328
#define XB_TOPGEN   3392
#define XCD_BAR_WORDS 3456
#define XB_SPIN_CAP (1u << 20)
typedef GAS unsigned gu32;
__device__ __forceinline__ unsigned xb_ld(gu32* p)              { return __hip_atomic_load(p, __ATOMIC_RELAXED, __HIP_MEMORY_SCOPE_AGENT); }
__device__ __forceinline__ unsigned xb_add(gu32* p, unsigned v) { return __hip_atomic_fetch_add(p, v, __ATOMIC_RELAXED, __HIP_MEMORY_SCOPE_AGENT); }
__device__ __forceinline__ unsigned xb_xcc_id() { return (unsigned)__builtin_amdgcn_s_getreg((3 << 11) | 20) & 0xFu; }
#define XB_SPIN(cond, bar) do { unsigned _sp = 0; while (cond) { __builtin_amdgcn_s_sleep(1); \
    if ((++_sp & 255u) == 0u) { if (xb_ld(&(bar)[XB_TMO])) break; if (_sp > XB_SPIN_CAP) { xb_add(&(bar)[XB_TMO], 1u); break; } } } } while (0)
struct XcdBarrier { gu32* bar; unsigned x; volatile LAS unsigned* st; };
__device__ __forceinline__ XcdBarrier xcd_barrier_post(gu32* bar, volatile LAS unsigned* st) {
    XcdBarrier b; b.bar = bar; b.x = xb_xcc_id(); b.st = st;
    if (pg8::tid_now() == 0) (void)xb_add(&bar[XB_XCNT(b.x)], 1u);
    return b;
}
__device__ __forceinline__ void xcd_barrier_complete(gu32* bar, unsigned x, unsigned& nloc, unsigned& nx) {
    const unsigned G = gridDim.x * gridDim.y * gridDim.z;
    unsigned sum, cnt, mine, sp = 0u;
    for (;;) {
        sum = 0u; cnt = 0u; mine = 0u;
#pragma unroll
        for (unsigned j = 0; j < 16; ++j) { const unsigned c = xb_ld(&bar[XB_XCNT(j)]); sum += c; cnt += (c > 0u) ? 1u : 0u; mine = (j == x) ? c : mine; }
        if (sum == G) break;
        __builtin_amdgcn_s_sleep(1);
        if ((++sp & 255u) == 0u) { if (xb_ld(&bar[XB_TMO])) break; if (sp > XB_SPIN_CAP) { xb_add(&bar[XB_TMO], 1u); break; } }
    }
    nloc = mine > 0u ? mine : 1u; nx = cnt > 0u ? cnt : 1u;
}
__device__ __forceinline__ void xcd_barrier(const XcdBarrier& b) {
    asm volatile("s_waitcnt vmcnt(0)" ::: "memory");
    __syncthreads();
    if (pg8::tid_now() == 0) {
        gu32* bar = b.bar; unsigned bx_ = b.x;
        asm volatile("" : "+s"(bar), "+s"(bx_));
        __builtin_amdgcn_s_waitcnt(0);
        unsigned nloc = b.st[0], nx = b.st[1];
        if (nloc == 0u) { xcd_barrier_complete(bar, bx_, nloc, nx); b.st[0] = nloc; b.st[1] = nx; }
        const unsigned old = xb_add(&bar[XB_XSUB(bx_)], 1u);
        const unsigned gen = old / nloc;
        if (old + 1u == (gen + 1u) * nloc) {
            __builtin_amdgcn_fence(__ATOMIC_RELEASE, "agent");
            asm volatile("s_waitcnt vmcnt(0)" ::: "memory");
            const unsigned og = xb_add(&bar[XB_TOP], 1u);
            const unsigned tg = og / nx;
            if (og + 1u == (tg + 1u) * nx) xb_add(&bar[XB_TOPGEN], 1u);
            else XB_SPIN(xb_ld(&bar[XB_TOPGEN]) == tg, bar);
            __builtin_amdgcn_fence(__ATOMIC_ACQUIRE, "agent");
            xb_add(&bar[XB_XGEN(bx_)], 1u);
            asm volatile("s_waitcnt vmcnt(0)" ::: "memory");
        } else {
            XB_SPIN(xb_ld(&bar[XB_XGEN(bx_)]) == gen, bar);
            __builtin_amdgcn_fence(__ATOMIC_ACQUIRE, "agent");
            asm volatile("s_waitcnt vmcnt(0)" ::: "memory");
        }
    }
    __syncthreads();
}

__device__ __forceinline__ float wave_sum(float v) {
    v += pg8::lane_xor<1>(v); v += pg8::lane_xor<2>(v); v += pg8::lane_xor<4>(v); v += pg8::lane_xor<8>(v); v += pg8::lane_xor<16>(v);
    return pg8::half_sum(v);
}

template <int MODE> __device__ __forceinline__ int srccol(int n) {
    if (MODE == 0) {
        if (n < 4096) return 2048 + n;
        if (n < 4160) return 6144 + (n - 4096);
        if (n < 4352) return -1;
        if (n < 6400) return n - 4352;
        if (n < 7424) return 6208 + (n - 6400);
        return 7232 + (n - 7424);
    }
    if (MODE == 2) { const int pn = n >> 8, c = n & 255, bj = c >> 7, wc = (c >> 5) & 3, fq = (c >> 3) & 3, sel = (c >> 2) & 1, j = pn * 128 + wc * 32 + 8 * fq + 4 * bj + (c & 3); return sel * FFH + j; }
    return n;
}
struct Args { const float* in[23]; float* out; unsigned char* ws; };
typedef const __attribute__((address_space(4))) unsigned long long* KA;
__device__ __forceinline__ KA ka_fresh() { KA p = (KA)__builtin_amdgcn_kernarg_segment_ptr(); asm volatile("" : "+s"(p)); return p; }
#define KIN(ka, k) ((const float*)(const GAS float*)(ka)[k])
#define KOUT(ka) ((float*)(GAS float*)(ka)[23])
#define KWS(ka) ((unsigned char*)(GAS unsigned char*)(ka)[24])

struct Ids { int tid, lane, wave, G, bx, vcu, gw, NGW; };
__device__ __forceinline__ Ids fresh(Ids I) { I.wave = pg8::opaque_s(pg8::wave_now()); I.tid = pg8::opaque_v(I.wave * 64 + pg8::lane_now()); I.lane = I.tid & 63; I.vcu = pg8::opaque_s(I.vcu); I.bx = pg8::opaque_s(I.bx); I.gw = I.vcu * NWAVES + I.wave; return I; }

struct ConvJob { const float* W; bf16* WT; const float* kscale; int K, Nsrc, Ndst, mode, item; };
__device__ __forceinline__ int srccol_rt(int mode, int n) { return mode == 0 ? srccol<0>(n) : (mode == 2 ? srccol<2>(n) : n); }
__device__ __forceinline__ void conv_load(const ConvJob& j, int lane, f32x4 (&v)[8]) {
    const int nblk = j.Ndst / 32, kb = j.item / nblk, nb = j.item % nblk, k0 = 64 * kb, n0 = 32 * nb;
    const int r8 = lane >> 3, c4 = lane & 7, sc = srccol_rt(j.mode, n0 + 4 * c4);
#pragma unroll
    for (int i = 0; i < 8; ++i) v[i] = sc >= 0 ? *(const f32x4*)(j.W + (size_t)(k0 + 8 * i + r8) * j.Nsrc + sc) : (f32x4){0.f, 0.f, 0.f, 0.f};
}
__device__ __forceinline__ void conv_store(const ConvJob& j, int lane, const f32x4 (&v)[8], LAS float* scr) {
    const int nblk = j.Ndst / 32, kb = j.item / nblk, nb = j.item % nblk, k0 = 64 * kb, n0 = 32 * nb;
    const int r8 = lane >> 3, c4 = lane & 7;
#pragma unroll
    for (int i = 0; i < 8; ++i) { const int kk = 8 * i + r8; f32x4 t = v[i]; if (j.kscale) t = t * j.kscale[k0 + kk];
        LAS float* d = scr + kk * 33 + 4 * c4; d[0] = t.x; d[1] = t.y; d[2] = t.z; d[3] = t.w; }
    LDS_WAIT(); asm volatile("" ::: "memory");
    const int c = lane & 7;
#pragma unroll
    for (int q = 0; q < 4; ++q) { const int n = (lane >> 3) + 8 * q; const LAS float* sp = scr + (8 * c) * 33 + n;
        v4u o; o.x = pk2(sp[0 * 33], sp[1 * 33]); o.y = pk2(sp[2 * 33], sp[3 * 33]); o.z = pk2(sp[4 * 33], sp[5 * 33]); o.w = pk2(sp[6 * 33], sp[7 * 33]);
        *(v4u*)(j.WT + (size_t)(n0 + n) * j.K + k0 + 8 * c) = o; }
    LDS_WAIT(); asm volatile("" ::: "memory");
}
__device__ __forceinline__ ConvJob conv_job(KA ka, unsigned char* ws, int which, int l, int it) {
    ConvJob j;
    if (which == 0) {
        constexpr int I_IN = 16 * ((NB1 + NB2) / 32), I_SSD = 32 * 32;
        if (it < I_IN) { j.W = KIN(ka, 7) + (size_t)l * D * INC; j.WT = (bf16*)(ws + WS_WIN); j.kscale = nullptr; j.K = D; j.Nsrc = INC; j.Ndst = NB1 + NB2; j.mode = 0; j.item = it; }
        else if (it < I_IN + I_SSD) { j.W = KIN(ka, 14) + (size_t)l * DI * D; j.WT = (bf16*)(ws + WS_WSSD); j.kscale = KIN(ka, 13) + (size_t)l * DI; j.K = DI; j.Nsrc = D; j.Ndst = D; j.mode = 1; j.item = it - I_IN; }
        else { j.W = KIN(ka, 18) + (size_t)l * D * D; j.WT = (bf16*)(ws + WS_WOUT); j.kscale = nullptr; j.K = D; j.Nsrc = D; j.Ndst = D; j.mode = 1; j.item = it - I_IN - I_SSD; }
    } else {
        constexpr int I_GU = 16 * (2 * FFH / 32);
        if (it < I_GU) { j.W = KIN(ka, 20) + (size_t)l * D * 2 * FFH; j.WT = (bf16*)(ws + WS_XBC + XO_WGU); j.kscale = nullptr; j.K = D; j.Nsrc = 2 * FFH; j.Ndst = 2 * FFH; j.mode = 2; j.item = it; }
        else { j.W = KIN(ka, 21) + (size_t)l * FFH * D; j.WT = (bf16*)(ws + WS_XBC + XO_WDN); j.kscale = nullptr; j.K = FFH; j.Nsrc = D; j.Ndst = D; j.mode = 1; j.item = it - I_GU; }
    }
    return j;
}
__device__ __forceinline__ void conv_pass(const Ids I, LAS unsigned char* lds, KA ka, unsigned char* ws, int which, int l, int it0, int nit, int gw, int ngw) {
    LAS float* scr = (LAS float*)(lds + I.wave * 8448);
    f32x4 va[8], vb[8], vc[8];
    for (int it = it0 + gw; it < nit; it += 3 * ngw) {
        const bool h1 = it + ngw < nit, h2 = it + 2 * ngw < nit;
        const ConvJob ja = conv_job(ka, ws, which, l, it); conv_load(ja, I.lane, va);
        ConvJob jb = ja, jc = ja;
        if (h1) { jb = conv_job(ka, ws, which, l, it + ngw); conv_load(jb, I.lane, vb); }
        if (h2) { jc = conv_job(ka, ws, which, l, it + 2 * ngw); conv_load(jc, I.lane, vc); }
        conv_store(ja, I.lane, va, scr);
        if (h1) conv_store(jb, I.lane, vb, scr);
        if (h2) conv_store(jc, I.lane, vc, scr);
    }
}

__device__ __forceinline__ void norm_row(const float* xrow, bf16* orow, const float* g, const float* sh, const float* sc, int lane) {
    const f32x4* xr = (const f32x4*)xrow + lane;
    f32x4 v[4]; float s = 0.f;
#pragma unroll
    for (int j = 0; j < 4; ++j) { v[j] = xr[64 * j]; s += (v[j].x * v[j].x + v[j].y * v[j].y) + (v[j].z * v[j].z + v[j].w * v[j].w); }
    const float rstd = rsqrtf(wave_sum(s) * (1.f / D) + 1e-6f);
    unsigned long long* o8 = (unsigned long long*)orow + lane;
#pragma unroll
    for (int j = 0; j < 4; ++j) { const f32x4 gg = ((const f32x4*)g)[lane + 64 * j], s1 = ((const f32x4*)sc)[lane + 64 * j], s0 = ((const f32x4*)sh)[lane + 64 * j];
        const f32x4 y = v[j] * rstd * gg * (s1 + 1.0f) + s0;
        o8[64 * j] = (unsigned long long)pk2(y.x, y.y) | ((unsigned long long)pk2(y.z, y.w) << 32); }
}

__device__ __forceinline__ void conv_mixer(const Ids I_, LAS unsigned char* lds, int l, bool skip_win = false) {
    const Ids I = fresh(I_);
    const KA ka = ka_fresh(); unsigned char* ws = KWS(ka);
    conv_pass(I, lds, ka, ws, 0, l, skip_win ? 16 * ((NB1 + NB2) / 32) : 0, 16 * ((NB1 + NB2) / 32) + 32 * 32 + 16 * 32, I.gw, I.NGW);
    const float* pw = KIN(ka, 15) + (size_t)l * 4 * 256 * 256; const float* psc = KIN(ka, 16) + (size_t)l * D; const float* wpo = KIN(ka, 17) + (size_t)l * D * D; bf16* WPC = (bf16*)(ws + WS_WPC);
    __syncthreads();
    for (int item = I.vcu; item < 256; item += I.G) {
        const int g = item >> 6, i0 = (item & 63) * 4, n = 2 * I.tid;
        LAS float* tab = (LAS float*)lds;
        for (int e = I.tid; e < 1024; e += NWAVES * 64) { const int q = e >> 8, o = e & 255; tab[o * 4 + q] = pw[((size_t)g * 256 + i0 + q) * 256 + o] * psc[g * 256 + o]; }
        __syncthreads();
        float a0[4] = {0.f, 0.f, 0.f, 0.f}, a1[4] = {0.f, 0.f, 0.f, 0.f};
        const float* wr_ = wpo + (size_t)g * 256 * D + n;
#pragma unroll 32
        for (int o = 0; o < 256; ++o) { const pg8::f32x2 wv = *(const pg8::f32x2*)(wr_ + (size_t)o * D); const f32x4 t = *(const LAS f32x4*)(tab + o * 4);
            a0[0] += t.x * wv.x; a0[1] += t.y * wv.x; a0[2] += t.z * wv.x; a0[3] += t.w * wv.x; a1[0] += t.x * wv.y; a1[1] += t.y * wv.y; a1[2] += t.z * wv.y; a1[3] += t.w * wv.y; }
        v2u o0, o1; o0.x = pk2(a0[0], a0[1]); o0.y = pk2(a0[2], a0[3]); o1.x = pk2(a1[0], a1[1]); o1.y = pk2(a1[2], a1[3]);
        *(v2u*)(WPC + (size_t)n * D + g * 256 + i0) = o0; *(v2u*)(WPC + (size_t)(n + 1) * D + g * 256 + i0) = o1;
        __syncthreads();
    }
}
__device__ __forceinline__ void conv_ffn(const Ids I_, LAS unsigned char* lds, int l) {
    const Ids I = fresh(I_);
    const KA ka = ka_fresh(); unsigned char* ws = KWS(ka);
    conv_pass(I, lds, ka, ws, 1, l, 0, 16 * (2 * FFH / 32) + (FFH / 64) * 32, I.gw, I.NGW);
}

__device__ __forceinline__ void conv_win_dyn(const Ids I_, LAS unsigned char* lds, int l) {
    const Ids I = fresh(I_);
    const KA ka = ka_fresh(); unsigned char* ws = KWS(ka);
    constexpr int NIT = 16 * ((NB1 + NB2) / 32), NCH = (NIT + 23) / 24;
    pg8::pg8_gu32* work = (pg8::pg8_gu32*)(ws + WS_CTL) + CW_WORK + 64 * 4;
    volatile LAS unsigned* slot = (volatile LAS unsigned*)(lds + MISC_OFF) + 48;
    if (I.tid == 0) slot[0] = __hip_atomic_fetch_add(work, 1u, __ATOMIC_RELAXED, __HIP_MEMORY_SCOPE_AGENT);
    __syncthreads();
    int ch = (int)slot[0], par = 0;
    while (ch < NCH) {
        unsigned nclaim = 0u;
        if (I.tid == 0) nclaim = __hip_atomic_fetch_add(work, 1u, __ATOMIC_RELAXED, __HIP_MEMORY_SCOPE_AGENT);
        { const int e = 24 * ch + 24; conv_pass(I, lds, ka, ws, 0, l, 24 * ch, e < NIT ? e : NIT, I.wave, NWAVES); }
        if (I.tid == 0) slot[par ^ 1] = nclaim;
        __syncthreads();
        par ^= 1; ch = (int)slot[par];
    }
}

__device__ __forceinline__ void phase_mod(const Ids I_, LAS unsigned char* lds) {
    const Ids I = fresh(I_);
    const KA ka = ka_fresh(); float* MOD = (float*)(KWS(ka) + WS_MOD);
    LAS float* sv = (LAS float*)lds;
    LAS float* red = (LAS float*)(lds + 20480);
    if (I.bx < 192) {
        const float* cvec = KIN(ka, 1); const float* cctx = KIN(ka, 3);
        for (int i = I.tid; i < 5 * 1024; i += NWAVES * 64) { const int c = i >> 10, k = i & 1023; const float v = c < 4 ? cvec[c * 1024 + k] : cctx[k]; sv[i] = v / (1.f + __expf(-v)); }
        __syncthreads();
        for (int item = I.bx; item < 192; item += I.G) {
            const int l = item / 96, c0 = (item % 96) * 64, kg = I.tid >> 4, cq = I.tid & 15;
            const float* w = KIN(ka, 4) + (size_t)l * D * 6144 + c0 + 4 * cq;
            f32x4 a[5];
#pragma unroll
            for (int c = 0; c < 5; ++c) a[c] = (f32x4){0.f, 0.f, 0.f, 0.f};
#pragma unroll 16
            for (int k = kg * 32; k < kg * 32 + 32; ++k) { const f32x4 wv = *(const f32x4*)(w + (size_t)k * 6144);
#pragma unroll
                for (int c = 0; c < 5; ++c) a[c] += wv * sv[c * 1024 + k]; }
#pragma unroll
            for (int c = 0; c < 5; ++c) *(LAS f32x4*)(red + (kg * 5 + c) * 64 + 4 * cq) = a[c];
            __syncthreads();
            if (I.tid < 320) { const int c = I.tid >> 6, col = I.tid & 63; float s = KIN(ka, 5)[l * 6144 + c0 + col];
#pragma unroll 8
                for (int q = 0; q < 32; ++q) s += red[(q * 5 + c) * 64 + col];
                MOD[((size_t)l * 5 + c) * 6144 + c0 + col] = s; }
            __syncthreads();
        }
    }
    __syncthreads();
}

__device__ __forceinline__ void phase_norm(const Ids I_, int l, int which  , int nrows, bool from_input) {
    const Ids I = fresh(I_);
    const KA ka = ka_fresh(); unsigned char* ws = KWS(ka);
    const float* modl = (const float*)(ws + WS_MOD) + (size_t)l * 5 * 6144 + which * 3072;
    const float* g = KIN(ka, which ? 19 : 6) + l * D;
    const float* xlat = from_input ? KIN(ka, 0) : KOUT(ka); const float* xctx = from_input ? KIN(ka, 2) : (const float*)(ws + WS_CX);
    bf16* H = (bf16*)(ws + WS_H);
    const bf16* xr = (const bf16*)KOUT(ka);
    const bool parts = (l == 1 && which == 0);
    const float* PP = (const float*)(ws + WS_Y); const float* gctx = (const float*)(ws + WS_MOD) + 5120 + 4 * 6144;
    f32x4 nxa[4], nxb[4];
#define NORM_LOAD(nx, mm) do { if ((mm) < MLAT && !from_input) { const v2u* q_ = (const v2u*)(xr + (size_t)(mm) * 2048) + I.lane; \
            _Pragma("unroll") for (int j = 0; j < 4; ++j) { const v2u t_ = q_[64 * j]; nx[j] = (f32x4){bf_lo(t_.x), bf_hi(t_.x), bf_lo(t_.y), bf_hi(t_.y)}; } } \
        else { const f32x4* q_ = (const f32x4*)((mm) < MLAT ? KIN(ka, 0) + (size_t)(mm) * D : xctx + (size_t)((mm) - MLAT) * D) + I.lane; \
            _Pragma("unroll") for (int j = 0; j < 4; ++j) nx[j] = q_[64 * j]; \
            if (parts && (mm) >= MLAT) { f32x4 s_[4]; _Pragma("unroll") for (int j = 0; j < 4; ++j) s_[j] = (f32x4){0.f, 0.f, 0.f, 0.f}; \
                _Pragma("unroll 4") for (int ks_ = 0; ks_ < 11; ++ks_) { const f32x4* p_ = (const f32x4*)(PP + ((size_t)ks_ * 1024 + ((mm) - MLAT)) * 1024) + I.lane; _Pragma("unroll") for (int j = 0; j < 4; ++j) s_[j] += p_[64 * j]; } \
                _Pragma("unroll") for (int j = 0; j < 4; ++j) nx[j] += ((const f32x4*)gctx)[I.lane + 64 * j] * s_[j]; } } } while (0)
#define NORM_ROW(nx, mm) do { f32x4 v[4]; float ss = 0.f; \
        _Pragma("unroll") for (int j = 0; j < 4; ++j) { v[j] = nx[j]; ss += (v[j].x * v[j].x + v[j].y * v[j].y) + (v[j].z * v[j].z + v[j].w * v[j].w); } \
        if ((mm) + 2 * I.NGW < nrows) NORM_LOAD(nx, (mm) + 2 * I.NGW); \
        const int cond = (mm) < MLAT ? (mm) / SEQ : 4; const float* sh = modl + cond * 6144; const float* sc = sh + 1024; \
        const float rstd = rsqrtf(wave_sum(ss) * (1.f / D) + 1e-6f); \
        unsigned long long* o8 = (unsigned long long*)(H + (size_t)(mm) * D) + I.lane; \
        _Pragma("unroll") for (int j = 0; j < 4; ++j) { const f32x4 gg = ((const f32x4*)g)[I.lane + 64 * j], s1 = ((const f32x4*)sc)[I.lane + 64 * j], s0 = ((const f32x4*)sh)[I.lane + 64 * j]; \
            const f32x4 y = v[j] * rstd * gg * (s1 + 1.0f) + s0; \
            o8[64 * j] = (unsigned long long)pk2(y.x, y.y) | ((unsigned long long)pk2(y.z, y.w) << 32); } } while (0)
    int m = I.gw;
    if (m < nrows) NORM_LOAD(nxa, m);
    if (m + I.NGW < nrows) NORM_LOAD(nxb, m + I.NGW);
    for (; m < nrows; m += 2 * I.NGW) {
        NORM_ROW(nxa, m);
        const int m1 = m + I.NGW; if (m1 >= nrows) break;
        NORM_ROW(nxb, m1);
    }
#undef NORM_ROW
#undef NORM_LOAD
}

__device__ __forceinline__ void phase_norm2_dyn(const Ids I_, LAS unsigned char* lds_base, int l, int nrows) {
    const Ids I = fresh(I_);
    const KA ka = ka_fresh(); unsigned char* ws = KWS(ka);
    const float* modl = (const float*)(ws + WS_MOD) + (size_t)l * 5 * 6144 + 3072;
    const float* g = KIN(ka, 19) + l * D;
    const float* xctx = (const float*)(ws + WS_CX); const bf16* xr = (const bf16*)KOUT(ka);
    bf16* H = (bf16*)(ws + WS_H);
    pg8::pg8_gu32* work = (pg8::pg8_gu32*)(ws + WS_CTL) + CW_WORK + 64 * (2 + l); pg8::pg8_gu32* cp_ = cnt_arr(ws, l, 4); pg8::pg8_gu32* tmo = (pg8::pg8_gu32*)(ws + WS_CTL) + CW_BAR + XB_TMO;
    const int nblk = nrows / 64;
#define N2_CLAIM_WAIT(claim_) do { const int b_ = (int)(claim_); \
        if (b_ < nblk) { unsigned sp_ = 0; \
            while (__hip_atomic_load(cp_ + 64 * (b_ >> 2), __ATOMIC_RELAXED, __HIP_MEMORY_SCOPE_AGENT) < 32u) { __builtin_amdgcn_s_sleep(2); \
                if ((++sp_ & 255u) == 0u) { if (__hip_atomic_load(tmo, __ATOMIC_RELAXED, __HIP_MEMORY_SCOPE_AGENT) != 0u) break; if (sp_ > (1u << 20)) { __hip_atomic_fetch_add(tmo, 1u, __ATOMIC_RELAXED, __HIP_MEMORY_SCOPE_AGENT); break; } } } \
            __builtin_amdgcn_fence(__ATOMIC_ACQUIRE, "agent"); asm volatile("s_waitcnt vmcnt(0)" ::: "memory"); } } while (0)
#define N2_LOAD(nx, mm) do { if ((mm) < MLAT) { const v2u* q_ = (const v2u*)(xr + (size_t)(mm) * 2048) + I.lane; \
            _Pragma("unroll") for (int j = 0; j < 4; ++j) { const v2u t_ = q_[64 * j]; nx[j] = (f32x4){bf_lo(t_.x), bf_hi(t_.x), bf_lo(t_.y), bf_hi(t_.y)}; } } \
        else { const f32x4* q_ = (const f32x4*)(xctx + (size_t)((mm) - MLAT) * D) + I.lane; _Pragma("unroll") for (int j = 0; j < 4; ++j) nx[j] = q_[64 * j]; } } while (0)
#define N2_ROW(nx, mm, mend) do { f32x4 v[4]; float ss = 0.f; \
        _Pragma("unroll") for (int j = 0; j < 4; ++j) { v[j] = nx[j]; ss += (v[j].x * v[j].x + v[j].y * v[j].y) + (v[j].z * v[j].z + v[j].w * v[j].w); } \
        if ((mm) + 16 < (mend)) N2_LOAD(nx, (mm) + 16); \
        const int cond = (mm) < MLAT ? (mm) / SEQ : 4; const float* sh = modl + cond * 6144; const float* sc = sh + 1024; \
        const float rstd = rsqrtf(wave_sum(ss) * (1.f / D) + 1e-6f); \
        unsigned long long* o8 = (unsigned long long*)(H + (size_t)(mm) * D) + I.lane; \
        _Pragma("unroll") for (int j = 0; j < 4; ++j) { const f32x4 gg = ((const f32x4*)g)[I.lane + 64 * j], s1 = ((const f32x4*)sc)[I.lane + 64 * j], s0 = ((const f32x4*)sh)[I.lane + 64 * j]; \
            const f32x4 y = v[j] * rstd * gg * (s1 + 1.0f) + s0; \
            o8[64 * j] = (unsigned long long)pk2(y.x, y.y) | ((unsigned long long)pk2(y.z, y.w) << 32); } } while (0)
    volatile LAS unsigned* slot = (volatile LAS unsigned*)(lds_base + MISC_OFF) + 44;
    if (I.tid == 0) { const unsigned c0 = __hip_atomic_fetch_add(work, 1u, __ATOMIC_RELAXED, __HIP_MEMORY_SCOPE_AGENT); N2_CLAIM_WAIT(c0); slot[0] = c0; }
    __syncthreads();
    int blk = (int)slot[0], par = 0;
    while (blk < nblk) {
        unsigned nclaim = 0u;
        if (I.tid == 0) nclaim = __hip_atomic_fetch_add(work, 1u, __ATOMIC_RELAXED, __HIP_MEMORY_SCOPE_AGENT);
        {
            const int mend = blk * 64 + 64; int m = blk * 64 + I.wave;
            f32x4 nxa[4], nxb[4];
            N2_LOAD(nxa, m); N2_LOAD(nxb, m + 8);
            for (; m < mend; m += 16) { N2_ROW(nxa, m, mend); N2_ROW(nxb, m + 8, mend); }
        }
        if (I.tid == 0) { N2_CLAIM_WAIT(nclaim); slot[par ^ 1] = nclaim; }
        __syncthreads();
        par ^= 1; blk = (int)slot[par];
    }
    if (I.tid < 64) {
        const int np = nrows / 256; unsigned sp = 0;
        for (;;) { bool ok = true; for (int p = I.lane; p < np; p += 64) ok = ok && __hip_atomic_load(cp_ + 64 * p, __ATOMIC_RELAXED, __HIP_MEMORY_SCOPE_AGENT) >= 32u;
            if (__builtin_amdgcn_ballot_w64(!ok) == 0ull) break;
            __builtin_amdgcn_s_sleep(127);
            if ((++sp & 15u) == 0u) { if (__hip_atomic_load(tmo, __ATOMIC_RELAXED, __HIP_MEMORY_SCOPE_AGENT) != 0u) break; if (sp > (1u << 14)) { if (I.tid == 0) __hip_atomic_fetch_add(tmo, 1u, __ATOMIC_RELAXED, __HIP_MEMORY_SCOPE_AGENT); break; } } }
    }
    __syncthreads();
#undef N2_ROW
#undef N2_LOAD
#undef N2_CLAIM_WAIT
}

__device__ const unsigned short CONV_PERM[544] = { 0, 1, 2, 3, 4, 5, 6, 73, 74, 75, 76, 77, 78, 137, 138, 139, 140, 141, 142, 209, 210, 211, 212, 213, 214, 273, 274, 275, 276, 277, 278, 345, 346, 347, 348, 349, 350, 409, 410, 411, 412, 413, 414, 481, 482, 483, 484, 485, 486, 7, 8, 9, 10, 11, 12, 13, 14, 15, 16, 17, 18, 19, 20, 21, 22, 79, 80, 81, 82, 83, 84, 85, 86, 87, 88, 89, 90, 91, 92, 93, 94, 143, 144, 145, 146, 147, 148, 149, 150, 151, 152, 153, 154, 155, 156, 157, 158, 215, 216, 217, 218, 219, 220, 221, 222, 223, 224, 225, 226, 227, 228, 229, 230, 279, 280, 281, 282, 283, 284, 285, 286, 287, 288, 289, 290, 291, 292, 293, 294, 351, 352, 353, 354, 355, 356, 357, 358, 359, 360, 361, 362, 363, 364, 365, 366, 415, 416, 417, 418, 419, 420, 421, 422, 423, 424, 425, 426, 427, 428, 429, 430, 487, 488, 489, 490, 491, 492, 493, 494, 495, 496, 497, 498, 499, 500, 501, 502, 23, 24, 25, 26, 27, 28, 29, 30, 31, 32, 33, 34, 35, 36, 37, 38, 95, 96, 97, 98, 99, 100, 101, 102, 103, 104, 105, 106, 107, 108, 109, 110, 159, 160, 161, 162, 163, 164, 165, 166, 167, 168, 169, 170, 171, 172, 173, 174, 231, 232, 233, 234, 235, 236, 237, 238, 239, 240, 241, 242, 243, 244, 245, 246, 295, 296, 297, 298, 299, 300, 301, 302, 303, 304, 305, 306, 307, 308, 309, 310, 367, 368, 369, 370, 371, 372, 373, 374, 375, 376, 377, 378, 379, 380, 381, 382, 431, 432, 433, 434, 435, 436, 437, 438, 439, 440, 441, 442, 443, 444, 445, 446, 503, 504, 505, 506, 507, 508, 509, 510, 511, 512, 513, 514, 515, 516, 517, 518, 39, 40, 41, 42, 43, 44, 45, 46, 47, 48, 49, 50, 51, 52, 53, 54, 111, 112, 113, 114, 115, 116, 117, 118, 119, 120, 121, 122, 123, 124, 125, 126, 175, 176, 177, 178, 179, 180, 181, 182, 183, 184, 185, 186, 187, 188, 189, 190, 247, 248, 249, 250, 251, 252, 253, 254, 255, 256, 257, 258, 259, 260, 261, 262, 311, 312, 313, 314, 315, 316, 317, 318, 319, 320, 321, 322, 323, 324, 325, 326, 383, 384, 385, 386, 387, 388, 389, 390, 391, 392, 393, 394, 395, 396, 397, 398, 447, 448, 449, 450, 451, 452, 453, 454, 455, 456, 457, 458, 459, 460, 461, 462, 519, 520, 521, 522, 523, 524, 525, 526, 527, 528, 529, 530, 531, 532, 533, 534, 55, 56, 57, 58, 59, 60, 61, 62, 63, 64, 65, 66, 67, 68, 69, 70, 71, 72, 127, 128, 129, 130, 131, 132, 133, 134, 135, 136, 191, 192, 193, 194, 195, 196, 197, 198, 199, 200, 201, 202, 203, 204, 205, 206, 207, 208, 263, 264, 265, 266, 267, 268, 269, 270, 271, 272, 327, 328, 329, 330, 331, 332, 333, 334, 335, 336, 337, 338, 339, 340, 341, 342, 343, 344, 399, 400, 401, 402, 403, 404, 405, 406, 407, 408, 463, 464, 465, 466, 467, 468, 469, 470, 471, 472, 473, 474, 475, 476, 477, 478, 479, 480, 535, 536, 537, 538, 539, 540, 541, 542, 543 };
__device__ __forceinline__ void phase_conv(const Ids I_, LAS unsigned char* lds_base, int l) {
    const Ids I = fresh(I_);
    const KA ka = ka_fresh(); unsigned char* ws = KWS(ka);
    bf16* XBC = (bf16*)(ws + WS_XBC); const bf16* HALO = (const bf16*)(ws + WS_Y);
    const int c0 = I.tid * 8;
    pg8::pg8_gu32* work = (pg8::pg8_gu32*)(ws + WS_CTL) + CW_WORK + 64 * (5 + l); const pg8::pg8_gu32* cb_ = cnt_arr(ws, l, 3); pg8::pg8_gu32* tmo = (pg8::pg8_gu32*)(ws + WS_CTL) + CW_BAR + XB_TMO;
#define CV_CLAIM_WAIT(claim_, out_) do { unsigned id_ = 0xffffu; \
        if ((claim_) < 544u) { id_ = CONV_PERM[claim_]; const int rb_ = 32 * (int)id_; const int p0_ = (rb_ - 2 < 0 ? 0 : rb_ - 2) >> 8, p1_ = (rb_ + 33 >= MTOT ? MTOT - 1 : rb_ + 33) >> 8; unsigned sp_ = 0; \
            for (;;) { bool ok_ = __hip_atomic_load(cb_ + 64 * p0_, __ATOMIC_RELAXED, __HIP_MEMORY_SCOPE_AGENT) >= 136u; if (ok_ && p1_ != p0_) ok_ = __hip_atomic_load(cb_ + 64 * p1_, __ATOMIC_RELAXED, __HIP_MEMORY_SCOPE_AGENT) >= 136u; \
                if (ok_) break; __builtin_amdgcn_s_sleep(2); \
                if ((++sp_ & 255u) == 0u) { if (__hip_atomic_load(tmo, __ATOMIC_RELAXED, __HIP_MEMORY_SCOPE_AGENT) != 0u) break; if (sp_ > (1u << 20)) { __hip_atomic_fetch_add(tmo, 1u, __ATOMIC_RELAXED, __HIP_MEMORY_SCOPE_AGENT); break; } } } \
            __builtin_amdgcn_fence(__ATOMIC_ACQUIRE, "agent"); asm volatile("s_waitcnt vmcnt(0)" ::: "memory"); } \
        out_ = id_; } while (0)
    volatile LAS unsigned* slot = (volatile LAS unsigned*)(lds_base + MISC_OFF) + 50;
    if (I.tid == 0) { const unsigned c0_ = __hip_atomic_fetch_add(work, 1u, __ATOMIC_RELAXED, __HIP_MEMORY_SCOPE_AGENT); unsigned id0; CV_CLAIM_WAIT(c0_, id0); slot[0] = id0; }
    __syncthreads();
    unsigned uid = slot[0]; int par = 0;
    const float* cw = KIN(ka, 8) + (size_t)l * 5 * XBCW + c0; const float* cb = KIN(ka, 9) + (size_t)l * XBCW + c0;
    float w[5][8], bias[8];
#pragma unroll
    for (int i = 0; i < 5; ++i) { const f32x4 a = *(const f32x4*)(cw + i * XBCW), b = *(const f32x4*)(cw + i * XBCW + 4); w[i][0] = a.x; w[i][1] = a.y; w[i][2] = a.z; w[i][3] = a.w; w[i][4] = b.x; w[i][5] = b.y; w[i][6] = b.z; w[i][7] = b.w; }
    { const f32x4 a = *(const f32x4*)cb, b = *(const f32x4*)(cb + 4); bias[0] = a.x; bias[1] = a.y; bias[2] = a.z; bias[3] = a.w; bias[4] = b.x; bias[5] = b.y; bias[6] = b.z; bias[7] = b.w; }
    const v4u zero4 = {0u, 0u, 0u, 0u};
    while (uid != 0xffffu) {
    unsigned nclaim = 0u;
    if (I.tid == 0) nclaim = __hip_atomic_fetch_add(work, 1u, __ATOMIC_RELAXED, __HIP_MEMORY_SCOPE_AGENT);
    const int u0 = (int)uid, rbase = 32 * u0;
#define LDROW(q_) ([&](int q) -> v4u { if (q < 0 || q >= MTOT) return zero4; \
        const bf16* p = q < rbase ? HALO + (size_t)((u0 - 1) * 4 + 2 + (q - (rbase - 2))) * XBCW : (q >= rbase + 32 ? HALO + (size_t)((u0 + 1) * 4 + (q - rbase - 32)) * XBCW : XBC + (size_t)q * XBCW); \
        return *(const v4u*)(p + c0); })(q_)
#define UNPK(dst, v_) do { dst[0] = bf_lo(v_.x); dst[1] = bf_hi(v_.x); dst[2] = bf_lo(v_.y); dst[3] = bf_hi(v_.y); dst[4] = bf_lo(v_.z); dst[5] = bf_hi(v_.z); dst[6] = bf_lo(v_.w); dst[7] = bf_hi(v_.w); } while (0)
    float f0[8], f1[8], f2[8], f3[8];
    { const v4u a0 = LDROW(rbase - 2), a1 = LDROW(rbase - 1), a2 = LDROW(rbase), a3 = LDROW(rbase + 1); UNPK(f0, a0); UNPK(f1, a1); UNPK(f2, a2); UNPK(f3, a3); }
    v4u q0 = LDROW(rbase + 2), q1 = LDROW(rbase + 3), q2 = LDROW(rbase + 4), q3 = LDROW(rbase + 5);
    for (int it = 0; it < 8; ++it) {
        const v4u c0v = q0, c1v = q1, c2v = q2, c3v = q3;
        const int nb = rbase + 2 + 4 * (it + 1);
        if (it + 1 < 8) { q0 = LDROW(nb); q1 = LDROW(nb + 1); q2 = LDROW(nb + 2); q3 = LDROW(nb + 3); }
#pragma unroll
        for (int k = 0; k < 4; ++k) {
            const v4u w4 = k == 0 ? c0v : (k == 1 ? c1v : (k == 2 ? c2v : c3v));
            float f4[8]; UNPK(f4, w4);
            const int r = rbase + 4 * it + k;
            const int s0 = r < MLAT ? (r & ~(SEQ - 1)) : (MLAT + ((r - MLAT) & ~(CTXL - 1))), e0 = s0 + (r < MLAT ? SEQ : CTXL);
            float o[8];
            if (r - 2 >= s0 && r + 2 < e0) {
#pragma unroll
                for (int j = 0; j < 8; ++j) o[j] = bias[j] + w[0][j] * f0[j] + w[1][j] * f1[j] + w[2][j] * f2[j] + w[3][j] * f3[j] + w[4][j] * f4[j];
            } else {
                const float m0 = (r - 2 >= s0) ? 1.f : 0.f, m1 = (r - 1 >= s0) ? 1.f : 0.f, m3 = (r + 1 < e0) ? 1.f : 0.f, m4 = (r + 2 < e0) ? 1.f : 0.f;
#pragma unroll
                for (int j = 0; j < 8; ++j) o[j] = bias[j] + m0 * w[0][j] * f0[j] + m1 * w[1][j] * f1[j] + w[2][j] * f2[j] + m3 * w[3][j] * f3[j] + m4 * w[4][j] * f4[j];
            }
#pragma unroll
            for (int j = 0; j < 8; ++j) o[j] = o[j] * __builtin_amdgcn_rcpf(1.f + __expf(-o[j]));
            v4u ov; ov.x = pk2(o[0], o[1]); ov.y = pk2(o[2], o[3]); ov.z = pk2(o[4], o[5]); ov.w = pk2(o[6], o[7]);
            *(v4u*)(XBC + (size_t)r * XBCW + c0) = ov;
#pragma unroll
            for (int j = 0; j < 8; ++j) { f0[j] = f1[j]; f1[j] = f2[j]; f2[j] = f3[j]; f3[j] = f4[j]; }
        }
    }
    if (I.tid == 0) { unsigned idn; CV_CLAIM_WAIT(nclaim, idn); slot[par ^ 1] = idn; }
    __syncthreads();
    par ^= 1; uid = slot[par];
    }
#undef UNPK
#undef LDROW
#undef CV_CLAIM_WAIT
}

__device__ __forceinline__ void phase_ssd(const Ids I_, LAS unsigned char* lds, int l) {
    const Ids I = fresh(I_);
    const KA ka = ka_fresh(); unsigned char* ws = KWS(ka);
    const bf16* XBC = (const bf16*)(ws + WS_XBC); const float* DT = (const float*)(ws + WS_DT); bf16* Y = (bf16*)(ws + WS_Y);
    const int tid = I.tid, id = I.vcu, b = id >> 6, h = (id >> 1) & 31, ph = id & 1, grp = h >> 2;
    const int pl = tid >> 4, nq = tid & 15;
    LAS float* XS = (LAS float*)lds;
    LAS unsigned char* BT = lds + 8192;
    LAS unsigned char* CT = lds + 24576;
    LAS float* DTT = (LAS float*)(lds + 40960);
    LAS float* YB = (LAS float*)(lds + 41216);
    const float Dsum = KIN(ka, 12)[l * 64 + h] + KIN(ka, 12)[l * 64 + 32 + h];
    for (int dir = 0; dir < 2; ++dir) {
        const float A = -__expf(KIN(ka, 11)[l * 64 + dir * 32 + h]);
        float S[8];
#pragma unroll
        for (int i = 0; i < 8; ++i) S[i] = 0.f;
        for (int part = 0; part < 2; ++part) {
            const int rows0 = part == 0 ? MLAT + b * CTXL : b * SEQ, ntile = (part == 0 ? CTXL : SEQ) / 64;
            for (int ti = 0; ti < ntile; ++ti) {
                const int tile = dir ? ntile - 1 - ti : ti, r0 = rows0 + tile * 64;
                __syncthreads();
#pragma unroll
                for (int q = 0; q < 2; ++q) { const int ch = tid + q * 512, row = ch >> 4, c16 = ch & 15;
                    *(LAS v4u*)(BT + ch * 16) = *(const v4u*)(XBC + (size_t)(r0 + row) * XBCW + 2048 + grp * 128 + c16 * 8);
                    *(LAS v4u*)(CT + ch * 16) = *(const v4u*)(XBC + (size_t)(r0 + row) * XBCW + 3072 + grp * 128 + c16 * 8); }
                if (tid < 256) { const int row = tid >> 2, c = tid & 3; const v4u xv = *(const v4u*)(XBC + (size_t)(r0 + row) * XBCW + h * 64 + ph * 32 + c * 8);
                    LAS float* d = XS + row * 32 + c * 8; d[0] = bf_lo(xv.x); d[1] = bf_hi(xv.x); d[2] = bf_lo(xv.y); d[3] = bf_hi(xv.y); d[4] = bf_lo(xv.z); d[5] = bf_hi(xv.z); d[6] = bf_lo(xv.w); d[7] = bf_hi(xv.w);
                    if (dir == 1) { const v4u yv = *(const v4u*)(Y + (size_t)(r0 + row) * DI + h * 64 + ph * 32 + c * 8);
                        LAS float* e = YB + row * 32 + c * 8; e[0] = bf_lo(yv.x); e[1] = bf_hi(yv.x); e[2] = bf_lo(yv.y); e[3] = bf_hi(yv.y); e[4] = bf_lo(yv.z); e[5] = bf_hi(yv.z); e[6] = bf_lo(yv.w); e[7] = bf_hi(yv.w); } }
                else if (tid < 320) DTT[tid - 256] = DT[(size_t)(dir * 32 + h) * MTOT + r0 + tid - 256];
                __syncthreads();
                for (int s = 0; s < 64; ++s) {
                    const int tt = dir ? 63 - s : s;
                    const float dtv = DTT[tt], a = __expf(dtv * A), xv = XS[tt * 32 + pl], xdt = xv * dtv;
                    const v4u bv = *(const LAS v4u*)(BT + tt * 256 + nq * 16), cv = *(const LAS v4u*)(CT + tt * 256 + nq * 16);
                    float yp;
                    S[0] = S[0] * a + xdt * bf_lo(bv.x); yp = bf_lo(cv.x) * S[0];
                    S[1] = S[1] * a + xdt * bf_hi(bv.x); yp += bf_hi(cv.x) * S[1];
                    S[2] = S[2] * a + xdt * bf_lo(bv.y); yp += bf_lo(cv.y) * S[2];
                    S[3] = S[3] * a + xdt * bf_hi(bv.y); yp += bf_hi(cv.y) * S[3];
                    S[4] = S[4] * a + xdt * bf_lo(bv.z); yp += bf_lo(cv.z) * S[4];
                    S[5] = S[5] * a + xdt * bf_hi(bv.z); yp += bf_hi(cv.z) * S[5];
                    S[6] = S[6] * a + xdt * bf_lo(bv.w); yp += bf_lo(cv.w) * S[6];
                    S[7] = S[7] * a + xdt * bf_hi(bv.w); yp += bf_hi(cv.w) * S[7];
                    yp += pg8::lane_xor<1>(yp); yp += pg8::lane_xor<2>(yp); yp += pg8::lane_xor<4>(yp); yp += pg8::lane_xor<8>(yp);
                    if (nq == 0) { if (dir == 0) YB[tt * 32 + pl] = yp + Dsum * xv; else YB[tt * 32 + pl] += yp; }
                }
                __syncthreads();
                if (tid < 256) { const int row = tid >> 2, c = tid & 3; const LAS float* e = YB + row * 32 + c * 8;
                    v4u o; o.x = pk2(e[0], e[1]); o.y = pk2(e[2], e[3]); o.z = pk2(e[4], e[5]); o.w = pk2(e[6], e[7]);
                    *(v4u*)(Y + (size_t)(r0 + row) * DI + h * 64 + ph * 32 + c * 8) = o; }
            }
        }
        VM_WAIT(); __syncthreads();
    }
}

namespace ssd {
typedef short bf16x8 __attribute__((ext_vector_type(8)));
typedef short s16x4 __attribute__((ext_vector_type(4)));
constexpr int ROW = 272;
constexpr int L_CS = 0, L_BS = 34816, L_XN = 69632  , L_XF = 79872, L_XB = 88576, L_XD = 97280, L_SS0 = 105984, L_SS1 = 114688;
constexpr int L_TAB = 123392;
constexpr int L_DT = L_TAB + 4096;
#define SSD_MFMA(a, b, c) __builtin_amdgcn_mfma_f32_16x16x32_bf16((a), (b), (c), 0, 0, 0)
template <int N> __device__ __forceinline__ float row_shr(float v) { return __int_as_float(__builtin_amdgcn_update_dpp(0, __float_as_int(v), 0x110 + N, 0xf, 0xf, false)); }
__device__ __forceinline__ void scan128(LAS float* dst, LAS float* ej, const LAS float* dt, float A, bool reverse, int lane) {
    const int e0 = reverse ? 127 - 2 * lane : 2 * lane, e1 = reverse ? 126 - 2 * lane : 2 * lane + 1;
    const float v0 = dt[e0] * A, v1 = dt[e1] * A; float sc = v0 + v1;
    sc += row_shr<1>(sc); sc += row_shr<2>(sc); sc += row_shr<4>(sc); sc += row_shr<8>(sc);
    const float t0 = __int_as_float(__builtin_amdgcn_readlane(__float_as_int(sc), 15)), t1 = __int_as_float(__builtin_amdgcn_readlane(__float_as_int(sc), 31)), t2 = __int_as_float(__builtin_amdgcn_readlane(__float_as_int(sc), 47));
    const int row = lane >> 4; sc += (row >= 1 ? t0 : 0.f) + (row >= 2 ? t1 : 0.f) + (row >= 3 ? t2 : 0.f);
    const float ex = sc - (v0 + v1), c0 = ex + v0, c1 = ex + v0 + v1; dst[e0] = c0; dst[e1] = c1;
    LDS_WAIT(); asm volatile("" ::: "memory");
    const float ref = dst[reverse ? (e0 & ~15) : (e0 | 15)];
    ej[e0] = __expf(ref - c0) * dt[e0]; ej[e1] = __expf(ref - c1) * dt[e1];
}
__device__ __forceinline__ bf16x8 pack8f(const float (&m)[8]) { v4u t; t.x = pk2(m[0], m[1]); t.y = pk2(m[2], m[3]); t.z = pk2(m[4], m[5]); t.w = pk2(m[6], m[7]); return __builtin_bit_cast(bf16x8, t); }
__device__ __forceinline__ bf16x8 ld2x8(const LAS unsigned char* p0, const LAS unsigned char* p1) { const v2u a = *(const LAS v2u*)p0, b = *(const LAS v2u*)p1; v4u t; t.x = a.x; t.y = a.y; t.z = b.x; t.w = b.y; return __builtin_bit_cast(bf16x8, t); }
__device__ __forceinline__ unsigned short bf1(float v) { return (unsigned short)(pk2(v, 0.f) & 0xffffu); }
}

template <int SWEEP> __device__ __forceinline__ void ssd_sweep(const Ids I_, LAS unsigned char* lds, int l) {
    constexpr int sweep = SWEEP, NSET = SWEEP ? 2 : 1;
    using namespace ssd;
    const Ids I = fresh(I_);
    const KA ka = ka_fresh(); unsigned char* ws = KWS(ka);
    const bf16* XBC = (const bf16*)(ws + WS_XBC); const float* DT = (const float*)(ws + WS_DT); bf16* Y = (bf16*)(ws + WS_Y);
    const int tid = I.tid, lane = I.lane, w = I.wave, li = lane & 15, lg = lane >> 4;
    const int id = I.vcu, b = id >> 6, h = (id >> 1) & 31, ph = id & 1, grp = h >> 2;
    const float Dsum = KIN(ka, 12)[l * 64 + h] + KIN(ka, 12)[l * 64 + 32 + h];
    const float A_f = -__expf(KIN(ka, 11)[l * 64 + h]), A_b = -__expf(KIN(ka, 11)[l * 64 + 32 + h]);
    const size_t xcol = (size_t)h * 64 + ph * 32;
    const int srow = tid >> 2, sc4 = tid & 3;

    {
        auto row_of = [&](int idx) -> int { const int c = idx < 2 ? (sweep ? 1 - idx : idx) : (sweep ? 31 - (idx - 2) : idx - 2); return idx < 2 ? MLAT + b * CTXL + 128 * c : b * SEQ + 128 * c; };
#define SSD_TAB(par) ((LAS float*)(lds + L_TAB + (par) * 2048))
#define SSD_DTP(par) ((LAS float*)(lds + L_DT + (par) * 1024))
#define SSD_LDDT(idx_) (DT[(size_t)((tid >> 7) * 32 + h) * MTOT + row_of(idx_) + (tid & 127)])
#define SSD_SCAN(par) do { if (sweep == 0) { if (w == 0) scan128(SSD_TAB(par), SSD_TAB(par) + 256, SSD_DTP(par), A_f, false, lane); else if (w == 1) scan128(SSD_TAB(par) + 128, SSD_TAB(par) + 384, SSD_DTP(par) + 128, A_b, true, lane); } \
        else { if (w == 0) scan128(SSD_TAB(par) + 128, SSD_TAB(par) + 384, SSD_DTP(par) + 128, A_b, true, lane); } } while (0)
        v4u pc[NSET][4], pb[NSET][4], px[NSET]; float pdt = 0.f;
#define SSD_ISSUE(idx_, u_) do { const int r0_ = row_of(idx_); \
        _Pragma("unroll") for (int q = 0; q < 4; ++q) { const int ch = tid + 512 * q, row = ch >> 4, c16 = ch & 15; \
            pc[u_][q] = *(const v4u*)(XBC + (size_t)(r0_ + row) * XBCW + 3072 + grp * 128 + c16 * 8); pb[u_][q] = *(const v4u*)(XBC + (size_t)(r0_ + row) * XBCW + 2048 + grp * 128 + c16 * 8); } \
        px[u_] = *(const v4u*)(XBC + (size_t)(r0_ + srow) * XBCW + xcol + sc4 * 8); } while (0)
        __syncthreads();
        for (int i = tid; i < (2 * 8704) / 4; i += NWAVES * 64) ((LAS unsigned*)(lds + L_SS0))[i] = 0u;
        f32x4 sacc[2] = {{0.f, 0.f, 0.f, 0.f}, {0.f, 0.f, 0.f, 0.f}};
        _Pragma("unroll") for (int u = 0; u < NSET; ++u) SSD_ISSUE(u, u);
        if (tid < 256) SSD_DTP(0)[tid] = SSD_LDDT(0);
        __syncthreads();
        SSD_SCAN(0);
        if (tid < 256) pdt = SSD_LDDT(1);
        for (int idx0 = 0; idx0 < 34; idx0 += NSET)
#pragma unroll
        for (int u = 0; u < NSET; ++u) {
            const int idx = idx0 + u;
            const int r0 = row_of(idx), par = idx & 1;
            const bool need_y = !(l == 1 && idx < 2);
            LAS unsigned char* SScur = lds + (par ? L_SS1 : L_SS0); LAS unsigned char* SSnxt = lds + (par ? L_SS0 : L_SS1);
            LAS float* AF = SSD_TAB(par); LAS float* RB = AF + 128; LAS float* EJF = AF + 256; LAS float* EJB = AF + 384; LAS float* DTF = SSD_DTP(par); LAS float* DTB = DTF + 128;
            __syncthreads();
#pragma unroll
            for (int q = 0; q < 4; ++q) { const int ch = tid + 512 * q, row = ch >> 4, c16 = ch & 15; *(LAS v4u*)(lds + L_CS + row * ROW + c16 * 16) = pc[u][q]; *(LAS v4u*)(lds + L_BS + row * ROW + c16 * 16) = pb[u][q]; }
            *(LAS v4u*)(lds + L_XN + srow * 80 + sc4 * 16) = px[u];
            {
                const v4u pxu = px[u]; const float xv[8] = {bf_lo(pxu.x), bf_hi(pxu.x), bf_lo(pxu.y), bf_hi(pxu.y), bf_lo(pxu.z), bf_hi(pxu.z), bf_lo(pxu.w), bf_hi(pxu.w)};
                LAS unsigned short* xf = (LAS unsigned short*)(lds + L_XF + (4 * sc4) * ROW) + srow; LAS unsigned short* xb = (LAS unsigned short*)(lds + L_XB + (4 * sc4) * ROW) + srow; LAS unsigned short* xd = (LAS unsigned short*)(lds + L_XD + (4 * sc4) * ROW) + srow;
                if (sweep == 0) { const float f = DTF[srow], gg = DTB[srow], e = f * __expf(AF[127] - AF[srow]);
#pragma unroll
                    for (int q = 0; q < 8; ++q) { const int ro = (16 * (q >> 2) + (q & 3)) * (ROW / 2); xf[ro] = bf1(xv[q]); xd[ro] = bf1(xv[q] * e); } (void)gg; (void)xb; }
                else { const float e = DTB[srow] * __expf(RB[0] - RB[srow]);
#pragma unroll
                    for (int q = 0; q < 8; ++q) xd[(16 * (q >> 2) + (q & 3)) * (ROW / 2)] = bf1(xv[q] * e); }
            }
            if (tid < 256 && idx + 1 < 34) SSD_DTP(par ^ 1)[tid] = pdt;
            __syncthreads();
            if (idx + NSET < 34) SSD_ISSUE(idx + NSET, u);
            if (idx + 1 < 34) SSD_SCAN(par ^ 1);
            if (tid < 256 && idx + 2 < 34) pdt = SSD_LDDT(idx + 2);
            v4u yold = {0u, 0u, 0u, 0u};
            if (sweep == 1 && need_y) yold = *(const v4u*)(Y + (size_t)(r0 + 16 * w + li) * DI + xcol + 8 * lg);
            bf16x8 cf[4];
#pragma unroll
            for (int ks = 0; ks < 4; ++ks) cf[ks] = *(const LAS bf16x8*)(lds + L_CS + (16 * w + li) * ROW + (32 * ks + 8 * lg) * 2);
            f32x4 yacc[2] = {{0.f, 0.f, 0.f, 0.f}, {0.f, 0.f, 0.f, 0.f}}, yi[2] = {{0.f, 0.f, 0.f, 0.f}, {0.f, 0.f, 0.f, 0.f}};
            if (need_y) {
            {
                bf16x8 sf[8];
#pragma unroll
                for (int ks = 0; ks < 4; ++ks)
#pragma unroll
                    for (int pt = 0; pt < 2; ++pt) sf[2 * ks + pt] = *(const LAS bf16x8*)(SScur + (16 * pt + li) * ROW + (32 * ks + 8 * lg) * 2);
                __builtin_amdgcn_sched_barrier(0);
#pragma unroll
                for (int ks = 0; ks < 4; ++ks)
#pragma unroll
                    for (int pt = 0; pt < 2; ++pt) yi[pt] = SSD_MFMA(sf[2 * ks + pt], cf[ks], yi[pt]);
            }
            float escale;
            if (sweep == 0) {
                const float af_i = AF[16 * w + li], rb_i = RB[16 * w + li];
                escale = __expf(af_i);
                f32x4 g[8];
                {
                    bf16x8 fa[8], fb[8];
#define SSD_GLOAD(dst, jp) do { _Pragma("unroll") for (int q_ = 0; q_ < 8; ++q_) dst[q_] = *(const LAS bf16x8*)(lds + L_BS + (16 * (2 * (jp) + (q_ >> 2)) + li) * ROW + (32 * (q_ & 3) + 8 * lg) * 2); } while (0)
#define SSD_GMMA(src, jp) do { g[2 * (jp)] = (f32x4){0.f, 0.f, 0.f, 0.f}; g[2 * (jp) + 1] = (f32x4){0.f, 0.f, 0.f, 0.f}; \
                        _Pragma("unroll") for (int q_ = 0; q_ < 8; ++q_) g[2 * (jp) + (q_ >> 2)] = SSD_MFMA(src[q_], cf[q_ & 3], g[2 * (jp) + (q_ >> 2)]); } while (0)
                    SSD_GLOAD(fa, 0); __builtin_amdgcn_sched_barrier(0);
                    SSD_GLOAD(fb, 1); __builtin_amdgcn_sched_barrier(0); SSD_GMMA(fa, 0); __builtin_amdgcn_sched_barrier(0);
                    SSD_GLOAD(fa, 2); __builtin_amdgcn_sched_barrier(0); SSD_GMMA(fb, 1); __builtin_amdgcn_sched_barrier(0);
                    SSD_GLOAD(fb, 3); __builtin_amdgcn_sched_barrier(0); SSD_GMMA(fa, 2); __builtin_amdgcn_sched_barrier(0);
                    SSD_GMMA(fb, 3); __builtin_amdgcn_sched_barrier(0);
#undef SSD_GLOAD
#undef SSD_GMMA
                }
#define SSD_TILE_F(t, mo) do { if ((t) < w) { const float ei = __expf(af_i - AF[16 * (t) + 15]); const f32x4 ejv = *(const LAS f32x4*)(EJF + 16 * (t) + 4 * lg); \
                        _Pragma("unroll") for (int r = 0; r < 4; ++r) m[(mo) + r] = g[t][r] * (ei * ejv[r]); } \
                    else if ((t) == w) { const f32x4 av = *(const LAS f32x4*)(AF + 16 * (t) + 4 * lg), dv = *(const LAS f32x4*)(DTF + 16 * (t) + 4 * lg); \
                        _Pragma("unroll") for (int r = 0; r < 4; ++r) m[(mo) + r] = (4 * lg + r <= li) ? g[t][r] * (dv[r] * __expf(fminf(af_i - av[r], 0.f))) : 0.f; } \
                    else { _Pragma("unroll") for (int r = 0; r < 4; ++r) m[(mo) + r] = 0.f; } } while (0)
#define SSD_TILE_B(t, mo) do { if ((t) > w) { const float ei = __expf(rb_i - RB[16 * (t)]); const f32x4 ejv = *(const LAS f32x4*)(EJB + 16 * (t) + 4 * lg); \
                        _Pragma("unroll") for (int r = 0; r < 4; ++r) m[(mo) + r] = g[t][r] * (ei * ejv[r]); } \
                    else if ((t) == w) { const f32x4 av = *(const LAS f32x4*)(RB + 16 * (t) + 4 * lg), dv = *(const LAS f32x4*)(DTB + 16 * (t) + 4 * lg); \
                        _Pragma("unroll") for (int r = 0; r < 4; ++r) m[(mo) + r] = (4 * lg + r >= li) ? g[t][r] * (dv[r] * __expf(fminf(rb_i - av[r], 0.f))) : 0.f; } \
                    else { _Pragma("unroll") for (int r = 0; r < 4; ++r) m[(mo) + r] = 0.f; } } while (0)
#pragma unroll
                for (int kk = 0; kk < 4; ++kk) {
                    const int t0 = 2 * kk, t1 = 2 * kk + 1;
                    if (t0 <= w) {
                        float m[8]; SSD_TILE_F(t0, 0); SSD_TILE_F(t1, 4);
                        const bf16x8 bfr = pack8f(m);
#pragma unroll
                        for (int pt = 0; pt < 2; ++pt) { const LAS unsigned char* rp = lds + L_XF + (16 * pt + li) * ROW; const bf16x8 a = ld2x8(rp + (32 * kk + 4 * lg) * 2, rp + (32 * kk + 16 + 4 * lg) * 2); yacc[pt] = SSD_MFMA(a, bfr, yacc[pt]); }
                    }
                    if (t1 >= w) {
                        float m[8]; SSD_TILE_B(t0, 0); SSD_TILE_B(t1, 4);
                        const bf16x8 bfr = pack8f(m);
#pragma unroll
                        for (int pt = 0; pt < 2; ++pt) { const LAS unsigned char* rp = lds + L_XF + (16 * pt + li) * ROW; const bf16x8 a = ld2x8(rp + (32 * kk + 4 * lg) * 2, rp + (32 * kk + 16 + 4 * lg) * 2); yacc[pt] = SSD_MFMA(a, bfr, yacc[pt]); }
                    }
                }
#undef SSD_TILE_F
#undef SSD_TILE_B
            } else escale = __expf(RB[16 * w + li]);
            {
                bf16* yp = Y + (size_t)(r0 + 16 * w + li) * DI + xcol + 8 * lg;
                float o[8];
                if (sweep == 0) { const v4u xv = *(const LAS v4u*)(lds + L_XN + (16 * w + li) * 80 + (8 * lg) * 2);
                    const float xs[8] = {bf_lo(xv.x), bf_hi(xv.x), bf_lo(xv.y), bf_hi(xv.y), bf_lo(xv.z), bf_hi(xv.z), bf_lo(xv.w), bf_hi(xv.w)};
#pragma unroll
                    for (int pt = 0; pt < 2; ++pt)
#pragma unroll
                        for (int r = 0; r < 4; ++r) o[4 * pt + r] = yacc[pt][r] + escale * yi[pt][r] + Dsum * xs[4 * pt + r]; }
                else { const float ys[8] = {bf_lo(yold.x), bf_hi(yold.x), bf_lo(yold.y), bf_hi(yold.y), bf_lo(yold.z), bf_hi(yold.z), bf_lo(yold.w), bf_hi(yold.w)};
#pragma unroll
                    for (int pt = 0; pt < 2; ++pt)
#pragma unroll
                        for (int r = 0; r < 4; ++r) o[4 * pt + r] = ys[4 * pt + r] + escale * yi[pt][r]; }
                v4u ov; ov.x = pk2(o[0], o[1]); ov.y = pk2(o[2], o[3]); ov.z = pk2(o[4], o[5]); ov.w = pk2(o[6], o[7]); *(v4u*)yp = ov;
            }
            }
            {
                const float atot = __expf(sweep == 0 ? AF[127] : RB[0]);
                sacc[0] = sacc[0] * atot; sacc[1] = sacc[1] * atot;
                const int q = li >> 2, pq = li & 3;
                bf16x8 ta[4], xd[8];
#pragma unroll
                for (int ks = 0; ks < 4; ++ks) {
                    const LAS unsigned char* tp = lds + L_BS + (32 * ks + 8 * lg + q) * ROW + (16 * w + 4 * pq) * 2;
                    const s16x4 lo = __builtin_amdgcn_ds_read_tr16_b64_v4i16((LAS s16x4*)tp), hi = __builtin_amdgcn_ds_read_tr16_b64_v4i16((LAS s16x4*)(tp + 4 * ROW));
                    ta[ks] = __builtin_shufflevector(lo, hi, 0, 1, 2, 3, 4, 5, 6, 7);
#pragma unroll
                    for (int pt = 0; pt < 2; ++pt) xd[2 * ks + pt] = *(const LAS bf16x8*)(lds + L_XD + (16 * pt + li) * ROW + (32 * ks + 8 * lg) * 2);
                }
                __builtin_amdgcn_sched_barrier(0);
#pragma unroll
                for (int ks = 0; ks < 4; ++ks)
#pragma unroll
                    for (int pt = 0; pt < 2; ++pt) sacc[pt] = SSD_MFMA(ta[ks], xd[2 * ks + pt], sacc[pt]);
#pragma unroll
                for (int pt = 0; pt < 2; ++pt) { v2u sv; sv.x = pk2(sacc[pt][0], sacc[pt][1]); sv.y = pk2(sacc[pt][2], sacc[pt][3]); *(LAS v2u*)(SSnxt + (16 * pt + li) * ROW + (16 * w + 4 * lg) * 2) = sv; }
            }
        }
#undef SSD_ISSUE
#undef SSD_SCAN
#undef SSD_LDDT
#undef SSD_TAB
#undef SSD_DTP
        VM_WAIT(); __syncthreads();
    }
}
__device__ __forceinline__ void phase_ssd_mfma(const Ids I, LAS unsigned char* lds, int l) { ssd_sweep<0>(I, lds, l); ssd_sweep<1>(I, lds, l); }
namespace ssdd {
constexpr int ROW = 272;
constexpr int XFP = 144;
constexpr int L_CS = 0, L_BS = 34816, L_XF = 69632  , L_XD = 88064  , L_SS0 = 106496, L_SS1 = 123904, L_TAB = 141312  , L_DT = 143360  ;
constexpr int FLAG_OFF = 90112;
}
template <int DIR> __device__ __forceinline__ void ssd_dir(const Ids I_, LAS unsigned char* lds, int l) {
    using namespace ssdd;
    using ssd::scan128; using ssd::pack8f; using ssd::ld2x8; using ssd::bf1; using ssd::bf16x8; using ssd::s16x4;
    const Ids I = fresh(I_);
    const KA ka = ka_fresh(); unsigned char* ws = KWS(ka);
    const bf16* XBC = (const bf16*)(ws + WS_XBC); const float* DT = (const float*)(ws + WS_DT); bf16* Y = (bf16*)(ws + WS_Y);
    const int tid = I.tid, lane = I.lane, w = I.wave, li = lane & 15, lg = lane >> 4;
    const int wt = w < 4 ? w : 11 - w;
    const int id = I.vcu, b = id >> 6, h = (id >> 1) & 31, grp = h >> 2;
    const float Dsum = KIN(ka, 12)[l * 64 + h] + KIN(ka, 12)[l * 64 + 32 + h];
    const float A_d = -__expf(KIN(ka, 11)[l * 64 + DIR * 32 + h]);
    const size_t xcol = (size_t)h * 64;
    const int srow = tid >> 2, sc4 = tid & 3;
    pg8::pg8_gu32* flags = (pg8::pg8_gu32*)(ws + WS_CTL) + FLAG_OFF + (size_t)((l * 128 + b * 32 + h) * 34) * 8 + w;
    const __amdgpu_buffer_rsrc_t rsY = __builtin_amdgcn_make_buffer_rsrc((void*)Y, (short)0, 17408 * 2048 * 2, 0x00020000);
    auto chunk_of = [&](int idx) -> int { return idx < 2 ? (DIR ? 1 - idx : idx) : 2 + (DIR ? 31 - (idx - 2) : idx - 2); };
    auto row_of = [&](int idx) -> int { const int c = chunk_of(idx); return c < 2 ? MLAT + b * CTXL + 128 * c : b * SEQ + 128 * (c - 2); };
#define SD_TAB(par) ((LAS float*)(lds + L_TAB + (par) * 1024))
#define SD_DTP(par) ((LAS float*)(lds + L_DT + (par) * 512))
#define SD_LDDT(idx_) (DT[(size_t)(DIR * 32 + h) * MTOT + row_of(idx_) + tid])
#define SD_SCAN(par) do { if (w == 0) scan128(SD_TAB(par), SD_TAB(par) + 128, SD_DTP(par), A_d, DIR != 0, lane); } while (0)
    v4u pc[4], pb[4], px[2]; float pdt = 0.f;
#define SD_ISSUE(idx_) do { const int r0_ = row_of(idx_); \
        _Pragma("unroll") for (int q = 0; q < 4; ++q) { const int ch = tid + 512 * q, row = ch >> 4, c16 = ch & 15; \
            pc[q] = *(const v4u*)(XBC + (size_t)(r0_ + row) * XBCW + 3072 + grp * 128 + c16 * 8); pb[q] = *(const v4u*)(XBC + (size_t)(r0_ + row) * XBCW + 2048 + grp * 128 + c16 * 8); } \
        px[0] = *(const v4u*)(XBC + (size_t)(r0_ + srow) * XBCW + xcol + sc4 * 16); px[1] = *(const v4u*)(XBC + (size_t)(r0_ + srow) * XBCW + xcol + sc4 * 16 + 8); } while (0)
    __syncthreads();
    for (int i = tid; i < (2 * 17408) / 4; i += NWAVES * 64) ((LAS unsigned*)(lds + L_SS0))[i] = 0u;
    f32x4 sacc[4];
#pragma unroll
    for (int pt = 0; pt < 4; ++pt) sacc[pt] = (f32x4){0.f, 0.f, 0.f, 0.f};
    SD_ISSUE(0);
    if (tid < 128) SD_DTP(0)[tid] = SD_LDDT(0);
    __syncthreads();
    SD_SCAN(0);
    if (tid < 128) pdt = SD_LDDT(1);
    int pend = -1;
    for (int idx = 0; idx < 34; ++idx) {
        const int r0 = row_of(idx), par = idx & 1, cid = chunk_of(idx);
        const bool need_y = !(l == 1 && idx < 2);
        const bool first = idx < 2 ? (idx == 0) : (idx <= 17);
        LAS unsigned char* SScur = lds + (par ? L_SS1 : L_SS0); LAS unsigned char* SSnxt = lds + (par ? L_SS0 : L_SS1);
        LAS float* AC = SD_TAB(par); LAS float* EJ = AC + 128; LAS float* DTC = SD_DTP(par);
        __syncthreads();
#pragma unroll
        for (int q = 0; q < 4; ++q) { const int ch = tid + 512 * q, row = ch >> 4, c16 = ch & 15; *(LAS v4u*)(lds + L_CS + row * ROW + c16 * 16) = pc[q]; *(LAS v4u*)(lds + L_BS + row * ROW + c16 * 16) = pb[q]; }
        {
            const v4u p0 = px[0], p1 = px[1];
            const float xv[16] = {bf_lo(p0.x), bf_hi(p0.x), bf_lo(p0.y), bf_hi(p0.y), bf_lo(p0.z), bf_hi(p0.z), bf_lo(p0.w), bf_hi(p0.w), bf_lo(p1.x), bf_hi(p1.x), bf_lo(p1.y), bf_hi(p1.y), bf_lo(p1.z), bf_hi(p1.z), bf_lo(p1.w), bf_hi(p1.w)};
            {
                LAS unsigned char* xr_ = lds + L_XF + srow * XFP + (4 * sc4) * 2;
                v2u t0; t0.x = p0.x; t0.y = p0.y; *(LAS v2u*)(xr_) = t0; t0.x = p0.z; t0.y = p0.w; *(LAS v2u*)(xr_ + 32) = t0; t0.x = p1.x; t0.y = p1.y; *(LAS v2u*)(xr_ + 64) = t0; t0.x = p1.z; t0.y = p1.w; *(LAS v2u*)(xr_ + 96) = t0; }
            const float e = DTC[srow] * __expf(AC[DIR ? 0 : 127] - AC[srow]);
#pragma unroll
            for (int g4 = 0; g4 < 4; ++g4) { v2u t1; t1.x = pk2(xv[4 * g4] * e, xv[4 * g4 + 1] * e); t1.y = pk2(xv[4 * g4 + 2] * e, xv[4 * g4 + 3] * e); *(LAS v2u*)(lds + L_XD + srow * XFP + (16 * g4 + 4 * sc4) * 2) = t1; }
        }
        if (tid < 128 && idx + 1 < 34) SD_DTP(par ^ 1)[tid] = pdt;
        if (pend >= 0) { asm volatile("s_waitcnt vmcnt(0)" ::: "memory"); if (lane == 0) __hip_atomic_store(flags + pend * 8, 1u, __ATOMIC_RELAXED, __HIP_MEMORY_SCOPE_AGENT); pend = -1; }
        __syncthreads();
        if (idx + 1 < 34) SD_ISSUE(idx + 1);
        if (idx + 1 < 34) SD_SCAN(par ^ 1);
        if (tid < 128 && idx + 2 < 34) pdt = SD_LDDT(idx + 2);
        const unsigned yoff = (unsigned)(((size_t)(r0 + 16 * wt + li) * DI + xcol + 16 * lg) * 2);
        v4u yo0 = {0u, 0u, 0u, 0u}, yo1 = {0u, 0u, 0u, 0u}, xs0 = {0u, 0u, 0u, 0u}, xs1 = {0u, 0u, 0u, 0u};
        if (need_y) {
            if (!first) {
                unsigned sp = 0;
                while (__builtin_amdgcn_readfirstlane(__hip_atomic_load(flags + cid * 8, __ATOMIC_RELAXED, __HIP_MEMORY_SCOPE_AGENT)) == 0u) { __builtin_amdgcn_s_sleep(2);
                    if ((++sp & 255u) == 0u) { pg8::pg8_gu32* tmo = (pg8::pg8_gu32*)(ws + WS_CTL) + CW_BAR + XB_TMO; if (__hip_atomic_load(tmo, __ATOMIC_RELAXED, __HIP_MEMORY_SCOPE_AGENT) != 0u) break; if (sp > (1u << 20)) { if (lane == 0) __hip_atomic_fetch_add(tmo, 1u, __ATOMIC_RELAXED, __HIP_MEMORY_SCOPE_AGENT); break; } } }
                asm volatile("" ::: "memory");
                yo0 = __builtin_amdgcn_raw_buffer_load_b128(rsY, yoff, 0, 17); yo1 = __builtin_amdgcn_raw_buffer_load_b128(rsY, yoff + 16, 0, 17);
            }
            if (DIR == 0) { const v4u* xp = (const v4u*)(XBC + (size_t)(r0 + 16 * wt + li) * XBCW + xcol + 16 * lg); xs0 = xp[0]; xs1 = xp[1]; }
        }
        bf16x8 cf[4];
#pragma unroll
        for (int ks = 0; ks < 4; ++ks) cf[ks] = *(const LAS bf16x8*)(lds + L_CS + (16 * wt + li) * ROW + (32 * ks + 8 * lg) * 2);
        f32x4 yacc[4], yi[4];
#pragma unroll
        for (int pt = 0; pt < 4; ++pt) { yacc[pt] = (f32x4){0.f, 0.f, 0.f, 0.f}; yi[pt] = (f32x4){0.f, 0.f, 0.f, 0.f}; }
        if (need_y) {
            {
#pragma unroll
                for (int ks = 0; ks < 4; ++ks) {
                    bf16x8 sf[4];
#pragma unroll
                    for (int pt = 0; pt < 4; ++pt) sf[pt] = *(const LAS bf16x8*)(SScur + (16 * pt + li) * ROW + (32 * ks + 8 * lg) * 2);
#pragma unroll
                    for (int pt = 0; pt < 4; ++pt) yi[pt] = SSD_MFMA(sf[pt], cf[ks], yi[pt]);
                }
            }
            const float a_i = AC[16 * wt + li];
            const float escale = __expf(a_i);
            f32x4 g[8];
            {
                bf16x8 fa[8], fb[8];
#define SD_GLOAD(dst, jp) do { _Pragma("unroll") for (int q_ = 0; q_ < 8; ++q_) dst[q_] = *(const LAS bf16x8*)(lds + L_BS + (16 * (2 * (jp) + (q_ >> 2)) + li) * ROW + (32 * (q_ & 3) + 8 * lg) * 2); } while (0)
#define SD_GMMA(src, jp) do { g[2 * (jp)] = (f32x4){0.f, 0.f, 0.f, 0.f}; g[2 * (jp) + 1] = (f32x4){0.f, 0.f, 0.f, 0.f}; \
                    _Pragma("unroll") for (int q_ = 0; q_ < 8; ++q_) g[2 * (jp) + (q_ >> 2)] = SSD_MFMA(src[q_], cf[q_ & 3], g[2 * (jp) + (q_ >> 2)]); } while (0)
#define SD_NEED(jp) (DIR == 0 ? (2 * (jp) <= wt) : (2 * (jp) + 1 >= wt))
                if (DIR == 0 ? (wt >= 6) : (wt <= 1)) {
                    SD_GLOAD(fa, 0); __builtin_amdgcn_sched_barrier(0);
                    SD_GLOAD(fb, 1); __builtin_amdgcn_sched_barrier(0); SD_GMMA(fa, 0); __builtin_amdgcn_sched_barrier(0);
                    SD_GLOAD(fa, 2); __builtin_amdgcn_sched_barrier(0); SD_GMMA(fb, 1); __builtin_amdgcn_sched_barrier(0);
                    SD_GLOAD(fb, 3); __builtin_amdgcn_sched_barrier(0); SD_GMMA(fa, 2); __builtin_amdgcn_sched_barrier(0);
                    SD_GMMA(fb, 3); __builtin_amdgcn_sched_barrier(0);
                } else {
#pragma unroll
                    for (int jp = 0; jp < 4; ++jp) {
                        if (SD_NEED(jp)) { SD_GLOAD(fa, jp); __builtin_amdgcn_sched_barrier(0); SD_GMMA(fa, jp); __builtin_amdgcn_sched_barrier(0); }
                        else { g[2 * jp] = (f32x4){0.f, 0.f, 0.f, 0.f}; g[2 * jp + 1] = (f32x4){0.f, 0.f, 0.f, 0.f}; }
                    }
                    (void)fb;
                }
#undef SD_NEED
#undef SD_GLOAD
#undef SD_GMMA
            }
#define SD_TILE(t, mo) do { if (DIR == 0 ? ((t) < wt) : ((t) > wt)) { const float ei = __expf(a_i - AC[DIR == 0 ? 16 * (t) + 15 : 16 * (t)]); const f32x4 ejv = *(const LAS f32x4*)(EJ + 16 * (t) + 4 * lg); \
                    _Pragma("unroll") for (int r = 0; r < 4; ++r) m[(mo) + r] = g[t][r] * (ei * ejv[r]); } \
                else if ((t) == wt) { const f32x4 av = *(const LAS f32x4*)(AC + 16 * (t) + 4 * lg), dv = *(const LAS f32x4*)(DTC + 16 * (t) + 4 * lg); \
                    _Pragma("unroll") for (int r = 0; r < 4; ++r) m[(mo) + r] = (DIR == 0 ? (4 * lg + r <= li) : (4 * lg + r >= li)) ? g[t][r] * (dv[r] * __expf(fminf(a_i - av[r], 0.f))) : 0.f; } \
                else { _Pragma("unroll") for (int r = 0; r < 4; ++r) m[(mo) + r] = 0.f; } } while (0)
#pragma unroll
            for (int kk = 0; kk < 4; ++kk) {
                const int t0 = 2 * kk, t1 = 2 * kk + 1;
                if (DIR == 0 ? (t0 <= wt) : (t1 >= wt)) {
                    float m[8]; SD_TILE(t0, 0); SD_TILE(t1, 4);
                    const bf16x8 bfr = pack8f(m);
#pragma unroll
                    for (int pt = 0; pt < 4; ++pt) {
                        const LAS unsigned char* tp = lds + L_XF + (32 * kk + 4 * lg + (li >> 2)) * XFP + (16 * pt + 4 * (li & 3)) * 2;
                        const s16x4 lo = __builtin_amdgcn_ds_read_tr16_b64_v4i16((LAS s16x4*)tp), hi = __builtin_amdgcn_ds_read_tr16_b64_v4i16((LAS s16x4*)(tp + 16 * XFP));
                        const bf16x8 a = __builtin_shufflevector(lo, hi, 0, 1, 2, 3, 4, 5, 6, 7); yacc[pt] = SSD_MFMA(a, bfr, yacc[pt]); }
                }
            }
#undef SD_TILE
            {
                float o[16];
#pragma unroll
                for (int pt = 0; pt < 4; ++pt)
#pragma unroll
                    for (int r = 0; r < 4; ++r) o[4 * pt + r] = yacc[pt][r] + escale * yi[pt][r];
                if (DIR == 0) { const float xs[16] = {bf_lo(xs0.x), bf_hi(xs0.x), bf_lo(xs0.y), bf_hi(xs0.y), bf_lo(xs0.z), bf_hi(xs0.z), bf_lo(xs0.w), bf_hi(xs0.w), bf_lo(xs1.x), bf_hi(xs1.x), bf_lo(xs1.y), bf_hi(xs1.y), bf_lo(xs1.z), bf_hi(xs1.z), bf_lo(xs1.w), bf_hi(xs1.w)};
#pragma unroll
                    for (int q = 0; q < 16; ++q) o[q] += Dsum * xs[q]; }
                if (!first) { const float ys[16] = {bf_lo(yo0.x), bf_hi(yo0.x), bf_lo(yo0.y), bf_hi(yo0.y), bf_lo(yo0.z), bf_hi(yo0.z), bf_lo(yo0.w), bf_hi(yo0.w), bf_lo(yo1.x), bf_hi(yo1.x), bf_lo(yo1.y), bf_hi(yo1.y), bf_lo(yo1.z), bf_hi(yo1.z), bf_lo(yo1.w), bf_hi(yo1.w)};
#pragma unroll
                    for (int q = 0; q < 16; ++q) o[q] += ys[q]; }
                v4u ov0, ov1; ov0.x = pk2(o[0], o[1]); ov0.y = pk2(o[2], o[3]); ov0.z = pk2(o[4], o[5]); ov0.w = pk2(o[6], o[7]); ov1.x = pk2(o[8], o[9]); ov1.y = pk2(o[10], o[11]); ov1.z = pk2(o[12], o[13]); ov1.w = pk2(o[14], o[15]);
                if (first) { __builtin_amdgcn_raw_buffer_store_b128(ov0, rsY, yoff, 0, 16); __builtin_amdgcn_raw_buffer_store_b128(ov1, rsY, yoff + 16, 0, 16); pend = cid; }
                else { __builtin_amdgcn_raw_buffer_store_b128(ov0, rsY, yoff, 0, 0); __builtin_amdgcn_raw_buffer_store_b128(ov1, rsY, yoff + 16, 0, 0); }
            }
        }
        {
            const float atot = __expf(AC[DIR ? 0 : 127]);
#pragma unroll
            for (int pt = 0; pt < 4; ++pt) sacc[pt] = sacc[pt] * atot;
            const int q = li >> 2, pq = li & 3;
#pragma unroll
            for (int ks = 0; ks < 4; ++ks) {
                const LAS unsigned char* tp = lds + L_BS + (32 * ks + 8 * lg + q) * ROW + (16 * w + 4 * pq) * 2;
                const s16x4 lo = __builtin_amdgcn_ds_read_tr16_b64_v4i16((LAS s16x4*)tp), hi = __builtin_amdgcn_ds_read_tr16_b64_v4i16((LAS s16x4*)(tp + 4 * ROW));
                const bf16x8 ta = __builtin_shufflevector(lo, hi, 0, 1, 2, 3, 4, 5, 6, 7);
                bf16x8 xdv[4];
#pragma unroll
                for (int pt = 0; pt < 4; ++pt) { const LAS unsigned char* xp_ = lds + L_XD + (32 * ks + 8 * lg + q) * XFP + (16 * pt + 4 * pq) * 2;
                    const s16x4 xl_ = __builtin_amdgcn_ds_read_tr16_b64_v4i16((LAS s16x4*)xp_), xh_ = __builtin_amdgcn_ds_read_tr16_b64_v4i16((LAS s16x4*)(xp_ + 4 * XFP)); xdv[pt] = __builtin_shufflevector(xl_, xh_, 0, 1, 2, 3, 4, 5, 6, 7); }
#pragma unroll
                for (int pt = 0; pt < 4; ++pt) sacc[pt] = SSD_MFMA(ta, xdv[pt], sacc[pt]);
            }
#pragma unroll
            for (int pt = 0; pt < 4; ++pt) { v2u sv; sv.x = pk2(sacc[pt][0], sacc[pt][1]); sv.y = pk2(sacc[pt][2], sacc[pt][3]); *(LAS v2u*)(SSnxt + (16 * pt + li) * ROW + (16 * w + 4 * lg) * 2) = sv; }
        }
    }
    asm volatile("s_waitcnt vmcnt(0)" ::: "memory");
    if (pend >= 0 && lane == 0) __hip_atomic_store(flags + pend * 8, 1u, __ATOMIC_RELAXED, __HIP_MEMORY_SCOPE_AGENT);
#undef SD_ISSUE
#undef SD_SCAN
#undef SD_LDDT
#undef SD_TAB
#undef SD_DTP
    __syncthreads();
}
__device__ __forceinline__ void phase_ssd_dir(const Ids I, LAS unsigned char* lds, int l) { if (I.vcu & 1) ssd_dir<1>(I, lds, l); else ssd_dir<0>(I, lds, l); }

namespace ssd3 {
typedef short bf16x8 __attribute__((ext_vector_type(8)));
typedef short s16x4 __attribute__((ext_vector_type(4)));
constexpr int ROW = 272;
constexpr int L_BS = 0, L_XF = 69632, L_XB = L_XF + 17408, L_XD = L_XB + 17408, L_SS = L_XD + 17408, L_TAB = L_SS + 17408;
constexpr int T_AFL = 0, T_RBL = 128, T_EJF = 256, T_EJB = 384, T_TF = 512, T_TB = 520, T_FLOATS = 528;
#define SSD3_MFMA32(a, b, c) __builtin_amdgcn_mfma_f32_16x16x32_bf16((a), (b), (c), 0, 0, 0)
#define SSD3_MFMA16(a, b, c) __builtin_amdgcn_mfma_f32_16x16x16bf16_1k((a), (b), (c), 0, 0, 0)
template <int N> __device__ __forceinline__ float row_shr(float v) { return __int_as_float(__builtin_amdgcn_update_dpp(0, __float_as_int(v), 0x110 + N, 0xf, 0xf, false)); }
__device__ __forceinline__ float rdlane(float v, int l) { return __int_as_float(__builtin_amdgcn_readlane(__float_as_int(v), l)); }
__device__ __forceinline__ float scan16x4(float a, int lane, float& tot) {
    float s = a; s += row_shr<4>(s); s += row_shr<8>(s);
    const float t0 = rdlane(s, 15), t1 = rdlane(s, 31), t2 = rdlane(s, 47), t3 = rdlane(s, 63); const int dr = lane >> 4;
    s += (dr >= 1 ? t0 : 0.f) + (dr >= 2 ? t1 : 0.f) + (dr >= 3 ? t2 : 0.f); tot = (t0 + t1) + (t2 + t3); return s;
}
__device__ __forceinline__ bf16x8 pack8f(const float (&m)[8]) { v4u t; t.x = pk2(m[0], m[1]); t.y = pk2(m[2], m[3]); t.z = pk2(m[4], m[5]); t.w = pk2(m[6], m[7]); return __builtin_bit_cast(bf16x8, t); }
__device__ __forceinline__ bf16x8 ld2x8(const LAS unsigned char* p0, const LAS unsigned char* p1) { const v2u a = *(const LAS v2u*)p0, b = *(const LAS v2u*)p1; v4u t; t.x = a.x; t.y = a.y; t.z = b.x; t.w = b.y; return __builtin_bit_cast(bf16x8, t); }
__device__ __forceinline__ unsigned short bf1(float v) { return (unsigned short)(pk2(v, 0.f) & 0xffffu); }
}

template <int SWEEP> __device__ __forceinline__ void ssd3_sweep(const Ids I_, LAS unsigned char* lds, int l) {
    using namespace ssd3;
    constexpr int sweep = SWEEP;
    const Ids I = fresh(I_);
    const KA ka = ka_fresh(); unsigned char* ws = KWS(ka);
    const bf16* XBC = (const bf16*)(ws + WS_XBC); const float* DT = (const float*)(ws + WS_DT); bf16* Y = (bf16*)(ws + WS_Y);
    const int tid = I.tid, lane = I.lane, w = I.wave, li = lane & 15, lg = lane >> 4;
    const int id = I.vcu, b = id >> 6, h = (id >> 1) & 31, ph = id & 1, grp = h >> 2;
    const float Dsum = KIN(ka, 12)[l * 64 + h] + KIN(ka, 12)[l * 64 + 32 + h];
    const float A_f = -__expf(KIN(ka, 11)[l * 64 + h]), A_b = -__expf(KIN(ka, 11)[l * 64 + 32 + h]);
    const size_t xcol = (size_t)h * 64 + ph * 32;
    const int srow = tid >> 2, sc4 = tid & 3;
    auto row_of = [&](int idx) -> int { const int c = idx < 2 ? (sweep ? 1 - idx : idx) : (sweep ? 31 - (idx - 2) : idx - 2); return idx < 2 ? MLAT + b * CTXL + 128 * c : b * SEQ + 128 * c; };

    v4u pb[4], px; float pdf = 0.f, pdb = 0.f; v4u pcn[4]; v2u pxo[2];
#define SSD3_LOAD_S(idx_) do { const int r0_ = row_of(idx_); \
        _Pragma("unroll") for (int q = 0; q < 4; ++q) { const int ch = tid + 512 * q; pb[q] = *(const v4u*)(XBC + (size_t)(r0_ + (ch >> 4)) * XBCW + 2048 + grp * 128 + (ch & 15) * 8); } \
        px = *(const v4u*)(XBC + (size_t)(r0_ + srow) * XBCW + xcol + sc4 * 8); pdf = DT[(size_t)h * MTOT + r0_ + srow]; pdb = DT[(size_t)(32 + h) * MTOT + r0_ + srow]; } while (0)
#define SSD3_LOAD_C(idx_) do { const int r0_ = row_of(idx_); \
        _Pragma("unroll") for (int q = 0; q < 4; ++q) pcn[q] = *(const v4u*)(XBC + (size_t)(r0_ + 16 * w + li) * XBCW + 3072 + grp * 128 + (4 * q + lg) * 8); \
        if (sweep == 0) { _Pragma("unroll") for (int pt = 0; pt < 2; ++pt) pxo[pt] = *(const v2u*)(XBC + (size_t)(r0_ + 16 * w + li) * XBCW + xcol + 16 * pt + 4 * lg); } } while (0)
#define SSD3_STAGE(gen) do { \
        LAS float* T_ = (LAS float*)(lds + L_TAB) + (gen) * T_FLOATS; \
        float tf_, tb_; const float af_ = scan16x4(pdf * A_f, lane, tf_); const float bv_ = pdb * A_b; const float sb_ = scan16x4(bv_, lane, tb_); \
        const float rb_ = tb_ - sb_ + bv_, ejf_ = __expf(tf_ - af_), ejb_ = __expf(tb_ - rb_); \
        if (sc4 == 0) { T_[T_AFL + srow] = af_; T_[T_RBL + srow] = rb_; T_[T_EJF + srow] = ejf_; T_[T_EJB + srow] = ejb_; } \
        if (lane == 0) { T_[T_TF + w] = tf_; T_[T_TB + w] = tb_; } \
        _Pragma("unroll") for (int q = 0; q < 4; ++q) { const int ch = tid + 512 * q; *(LAS v4u*)(lds + L_BS + (gen) * 34816 + (ch >> 4) * ROW + (ch & 15) * 16) = pb[q]; } \
        const float xv_[8] = {bf_lo(px.x), bf_hi(px.x), bf_lo(px.y), bf_hi(px.y), bf_lo(px.z), bf_hi(px.z), bf_lo(px.w), bf_hi(px.w)}; \
        LAS unsigned short* xd_ = (LAS unsigned short*)(lds + L_XD + (gen) * 8704 + (8 * sc4) * ROW) + srow; \
        if (sweep == 0) { LAS unsigned short* xf_ = (LAS unsigned short*)(lds + L_XF + (gen) * 8704 + (8 * sc4) * ROW) + srow; LAS unsigned short* xb_ = (LAS unsigned short*)(lds + L_XB + (gen) * 8704 + (8 * sc4) * ROW) + srow; \
            const float e_ = pdf * ejf_; \
            _Pragma("unroll") for (int q = 0; q < 8; ++q) { xf_[q * (ROW / 2)] = bf1(xv_[q] * pdf); xb_[q * (ROW / 2)] = bf1(xv_[q] * pdb); xd_[q * (ROW / 2)] = bf1(xv_[q] * e_); } } \
        else { const float e_ = pdb * ejb_; _Pragma("unroll") for (int q = 0; q < 8; ++q) xd_[q * (ROW / 2)] = bf1(xv_[q] * e_); } } while (0)

    __syncthreads();
    for (int i = tid; i < 17408 / 4; i += NWAVES * 64) ((LAS unsigned*)(lds + L_SS))[i] = 0u;
    f32x4 sacc[2] = {{0.f, 0.f, 0.f, 0.f}, {0.f, 0.f, 0.f, 0.f}};
    SSD3_LOAD_S(0); SSD3_STAGE(0);
    SSD3_LOAD_S(1); SSD3_LOAD_C(0);
    for (int idx = 0; idx < 34; ++idx) {
        const int r0 = row_of(idx), par = idx & 1;
        const bool need_y = !(l == 1 && idx < 2);
        __syncthreads();
        if (idx + 1 < 34) SSD3_STAGE(par ^ 1);
        bf16x8 cf[4]; v2u xo[2] = {{0u, 0u}, {0u, 0u}};
#pragma unroll
        for (int ks = 0; ks < 4; ++ks) cf[ks] = __builtin_bit_cast(bf16x8, pcn[ks]);
        if (sweep == 0) { xo[0] = pxo[0]; xo[1] = pxo[1]; }
        if (idx + 2 < 34) SSD3_LOAD_S(idx + 2);
        if (idx + 1 < 34) SSD3_LOAD_C(idx + 1);
        const LAS unsigned char* BSc = lds + L_BS + par * 34816; const LAS unsigned char* XFc = lds + L_XF + par * 8704; const LAS unsigned char* XBc = lds + L_XB + par * 8704; const LAS unsigned char* XDc = lds + L_XD + par * 8704;
        const LAS unsigned char* SScur = lds + L_SS + par * 8704; LAS unsigned char* SSnxt = lds + L_SS + (par ^ 1) * 8704;
        const LAS float* T = (const LAS float*)(lds + L_TAB) + par * T_FLOATS;
        v2u yold[2] = {{0u, 0u}, {0u, 0u}};
        if (sweep == 1 && need_y) { _Pragma("unroll") for (int pt = 0; pt < 2; ++pt) yold[pt] = *(const v2u*)(Y + (size_t)(r0 + 16 * w + li) * DI + xcol + 16 * pt + 4 * lg); }
        float PF[9], SB[9], TFv[8], TBv[8];
#pragma unroll
        for (int t = 0; t < 8; ++t) { TFv[t] = T[T_TF + t]; TBv[t] = T[T_TB + t]; }
        PF[0] = 0.f; SB[8] = 0.f;
#pragma unroll
        for (int t = 0; t < 8; ++t) { PF[t + 1] = PF[t] + TFv[t]; SB[7 - t] = SB[8 - t] + TBv[7 - t]; }
        float PFw = 0.f, SBw1 = 0.f;
#pragma unroll
        for (int t = 0; t < 8; ++t) { PFw = (t == w) ? PF[t] : PFw; SBw1 = (t == w) ? SB[t + 1] : SBw1; }
        const float afl_i = T[T_AFL + 16 * w + li], rbl_i = T[T_RBL + 16 * w + li];
        const float af_i = PFw + afl_i, rb_i = SBw1 + rbl_i;
        if (need_y) {
        f32x4 yacc[2] = {{0.f, 0.f, 0.f, 0.f}, {0.f, 0.f, 0.f, 0.f}}, yi[2] = {{0.f, 0.f, 0.f, 0.f}, {0.f, 0.f, 0.f, 0.f}};
        {
            bf16x8 sf[8];
#pragma unroll
            for (int ks = 0; ks < 4; ++ks)
#pragma unroll
                for (int pt = 0; pt < 2; ++pt) sf[2 * ks + pt] = *(const LAS bf16x8*)(SScur + (16 * pt + li) * ROW + (32 * ks + 8 * lg) * 2);
            __builtin_amdgcn_sched_barrier(0);
#pragma unroll
            for (int ks = 0; ks < 4; ++ks)
#pragma unroll
                for (int pt = 0; pt < 2; ++pt) yi[pt] = SSD3_MFMA32(sf[2 * ks + pt], cf[ks], yi[pt]);
        }
        const float escale = __expf(sweep == 0 ? af_i : rb_i);
        if (sweep == 0) {
            f32x4 g[8];
            {
                bf16x8 fa[8], fb[8];
#define SSD3_GLOAD(dst, jp) do { _Pragma("unroll") for (int q_ = 0; q_ < 8; ++q_) dst[q_] = *(const LAS bf16x8*)(BSc + (16 * (2 * (jp) + (q_ >> 2)) + li) * ROW + (32 * (q_ & 3) + 8 * lg) * 2); } while (0)
#define SSD3_GMMA(src, jp) do { g[2 * (jp)] = (f32x4){0.f, 0.f, 0.f, 0.f}; g[2 * (jp) + 1] = (f32x4){0.f, 0.f, 0.f, 0.f}; \
                    _Pragma("unroll") for (int q_ = 0; q_ < 8; ++q_) g[2 * (jp) + (q_ >> 2)] = SSD3_MFMA32(src[q_], cf[q_ & 3], g[2 * (jp) + (q_ >> 2)]); } while (0)
                SSD3_GLOAD(fa, 0); __builtin_amdgcn_sched_barrier(0);
                SSD3_GLOAD(fb, 1); __builtin_amdgcn_sched_barrier(0); SSD3_GMMA(fa, 0); __builtin_amdgcn_sched_barrier(0);
                SSD3_GLOAD(fa, 2); __builtin_amdgcn_sched_barrier(0); SSD3_GMMA(fb, 1); __builtin_amdgcn_sched_barrier(0);
                SSD3_GLOAD(fb, 3); __builtin_amdgcn_sched_barrier(0); SSD3_GMMA(fa, 2); __builtin_amdgcn_sched_barrier(0);
                SSD3_GMMA(fb, 3); __builtin_amdgcn_sched_barrier(0);
#undef SSD3_GLOAD
#undef SSD3_GMMA
            }
#define SSD3_TILE_F(t, mo) do { if ((t) < w) { const float ei = __expf(af_i - PF[(t) + 1]); const f32x4 ejv = *(const LAS f32x4*)(T + T_EJF + 16 * (t) + 4 * lg); \
                    _Pragma("unroll") for (int r = 0; r < 4; ++r) m[(mo) + r] = g[t][r] * (ei * ejv[r]); } \
                else if ((t) == w) { const f32x4 av = *(const LAS f32x4*)(T + T_AFL + 16 * (t) + 4 * lg); \
                    _Pragma("unroll") for (int r = 0; r < 4; ++r) m[(mo) + r] = (4 * lg + r <= li) ? g[t][r] * __expf(fminf(afl_i - av[r], 0.f)) : 0.f; } \
                else { _Pragma("unroll") for (int r = 0; r < 4; ++r) m[(mo) + r] = 0.f; } } while (0)
#define SSD3_TILE_B(t, mo) do { if ((t) > w) { const float ei = __expf(rb_i - SB[t]); const f32x4 ejv = *(const LAS f32x4*)(T + T_EJB + 16 * (t) + 4 * lg); \
                    _Pragma("unroll") for (int r = 0; r < 4; ++r) m[(mo) + r] = g[t][r] * (ei * ejv[r]); } \
                else if ((t) == w) { const f32x4 av = *(const LAS f32x4*)(T + T_RBL + 16 * (t) + 4 * lg); \
                    _Pragma("unroll") for (int r = 0; r < 4; ++r) m[(mo) + r] = (4 * lg + r >= li) ? g[t][r] * __expf(fminf(rbl_i - av[r], 0.f)) : 0.f; } \
                else { _Pragma("unroll") for (int r = 0; r < 4; ++r) m[(mo) + r] = 0.f; } } while (0)
#pragma unroll
            for (int kk = 0; kk < 4; ++kk) {
                const int t0 = 2 * kk, t1 = 2 * kk + 1;
                if (t0 <= w) {
                    float m[8]; SSD3_TILE_F(t0, 0); SSD3_TILE_F(t1, 4);
                    const bf16x8 bfr = pack8f(m);
#pragma unroll
                    for (int pt = 0; pt < 2; ++pt) { const LAS unsigned char* rp = XFc + (16 * pt + li) * ROW; const bf16x8 a = ld2x8(rp + (32 * kk + 4 * lg) * 2, rp + (32 * kk + 16 + 4 * lg) * 2); yacc[pt] = SSD3_MFMA32(a, bfr, yacc[pt]); }
                }
                if (t1 >= w) {
                    float m[8]; SSD3_TILE_B(t0, 0); SSD3_TILE_B(t1, 4);
                    const bf16x8 bfr = pack8f(m);
#pragma unroll
                    for (int pt = 0; pt < 2; ++pt) { const LAS unsigned char* rp = XBc + (16 * pt + li) * ROW; const bf16x8 a = ld2x8(rp + (32 * kk + 4 * lg) * 2, rp + (32 * kk + 16 + 4 * lg) * 2); yacc[pt] = SSD3_MFMA32(a, bfr, yacc[pt]); }
                }
            }
#undef SSD3_TILE_F
#undef SSD3_TILE_B
        }
#pragma unroll
        for (int pt = 0; pt < 2; ++pt) {
            bf16* yp = Y + (size_t)(r0 + 16 * w + li) * DI + xcol + 16 * pt + 4 * lg;
            float o[4];
            if (sweep == 0) { const v2u xv = xo[pt];
                o[0] = yacc[pt][0] + escale * yi[pt][0] + Dsum * bf_lo(xv.x); o[1] = yacc[pt][1] + escale * yi[pt][1] + Dsum * bf_hi(xv.x);
                o[2] = yacc[pt][2] + escale * yi[pt][2] + Dsum * bf_lo(xv.y); o[3] = yacc[pt][3] + escale * yi[pt][3] + Dsum * bf_hi(xv.y); }
            else { const v2u yv = yold[pt];
                o[0] = bf_lo(yv.x) + escale * yi[pt][0]; o[1] = bf_hi(yv.x) + escale * yi[pt][1]; o[2] = bf_lo(yv.y) + escale * yi[pt][2]; o[3] = bf_hi(yv.y) + escale * yi[pt][3]; }
            v2u ov; ov.x = pk2(o[0], o[1]); ov.y = pk2(o[2], o[3]); *(v2u*)yp = ov;
        }
        }
        {
            const int q = li >> 2, pq = li & 3;
            s16x4 ta[8]; s16x4 xd[8][2];
#pragma unroll
            for (int t = 0; t < 8; ++t) { ta[t] = __builtin_amdgcn_ds_read_tr16_b64_v4i16((LAS s16x4*)(BSc + (16 * t + 4 * lg + q) * ROW + (16 * w + 4 * pq) * 2));
#pragma unroll
                for (int pt = 0; pt < 2; ++pt) xd[t][pt] = *(const LAS s16x4*)(XDc + (16 * pt + li) * ROW + (16 * t + 4 * lg) * 2); }
            __builtin_amdgcn_sched_barrier(0);
#pragma unroll
            for (int tt = 0; tt < 8; ++tt) { const int t = sweep == 0 ? tt : 7 - tt; const float dec = __expf(sweep == 0 ? TFv[t] : TBv[t]);
#pragma unroll
                for (int pt = 0; pt < 2; ++pt) { sacc[pt] = sacc[pt] * dec; sacc[pt] = SSD3_MFMA16(ta[t], xd[t][pt], sacc[pt]); } }
#pragma unroll
            for (int pt = 0; pt < 2; ++pt) { v2u sv; sv.x = pk2(sacc[pt][0], sacc[pt][1]); sv.y = pk2(sacc[pt][2], sacc[pt][3]); *(LAS v2u*)(SSnxt + (16 * pt + li) * ROW + (16 * w + 4 * lg) * 2) = sv; }
        }
    }
#undef SSD3_LOAD_S
#undef SSD3_LOAD_C
#undef SSD3_STAGE
    VM_WAIT(); __syncthreads();
}
__device__ __forceinline__ void phase_ssd3(const Ids I, LAS unsigned char* lds, int l) { ssd3_sweep<0>(I, lds, l); ssd3_sweep<1>(I, lds, l); }

__device__ __forceinline__ void phase_pool(const Ids I_, LAS unsigned char* lds_base, int l) {
    LAS unsigned char* lds_misc = lds_base + MISC_OFF;
    const Ids I = fresh(I_);
    const KA ka = ka_fresh(); unsigned char* ws = KWS(ka);
    const bf16* UPOOL = (const bf16*)(ws + WS_XBC + XO_UPOOL);
    bf16* PML = (bf16*)(ws + WS_XBC + XO_UPOOL); bf16* PMC = (bf16*)(ws + WS_DT);
    const int nitems = (l == 0) ? 1024 + 64 : 1024;
    pg8::pg8_gu32* work = (pg8::pg8_gu32*)(ws + WS_CTL) + CW_WORK + 64 * l; pg8::pg8_gu32* cp_ = cnt_arr(ws, l, 0); pg8::pg8_gu32* tmo = (pg8::pg8_gu32*)(ws + WS_CTL) + CW_BAR + XB_TMO;
#define POOL_GEOM(item_) int seqb, L, w0, gi; \
        if ((item_) < 1024) { seqb = ((item_) >> 2) * 64; L = 64; w0 = 0; gi = (item_) & 3; } \
        else { const int ci = (item_) - 1024; gi = ci & 3; w0 = 64 * ((ci >> 2) & 3); seqb = MLAT + 256 * (ci >> 4); L = 256; } \
        const int cp = I.tid & 127, rs = I.tid >> 7, t0 = w0 + 16 * rs, col = gi * 256 + 2 * cp;
#define POOL_OUT(HK) do { _Pragma("unroll") for (int i = 0; i < 16; ++i) { const int t = t0 + i; const float slo = plo[i + 8 + HK] - plo[i + 8 - HK], shi = phi[i + 8 + HK] - phi[i + 8 - HK]; \
            const int lo = t - HK < 0 ? 0 : t - HK, hi = t + HK > L ? L : t + HK; const float inv = __builtin_amdgcn_rcpf((float)(hi - lo)); \
            *(unsigned*)(pout + (size_t)t * 1024 + col) = pk2(slo * inv - bf_lo(r_[i + 8]), shi * inv - bf_hi(r_[i + 8])); } } while (0)
#define POOL_CLAIM_WAIT(claim_) do { const int it_ = 2 * (int)(claim_); \
        if (it_ < nitems) { const int pmi_ = it_ < 1024 ? (it_ >> 4) : 64 + ((it_ - 1024) >> 4); unsigned sp_ = 0; \
            while (__hip_atomic_load(cp_ + 64 * pmi_, __ATOMIC_RELAXED, __HIP_MEMORY_SCOPE_AGENT) < 32u) { __builtin_amdgcn_s_sleep(2); \
                if ((++sp_ & 255u) == 0u) { if (__hip_atomic_load(tmo, __ATOMIC_RELAXED, __HIP_MEMORY_SCOPE_AGENT) != 0u) break; if (sp_ > (1u << 20)) { __hip_atomic_fetch_add(tmo, 1u, __ATOMIC_RELAXED, __HIP_MEMORY_SCOPE_AGENT); break; } } } \
            __builtin_amdgcn_fence(__ATOMIC_ACQUIRE, "agent"); asm volatile("s_waitcnt vmcnt(0)" ::: "memory"); } } while (0)
#define POOL_LOAD(r_, item_) do { POOL_GEOM(item_) \
        _Pragma("unroll") for (int i = 0; i < 32; ++i) { const int t = t0 - 8 + i; unsigned v = 0u; if (t >= 0 && t < L) v = *(const unsigned*)(UPOOL + (size_t)(seqb + t) * 1024 + col); r_[i] = v; } } while (0)
#define POOL_COMP(rr_, item_) do { POOL_GEOM(item_) const unsigned (&r_)[32] = rr_; bf16* pout = (item_) < 1024 ? PML + (size_t)seqb * 1024 : PMC + (size_t)(seqb - MLAT) * 1024; \
        float plo[33], phi[33]; plo[0] = 0.f; phi[0] = 0.f; \
        _Pragma("unroll") for (int i = 0; i < 32; ++i) { plo[i + 1] = plo[i] + bf_lo(r_[i]); phi[i + 1] = phi[i] + bf_hi(r_[i]); } \
        if (gi == 0) POOL_OUT(1); else if (gi == 1) POOL_OUT(2); else if (gi == 2) POOL_OUT(4); else POOL_OUT(8); } while (0)
    volatile LAS unsigned* slot = (volatile LAS unsigned*)(lds_misc) + 40;
    if (I.tid == 0) { const unsigned c0 = __hip_atomic_fetch_add(work, 1u, __ATOMIC_RELAXED, __HIP_MEMORY_SCOPE_AGENT); POOL_CLAIM_WAIT(c0); slot[0] = c0; }
    __syncthreads();
    int item = 2 * (int)slot[0], par = 0;
    while (item < nitems) {
        unsigned nclaim = 0u;
        unsigned ra[32], rb[32];
        POOL_LOAD(ra, item); POOL_LOAD(rb, item + 1);
        asm volatile("s_waitcnt vmcnt(0)" ::: "memory"); __syncthreads();
        if (I.tid == 0) nclaim = __hip_atomic_fetch_add(work, 1u, __ATOMIC_RELAXED, __HIP_MEMORY_SCOPE_AGENT);
        POOL_COMP(ra, item); POOL_COMP(rb, item + 1);
        if (I.tid == 0) { POOL_CLAIM_WAIT(nclaim); slot[par ^ 1] = nclaim; }
        __syncthreads();
        par ^= 1; item = 2 * (int)slot[par];
    }
#undef POOL_COMP
#undef POOL_LOAD
#undef POOL_CLAIM_WAIT
#undef POOL_OUT
#undef POOL_GEOM
}

__device__ __forceinline__ void phase_final(const Ids I_) {
    const Ids I = fresh(I_);
    const KA ka = ka_fresh(); float* OUT = KOUT(ka); const float* g = KIN(ka, 22);
    const bool dead = xb_ld((gu32*)(KWS(ka) + WS_CTL) + CW_BAR + XB_TMO) != 0u;
    v2u ta[4], tb[4];
#define FIN_LOAD(t_, mm) do { const v2u* q_ = (const v2u*)((const bf16*)OUT + (size_t)(mm) * 2048) + I.lane; _Pragma("unroll") for (int j = 0; j < 4; ++j) t_[j] = q_[64 * j]; } while (0)
#define FIN_ROW(t_, mm) do { f32x4 v[4]; float s = 0.f; \
        _Pragma("unroll") for (int j = 0; j < 4; ++j) { const v2u t = t_[j]; v[j] = (f32x4){bf_lo(t.x), bf_hi(t.x), bf_lo(t.y), bf_hi(t.y)}; s += (v[j].x * v[j].x + v[j].y * v[j].y) + (v[j].z * v[j].z + v[j].w * v[j].w); } \
        if ((mm) + 2 * I.NGW < MLAT) FIN_LOAD(t_, (mm) + 2 * I.NGW); \
        const float rstd = rsqrtf(wave_sum(s) * (1.f / D) + 1e-6f); \
        f32x4* xr = (f32x4*)(OUT + (size_t)(mm) * D) + I.lane; \
        _Pragma("unroll") for (int j = 0; j < 4; ++j) { f32x4 o = v[j] * rstd * ((const f32x4*)g)[I.lane + 64 * j]; if (dead) { const float qn = __builtin_nanf(""); o = (f32x4){qn, qn, qn, qn}; } xr[64 * j] = o; } } while (0)
    int m = I.gw;
    if (m < MLAT) FIN_LOAD(ta, m);
    if (m + I.NGW < MLAT) FIN_LOAD(tb, m + I.NGW);
    for (; m < MLAT; m += 2 * I.NGW) {
        FIN_ROW(ta, m);
        const int m1 = m + I.NGW; if (m1 >= MLAT) break;
        FIN_ROW(tb, m1);
    }
#undef FIN_ROW
#undef FIN_LOAD
}

#ifndef DBG_STOP
#define DBG_STOP 0
#endif
__device__ __forceinline__ void phase_dump(const Ids I_, size_t ws_off, int cols, bool ctx_rows, bool isf32, bool accum = false) {
    const Ids I = fresh(I_);
    const KA ka = ka_fresh(); float* OUT = KOUT(ka); unsigned char* base = KWS(ka) + ws_off;
    for (int m = I.gw; m < MLAT; m += I.NGW) {
        for (int c = I.lane; c < 1024; c += 64) { float s = 0.f;
            for (int j = 0; j < cols / 1024; ++j) {
                if (isf32) { s += ((const float*)base)[(size_t)m * cols + c + 1024 * j]; }
                else {
#ifdef DBG_ATOMIC_DUMP
                    { const size_t e = (size_t)m * cols + c + 1024 * j; const unsigned w = __hip_atomic_fetch_or((unsigned*)base + (e >> 1), 0u, __ATOMIC_RELAXED, __HIP_MEMORY_SCOPE_AGENT); s += (e & 1) ? bf_hi(w) : bf_lo(w); }
                    if (ctx_rows) { const size_t e = (size_t)(MLAT + (m & 1023)) * cols + c + 1024 * j; const unsigned w = __hip_atomic_fetch_or((unsigned*)base + (e >> 1), 0u, __ATOMIC_RELAXED, __HIP_MEMORY_SCOPE_AGENT); s += (e & 1) ? bf_hi(w) : bf_lo(w); }
#else
                    s += bf_lo(((const bf16*)base)[(size_t)m * cols + c + 1024 * j]); if (ctx_rows) s += bf_lo(((const bf16*)base)[(size_t)(MLAT + (m & 1023)) * cols + c + 1024 * j]);
#endif
                } }
            if (accum) s += OUT[(size_t)m * D + c]; OUT[(size_t)m * D + c] = s; } }
}

__global__ void __launch_bounds__(NWAVES * 64, 2) fwd_kernel(Args args) {
    LAS unsigned char* lds = (LAS unsigned char*)pg8::lds_dyn;
    volatile LAS unsigned* MISC = (volatile LAS unsigned*)(lds + MISC_OFF);
    LAS unsigned char* xl = lds + XL_OFF;
    if ((threadIdx.x & 63u) == 0u) ((volatile LAS unsigned*)(lds + pg8::WAVE_TAB_OFF))[pg8::hw_slot()] = threadIdx.x >> 6;
    __syncthreads();
    Ids I; I.wave = pg8::wave_now(); I.tid = I.wave * 64 + pg8::lane_now(); I.lane = I.tid & 63;
    I.G = gridDim.x; I.bx = blockIdx.x; I.vcu = (I.G % 8 == 0) ? (I.bx % 8) * (I.G / 8) + I.bx / 8 : I.bx;
    I.gw = I.vcu * NWAVES + I.wave; I.NGW = I.G * NWAVES;
    const int G = I.G, bx = I.bx;

    for (int u = I.tid; u < 64; u += NWAVES * 64) MISC[u] = 0u;
    __syncthreads();
    XcdBarrier bar = xcd_barrier_post((gu32*)(KWS(ka_fresh()) + WS_CTL) + CW_BAR, MISC + 8);
#ifdef TSEL
    unsigned long long t_prev = __builtin_amdgcn_s_memrealtime(), t_acc = 0ull; int t_stage = 0;
#define GRID_BAR() do { xcd_barrier(bar); { const unsigned long long t_now = __builtin_amdgcn_s_memrealtime(); if ((TSEL >> t_stage) & 1ull) t_acc += t_now - t_prev; t_prev = t_now; ++t_stage; } } while (0)
#else
#define GRID_BAR() xcd_barrier(bar)
#endif

    phase_mod(I, lds);
    conv_mixer(I, lds, 0);
    GRID_BAR();

    for (int l = 0; l < 2; ++l) {
        const int Mfull = (l == 0) ? MTOT : MLAT;
        phase_norm(I, l, 0, MTOT, l == 0);
        GRID_BAR();
        if (DBG_STOP != 11) {
            const KA ka = ka_fresh(); unsigned char* ws = KWS(ka);
            pg8::Gemm g{(const bf16*)(ws + WS_H), (const bf16*)(ws + WS_WIN), 1024, 1024, MTOT, NB1, 1024, 0};
            pg8::PanelOrder S; S.init(MTOT, NB1, G, bx); S.set_base(ws + WS_CTL); S.wait0 = -1; S.need0 = 0u; S.wait1 = -1; S.need1 = 0u; S.done_cnt = cnt_off(l, 3); S.tmo = CW_BAR + XB_TMO;
            pg8::EpiXbcDt E{(bf16*)(ws + WS_XBC), (bf16*)(ws + WS_Y), (float*)(ws + WS_DT), KIN(ka, 10) + l * 64};
            pg8::gemm_phase<pg8::EpiXbcDt, pg8::PanelOrder>(lds, xl, g, S, E);
        }
        phase_conv(I, lds, l);
        GRID_BAR();
        if (DBG_STOP == 2) { phase_dump(I, WS_XBC, 4096, true, false); return; }
#ifdef SSD_NAIVE
        phase_ssd(I, lds, l);
#elif defined(SSD_V2)
        phase_ssd_dir(I, lds, l);
#else
        phase_ssd3(I, lds, l);
#ifdef REP_SSD
        phase_ssd_mfma(I, lds, l);
#endif
#endif
        GRID_BAR();
        if (DBG_STOP == 1) { phase_dump(I, WS_Y, 2048, true, false); return; }
        if (DBG_STOP == 9) { phase_dump(I, WS_H, 1024, true, false); phase_dump(I, WS_WIN, 1024, false, false, true); return; }
        {
            const KA ka = ka_fresh(); unsigned char* ws = KWS(ka);
            pg8::Gemm g{(const bf16*)(ws + WS_H), (const bf16*)(ws + WS_WIN) + (size_t)NB1 * 1024, 1024, 1024, Mfull, NB2, 1024, 0};
            pg8::PoolChainOrder S; S.init(Mfull, NB2, G, bx); S.set_base(ws + WS_CTL); S.wait0 = -1; S.need0 = 0u; S.wait1 = -1; S.need1 = 0u; S.done_cnt = cnt_off(l, 0); S.tmo = CW_BAR + XB_TMO;
            pg8::EpiZPG E{(bf16*)(ws + WS_Y), (bf16*)(ws + WS_XBC + XO_UPOOL), (bf16*)(ws + WS_XBC + XO_GATES)};
            pg8::gemm_phase<pg8::EpiZPG, pg8::PoolChainOrder>(lds, xl, g, S, E);
        }
        phase_pool(I, lds, l);
        GRID_BAR();
        if (DBG_STOP == 5) { phase_dump(I, WS_Y, 2048, true, false); phase_dump(I, WS_XBC + XO_GATES, 2048, true, false, true); phase_dump(I, WS_XBC + XO_UPOOL, 1024, true, false, true); return; }
        if (DBG_STOP == 8) { { const unsigned long long t0 = __builtin_amdgcn_s_memrealtime(); while (__builtin_amdgcn_s_memrealtime() - t0 < 50000ull) __builtin_amdgcn_s_sleep(32); } GRID_BAR(); phase_dump(I, WS_XBC + XO_GATES, 2048, true, false); phase_dump(I, WS_XBC + XO_UPOOL, 1024, true, false, true); return; }
        {
            const KA ka = ka_fresh(); unsigned char* ws = KWS(ka);
            pg8::Gemm g{(const bf16*)(ws + WS_Y), (const bf16*)(ws + WS_WSSD), 2048, 2048, Mfull, 1024, 2048, 0};
            pg8::ChainOrder S; S.init(Mfull, 1024, G, bx); S.set_base(ws + WS_CTL); S.wait0 = -1; S.need0 = 0u; S.wait1 = -1; S.need1 = 0u; S.done_cnt = cnt_off(l, 1); S.tmo = CW_BAR + XB_TMO;
            pg8::EpiGate<0> E{(bf16*)(ws + WS_XBC + XO_M1), (const bf16*)(ws + WS_XBC + XO_GATES)};
            pg8::gemm_phase<pg8::EpiGate<0>, pg8::ChainOrder>(lds, xl, g, S, E);
        }
        {
            const KA ka = ka_fresh(); unsigned char* ws = KWS(ka);
            pg8::Gemm g{(const bf16*)(ws + WS_XBC + XO_UPOOL), (const bf16*)(ws + WS_WPC), 1024, 1024, Mfull, 1024, 1024, 0};
            pg8::FOrder S; S.ctx_delta = (size_t)((long long)WS_DT - (long long)(WS_XBC + XO_UPOOL) - 64ll * 256 * 1024 * 2); S.init(Mfull, 1024, G, (bx + 16) % G); S.set_base(ws + WS_CTL); S.wait0 = cnt_off(l, 1); S.need0 = 32u; S.wait1 = -1; S.need1 = 0u; S.done_cnt = cnt_off(l, 2); S.tmo = CW_BAR + XB_TMO;
            pg8::EpiGate<1> E{(bf16*)(ws + WS_XBC + XO_M1), (const bf16*)(ws + WS_XBC + XO_GATES)};
            pg8::gemm_phase<pg8::EpiGate<1>, pg8::FOrder>(lds, xl, g, S, E);
        }
        {
            const KA ka = ka_fresh(); unsigned char* ws = KWS(ka);
            pg8::Gemm g{(const bf16*)(ws + WS_XBC + XO_M1), (const bf16*)(ws + WS_WOUT), 1024, 1024, Mfull, 1024, 1024, 0};
            pg8::RelChainOrder S; S.init(Mfull, 1024, G, (bx + 32) % G); S.set_base(ws + WS_CTL); S.wait0 = cnt_off(l, 2); S.need0 = 32u; S.wait1 = -1; S.need1 = 0u; S.done_cnt = cnt_off(l, 4); S.lds_word = (unsigned)(size_t)(lds + MISC_OFF + 46 * 4); S.tmo = CW_BAR + XB_TMO;
            if (l == 0) { pg8::EpiRes<false> E{KIN(ka, 0), (bf16*)KOUT(ka), KIN(ka, 2), (float*)(ws + WS_CX), (const float*)(ws + WS_MOD) + 2048};
                pg8::gemm_phase<pg8::EpiRes<false>, pg8::RelChainOrder>(lds, xl, g, S, E); }
            else { pg8::EpiRes<true> E{nullptr, (bf16*)KOUT(ka), (const float*)(ws + WS_CX), (float*)(ws + WS_CX), (const float*)(ws + WS_MOD) + (size_t)5 * 6144 + 2048};
                pg8::gemm_phase<pg8::EpiRes<true>, pg8::RelChainOrder>(lds, xl, g, S, E); }
        }
        if (l == 0) conv_win_dyn(I, lds, 1);
        phase_norm2_dyn(I, lds, l, Mfull);
        conv_ffn(I, lds, l);
        if (l == 0) conv_mixer(I, lds, 1, true);
        GRID_BAR();
        {
            const KA ka = ka_fresh(); unsigned char* ws = KWS(ka);
            pg8::Gemm g{(const bf16*)(ws + WS_H), (const bf16*)(ws + WS_XBC + XO_WGU), 1024, 1024, Mfull, 2 * FFH, 1024, 0}; pg8::StaticOrder S; S.init(Mfull, 2 * FFH, G, bx);
            pg8::EpiSwiglu E{(bf16*)(ws + WS_XBC + XO_ACT)};
            pg8::gemm_phase<pg8::EpiSwiglu, pg8::StaticOrder>(lds, xl, g, S, E);
        }
        GRID_BAR();
        if (DBG_STOP == 4) { phase_dump(I, WS_XBC + XO_ACT, 2048, false, false); return; }
        {
            const KA ka = ka_fresh(); unsigned char* ws = KWS(ka);
            pg8::Gemm g{(const bf16*)(ws + WS_XBC + XO_ACT), (const bf16*)(ws + WS_XBC + XO_WDN), FFH, FFH, MLAT, 1024, FFH, 0}; pg8::StaticOrder S; S.init(MLAT, 1024, G, bx);
            pg8::EpiRes<true> E{nullptr, (bf16*)KOUT(ka), (const float*)(ws + WS_CX), (float*)(ws + WS_CX), (const float*)(ws + WS_MOD) + (size_t)l * 5 * 6144 + 5120};
            pg8::gemm_phase<pg8::EpiRes<true>, pg8::StaticOrder>(lds, xl, g, S, E);
        }
        if (l == 0) {
            const KA ka = ka_fresh(); unsigned char* ws = KWS(ka);
            pg8::Gemm g{(const bf16*)(ws + WS_XBC + XO_ACT), (const bf16*)(ws + WS_XBC + XO_WDN), FFH, FFH, MTOT, 1024, 256, 0}; pg8::SplitKOrder S; S.G = G; S.c = bx;
            pg8::EpiPart E{(float*)(ws + WS_Y)};
            pg8::gemm_phase<pg8::EpiPart, pg8::SplitKOrder>(lds, xl, g, S, E);
        }
        GRID_BAR();
    }
#ifdef TSEL
    {
        gu32* tw = (gu32*)(KWS(ka_fresh()) + WS_CTL) + 8192;
        if (I.bx == 0 && I.tid == 0) __hip_atomic_store(tw, (unsigned)t_acc, __ATOMIC_RELAXED, __HIP_MEMORY_SCOPE_AGENT);
        xcd_barrier(bar);
        const unsigned long long dur = (unsigned long long)__hip_atomic_load(tw, __ATOMIC_RELAXED, __HIP_MEMORY_SCOPE_AGENT) * TMUL;
        const unsigned long long t0 = __builtin_amdgcn_s_memrealtime(); while (__builtin_amdgcn_s_memrealtime() - t0 < dur) __builtin_amdgcn_s_sleep(16);
    }
#endif
    phase_final(I);
}

extern "C" void kernel_launch(void* const* d_in, const int* in_sizes, int n_in, void* d_out, int out_size, void* d_ws, size_t ws_size, hipStream_t stream) {
    static int grid = 0;
    if (grid == 0) {
        if (n_in != 23 || in_sizes[0] != MLAT * D || out_size != MLAT * D || ws_size < WS_END) { fprintf(stderr, "kernel_launch: unexpected shapes / workspace (n_in %d, ws %zu, need %zu); nothing launched\n", n_in, ws_size, (size_t)WS_END); grid = -1; return; }
        int dev = 0, cus = 0, per_cu = 0;
        if (hipGetDevice(&dev) != hipSuccess || hipDeviceGetAttribute(&cus, hipDeviceAttributeMultiprocessorCount, dev) != hipSuccess) { grid = -1; return; }
        if (hipFuncSetAttribute((const void*)fwd_kernel, hipFuncAttributeMaxDynamicSharedMemorySize, LDS_BYTES) != hipSuccess) { fprintf(stderr, "kernel_launch: hipFuncSetAttribute failed\n"); grid = -1; return; }
        if (hipOccupancyMaxActiveBlocksPerMultiprocessor(&per_cu, (const void*)fwd_kernel, NWAVES * 64, LDS_BYTES) != hipSuccess || per_cu < 1) { fprintf(stderr, "kernel_launch: occupancy query says %d blocks per CU; nothing launched\n", per_cu); (void)hipGetLastError(); grid = -1; return; }
        grid = cus;
        if (grid != 256) { fprintf(stderr, "kernel_launch: built for a 256-CU device (got %d)\n", grid); grid = -1; return; }
    }
    if (grid < 0) return;
    if (hipMemsetAsync((char*)d_ws + WS_CTL, 0, CTL_ZERO_BYTES, stream) != hipSuccess) return;
    Args a{};
    for (int i = 0; i < 23; ++i) a.in[i] = (const float*)d_in[i];
    a.out = (float*)d_out; a.ws = (unsigned char*)d_ws;
    hipLaunchKernelGGL(fwd_kernel, dim3(grid), dim3(NWAVES * 64), LDS_BYTES, stream, a);
}
```

```cpp
#include <hip/hip_runtime.h>
#define SSD_V2 1
#define TSEL_OFF 0ull
#define TMUL 4ull
#include <cstdio>
#include <cstdint>

namespace pg8 {
#define PG8_LAS __attribute__((address_space(3)))
typedef unsigned short bf16_t;
typedef short bf16x8 __attribute__((ext_vector_type(8)));
typedef float f32x4 __attribute__((ext_vector_type(4)));
typedef float f32x2 __attribute__((ext_vector_type(2)));
typedef unsigned u32x4 __attribute__((ext_vector_type(4)));
typedef unsigned u32x2 __attribute__((ext_vector_type(2)));
constexpr int BM = 256, BK = 64, HALF = 128, HTB = HALF * BK * 2, STAGE_BYTES = 8 * HTB, NXCD = 8, WGM = 8;

__host__ __device__ __forceinline__ int lds_byte(int r, int c) { const int st = (r >> 4) * 2 + (c >> 5), rr = r & 15, cc = c & 31, ob = rr * 64 + cc * 2; return st * 1024 + (ob ^ (((ob >> 9) & 1) << 5)); }
__host__ __device__ __forceinline__ void stage_rc(int b, int& R, int& C) { const int st = b / 1024, sb = b % 1024, swz = sb ^ (((sb >> 9) & 1) << 5); R = (st >> 1) * 16 + swz / 64; C = (st & 1) * 32 + (swz % 64) / 2; }
__host__ __device__ __forceinline__ int perm32(int rho) { const int n = rho >> 4, i = rho & 15; return 8 * (i >> 2) + 4 * n + (i & 3); }

extern __shared__ __attribute__((aligned(16))) unsigned char lds_dyn[];
constexpr int WAVE_TAB_OFF = 159744 + 1024;
__device__ __forceinline__ int lane_now() { int r; asm volatile("v_mbcnt_lo_u32_b32 %0, -1, 0\n\tv_mbcnt_hi_u32_b32 %0, -1, %0" : "=v"(r)); return r; }
__device__ __forceinline__ int hw_slot() { return (int)(__builtin_amdgcn_s_getreg(4 | (0 << 6) | (5 << 11)) & 63u); }
__device__ __forceinline__ int wave_now() { return __builtin_amdgcn_readfirstlane((int)((volatile PG8_LAS unsigned*)(lds_dyn + WAVE_TAB_OFF))[hw_slot()]); }
__device__ __forceinline__ int tid_now() { return wave_now() * 64 + lane_now(); }
struct Unit { int pm, pn; };
struct Gemm { const bf16_t* A; const bf16_t* Bt; int lda, ldb, M, N, K, a_pn_off; };

struct StaticOrder {
    int nM, nN, nwg, G, c;
    __host__ __device__ void init(int M, int N, int G_, int c_) { nM = M / BM; nN = N / BM; nwg = nM * nN; G = G_; c = c_; }
    __host__ __device__ bool next(int i, Unit& u) const {
        const long L = (long)i * G + c; if (L >= nwg) return false;
        int wgid = (int)L; { const int q = nwg / NXCD, r = nwg % NXCD, xcd = wgid % NXCD, off = wgid / NXCD; wgid = (xcd < r ? xcd * (q + 1) : r * (q + 1) + (xcd - r) * q) + off; }
        const int nig = WGM * nN, gid = wgid / nig, fm = gid * WGM, gsz = (nM - fm) < WGM ? (nM - fm) : WGM;
        u.pm = fm + ((wgid % nig) % gsz); u.pn = (wgid % nig) / gsz; return true;
    }
    __device__ __forceinline__ size_t a_off(const Unit& u, const Gemm& g, size_t tsA) const { return (size_t)u.pm * tsA + (size_t)u.pn * g.a_pn_off * 2; }
    __device__ __forceinline__ size_t b_off(const Unit& u, const Gemm&, size_t tsB) const { return (size_t)u.pn * tsB; }
    __device__ __forceinline__ void a_ready(const Unit&) const {}
    __device__ __forceinline__ void done(const Unit&) const {}
};
#define PG8_GAS __attribute__((address_space(1)))
typedef PG8_GAS unsigned pg8_gu32;
struct ChainOrder : StaticOrder {
    unsigned ctl_lo, ctl_hi;
    int wait0, wait1, done_cnt, tmo;
    unsigned need0, need1;
    __device__ __forceinline__ void set_base(const void* ctl) { const unsigned long long a = (unsigned long long)ctl; ctl_lo = (unsigned)__builtin_amdgcn_readfirstlane((int)(unsigned)a); ctl_hi = (unsigned)__builtin_amdgcn_readfirstlane((int)(unsigned)(a >> 32)); }
    __device__ __forceinline__ pg8_gu32* word(int off) const { return (pg8_gu32*)(((unsigned long long)ctl_hi << 32) | (unsigned long long)ctl_lo) + off; }
    __device__ __forceinline__ void a_ready(const Unit& u) const {
        if (wait0 >= 0) {
            if (wave_now() == 0) {
                unsigned sp = 0;
                for (;;) {
                    bool ok = (unsigned)__builtin_amdgcn_readfirstlane(__hip_atomic_load(word(wait0 + 64 * u.pm), __ATOMIC_RELAXED, __HIP_MEMORY_SCOPE_AGENT)) >= need0;
                    if (ok && wait1 >= 0) ok = (unsigned)__builtin_amdgcn_readfirstlane(__hip_atomic_load(word(wait1 + 64 * u.pm), __ATOMIC_RELAXED, __HIP_MEMORY_SCOPE_AGENT)) >= need1;
                    if (ok) break;
                    __builtin_amdgcn_s_sleep(2);
                    if ((++sp & 255u) == 0u) { if (__builtin_amdgcn_readfirstlane(__hip_atomic_load(word(tmo), __ATOMIC_RELAXED, __HIP_MEMORY_SCOPE_AGENT)) != 0u) break;
                        if (sp > (1u << 20)) { if (lane_now() == 0) __hip_atomic_fetch_add(word(tmo), 1u, __ATOMIC_RELAXED, __HIP_MEMORY_SCOPE_AGENT); break; } }
                }
                __builtin_amdgcn_fence(__ATOMIC_ACQUIRE, "agent");
                asm volatile("s_waitcnt vmcnt(0)" ::: "memory");
            }
            asm volatile("" ::: "memory"); __builtin_amdgcn_s_barrier(); asm volatile("" ::: "memory");
        }
    }
    __device__ __forceinline__ void done(const Unit& u) const {
        if (done_cnt >= 0) { asm volatile("s_waitcnt vmcnt(0)" ::: "memory");
            if (lane_now() == 0) __hip_atomic_fetch_add(word(done_cnt + 64 * u.pm), 1u, __ATOMIC_RELAXED, __HIP_MEMORY_SCOPE_AGENT); }
    }
};

struct PanelOrder : ChainOrder {
    __device__ __forceinline__ bool next(int i, Unit& u) const {
        const int x = c & 7, j = c >> 3, k0 = (nwg * x) >> 3, k1 = (nwg * (x + 1)) >> 3, k = k0 + j + (G >> 3) * i;
        if (k >= k1) return false;
        u.pm = k / nN; u.pn = k - u.pm * nN; return true;
    }
};
struct PoolChainOrder : PanelOrder {
    __device__ __forceinline__ void done(const Unit& u) const { if (u.pn >= 8 && u.pn < 12) ChainOrder::done(u); }
};
struct RelChainOrder : ChainOrder {
    unsigned lds_word;
    __device__ __forceinline__ void done(const Unit& u) const {
        asm volatile("s_waitcnt vmcnt(0)" ::: "memory");
        unsigned prev = 0u;
        if (lane_now() == 0) prev = __hip_atomic_fetch_add((PG8_LAS unsigned*)(size_t)lds_word, 1u, __ATOMIC_RELAXED, __HIP_MEMORY_SCOPE_WORKGROUP);
        prev = (unsigned)__builtin_amdgcn_readfirstlane((int)prev);
        if (prev == 7u) {
            if (lane_now() == 0) __hip_atomic_store((PG8_LAS unsigned*)(size_t)lds_word, 0u, __ATOMIC_RELAXED, __HIP_MEMORY_SCOPE_WORKGROUP);
            __builtin_amdgcn_fence(__ATOMIC_RELEASE, "agent"); asm volatile("s_waitcnt vmcnt(0)" ::: "memory");
            if (lane_now() == 0) __hip_atomic_fetch_add(word(done_cnt + 64 * u.pm), 8u, __ATOMIC_RELAXED, __HIP_MEMORY_SCOPE_AGENT);
        }
    }
};
struct FOrder : ChainOrder {
    size_t ctx_delta;
    __device__ __forceinline__ size_t a_off(const Unit& u, const Gemm& g, size_t tsA) const { return (size_t)u.pm * tsA + (u.pm >= 64 ? ctx_delta : (size_t)0); }
};
struct SplitChain : ChainOrder {
    int nun, nsl, ksb, a_pm_sub;
    __device__ __forceinline__ bool next(int i, Unit& u) const { const int L = i * G + c; if (L >= nun) return false; const int ks = L % nsl, tile = L / nsl; u.pm = 64 + (tile >> 2); u.pn = (tile & 3) + 4 * ks; return true; }
    __device__ __forceinline__ size_t a_off(const Unit& u, const Gemm&, size_t tsA) const { return (size_t)(u.pm - a_pm_sub) * tsA + (size_t)(u.pn >> 2) * ksb; }
    __device__ __forceinline__ size_t b_off(const Unit& u, const Gemm&, size_t tsB) const { return (size_t)(u.pn & 3) * tsB + (size_t)(u.pn >> 2) * ksb; }
};
__device__ __forceinline__ int opaque_v(int x) { asm volatile("" : "+v"(x)); return x; }
__device__ __forceinline__ int opaque_s(int x) { asm volatile("" : "+s"(x)); return x; }
template <int O> __device__ __forceinline__ float lane_xor(float v) { static_assert(O < 32, "within a 32-lane half"); return __int_as_float(__builtin_amdgcn_ds_swizzle(__float_as_int(v), (O << 10) | 0x1f)); }
__device__ __forceinline__ float half_sum(float v) { const auto r = __builtin_amdgcn_permlane32_swap(__float_as_uint(v), __float_as_uint(v), false, false); return __uint_as_float(r[0]) + __uint_as_float(r[1]); }
__device__ __forceinline__ float softplus(float x) { if (x > 20.f) return x; const float e = __expf(x), u = 1.f + e; return u == 1.f ? e : __logf(u) * e * __builtin_amdgcn_rcpf(u - 1.f); }
typedef __bf16 bf16x2_t __attribute__((ext_vector_type(2)));
__device__ __forceinline__ unsigned cvt_pk_bf16(float lo, float hi) { const f32x2 v = {lo, hi}; return __builtin_bit_cast(unsigned, __builtin_convertvector(v, bf16x2_t)); }
__device__ __forceinline__ float bflo(unsigned u) { return __uint_as_float(u << 16); }
__device__ __forceinline__ float bfhi(unsigned u) { return __uint_as_float(u & 0xffff0000u); }
__device__ __forceinline__ float sigm(float v) { return __builtin_amdgcn_rcpf(1.f + __expf(-v)); }
__device__ __forceinline__ float silu(float v) { return v * sigm(v); }
__device__ __forceinline__ u32x4 pack8(const f32x4 a, const f32x4 b) { u32x4 w; w.x = cvt_pk_bf16(a[0], a[1]); w.y = cvt_pk_bf16(a[2], a[3]); w.z = cvt_pk_bf16(b[0], b[1]); w.w = cvt_pk_bf16(b[2], b[3]); return w; }

constexpr int SEGR = 68;
constexpr int MTOT_ROWS = 17408;

struct EpiPlain {
    static constexpr bool PERM = true;
    bf16_t* O; int ldc;
    __device__ __forceinline__ void operator()(f32x4 (&acc)[2][2][4][2], const Unit& u, int wr, int wc, int fr, int fq, PG8_LAS unsigned char*) const {
        const int row0 = u.pm * BM + wr * 64 + fr, col0 = u.pn * BM + wc * 32 + 8 * fq;
#pragma unroll
        for (int ai = 0; ai < 2; ++ai)
#pragma unroll
            for (int m = 0; m < 4; ++m) { bf16_t* rowp = O + (size_t)(row0 + ai * HALF + m * 16) * ldc + col0;
#pragma unroll
                for (int bj = 0; bj < 2; ++bj) *(u32x4*)(rowp + bj * HALF) = pack8(acc[ai][bj][m][0], acc[ai][bj][m][1]); }
    }
};

struct EpiXbcDt {
    static constexpr bool PERM = true;
    bf16_t* XBC; bf16_t* HALO; float* DT; const float* dt_bias;
    __device__ __forceinline__ void operator()(f32x4 (&acc)[2][2][4][2], const Unit& u, int wr, int wc, int fr, int fq, PG8_LAS unsigned char*) const {
        const int row0 = u.pm * BM + wr * 64 + fr;
        if (u.pn < 16) {
            const int col0 = u.pn * BM + wc * 32 + 8 * fq;
            const __amdgpu_buffer_rsrc_t rsx = __builtin_amdgcn_make_buffer_rsrc((void*)XBC, (short)0, 17408 * 4096 * 2, 0x00020000), rsh = __builtin_amdgcn_make_buffer_rsrc((void*)HALO, (short)0, 544 * 4 * 4096 * 2, 0x00020000);
#pragma unroll
            for (int ai = 0; ai < 2; ++ai)
#pragma unroll
                for (int m = 0; m < 4; ++m) { const int r = row0 + ai * HALF + m * 16; const unsigned ro = (unsigned)(((size_t)r * 4096 + col0) * 2);
                    const int seg = r >> 5, rs = r & 31; const int hs = rs < 2 ? rs : (rs >= 30 ? rs - 28 : -1);
#pragma unroll
                    for (int bj = 0; bj < 2; ++bj) { const u32x4 w = pack8(acc[ai][bj][m][0], acc[ai][bj][m][1]); __builtin_amdgcn_raw_buffer_store_b128(w, rsx, ro + bj * HALF * 2, 0, 16);
                        if (hs >= 0) __builtin_amdgcn_raw_buffer_store_b128(w, rsh, (unsigned)(((size_t)(seg * 4 + hs) * 4096 + col0 + bj * HALF) * 2), 0, 16); } }
        } else if (wc < 2) {
            const int c0 = wc * 32 + 8 * fq;
            const f32x4 b0 = *(const f32x4*)(dt_bias + c0), b1 = *(const f32x4*)(dt_bias + c0 + 4);
#pragma unroll
            for (int ai = 0; ai < 2; ++ai)
#pragma unroll
                for (int m = 0; m < 4; ++m) { const int r = row0 + ai * HALF + m * 16; float* colp = DT + (size_t)c0 * MTOT_ROWS + r;
                    f32x4 v0 = acc[ai][0][m][0] + b0, v1 = acc[ai][0][m][1] + b1;
#pragma unroll
                    for (int j = 0; j < 4; ++j) { colp[(size_t)j * MTOT_ROWS] = softplus(v0[j]); colp[(size_t)(4 + j) * MTOT_ROWS] = softplus(v1[j]); } }
        }
    }
};

struct EpiZPG {
    static constexpr bool PERM = true;
    bf16_t* Y; bf16_t* UPOOL; bf16_t* GATES;
    __device__ __forceinline__ void operator()(f32x4 (&acc)[2][2][4][2], const Unit& u, int wr, int wc, int fr, int fq, PG8_LAS unsigned char* xl) const {
        const int row0 = u.pm * BM + wr * 64 + fr;
#ifdef DBG_SKIPZ
        if (u.pn < 8) { return; }
#endif
        if (u.pn < 8) {
            const int col0 = u.pn * BM + wc * 32 + 8 * fq;
            PG8_LAS float* P = (PG8_LAS float*)xl;
            u32x4 yva[2][4][2];
#pragma unroll
            for (int ai = 0; ai < 2; ++ai)
#pragma unroll
                for (int m = 0; m < 4; ++m) { const bf16_t* yp = Y + (size_t)(row0 + ai * HALF + m * 16) * 2048 + col0; yva[ai][m][0] = *(const u32x4*)yp; yva[ai][m][1] = *(const u32x4*)(yp + HALF); }
#pragma unroll
            for (int ai = 0; ai < 2; ++ai) {
#pragma unroll
                for (int m = 0; m < 4; ++m) { float s = 0.f;
#pragma unroll
                    for (int bj = 0; bj < 2; ++bj) { const u32x4 yv = yva[ai][m][bj]; f32x4 v0 = acc[ai][bj][m][0], v1 = acc[ai][bj][m][1];
                        v0[0] = bflo(yv.x) * silu(v0[0]); v0[1] = bfhi(yv.x) * silu(v0[1]); v0[2] = bflo(yv.y) * silu(v0[2]); v0[3] = bfhi(yv.y) * silu(v0[3]);
                        v1[0] = bflo(yv.z) * silu(v1[0]); v1[1] = bfhi(yv.z) * silu(v1[1]); v1[2] = bflo(yv.w) * silu(v1[2]); v1[3] = bfhi(yv.w) * silu(v1[3]);
                        s += (v0[0] * v0[0] + v0[1] * v0[1]) + (v0[2] * v0[2] + v0[3] * v0[3]) + (v1[0] * v1[0] + v1[1] * v1[1]) + (v1[2] * v1[2] + v1[3] * v1[3]);
                        acc[ai][bj][m][0] = v0; acc[ai][bj][m][1] = v1; }
                    s += lane_xor<16>(s); s = half_sum(s);
                    if (fq == 0) P[(ai * HALF + wr * 64 + m * 16 + fr) * 4 + wc] = s; }
                asm volatile("" ::: "memory"); }
#ifndef DBG_NOZBAR
            asm volatile("s_waitcnt lgkmcnt(0)" ::: "memory"); __builtin_amdgcn_s_barrier(); asm volatile("" ::: "memory");
#else
            asm volatile("s_waitcnt lgkmcnt(0)" ::: "memory");
#endif
#pragma unroll
            for (int ai = 0; ai < 2; ++ai)
#pragma unroll
                for (int m = 0; m < 4; ++m) {
#ifndef DBG_NOZBAR
                    const f32x4 p = *(const PG8_LAS f32x4*)(P + (ai * HALF + wr * 64 + m * 16 + fr) * 4);
#else
                    const float pw_ = P[(ai * HALF + wr * 64 + m * 16 + fr) * 4 + wc]; const f32x4 p = {pw_, pw_, pw_, pw_};
#endif

                    const float rstd = rsqrtf(((p[0] + p[1]) + (p[2] + p[3])) * (1.0f / 256.0f) + 1e-6f);
                    bf16_t* yp = Y + (size_t)(row0 + ai * HALF + m * 16) * 2048 + col0;
#pragma unroll
                    for (int bj = 0; bj < 2; ++bj) *(u32x4*)(yp + bj * HALF) = pack8(acc[ai][bj][m][0] * rstd, acc[ai][bj][m][1] * rstd); }
        } else if (u.pn < 12) {
            const int col0 = (u.pn - 8) * BM + wc * 32 + 8 * fq;
            const __amdgpu_buffer_rsrc_t rsU = __builtin_amdgcn_make_buffer_rsrc((void*)UPOOL, (short)0, 17408 * 1024 * 2, 0x00020000);
#pragma unroll
            for (int ai = 0; ai < 2; ++ai)
#pragma unroll
                for (int m = 0; m < 4; ++m) { const unsigned ro = (unsigned)(((size_t)(row0 + ai * HALF + m * 16) * 1024 + col0) * 2);
#pragma unroll
                    for (int bj = 0; bj < 2; ++bj) __builtin_amdgcn_raw_buffer_store_b128(pack8(acc[ai][bj][m][0], acc[ai][bj][m][1]), rsU, ro + bj * HALF * 2, 0, 16); }
        } else {
            const int col0 = (u.pn - 12) * BM + wc * 32 + 8 * fq;
#pragma unroll
            for (int ai = 0; ai < 2; ++ai)
#pragma unroll
                for (int m = 0; m < 4; ++m) { bf16_t* rowp = GATES + (size_t)(row0 + ai * HALF + m * 16) * 2048 + col0;
#pragma unroll
                    for (int bj = 0; bj < 2; ++bj) { f32x4 v0 = acc[ai][bj][m][0], v1 = acc[ai][bj][m][1];
#pragma unroll
                        for (int j = 0; j < 4; ++j) { v0[j] = sigm(v0[j]); v1[j] = sigm(v1[j]); }
                        *(u32x4*)(rowp + bj * HALF) = pack8(v0, v1); } }
        }
    }
};

template <int MODE  > struct EpiGate {
    static constexpr bool PERM = true;
    bf16_t* M1; const bf16_t* GATES;
    __device__ __forceinline__ void operator()(f32x4 (&acc)[2][2][4][2], const Unit& u, int wr, int wc, int fr, int fq, PG8_LAS unsigned char*) const {
        const int row0 = u.pm * BM + wr * 64 + fr, col0 = u.pn * BM + wc * 32 + 8 * fq;
        const __amdgpu_buffer_rsrc_t rs = __builtin_amdgcn_make_buffer_rsrc((void*)M1, (short)0, 17408 * 1024 * 2, 0x00020000);
#pragma unroll
        for (int ai = 0; ai < 2; ++ai) {
            u32x4 gv[4][2], ov[4][2];
#pragma unroll
            for (int m = 0; m < 4; ++m) { const int r = row0 + ai * HALF + m * 16; const bf16_t* gp = GATES + (size_t)r * 2048 + MODE * 1024 + col0; const bf16_t* mp = M1 + (size_t)r * 1024 + col0;
                gv[m][0] = *(const u32x4*)gp; gv[m][1] = *(const u32x4*)(gp + HALF);
                if (MODE == 1) { ov[m][0] = *(const u32x4*)mp; ov[m][1] = *(const u32x4*)(mp + HALF); } }
#pragma unroll
            for (int m = 0; m < 4; ++m) { bf16_t* mp = M1 + (size_t)(row0 + ai * HALF + m * 16) * 1024 + col0;
#pragma unroll
                for (int bj = 0; bj < 2; ++bj) { const u32x4 g = gv[m][bj]; f32x4 v0 = acc[ai][bj][m][0], v1 = acc[ai][bj][m][1];
                    v0[0] *= bflo(g.x); v0[1] *= bfhi(g.x); v0[2] *= bflo(g.y); v0[3] *= bfhi(g.y); v1[0] *= bflo(g.z); v1[1] *= bfhi(g.z); v1[2] *= bflo(g.w); v1[3] *= bfhi(g.w);
                    if (MODE == 1) { const u32x4 o = ov[m][bj];
                        v0[0] += bflo(o.x); v0[1] += bfhi(o.x); v0[2] += bflo(o.y); v0[3] += bfhi(o.y); v1[0] += bflo(o.z); v1[1] += bfhi(o.z); v1[2] += bflo(o.w); v1[3] += bfhi(o.w); }
                    __builtin_amdgcn_raw_buffer_store_b128(pack8(v0, v1), rs, (unsigned)((size_t)((const char*)(mp + bj * HALF) - (const char*)M1)), 0,   16); } }
            asm volatile("" ::: "memory"); }
    }
};

template <bool LAT_BASE_BF16, int AUX = 0  > struct EpiRes {
    static constexpr bool PERM = true;
    const float* base_lat_f32; bf16_t* xr; const float* base_ctx; float* out_ctx; const float* gate;
    __device__ __forceinline__ void operator()(f32x4 (&acc)[2][2][4][2], const Unit& u, int wr, int wc, int fr, int fq, PG8_LAS unsigned char*) const {
        constexpr bool lat = true;
        const int row0 = (lat ? u.pm : u.pm - 64) * BM + wr * 64 + fr, col0 = u.pn * BM + wc * 32 + 8 * fq;
        const float* gp = gate + (lat ? (u.pm >> 4) : 4) * 6144 + col0;
        f32x4 gv[2][2];
#pragma unroll
        for (int bj = 0; bj < 2; ++bj)
#pragma unroll
            for (int n = 0; n < 2; ++n) gv[bj][n] = *(const f32x4*)(gp + bj * HALF + 4 * n);
        const __amdgpu_buffer_rsrc_t rsX = __builtin_amdgcn_make_buffer_rsrc((void*)xr, (short)0, 16384 * 2048 * 2, 0x00020000);
        if (lat && LAT_BASE_BF16) {
#pragma unroll
            for (int ai = 0; ai < 2; ++ai) {
                u32x4 bb[4][2];
#pragma unroll
                for (int m = 0; m < 4; ++m)
#pragma unroll
                    for (int bj = 0; bj < 2; ++bj) bb[m][bj] = *(const u32x4*)(xr + (size_t)(row0 + ai * HALF + m * 16) * 2048 + col0 + bj * HALF);
#pragma unroll
                for (int m = 0; m < 4; ++m)
#pragma unroll
                    for (int bj = 0; bj < 2; ++bj) { const u32x4 o = bb[m][bj]; f32x4 v0 = gv[bj][0] * acc[ai][bj][m][0], v1 = gv[bj][1] * acc[ai][bj][m][1];
                        v0[0] += bflo(o.x); v0[1] += bfhi(o.x); v0[2] += bflo(o.y); v0[3] += bfhi(o.y); v1[0] += bflo(o.z); v1[1] += bfhi(o.z); v1[2] += bflo(o.w); v1[3] += bfhi(o.w);
                        __builtin_amdgcn_raw_buffer_store_b128(pack8(v0, v1), rsX, (unsigned)(((size_t)(row0 + ai * HALF + m * 16) * 2048 + col0 + bj * HALF) * 2), 0, AUX); }
                asm volatile("" ::: "memory"); }
        } else {
            const float* base = lat ? base_lat_f32 : base_ctx;
#pragma unroll
            for (int ai = 0; ai < 2; ++ai) {
                f32x4 bs[4][2][2];
#pragma unroll
                for (int m = 0; m < 4; ++m) { const size_t off = (size_t)(row0 + ai * HALF + m * 16) * 1024 + col0;
#pragma unroll
                    for (int bj = 0; bj < 2; ++bj)
#pragma unroll
                        for (int n = 0; n < 2; ++n) bs[m][bj][n] = *(const f32x4*)(base + off + bj * HALF + 4 * n); }
#pragma unroll
                for (int m = 0; m < 4; ++m) { const int r = row0 + ai * HALF + m * 16;
#pragma unroll
                    for (int bj = 0; bj < 2; ++bj) { const f32x4 v0 = bs[m][bj][0] + gv[bj][0] * acc[ai][bj][m][0], v1 = bs[m][bj][1] + gv[bj][1] * acc[ai][bj][m][1];
                        if (lat) __builtin_amdgcn_raw_buffer_store_b128(pack8(v0, v1), rsX, (unsigned)(((size_t)r * 2048 + col0 + bj * HALF) * 2), 0, AUX);
                        else { float* op = out_ctx + (size_t)r * 1024 + col0 + bj * HALF; *(f32x4*)op = v0; *(f32x4*)(op + 4) = v1; } } }
                asm volatile("" ::: "memory"); }
        }
    }
};

struct SplitKOrder {
    int G, c;
    __device__ __forceinline__ bool next(int i, Unit& u) const { const int L = i * G + c; if (L >= 176) return false; const int ks = L % 11, tile = L / 11; u.pm = 64 + (tile >> 2); u.pn = (tile & 3) + 4 * ks; return true; }
    __device__ __forceinline__ size_t a_off(const Unit& u, const Gemm&, size_t tsA) const { return (size_t)u.pm * tsA + (size_t)(u.pn >> 2) * 512; }
    __device__ __forceinline__ size_t b_off(const Unit& u, const Gemm&, size_t tsB) const { return (size_t)(u.pn & 3) * tsB + (size_t)(u.pn >> 2) * 512; }
    __device__ __forceinline__ void a_ready(const Unit&) const {}
    __device__ __forceinline__ void done(const Unit&) const {}
};
struct EpiPart {
    static constexpr bool PERM = true;
    float* P;
    __device__ __forceinline__ void operator()(f32x4 (&acc)[2][2][4][2], const Unit& u, int wr, int wc, int fr, int fq, PG8_LAS unsigned char*) const {
        const int ks = u.pn >> 2, row0 = (u.pm - 64) * BM + opaque_v(wr * 64 + fr), col0 = (u.pn & 3) * BM + wc * 32 + 8 * fq;
#pragma unroll
        for (int ai = 0; ai < 2; ++ai)
#pragma unroll
            for (int m = 0; m < 4; ++m) { float* op = P + ((size_t)ks * 1024 + row0 + ai * HALF + m * 16) * 1024 + col0;
#pragma unroll
                for (int bj = 0; bj < 2; ++bj) { *(f32x4*)(op + bj * HALF) = acc[ai][bj][m][0]; *(f32x4*)(op + bj * HALF + 4) = acc[ai][bj][m][1]; } }
    }
};

template <int AUX  , bool BF = false  > struct EpiPartW {
    static constexpr bool PERM = true;
    float* P; int ks_base;
    __device__ __forceinline__ void operator()(f32x4 (&acc)[2][2][4][2], const Unit& u, int wr, int wc, int fr, int fq, PG8_LAS unsigned char*) const {
        const int ks = (u.pn >> 2) + ks_base, row0 = (u.pm - 64) * BM + opaque_v(wr * 64 + fr), col0 = (u.pn & 3) * BM + wc * 32 + 8 * fq;
        const __amdgpu_buffer_rsrc_t rs = __builtin_amdgcn_make_buffer_rsrc((void*)P, (short)0, 12 * 1024 * 1024 * 4, 0x00020000);
#pragma unroll
        for (int ai = 0; ai < 2; ++ai)
#pragma unroll
            for (int m = 0; m < 4; ++m) { const unsigned oe = (unsigned)(((size_t)ks * 1024 + row0 + ai * HALF + m * 16) * 1024 + col0);
#pragma unroll
                for (int bj = 0; bj < 2; ++bj) {
                    if (BF) __builtin_amdgcn_raw_buffer_store_b128(pack8(acc[ai][bj][m][0], acc[ai][bj][m][1]), rs, (oe + bj * HALF) * 2, 0, AUX);
                    else { __builtin_amdgcn_raw_buffer_store_b128(__builtin_bit_cast(u32x4, acc[ai][bj][m][0]), rs, (oe + bj * HALF) * 4, 0, AUX); __builtin_amdgcn_raw_buffer_store_b128(__builtin_bit_cast(u32x4, acc[ai][bj][m][1]), rs, (oe + bj * HALF) * 4 + 16, 0, AUX); } } }
    }
};

struct EpiSwiglu {
    static constexpr bool PERM = true;
    bf16_t* ACT;
    __device__ __forceinline__ void operator()(f32x4 (&acc)[2][2][4][2], const Unit& u, int wr, int wc, int fr, int fq, PG8_LAS unsigned char*) const {
        const int row0 = u.pm * BM + wr * 64 + fr, j0 = u.pn * 128 + wc * 32 + 8 * fq;
#pragma unroll
        for (int ai = 0; ai < 2; ++ai)
#pragma unroll
            for (int m = 0; m < 4; ++m) { bf16_t* rowp = ACT + (size_t)(row0 + ai * HALF + m * 16) * 2816 + j0;
                const f32x4 a0 = acc[ai][0][m][0], b0 = acc[ai][0][m][1], a1 = acc[ai][1][m][0], b1 = acc[ai][1][m][1];
                u32x4 w; w.x = cvt_pk_bf16(silu(a0[0]) * b0[0], silu(a0[1]) * b0[1]); w.y = cvt_pk_bf16(silu(a0[2]) * b0[2], silu(a0[3]) * b0[3]);
                w.z = cvt_pk_bf16(silu(a1[0]) * b1[0], silu(a1[1]) * b1[1]); w.w = cvt_pk_bf16(silu(a1[2]) * b1[2], silu(a1[3]) * b1[3]);
                *(u32x4*)rowp = w; }
    }
};

template <class Epi, class Sched, bool ALIGN_EPI = true, bool SP2 = true>
__device__ __forceinline__ void gemm_phase(PG8_LAS unsigned char* lds, PG8_LAS unsigned char* xl, const Gemm g, const Sched& S, const Epi& E) {
    const int tid = opaque_v(tid_now()), wid = __builtin_amdgcn_readfirstlane(tid >> 6), lane = tid & 63, wr = wid >> 2, wc = wid & 3, fr = lane & 15, fq = lane >> 4;
    const int K = g.K, nt = K / BK;
    unsigned voffA[2], voffB[2];
#pragma unroll
    for (int i = 0; i < 2; ++i) { int R, C; stage_rc(tid * 16 + i * 8192, R, C); const int Rb = Epi::PERM ? ((R & ~31) + perm32(R & 31)) : R;
        voffA[i] = (unsigned)(R * g.lda + C) * 2u; voffB[i] = (unsigned)(Rb * g.ldb + C) * 2u; }
    const size_t kstep = (size_t)(BK * 2);
    const size_t hsA = (size_t)HALF * g.lda * 2, hsB = (size_t)HALF * g.ldb * 2;
    const size_t tsA = 2 * hsA, tsB = 2 * hsB;
    const unsigned ldsw = (unsigned)wid * 1024u;
    const int aoff = lds_byte(wr * 64 + fr, fq * 8), boff = lds_byte(wc * 32 + fr, fq * 8);
#define PG8_SA(b, h) (((b) * 2 + (h)) * HTB)
#define PG8_SB(b, h) ((4 + (b) * 2 + (h)) * HTB)
#define PG8_STAGE(bufoff, gbase, voff) do { _Pragma("unroll") for (int _i = 0; _i < 2; ++_i) \
        __builtin_amdgcn_global_load_lds((const unsigned*)((const char*)(gbase) + (voff)[_i]), (PG8_LAS unsigned*)(lds + (bufoff) + ldsw + _i * 8192), 16, 0, 0); } while (0)
#define PG8_LDA(dst, b, h) do { _Pragma("unroll") for (int m = 0; m < 4; ++m) _Pragma("unroll") for (int k = 0; k < 2; ++k) dst[m][k] = *(const PG8_LAS bf16x8*)(lds + PG8_SA(b, h) + aoff + m * 2048 + k * 1024); } while (0)
#define PG8_LDB(dst, b, h) do { _Pragma("unroll") for (int n = 0; n < 2; ++n) _Pragma("unroll") for (int k = 0; k < 2; ++k) dst[n][k] = *(const PG8_LAS bf16x8*)(lds + PG8_SB(b, h) + boff + n * 2048 + k * 1024); } while (0)
#define PG8_MMA(ai, bj, At, Bt) do { __builtin_amdgcn_s_setprio(1); _Pragma("unroll") for (int m = 0; m < 4; ++m) _Pragma("unroll") for (int n = 0; n < 2; ++n) _Pragma("unroll") for (int k = 0; k < 2; ++k) \
        acc[ai][bj][m][n] = __builtin_amdgcn_mfma_f32_16x16x32_bf16(Bt[n][k], At[m][k], acc[ai][bj][m][n], 0, 0, 0); __builtin_amdgcn_s_setprio(0); } while (0)
#define PG8_WAIT_V(n) asm volatile("s_waitcnt vmcnt(" #n ")" ::: "memory")
#define PG8_WAIT_L(n) asm volatile("s_waitcnt lgkmcnt(" #n ")" ::: "memory")
#define PG8_BAR __builtin_amdgcn_s_barrier()
#define PG8_SCHED __builtin_amdgcn_sched_barrier(0)
    Unit cur, nxt; int ui = 0;
    if (!S.next(0, cur)) return;
    f32x4 acc[2][2][4][2];
#pragma unroll
    for (int a = 0; a < 2; ++a)
#pragma unroll
        for (int b = 0; b < 2; ++b)
#pragma unroll
            for (int m = 0; m < 4; ++m)
#pragma unroll
                for (int n = 0; n < 2; ++n) acc[a][b][m][n] = (f32x4){0.f, 0.f, 0.f, 0.f};
    bf16x8 At[4][2], B0[2][2], B1[2][2];
    const char* cA = (const char*)g.A + S.a_off(cur, g, tsA); const char* cB = (const char*)g.Bt + S.b_off(cur, g, tsB);
    S.a_ready(cur);
    if constexpr (SP2) {
        PG8_STAGE(PG8_SB(0, 0), cB, voffB); PG8_STAGE(PG8_SB(0, 1), cB + hsB, voffB); PG8_STAGE(PG8_SA(0, 0), cA, voffA); PG8_STAGE(PG8_SA(0, 1), cA + hsA, voffA);
        if (wr == 1) PG8_BAR;
        PG8_WAIT_V(2); PG8_BAR;
        PG8_STAGE(PG8_SB(1, 0), cB + kstep, voffB); PG8_STAGE(PG8_SA(1, 0), cA + kstep, voffA); PG8_STAGE(PG8_SB(1, 1), cB + hsB + kstep, voffB);
        PG8_WAIT_V(6); PG8_BAR;
    } else {
        PG8_STAGE(PG8_SB(0, 0), cB, voffB); PG8_STAGE(PG8_SA(0, 0), cA, voffA); PG8_STAGE(PG8_SB(0, 1), cB + hsB, voffB); PG8_STAGE(PG8_SA(0, 1), cA + hsA, voffA);
        if (wr == 1) PG8_BAR;
        PG8_WAIT_V(4); PG8_BAR;
        PG8_STAGE(PG8_SB(1, 0), cB + kstep, voffB); PG8_STAGE(PG8_SA(1, 0), cA + kstep, voffA); PG8_STAGE(PG8_SB(1, 1), cB + hsB + kstep, voffB);
        PG8_WAIT_V(6); PG8_BAR;
    }
    for (;;) {
        const bool has_next = S.next(ui + 1, nxt);
        const char* nA = has_next ? (const char*)g.A + S.a_off(nxt, g, tsA) : cA; const char* nB = has_next ? (const char*)g.Bt + S.b_off(nxt, g, tsB) : cB;
        for (int t = 0; t < nt; t += 2) {
            const bool last = (t == nt - 2);
            const char* a1 = cA + (size_t)(t + 1) * kstep;
            const char* a2 = last ? nA : cA + (size_t)(t + 2) * kstep; const char* b2 = last ? nB : cB + (size_t)(t + 2) * kstep;
            const char* a3 = a2 + kstep; const char* b3 = b2 + kstep;
            if (last && has_next) S.a_ready(nxt);
            if constexpr (SP2) {
            PG8_LDB(B0, 0, 0); PG8_LDB(B1, 0, 1); PG8_SCHED; PG8_LDA(At, 0, 0); PG8_STAGE(PG8_SA(1, 1), a1 + hsA, voffA);
            PG8_WAIT_V(8); PG8_WAIT_L(0); PG8_BAR; PG8_MMA(0, 0, At, B0); PG8_MMA(0, 1, At, B1); PG8_BAR; PG8_SCHED;
            PG8_LDA(At, 0, 1); PG8_STAGE(PG8_SB(0, 0), b2, voffB); PG8_STAGE(PG8_SB(0, 1), b2 + hsB, voffB); PG8_STAGE(PG8_SA(0, 0), a2, voffA);
            PG8_WAIT_V(8); PG8_WAIT_L(0); PG8_BAR; PG8_MMA(1, 0, At, B0); PG8_MMA(1, 1, At, B1); PG8_BAR; PG8_SCHED;
            PG8_LDB(B0, 1, 0); PG8_LDB(B1, 1, 1); PG8_SCHED; PG8_LDA(At, 1, 0); PG8_STAGE(PG8_SA(0, 1), a2 + hsA, voffA);
            PG8_WAIT_V(8); PG8_WAIT_L(0); PG8_BAR; PG8_MMA(0, 0, At, B0); PG8_MMA(0, 1, At, B1); PG8_BAR; PG8_SCHED;
            PG8_LDA(At, 1, 1); PG8_STAGE(PG8_SB(1, 0), b3, voffB); PG8_STAGE(PG8_SB(1, 1), b3 + hsB, voffB); PG8_STAGE(PG8_SA(1, 0), a3, voffA);
            PG8_WAIT_V(8); PG8_WAIT_L(0); PG8_BAR; PG8_MMA(1, 0, At, B0); PG8_MMA(1, 1, At, B1); PG8_BAR; PG8_SCHED;
            } else {
            PG8_LDB(B0, 0, 0); PG8_SCHED; PG8_LDA(At, 0, 0); PG8_STAGE(PG8_SA(1, 1), a1 + hsA, voffA);
            PG8_WAIT_L(8); PG8_BAR; PG8_WAIT_L(0); PG8_MMA(0, 0, At, B0); PG8_BAR; PG8_SCHED;
            PG8_LDB(B1, 0, 1); PG8_STAGE(PG8_SB(0, 0), b2, voffB);
            PG8_BAR; PG8_WAIT_L(0); PG8_MMA(0, 1, At, B1); PG8_BAR;
            PG8_LDA(At, 0, 1); PG8_STAGE(PG8_SA(0, 0), a2, voffA);
            PG8_BAR; PG8_WAIT_L(0); PG8_MMA(1, 0, At, B0); PG8_BAR; PG8_SCHED;
            PG8_STAGE(PG8_SB(0, 1), b2 + hsB, voffB);
            PG8_WAIT_V(6); PG8_BAR; PG8_MMA(1, 1, At, B1); PG8_BAR;
            PG8_LDB(B0, 1, 0); PG8_SCHED; PG8_LDA(At, 1, 0); PG8_STAGE(PG8_SA(0, 1), a2 + hsA, voffA);
            PG8_WAIT_L(8); PG8_BAR; PG8_WAIT_L(0); PG8_MMA(0, 0, At, B0); PG8_BAR; PG8_SCHED;
            PG8_LDB(B1, 1, 1); PG8_STAGE(PG8_SB(1, 0), b3, voffB);
            PG8_BAR; PG8_WAIT_L(0); PG8_MMA(0, 1, At, B1); PG8_BAR;
            PG8_LDA(At, 1, 1); PG8_STAGE(PG8_SA(1, 0), a3, voffA);
            PG8_BAR; PG8_WAIT_L(0); PG8_MMA(1, 0, At, B0); PG8_BAR; PG8_SCHED;
            PG8_STAGE(PG8_SB(1, 1), b3 + hsB, voffB);
            PG8_WAIT_V(6); PG8_BAR; PG8_MMA(1, 1, At, B1); PG8_BAR;
            }
        }
        if constexpr (ALIGN_EPI) { if (wr == 0) PG8_BAR; }
        { const int ln_ = lane_now(); E(acc, cur, wr, wc, ln_ & 15, ln_ >> 4, xl); }
        S.done(cur);
        if (!has_next) break;
#pragma unroll
        for (int a = 0; a < 2; ++a)
#pragma unroll
            for (int b = 0; b < 2; ++b)
#pragma unroll
                for (int m = 0; m < 4; ++m)
#pragma unroll
                    for (int n = 0; n < 2; ++n) acc[a][b][m][n] = (f32x4){0.f, 0.f, 0.f, 0.f};
        cur = nxt; cA = nA; cB = nB; ++ui;
        if constexpr (ALIGN_EPI) { if (wr == 1) PG8_BAR; }
    }
    PG8_WAIT_V(0);
    if constexpr (!ALIGN_EPI) { if (wr == 0) PG8_BAR; }
    PG8_BAR;
#undef PG8_SA
#undef PG8_SB
#undef PG8_STAGE
#undef PG8_LDA
#undef PG8_LDB
#undef PG8_MMA
#undef PG8_WAIT_V
#undef PG8_WAIT_L
#undef PG8_BAR
#undef PG8_SCHED
}
}

#define GAS __attribute__((address_space(1)))
#define LAS __attribute__((address_space(3)))
typedef unsigned short bf16;
typedef unsigned v4u __attribute__((ext_vector_type(4)));
typedef unsigned v2u __attribute__((ext_vector_type(2)));
typedef float f32x4 __attribute__((ext_vector_type(4)));
#define LDS_WAIT() asm volatile("s_waitcnt lgkmcnt(0)" ::: "memory")
#define VM_WAIT() asm volatile("s_waitcnt vmcnt(0)" ::: "memory")

constexpr int D = 1024, NB = 4, SEQ = 4096, CTXL = 256, MLAT = NB * SEQ, MCTX = NB * CTXL, MTOT = MLAT + MCTX;
constexpr int DI = 2048, XBCW = 4096, NHEAD = 32, FFH = 2816, INC = 9280;
constexpr int NB1 = 4352  , NB2 = 5120  ;
constexpr int NWAVES = 8;

constexpr size_t MiB = 1u << 20;
constexpr size_t WS_CTL = 0, CTL_ZERO_BYTES = 1 * MiB;
constexpr size_t WS_MOD = 1 * MiB;
constexpr size_t WS_WIN = 2 * MiB;
constexpr size_t WS_WSSD = WS_WIN + (size_t)(NB1 + NB2) * 1024 * 2;
constexpr size_t WS_WPC = WS_WSSD + (size_t)1024 * 2048 * 2;
constexpr size_t WS_WOUT = WS_WPC + (size_t)1024 * 1024 * 2;
constexpr size_t WS_CX = WS_WOUT + (size_t)1024 * 1024 * 2;
constexpr size_t WS_H = WS_CX + (size_t)MCTX * D * 4;
constexpr size_t WS_DT = WS_H + (size_t)MTOT * D * 2;
constexpr size_t WS_Y = WS_DT + (size_t)MTOT * 64 * 4;
constexpr size_t WS_XBC = WS_Y + (size_t)MTOT * DI * 2;
constexpr size_t WS_END = WS_XBC + (size_t)MTOT * XBCW * 2;
constexpr size_t WS_PG = WS_END, WS_WPC1 = WS_PG + (size_t)2 * 1024 * 1024 * 4, WS_END2 = WS_WPC1 + (size_t)1024 * 1024 * 2;
constexpr size_t XO_GATES = 0, XO_UPOOL = (size_t)MTOT * 2048 * 2, XO_M1 = XO_UPOOL + (size_t)MTOT * 1024 * 2;
constexpr size_t XO_ACT = 0, XO_WGU = (size_t)MTOT * FFH * 2, XO_WDN = XO_WGU + (size_t)2 * FFH * 1024 * 2;
static_assert(XO_M1 + (size_t)MTOT * 1024 * 2 <= (size_t)MTOT * XBCW * 2 && XO_WDN + (size_t)1024 * FFH * 2 <= (size_t)MTOT * XBCW * 2, "xbc overlay map");
constexpr int CW_BAR = 4096;
constexpr int CW_WORK = 12288;
constexpr int CW_CNT = 16384, CNT_ARR = 68 * 64;
__device__ __forceinline__ int cnt_off(int l, int kind) { return CW_CNT + (l * 8 + kind) * CNT_ARR; }
__device__ __forceinline__ pg8::pg8_gu32* cnt_arr(unsigned char* ws, int l, int kind) { return (pg8::pg8_gu32*)(ws + WS_CTL) + cnt_off(l, kind); }

constexpr int RING_BYTES = 131072, LDS_BYTES = 163840  , XL_OFF = 155648  , MISC_OFF = 159744  ;

__device__ __forceinline__ unsigned pk2(float lo, float hi) { return pg8::cvt_pk_bf16(lo, hi); }
__device__ __forceinline__ float bf_lo(unsigned u) { return __uint_as_float(u << 16); }
__device__ __forceinline__ float bf_hi(unsigned u) { return __uint_as_float(u & 0xffff0000u); }

#define XB_TMO      128
#define XB_XCNT(j)  (256  + 64 * (j))
#define XB_XSUB(j)  (1280 + 64 * (j))
#define XB_XGEN(j)  (2304 + 64 * (j))
#define XB_TOP      3328
#define XB_TOPGEN   3392
#define XCD_BAR_WORDS 3456
#define XB_SPIN_CAP (1u << 20)
typedef GAS unsigned gu32;
__device__ __forceinline__ unsigned xb_ld(gu32* p)              { return __hip_atomic_load(p, __ATOMIC_RELAXED, __HIP_MEMORY_SCOPE_AGENT); }
__device__ __forceinline__ unsigned xb_add(gu32* p, unsigned v) { return __hip_atomic_fetch_add(p, v, __ATOMIC_RELAXED, __HIP_MEMORY_SCOPE_AGENT); }
__device__ __forceinline__ unsigned xb_xcc_id() { return (unsigned)__builtin_amdgcn_s_getreg((3 << 11) | 20) & 0xFu; }
#define XB_SPIN(cond, bar) do { unsigned _sp = 0; while (cond) { __builtin_amdgcn_s_sleep(1); \
    if ((++_sp & 255u) == 0u) { if (xb_ld(&(bar)[XB_TMO])) break; if (_sp > XB_SPIN_CAP) { xb_add(&(bar)[XB_TMO], 1u); break; } } } } while (0)
struct XcdBarrier { gu32* bar; unsigned x; volatile LAS unsigned* st; };
__device__ __forceinline__ XcdBarrier xcd_barrier_post(gu32* bar, volatile LAS unsigned* st) {
    XcdBarrier b; b.bar = bar; b.x = xb_xcc_id(); b.st = st;
    if (pg8::tid_now() == 0) (void)xb_add(&bar[XB_XCNT(b.x)], 1u);
    return b;
}
__device__ __forceinline__ void xcd_barrier_complete(gu32* bar, unsigned x, unsigned& nloc, unsigned& nx) {
    const unsigned G = gridDim.x * gridDim.y * gridDim.z;
    unsigned sum, cnt, mine, sp = 0u;
    for (;;) {
        sum = 0u; cnt = 0u; mine = 0u;
#pragma unroll
        for (unsigned j = 0; j < 16; ++j) { const unsigned c = xb_ld(&bar[XB_XCNT(j)]); sum += c; cnt += (c > 0u) ? 1u : 0u; mine = (j == x) ? c : mine; }
        if (sum == G) break;
        __builtin_amdgcn_s_sleep(1);
        if ((++sp & 255u) == 0u) { if (xb_ld(&bar[XB_TMO])) break; if (sp > XB_SPIN_CAP) { xb_add(&bar[XB_TMO], 1u); break; } }
    }
    nloc = mine > 0u ? mine : 1u; nx = cnt > 0u ? cnt : 1u;
}
__device__ __forceinline__ void xcd_barrier(const XcdBarrier& b) {
    asm volatile("s_waitcnt vmcnt(0)" ::: "memory");
    __syncthreads();
    if (pg8::tid_now() == 0) {
        gu32* bar = b.bar; unsigned bx_ = b.x;
        asm volatile("" : "+s"(bar), "+s"(bx_));
        __builtin_amdgcn_s_waitcnt(0);
        unsigned nloc = b.st[0], nx = b.st[1];
        if (nloc == 0u) { xcd_barrier_complete(bar, bx_, nloc, nx); b.st[0] = nloc; b.st[1] = nx; }
        const unsigned old = xb_add(&bar[XB_XSUB(bx_)], 1u);
        const unsigned gen = old / nloc;
        if (old + 1u == (gen + 1u) * nloc) {
            __builtin_amdgcn_fence(__ATOMIC_RELEASE, "agent");
            asm volatile("s_waitcnt vmcnt(0)" ::: "memory");
            const unsigned og = xb_add(&bar[XB_TOP], 1u);
            const unsigned tg = og / nx;
            if (og + 1u == (tg + 1u) * nx) xb_add(&bar[XB_TOPGEN], 1u);
            else XB_SPIN(xb_ld(&bar[XB_TOPGEN]) == tg, bar);
            __builtin_amdgcn_fence(__ATOMIC_ACQUIRE, "agent");
            xb_add(&bar[XB_XGEN(bx_)], 1u);
            asm volatile("s_waitcnt vmcnt(0)" ::: "memory");
        } else {
            XB_SPIN(xb_ld(&bar[XB_XGEN(bx_)]) == gen, bar);
            __builtin_amdgcn_fence(__ATOMIC_ACQUIRE, "agent");
            asm volatile("s_waitcnt vmcnt(0)" ::: "memory");
        }
    }
    __syncthreads();
}

__device__ __forceinline__ float wave_sum(float v) {
    v += pg8::lane_xor<1>(v); v += pg8::lane_xor<2>(v); v += pg8::lane_xor<4>(v); v += pg8::lane_xor<8>(v); v += pg8::lane_xor<16>(v);
    return pg8::half_sum(v);
}

template <int MODE> __device__ __forceinline__ int srccol(int n) {
    if (MODE == 0) {
        if (n < 4096) return 2048 + n;
        if (n < 4160) return 6144 + (n - 4096);
        if (n < 4352) return -1;
        if (n < 6400) return n - 4352;
        if (n < 7424) return 6208 + (n - 6400);
        return 7232 + (n - 7424);
    }
    if (MODE == 2) { const int pn = n >> 8, c = n & 255, bj = c >> 7, wc = (c >> 5) & 3, fq = (c >> 3) & 3, sel = (c >> 2) & 1, j = pn * 128 + wc * 32 + 8 * fq + 4 * bj + (c & 3); return sel * FFH + j; }
    return n;
}
struct Args { const float* in[23]; float* out; unsigned char* ws; };
typedef const __attribute__((address_space(4))) unsigned long long* KA;
__device__ __forceinline__ KA ka_fresh() { KA p = (KA)__builtin_amdgcn_kernarg_segment_ptr(); asm volatile("" : "+s"(p)); return p; }
#define KIN(ka, k) ((const float*)(const GAS float*)(ka)[k])
#define KOUT(ka) ((float*)(GAS float*)(ka)[23])
#define KWS(ka) ((unsigned char*)(GAS unsigned char*)(ka)[24])

struct Ids { int tid, lane, wave, G, bx, vcu, gw, NGW; };
__device__ __forceinline__ Ids fresh(Ids I) { I.wave = pg8::opaque_s(pg8::wave_now()); I.tid = pg8::opaque_v(I.wave * 64 + pg8::lane_now()); I.lane = I.tid & 63; I.vcu = pg8::opaque_s(I.vcu); I.bx = pg8::opaque_s(I.bx); I.gw = I.vcu * NWAVES + I.wave; return I; }

struct ConvJob { const float* W; bf16* WT; const float* kscale; int K, Nsrc, Ndst, mode, item; };
__device__ __forceinline__ int srccol_rt(int mode, int n) { return mode == 0 ? srccol<0>(n) : (mode == 2 ? srccol<2>(n) : n); }
__device__ __forceinline__ void conv_load(const ConvJob& j, int lane, f32x4 (&v)[8]) {
    const int nblk = j.Ndst / 32, kb = j.item / nblk, nb = j.item % nblk, k0 = 64 * kb, n0 = 32 * nb;
    const int r8 = lane >> 3, c4 = lane & 7, sc = srccol_rt(j.mode, n0 + 4 * c4);
#pragma unroll
    for (int i = 0; i < 8; ++i) v[i] = sc >= 0 ? *(const f32x4*)(j.W + (size_t)(k0 + 8 * i + r8) * j.Nsrc + sc) : (f32x4){0.f, 0.f, 0.f, 0.f};
}
__device__ __forceinline__ void conv_store(const ConvJob& j, int lane, const f32x4 (&v)[8], LAS float* scr) {
    const int nblk = j.Ndst / 32, kb = j.item / nblk, nb = j.item % nblk, k0 = 64 * kb, n0 = 32 * nb;
    const int r8 = lane >> 3, c4 = lane & 7;
#pragma unroll
    for (int i = 0; i < 8; ++i) { const int kk = 8 * i + r8; f32x4 t = v[i]; if (j.kscale) t = t * j.kscale[k0 + kk];
        LAS float* d = scr + kk * 33 + 4 * c4; d[0] = t.x; d[1] = t.y; d[2] = t.z; d[3] = t.w; }
    LDS_WAIT(); asm volatile("" ::: "memory");
    const int c = lane & 7;
#pragma unroll
    for (int q = 0; q < 4; ++q) { const int n = (lane >> 3) + 8 * q; const LAS float* sp = scr + (8 * c) * 33 + n;
        v4u o; o.x = pk2(sp[0 * 33], sp[1 * 33]); o.y = pk2(sp[2 * 33], sp[3 * 33]); o.z = pk2(sp[4 * 33], sp[5 * 33]); o.w = pk2(sp[6 * 33], sp[7 * 33]);
        *(v4u*)(j.WT + (size_t)(n0 + n) * j.K + k0 + 8 * c) = o; }
    LDS_WAIT(); asm volatile("" ::: "memory");
}
__device__ __forceinline__ ConvJob conv_job(KA ka, unsigned char* ws, int which, int l, int it) {
    ConvJob j;
    if (which == 0) {
        constexpr int I_IN = 16 * ((NB1 + NB2) / 32), I_SSD = 32 * 32;
        if (it < I_IN) { j.W = KIN(ka, 7) + (size_t)l * D * INC; j.WT = (bf16*)(ws + WS_WIN); j.kscale = nullptr; j.K = D; j.Nsrc = INC; j.Ndst = NB1 + NB2; j.mode = 0; j.item = it; }
        else if (it < I_IN + I_SSD) { j.W = KIN(ka, 14) + (size_t)l * DI * D; j.WT = (bf16*)(ws + WS_WSSD); j.kscale = KIN(ka, 13) + (size_t)l * DI; j.K = DI; j.Nsrc = D; j.Ndst = D; j.mode = 1; j.item = it - I_IN; }
        else { j.W = KIN(ka, 18) + (size_t)l * D * D; j.WT = (bf16*)(ws + WS_WOUT); j.kscale = nullptr; j.K = D; j.Nsrc = D; j.Ndst = D; j.mode = 1; j.item = it - I_IN - I_SSD; }
    } else {
        constexpr int I_GU = 16 * (2 * FFH / 32);
        if (it < I_GU) { j.W = KIN(ka, 20) + (size_t)l * D * 2 * FFH; j.WT = (bf16*)(ws + WS_XBC + XO_WGU); j.kscale = nullptr; j.K = D; j.Nsrc = 2 * FFH; j.Ndst = 2 * FFH; j.mode = 2; j.item = it; }
        else { j.W = KIN(ka, 21) + (size_t)l * FFH * D; j.WT = (bf16*)(ws + WS_XBC + XO_WDN); j.kscale = nullptr; j.K = FFH; j.Nsrc = D; j.Ndst = D; j.mode = 1; j.item = it - I_GU; }
    }
    return j;
}
__device__ __forceinline__ void conv_pass(const Ids I, LAS unsigned char* lds, KA ka, unsigned char* ws, int which, int l, int it0, int nit, int gw, int ngw) {
    LAS float* scr = (LAS float*)(lds + I.wave * 8448);
    f32x4 va[8], vb[8], vc[8];
    for (int it = it0 + gw; it < nit; it += 3 * ngw) {
        const bool h1 = it + ngw < nit, h2 = it + 2 * ngw < nit;
        const ConvJob ja = conv_job(ka, ws, which, l, it); conv_load(ja, I.lane, va);
        ConvJob jb = ja, jc = ja;
        if (h1) { jb = conv_job(ka, ws, which, l, it + ngw); conv_load(jb, I.lane, vb); }
        if (h2) { jc = conv_job(ka, ws, which, l, it + 2 * ngw); conv_load(jc, I.lane, vc); }
        conv_store(ja, I.lane, va, scr);
        if (h1) conv_store(jb, I.lane, vb, scr);
        if (h2) conv_store(jc, I.lane, vc, scr);
    }
}

__device__ __forceinline__ void norm_row(const float* xrow, bf16* orow, const float* g, const float* sh, const float* sc, int lane) {
    const f32x4* xr = (const f32x4*)xrow + lane;
    f32x4 v[4]; float s = 0.f;
#pragma unroll
    for (int j = 0; j < 4; ++j) { v[j] = xr[64 * j]; s += (v[j].x * v[j].x + v[j].y * v[j].y) + (v[j].z * v[j].z + v[j].w * v[j].w); }
    const float rstd = rsqrtf(wave_sum(s) * (1.f / D) + 1e-6f);
    unsigned long long* o8 = (unsigned long long*)orow + lane;
#pragma unroll
    for (int j = 0; j < 4; ++j) { const f32x4 gg = ((const f32x4*)g)[lane + 64 * j], s1 = ((const f32x4*)sc)[lane + 64 * j], s0 = ((const f32x4*)sh)[lane + 64 * j];
        const f32x4 y = v[j] * rstd * gg * (s1 + 1.0f) + s0;
        o8[64 * j] = (unsigned long long)pk2(y.x, y.y) | ((unsigned long long)pk2(y.z, y.w) << 32); }
}

__device__ __forceinline__ void conv_mixer(const Ids I_, LAS unsigned char* lds, int l, bool skip_win = false, int wpc_layers = 1) {
    const Ids I = fresh(I_);
    const KA ka = ka_fresh(); unsigned char* ws = KWS(ka);
    conv_pass(I, lds, ka, ws, 0, l, skip_win ? 16 * ((NB1 + NB2) / 32) : 0, 16 * ((NB1 + NB2) / 32) + 32 * 32 + 16 * 32, I.gw, I.NGW);
    __syncthreads();
    if (wpc_layers == 2 && I.G == 256) {
        const int ll = l + (I.vcu >> 7), it = I.vcu & 127, g = it >> 5, i0 = (it & 31) * 8, n = 2 * I.tid;
        const float* pw = KIN(ka, 15) + (size_t)ll * 4 * 256 * 256; const float* psc = KIN(ka, 16) + (size_t)ll * D; const float* wpo = KIN(ka, 17) + (size_t)ll * D * D; bf16* WPC = (bf16*)(ws + ((I.vcu >> 7) ? WS_WPC1 : WS_WPC));
        LAS float* tab = (LAS float*)lds;
        for (int e = I.tid; e < 2048; e += NWAVES * 64) { const int q = e >> 8, o = e & 255; tab[o * 8 + q] = pw[((size_t)g * 256 + i0 + q) * 256 + o] * psc[g * 256 + o]; }
        __syncthreads();
        f32x4 a00 = {0.f, 0.f, 0.f, 0.f}, a01 = {0.f, 0.f, 0.f, 0.f}, a10 = {0.f, 0.f, 0.f, 0.f}, a11 = {0.f, 0.f, 0.f, 0.f};
        const float* wr_ = wpo + (size_t)g * 256 * D + n;
#pragma unroll 16
        for (int o = 0; o < 256; ++o) { const pg8::f32x2 wv = *(const pg8::f32x2*)(wr_ + (size_t)o * D); const f32x4 t0 = *(const LAS f32x4*)(tab + o * 8), t1 = *(const LAS f32x4*)(tab + o * 8 + 4);
            a00 += t0 * wv.x; a01 += t1 * wv.x; a10 += t0 * wv.y; a11 += t1 * wv.y; }
        v4u o0, o1; o0.x = pk2(a00[0], a00[1]); o0.y = pk2(a00[2], a00[3]); o0.z = pk2(a01[0], a01[1]); o0.w = pk2(a01[2], a01[3]); o1.x = pk2(a10[0], a10[1]); o1.y = pk2(a10[2], a10[3]); o1.z = pk2(a11[0], a11[1]); o1.w = pk2(a11[2], a11[3]);
        *(v4u*)(WPC + (size_t)n * D + g * 256 + i0) = o0; *(v4u*)(WPC + (size_t)(n + 1) * D + g * 256 + i0) = o1;
        __syncthreads();
        return;
    }
    for (int wl = 0; wl < wpc_layers; ++wl) {
    const int ll = l + wl;
    const float* pw = KIN(ka, 15) + (size_t)ll * 4 * 256 * 256; const float* psc = KIN(ka, 16) + (size_t)ll * D; const float* wpo = KIN(ka, 17) + (size_t)ll * D * D; bf16* WPC = (bf16*)(ws + (wl ? WS_WPC1 : WS_WPC));
    for (int item = I.vcu; item < 256; item += I.G) {
        const int g = item >> 6, i0 = (item & 63) * 4, n = 2 * I.tid;
        LAS float* tab = (LAS float*)lds;
        for (int e = I.tid; e < 1024; e += NWAVES * 64) { const int q = e >> 8, o = e & 255; tab[o * 4 + q] = pw[((size_t)g * 256 + i0 + q) * 256 + o] * psc[g * 256 + o]; }
        __syncthreads();
        float a0[4] = {0.f, 0.f, 0.f, 0.f}, a1[4] = {0.f, 0.f, 0.f, 0.f};
        const float* wr_ = wpo + (size_t)g * 256 * D + n;
#pragma unroll 32
        for (int o = 0; o < 256; ++o) { const pg8::f32x2 wv = *(const pg8::f32x2*)(wr_ + (size_t)o * D); const f32x4 t = *(const LAS f32x4*)(tab + o * 4);
            a0[0] += t.x * wv.x; a0[1] += t.y * wv.x; a0[2] += t.z * wv.x; a0[3] += t.w * wv.x; a1[0] += t.x * wv.y; a1[1] += t.y * wv.y; a1[2] += t.z * wv.y; a1[3] += t.w * wv.y; }
        v2u o0, o1; o0.x = pk2(a0[0], a0[1]); o0.y = pk2(a0[2], a0[3]); o1.x = pk2(a1[0], a1[1]); o1.y = pk2(a1[2], a1[3]);
        *(v2u*)(WPC + (size_t)n * D + g * 256 + i0) = o0; *(v2u*)(WPC + (size_t)(n + 1) * D + g * 256 + i0) = o1;
        __syncthreads();
    }
    }
}
__device__ __forceinline__ void conv_ffn(const Ids I_, LAS unsigned char* lds, int l) {
    const Ids I = fresh(I_);
    const KA ka = ka_fresh(); unsigned char* ws = KWS(ka);
    conv_pass(I, lds, ka, ws, 1, l, 0, 16 * (2 * FFH / 32) + (FFH / 64) * 32, I.gw, I.NGW);
}

__device__ __forceinline__ void conv_win_dyn(const Ids I_, LAS unsigned char* lds, int l) {
    const Ids I = fresh(I_);
    const KA ka = ka_fresh(); unsigned char* ws = KWS(ka);
    constexpr int NIT = 16 * ((NB1 + NB2) / 32), NCH = (NIT + 23) / 24;
    pg8::pg8_gu32* work = (pg8::pg8_gu32*)(ws + WS_CTL) + CW_WORK + 64 * 4;
    volatile LAS unsigned* slot = (volatile LAS unsigned*)(lds + MISC_OFF) + 48;
    if (I.tid == 0) slot[0] = __hip_atomic_fetch_add(work, 1u, __ATOMIC_RELAXED, __HIP_MEMORY_SCOPE_AGENT);
    __syncthreads();
    int ch = (int)slot[0], par = 0;
    while (ch < NCH) {
        unsigned nclaim = 0u;
        if (I.tid == 0) nclaim = __hip_atomic_fetch_add(work, 1u, __ATOMIC_RELAXED, __HIP_MEMORY_SCOPE_AGENT);
        { const int e = 24 * ch + 24; conv_pass(I, lds, ka, ws, 0, l, 24 * ch, e < NIT ? e : NIT, I.wave, NWAVES); }
        if (I.tid == 0) slot[par ^ 1] = nclaim;
        __syncthreads();
        par ^= 1; ch = (int)slot[par];
    }
}

__device__ __forceinline__ void phase_mod(const Ids I_, LAS unsigned char* lds) {
    const Ids I = fresh(I_);
    const KA ka = ka_fresh(); float* MOD = (float*)(KWS(ka) + WS_MOD);
    LAS float* sv = (LAS float*)lds;
    LAS float* red = (LAS float*)(lds + 20480);
    if (I.bx < 192) {
        const float* cvec = KIN(ka, 1); const float* cctx = KIN(ka, 3);
        for (int i = I.tid; i < 5 * 1024; i += NWAVES * 64) { const int c = i >> 10, k = i & 1023; const float v = c < 4 ? cvec[c * 1024 + k] : cctx[k]; sv[i] = v / (1.f + __expf(-v)); }
        __syncthreads();
        for (int item = I.bx; item < 192; item += I.G) {
            const int l = item / 96, c0 = (item % 96) * 64, kg = I.tid >> 4, cq = I.tid & 15;
            const float* w = KIN(ka, 4) + (size_t)l * D * 6144 + c0 + 4 * cq;
            f32x4 a[5];
#pragma unroll
            for (int c = 0; c < 5; ++c) a[c] = (f32x4){0.f, 0.f, 0.f, 0.f};
#pragma unroll 16
            for (int k = kg * 32; k < kg * 32 + 32; ++k) { const f32x4 wv = *(const f32x4*)(w + (size_t)k * 6144);
#pragma unroll
                for (int c = 0; c < 5; ++c) a[c] += wv * sv[c * 1024 + k]; }
#pragma unroll
            for (int c = 0; c < 5; ++c) *(LAS f32x4*)(red + (kg * 5 + c) * 64 + 4 * cq) = a[c];
            __syncthreads();
            if (I.tid < 320) { const int c = I.tid >> 6, col = I.tid & 63; float s = KIN(ka, 5)[l * 6144 + c0 + col];
#pragma unroll 8
                for (int q = 0; q < 32; ++q) s += red[(q * 5 + c) * 64 + col];
                MOD[((size_t)l * 5 + c) * 6144 + c0 + col] = s; }
            __syncthreads();
        }
    }
    __syncthreads();
}

__device__ __forceinline__ void phase_norm(const Ids I_, LAS unsigned char* lds, int l, int which  , int nrows, bool from_input) {
    const Ids I = fresh(I_);
    const KA ka = ka_fresh(); unsigned char* ws = KWS(ka);
    const float* modl = (const float*)(ws + WS_MOD) + (size_t)l * 5 * 6144 + which * 3072;
    const float* g = KIN(ka, which ? 19 : 6) + l * D;
    const float* xlat = from_input ? KIN(ka, 0) : KOUT(ka); const float* xctx = from_input ? KIN(ka, 2) : (const float*)(ws + WS_CX);
    bf16* H = (bf16*)(ws + WS_H);
    LAS f32x4* T4 = (LAS f32x4*)lds;
    for (int i = I.tid; i < 11 * 256; i += NWAVES * 64) { const int v_ = i >> 8, e_ = i & 255; f32x4 t_;
        if (v_ == 0) t_ = ((const f32x4*)g)[e_]; else if (v_ < 6) t_ = ((const f32x4*)(modl + (v_ - 1) * 6144))[e_]; else t_ = ((const f32x4*)(modl + (v_ - 6) * 6144 + 1024))[e_] + 1.0f;
        T4[i] = t_; }
    __syncthreads();
    const bf16* xr = (const bf16*)KOUT(ka);
    const bool parts = (l == 1 && which == 0);
    const float* PP = (const float*)(ws + WS_Y); const float* gctx = (const float*)(ws + WS_MOD) + 5120 + 4 * 6144;
    f32x4 nxa[4], nxb[4];
#define NORM_LOAD(nx, mm) do { if ((mm) < MLAT && !from_input) { const v2u* q_ = (const v2u*)(xr + (size_t)(mm) * 2048) + I.lane; \
            _Pragma("unroll") for (int j = 0; j < 4; ++j) { const v2u t_ = q_[64 * j]; nx[j] = (f32x4){bf_lo(t_.x), bf_hi(t_.x), bf_lo(t_.y), bf_hi(t_.y)}; } } \
        else { const f32x4* q_ = (const f32x4*)((mm) < MLAT ? KIN(ka, 0) + (size_t)(mm) * D : xctx + (size_t)((mm) - MLAT) * D) + I.lane; \
            _Pragma("unroll") for (int j = 0; j < 4; ++j) nx[j] = q_[64 * j]; \
            if (parts && (mm) >= MLAT) { f32x4 s_[4]; _Pragma("unroll") for (int j = 0; j < 4; ++j) s_[j] = (f32x4){0.f, 0.f, 0.f, 0.f}; \
                _Pragma("unroll 4") for (int ks_ = 0; ks_ < 11; ++ks_) { const f32x4* p_ = (const f32x4*)(PP + ((size_t)ks_ * 1024 + ((mm) - MLAT)) * 1024) + I.lane; _Pragma("unroll") for (int j = 0; j < 4; ++j) s_[j] += p_[64 * j]; } \
                _Pragma("unroll") for (int j = 0; j < 4; ++j) nx[j] += ((const f32x4*)gctx)[I.lane + 64 * j] * s_[j]; } } } while (0)
#define NORM_ROW(nx, mm) do { f32x4 v[4]; float ss = 0.f; \
        _Pragma("unroll") for (int j = 0; j < 4; ++j) { v[j] = nx[j]; ss += (v[j].x * v[j].x + v[j].y * v[j].y) + (v[j].z * v[j].z + v[j].w * v[j].w); } \
        if (kk_ + 2 < nk) { const int mn_ = rowk(kk_ + 2); NORM_LOAD(nx, mn_); } \
        const int cond = (mm) < MLAT ? (mm) / SEQ : 4; \
        const float rstd = rsqrtf(wave_sum(ss) * (1.f / D) + 1e-6f); \
        unsigned long long* o8 = (unsigned long long*)(H + (size_t)(mm) * D) + I.lane; \
        _Pragma("unroll") for (int j = 0; j < 4; ++j) { const f32x4 gg = T4[I.lane + 64 * j], s1 = T4[(6 + cond) * 256 + I.lane + 64 * j], s0 = T4[(1 + cond) * 256 + I.lane + 64 * j]; \
            const f32x4 y = v[j] * rstd * gg * s1 + s0; \
            o8[64 * j] = (unsigned long long)pk2(y.x, y.y) | ((unsigned long long)pk2(y.z, y.w) << 32); } } while (0)
    const bool bal = parts && I.NGW == 2048 && nrows == MTOT;
    const int gw = I.gw, nk = bal ? (gw < 1024 ? 7 : 10) : (gw < nrows ? (nrows - gw + I.NGW - 1) / I.NGW : 0);
    auto rowk = [&](int k) -> int { if (!bal) return gw + k * I.NGW; if (gw < 1024) return k == 0 ? MLAT + gw : gw + 2048 * (k - 1); return k < 8 ? gw + 2048 * k : (gw - 1024) + 2048 * (k - 2); };
    if (nk > 0) { const int m0_ = rowk(0); NORM_LOAD(nxa, m0_); }
    if (nk > 1) { const int m1_ = rowk(1); NORM_LOAD(nxb, m1_); }
    for (int kk_ = 0; kk_ < nk; kk_ += 2) {
        { const int m = rowk(kk_); NORM_ROW(nxa, m); }
        if (kk_ + 1 >= nk) break;
        { const int kk0_ = kk_; { const int kk_ = kk0_ + 1; const int m = rowk(kk_); NORM_ROW(nxb, m); } }
    }
#undef NORM_ROW
#undef NORM_LOAD
}

__device__ __forceinline__ void phase_m1ctx(const Ids I_, int l) {
    const Ids I = fresh(I_);
    const KA ka = ka_fresh(); unsigned char* ws = KWS(ka);
    if (I.gw >= 1024) return;
    const int row = I.gw, panel = 64 + (row >> 8);
    { pg8::pg8_gu32* cp_ = cnt_arr(ws, l, 5) + 64 * panel; pg8::pg8_gu32* tmo = (pg8::pg8_gu32*)(ws + WS_CTL) + CW_BAR + XB_TMO; unsigned sp = 0;
        while (__builtin_amdgcn_readfirstlane(__hip_atomic_load(cp_, __ATOMIC_RELAXED, __HIP_MEMORY_SCOPE_AGENT)) < 384u) { __builtin_amdgcn_s_sleep(2);
            if ((++sp & 255u) == 0u) { if (__hip_atomic_load(tmo, __ATOMIC_RELAXED, __HIP_MEMORY_SCOPE_AGENT) != 0u) break; if (sp > (1u << 20)) { if (I.lane == 0) __hip_atomic_fetch_add(tmo, 1u, __ATOMIC_RELAXED, __HIP_MEMORY_SCOPE_AGENT); break; } } }
        __builtin_amdgcn_fence(__ATOMIC_ACQUIRE, "agent"); asm volatile("s_waitcnt vmcnt(0)" ::: "memory"); }
    const float* P = (const float*)(ws + WS_H); const bf16* GT = (const bf16*)(ws + WS_XBC + XO_GATES) + (size_t)(MLAT + row) * 2048; bf16* M1 = (bf16*)(ws + WS_XBC + XO_M1);
    const __amdgpu_buffer_rsrc_t rs = __builtin_amdgcn_make_buffer_rsrc((void*)M1, (short)0, 17408 * 1024 * 2, 0x00020000);
#pragma unroll
    for (int j = 0; j < 4; ++j) { const int col = 4 * (I.lane + 64 * j);
        v2u p[12];
#pragma unroll
        for (int k = 0; k < 12; ++k) p[k] = *(const v2u*)((const bf16*)P + ((size_t)k * 1024 + row) * 1024 + col);
        const v2u gs = *(const v2u*)(GT + col), gp = *(const v2u*)(GT + 1024 + col);
        f32x4 es = {0.f, 0.f, 0.f, 0.f}, ep = {0.f, 0.f, 0.f, 0.f};
#pragma unroll
        for (int k = 0; k < 8; ++k) es += (f32x4){bf_lo(p[k].x), bf_hi(p[k].x), bf_lo(p[k].y), bf_hi(p[k].y)};
#pragma unroll
        for (int k = 8; k < 12; ++k) ep += (f32x4){bf_lo(p[k].x), bf_hi(p[k].x), bf_lo(p[k].y), bf_hi(p[k].y)};
        v2u o; o.x = pk2(bf_lo(gs.x) * es.x + bf_lo(gp.x) * ep.x, bf_hi(gs.x) * es.y + bf_hi(gp.x) * ep.y); o.y = pk2(bf_lo(gs.y) * es.z + bf_lo(gp.y) * ep.z, bf_hi(gs.y) * es.w + bf_hi(gp.y) * ep.w);
        __builtin_amdgcn_raw_buffer_store_b64(__builtin_bit_cast(pg8::u32x2, o), rs, (unsigned)(((size_t)(MLAT + row) * 1024 + col) * 2), 0, 16); }
    asm volatile("s_waitcnt vmcnt(0)" ::: "memory");
    if (I.lane == 0) __hip_atomic_fetch_add(cnt_arr(ws, l, 6) + 64 * panel, 1u, __ATOMIC_RELAXED, __HIP_MEMORY_SCOPE_AGENT);
}

__device__ __forceinline__ void phase_norm2_dyn(const Ids I_, LAS unsigned char* lds_base, int l, int nrows) {
    const Ids I = fresh(I_);
    const KA ka = ka_fresh(); unsigned char* ws = KWS(ka);
    const float* modl = (const float*)(ws + WS_MOD) + (size_t)l * 5 * 6144 + 3072;
    const float* g = KIN(ka, 19) + l * D;
    const float* xctx = (l == 0) ? KIN(ka, 2) : (const float*)(ws + WS_CX); const bf16* xr = (const bf16*)KOUT(ka);
    bf16* H = (bf16*)(ws + WS_H);
    LAS f32x4* T4 = (LAS f32x4*)lds_base;
    for (int i = I.tid; i < 11 * 256; i += NWAVES * 64) { const int v_ = i >> 8, e_ = i & 255; f32x4 t_;
        if (v_ == 0) t_ = ((const f32x4*)g)[e_]; else if (v_ < 6) t_ = ((const f32x4*)(modl + (v_ - 1) * 6144))[e_]; else t_ = ((const f32x4*)(modl + (v_ - 6) * 6144 + 1024))[e_] + 1.0f;
        T4[i] = t_; }
    __syncthreads();
    pg8::pg8_gu32* work = (pg8::pg8_gu32*)(ws + WS_CTL) + CW_WORK + 64 * (2 + l); pg8::pg8_gu32* cp_ = cnt_arr(ws, l, 4); pg8::pg8_gu32* tmo = (pg8::pg8_gu32*)(ws + WS_CTL) + CW_BAR + XB_TMO;
    const int nblk = nrows / 64;
    const bool cs = (l == 0);
    const float* PG = (const float*)(ws + WS_PG); const float* gctx1 = (const float*)(ws + WS_MOD) + 2048 + 4 * 6144; float* cxw = (float*)(ws + WS_CX);
#define N2_CLAIM_WAIT(claim_) do { const int b_ = (int)(claim_); \
        if (b_ < nblk) { unsigned sp_ = 0; const unsigned need_ = (cs && (b_ >> 2) >= 64) ? 128u : 32u; \
            while (__hip_atomic_load(cp_ + 64 * (b_ >> 2), __ATOMIC_RELAXED, __HIP_MEMORY_SCOPE_AGENT) < need_) { __builtin_amdgcn_s_sleep(2); \
                if ((++sp_ & 255u) == 0u) { if (__hip_atomic_load(tmo, __ATOMIC_RELAXED, __HIP_MEMORY_SCOPE_AGENT) != 0u) break; if (sp_ > (1u << 20)) { __hip_atomic_fetch_add(tmo, 1u, __ATOMIC_RELAXED, __HIP_MEMORY_SCOPE_AGENT); break; } } } \
            __builtin_amdgcn_fence(__ATOMIC_ACQUIRE, "agent"); asm volatile("s_waitcnt vmcnt(0)" ::: "memory"); } } while (0)
#define N2_LOAD(nx, mm) do { if ((mm) < MLAT) { const v2u* q_ = (const v2u*)(xr + (size_t)(mm) * 2048) + I.lane; \
            _Pragma("unroll") for (int j = 0; j < 4; ++j) { const v2u t_ = q_[64 * j]; nx[j] = (f32x4){bf_lo(t_.x), bf_hi(t_.x), bf_lo(t_.y), bf_hi(t_.y)}; } } \
        else { const f32x4* q_ = (const f32x4*)(xctx + (size_t)((mm) - MLAT) * D) + I.lane; _Pragma("unroll") for (int j = 0; j < 4; ++j) nx[j] = q_[64 * j]; \
            if (cs) { const v2u* a_ = (const v2u*)((const bf16*)PG + (size_t)((mm) - MLAT) * 1024) + I.lane; \
                _Pragma("unroll") for (int j = 0; j < 4; ++j) { f32x4 s_ = {0.f, 0.f, 0.f, 0.f}; \
                    _Pragma("unroll") for (int k_ = 0; k_ < 4; ++k_) { const v2u t_ = a_[(size_t)k_ * (1024 * 1024 / 4) + 64 * j]; s_ += (f32x4){bf_lo(t_.x), bf_hi(t_.x), bf_lo(t_.y), bf_hi(t_.y)}; } \
                    nx[j] += ((const f32x4*)gctx1)[I.lane + 64 * j] * s_; } } } } while (0)
#define N2_ROW(nx, mm, mend) do { f32x4 v[4]; float ss = 0.f; \
        _Pragma("unroll") for (int j = 0; j < 4; ++j) { v[j] = nx[j]; ss += (v[j].x * v[j].x + v[j].y * v[j].y) + (v[j].z * v[j].z + v[j].w * v[j].w); } \
        if (cs && (mm) >= MLAT) { f32x4* w_ = (f32x4*)(cxw + (size_t)((mm) - MLAT) * D) + I.lane; _Pragma("unroll") for (int j = 0; j < 4; ++j) w_[64 * j] = v[j]; } \
        if ((mm) + 16 < (mend)) N2_LOAD(nx, (mm) + 16); \
        const int cond = (mm) < MLAT ? (mm) / SEQ : 4; \
        const float rstd = rsqrtf(wave_sum(ss) * (1.f / D) + 1e-6f); \
        unsigned long long* o8 = (unsigned long long*)(H + (size_t)(mm) * D) + I.lane; \
        _Pragma("unroll") for (int j = 0; j < 4; ++j) { const f32x4 gg = T4[I.lane + 64 * j], s1 = T4[(6 + cond) * 256 + I.lane + 64 * j], s0 = T4[(1 + cond) * 256 + I.lane + 64 * j]; \
            const f32x4 y = v[j] * rstd * gg * s1 + s0; \
            o8[64 * j] = (unsigned long long)pk2(y.x, y.y) | ((unsigned long long)pk2(y.z, y.w) << 32); } } while (0)
    if (cs && I.tid < 64) {
        pg8::pg8_gu32* c6 = cnt_arr(ws, l, 6); unsigned sp = 0;
        for (;;) { const bool ok = I.lane >= 4 || __hip_atomic_load(c6 + 64 * (64 + I.lane), __ATOMIC_RELAXED, __HIP_MEMORY_SCOPE_AGENT) >= 256u;
            if (__builtin_amdgcn_ballot_w64(!ok) == 0ull) break; __builtin_amdgcn_s_sleep(32);
            if ((++sp & 63u) == 0u) { if (__hip_atomic_load(tmo, __ATOMIC_RELAXED, __HIP_MEMORY_SCOPE_AGENT) != 0u) break; if (sp > (1u << 16)) { if (I.tid == 0) __hip_atomic_fetch_add(tmo, 1u, __ATOMIC_RELAXED, __HIP_MEMORY_SCOPE_AGENT); break; } } }
    }
    __syncthreads();
    volatile LAS unsigned* slot = (volatile LAS unsigned*)(lds_base + MISC_OFF) + 44;
    if (I.tid == 0) { const unsigned c0 = __hip_atomic_fetch_add(work, 1u, __ATOMIC_RELAXED, __HIP_MEMORY_SCOPE_AGENT); N2_CLAIM_WAIT(c0); slot[0] = c0; }
    __syncthreads();
    int blk = (int)slot[0], par = 0;
    while (blk < nblk) {
        unsigned nclaim = 0u;
        if (I.tid == 0) nclaim = __hip_atomic_fetch_add(work, 1u, __ATOMIC_RELAXED, __HIP_MEMORY_SCOPE_AGENT);
        {
            const int mend = blk * 64 + 64; int m = blk * 64 + I.wave;
            f32x4 nxa[4], nxb[4];
            N2_LOAD(nxa, m); N2_LOAD(nxb, m + 8);
            for (; m < mend; m += 16) { N2_ROW(nxa, m, mend); N2_ROW(nxb, m + 8, mend); }
        }
        if (I.tid == 0) { N2_CLAIM_WAIT(nclaim); slot[par ^ 1] = nclaim; }
        __syncthreads();
        par ^= 1; blk = (int)slot[par];
    }
    if (I.tid < 64) {
        const int np = nrows / 256; unsigned sp = 0;
        for (;;) { bool ok = true; for (int p = I.lane; p < np; p += 64) ok = ok && __hip_atomic_load(cp_ + 64 * p, __ATOMIC_RELAXED, __HIP_MEMORY_SCOPE_AGENT) >= ((cs && p >= 64) ? 128u : 32u);
            if (__builtin_amdgcn_ballot_w64(!ok) == 0ull) break;
            __builtin_amdgcn_s_sleep(127);
            if ((++sp & 15u) == 0u) { if (__hip_atomic_load(tmo, __ATOMIC_RELAXED, __HIP_MEMORY_SCOPE_AGENT) != 0u) break; if (sp > (1u << 14)) { if (I.tid == 0) __hip_atomic_fetch_add(tmo, 1u, __ATOMIC_RELAXED, __HIP_MEMORY_SCOPE_AGENT); break; } } }
    }
    __syncthreads();
#undef N2_ROW
#undef N2_LOAD
#undef N2_CLAIM_WAIT
}

__device__ const unsigned short CONV_PERM[544] = { 0, 1, 2, 3, 4, 5, 6, 73, 74, 75, 76, 77, 78, 137, 138, 139, 140, 141, 142, 209, 210, 211, 212, 213, 214, 273, 274, 275, 276, 277, 278, 345, 346, 347, 348, 349, 350, 409, 410, 411, 412, 413, 414, 481, 482, 483, 484, 485, 486, 7, 8, 9, 10, 11, 12, 13, 14, 15, 16, 17, 18, 19, 20, 21, 22, 79, 80, 81, 82, 83, 84, 85, 86, 87, 88, 89, 90, 91, 92, 93, 94, 143, 144, 145, 146, 147, 148, 149, 150, 151, 152, 153, 154, 155, 156, 157, 158, 215, 216, 217, 218, 219, 220, 221, 222, 223, 224, 225, 226, 227, 228, 229, 230, 279, 280, 281, 282, 283, 284, 285, 286, 287, 288, 289, 290, 291, 292, 293, 294, 351, 352, 353, 354, 355, 356, 357, 358, 359, 360, 361, 362, 363, 364, 365, 366, 415, 416, 417, 418, 419, 420, 421, 422, 423, 424, 425, 426, 427, 428, 429, 430, 487, 488, 489, 490, 491, 492, 493, 494, 495, 496, 497, 498, 499, 500, 501, 502, 23, 24, 25, 26, 27, 28, 29, 30, 31, 32, 33, 34, 35, 36, 37, 38, 95, 96, 97, 98, 99, 100, 101, 102, 103, 104, 105, 106, 107, 108, 109, 110, 159, 160, 161, 162, 163, 164, 165, 166, 167, 168, 169, 170, 171, 172, 173, 174, 231, 232, 233, 234, 235, 236, 237, 238, 239, 240, 241, 242, 243, 244, 245, 246, 295, 296, 297, 298, 299, 300, 301, 302, 303, 304, 305, 306, 307, 308, 309, 310, 367, 368, 369, 370, 371, 372, 373, 374, 375, 376, 377, 378, 379, 380, 381, 382, 431, 432, 433, 434, 435, 436, 437, 438, 439, 440, 441, 442, 443, 444, 445, 446, 503, 504, 505, 506, 507, 508, 509, 510, 511, 512, 513, 514, 515, 516, 517, 518, 39, 40, 41, 42, 43, 44, 45, 46, 47, 48, 49, 50, 51, 52, 53, 54, 111, 112, 113, 114, 115, 116, 117, 118, 119, 120, 121, 122, 123, 124, 125, 126, 175, 176, 177, 178, 179, 180, 181, 182, 183, 184, 185, 186, 187, 188, 189, 190, 247, 248, 249, 250, 251, 252, 253, 254, 255, 256, 257, 258, 259, 260, 261, 262, 311, 312, 313, 314, 315, 316, 317, 318, 319, 320, 321, 322, 323, 324, 325, 326, 383, 384, 385, 386, 387, 388, 389, 390, 391, 392, 393, 394, 395, 396, 397, 398, 447, 448, 449, 450, 451, 452, 453, 454, 455, 456, 457, 458, 459, 460, 461, 462, 519, 520, 521, 522, 523, 524, 525, 526, 527, 528, 529, 530, 531, 532, 533, 534, 55, 56, 57, 58, 59, 60, 61, 62, 63, 64, 65, 66, 67, 68, 69, 70, 71, 72, 127, 128, 129, 130, 131, 132, 133, 134, 135, 136, 191, 192, 193, 194, 195, 196, 197, 198, 199, 200, 201, 202, 203, 204, 205, 206, 207, 208, 263, 264, 265, 266, 267, 268, 269, 270, 271, 272, 327, 328, 329, 330, 331, 332, 333, 334, 335, 336, 337, 338, 339, 340, 341, 342, 343, 344, 399, 400, 401, 402, 403, 404, 405, 406, 407, 408, 463, 464, 465, 466, 467, 468, 469, 470, 471, 472, 473, 474, 475, 476, 477, 478, 479, 480, 535, 536, 537, 538, 539, 540, 541, 542, 543 };
__device__ __forceinline__ void phase_conv(const Ids I_, LAS unsigned char* lds_base, int l) {
    const Ids I = fresh(I_);
    const KA ka = ka_fresh(); unsigned char* ws = KWS(ka);
    bf16* XBC = (bf16*)(ws + WS_XBC); const bf16* HALO = (const bf16*)(ws + WS_Y);
    const int c0 = I.tid * 8;
    pg8::pg8_gu32* work = (pg8::pg8_gu32*)(ws + WS_CTL) + CW_WORK + 64 * (5 + l); const pg8::pg8_gu32* cb_ = cnt_arr(ws, l, 3); pg8::pg8_gu32* tmo = (pg8::pg8_gu32*)(ws + WS_CTL) + CW_BAR + XB_TMO;
#define CV_CLAIM_WAIT(claim_, out_) do { unsigned id_ = 0xffffu; \
        if ((claim_) < 544u) { id_ = CONV_PERM[claim_]; const int rb_ = 32 * (int)id_; const int p0_ = (rb_ - 2 < 0 ? 0 : rb_ - 2) >> 8, p1_ = (rb_ + 33 >= MTOT ? MTOT - 1 : rb_ + 33) >> 8; unsigned sp_ = 0; \
            for (;;) { bool ok_ = __hip_atomic_load(cb_ + 64 * p0_, __ATOMIC_RELAXED, __HIP_MEMORY_SCOPE_AGENT) >= 136u; if (ok_ && p1_ != p0_) ok_ = __hip_atomic_load(cb_ + 64 * p1_, __ATOMIC_RELAXED, __HIP_MEMORY_SCOPE_AGENT) >= 136u; \
                if (ok_) break; __builtin_amdgcn_s_sleep(2); \
                if ((++sp_ & 255u) == 0u) { if (__hip_atomic_load(tmo, __ATOMIC_RELAXED, __HIP_MEMORY_SCOPE_AGENT) != 0u) break; if (sp_ > (1u << 20)) { __hip_atomic_fetch_add(tmo, 1u, __ATOMIC_RELAXED, __HIP_MEMORY_SCOPE_AGENT); break; } } } \
            __builtin_amdgcn_fence(__ATOMIC_ACQUIRE, "agent"); asm volatile("s_waitcnt vmcnt(0)" ::: "memory"); } \
        out_ = id_; } while (0)
    volatile LAS unsigned* slot = (volatile LAS unsigned*)(lds_base + MISC_OFF) + 50;
    if (I.tid == 0) { const unsigned c0_ = __hip_atomic_fetch_add(work, 1u, __ATOMIC_RELAXED, __HIP_MEMORY_SCOPE_AGENT); unsigned id0; CV_CLAIM_WAIT(c0_, id0); slot[0] = id0; }
    __syncthreads();
    unsigned uid = slot[0]; int par = 0;
    const float* cw = KIN(ka, 8) + (size_t)l * 5 * XBCW + c0; const float* cb = KIN(ka, 9) + (size_t)l * XBCW + c0;
    float w[5][8], bias[8];
#pragma unroll
    for (int i = 0; i < 5; ++i) { const f32x4 a = *(const f32x4*)(cw + i * XBCW), b = *(const f32x4*)(cw + i * XBCW + 4); w[i][0] = a.x; w[i][1] = a.y; w[i][2] = a.z; w[i][3] = a.w; w[i][4] = b.x; w[i][5] = b.y; w[i][6] = b.z; w[i][7] = b.w; }
    { const f32x4 a = *(const f32x4*)cb, b = *(const f32x4*)(cb + 4); bias[0] = a.x; bias[1] = a.y; bias[2] = a.z; bias[3] = a.w; bias[4] = b.x; bias[5] = b.y; bias[6] = b.z; bias[7] = b.w; }
    const v4u zero4 = {0u, 0u, 0u, 0u};
    while (uid != 0xffffu) {
    unsigned nclaim = 0u;
    if (I.tid == 0) nclaim = __hip_atomic_fetch_add(work, 1u, __ATOMIC_RELAXED, __HIP_MEMORY_SCOPE_AGENT);
    const int u0 = (int)uid, rbase = 32 * u0;
#define LDROW(q_) ([&](int q) -> v4u { if (q < 0 || q >= MTOT) return zero4; \
        const bf16* p = q < rbase ? HALO + (size_t)((u0 - 1) * 4 + 2 + (q - (rbase - 2))) * XBCW : (q >= rbase + 32 ? HALO + (size_t)((u0 + 1) * 4 + (q - rbase - 32)) * XBCW : XBC + (size_t)q * XBCW); \
        return *(const v4u*)(p + c0); })(q_)
#define UNPK(dst, v_) do { dst[0] = bf_lo(v_.x); dst[1] = bf_hi(v_.x); dst[2] = bf_lo(v_.y); dst[3] = bf_hi(v_.y); dst[4] = bf_lo(v_.z); dst[5] = bf_hi(v_.z); dst[6] = bf_lo(v_.w); dst[7] = bf_hi(v_.w); } while (0)
    float f0[8], f1[8], f2[8], f3[8];
    { const v4u a0 = LDROW(rbase - 2), a1 = LDROW(rbase - 1), a2 = LDROW(rbase), a3 = LDROW(rbase + 1); UNPK(f0, a0); UNPK(f1, a1); UNPK(f2, a2); UNPK(f3, a3); }
    v4u q0 = LDROW(rbase + 2), q1 = LDROW(rbase + 3), q2 = LDROW(rbase + 4), q3 = LDROW(rbase + 5);
    for (int it = 0; it < 8; ++it) {
        const v4u c0v = q0, c1v = q1, c2v = q2, c3v = q3;
        const int nb = rbase + 2 + 4 * (it + 1);
        if (it + 1 < 8) { q0 = LDROW(nb); q1 = LDROW(nb + 1); q2 = LDROW(nb + 2); q3 = LDROW(nb + 3); }
#pragma unroll
        for (int k = 0; k < 4; ++k) {
            const v4u w4 = k == 0 ? c0v : (k == 1 ? c1v : (k == 2 ? c2v : c3v));
            float f4[8]; UNPK(f4, w4);
            const int r = rbase + 4 * it + k;
            const int s0 = r < MLAT ? (r & ~(SEQ - 1)) : (MLAT + ((r - MLAT) & ~(CTXL - 1))), e0 = s0 + (r < MLAT ? SEQ : CTXL);
            float o[8];
            if (r - 2 >= s0 && r + 2 < e0) {
#pragma unroll
                for (int j = 0; j < 8; ++j) o[j] = bias[j] + w[0][j] * f0[j] + w[1][j] * f1[j] + w[2][j] * f2[j] + w[3][j] * f3[j] + w[4][j] * f4[j];
            } else {
                const float m0 = (r - 2 >= s0) ? 1.f : 0.f, m1 = (r - 1 >= s0) ? 1.f : 0.f, m3 = (r + 1 < e0) ? 1.f : 0.f, m4 = (r + 2 < e0) ? 1.f : 0.f;
#pragma unroll
                for (int j = 0; j < 8; ++j) o[j] = bias[j] + m0 * w[0][j] * f0[j] + m1 * w[1][j] * f1[j] + w[2][j] * f2[j] + m3 * w[3][j] * f3[j] + m4 * w[4][j] * f4[j];
            }
#pragma unroll
            for (int j = 0; j < 8; ++j) o[j] = o[j] * __builtin_amdgcn_rcpf(1.f + __expf(-o[j]));
            v4u ov; ov.x = pk2(o[0], o[1]); ov.y = pk2(o[2], o[3]); ov.z = pk2(o[4], o[5]); ov.w = pk2(o[6], o[7]);
            *(v4u*)(XBC + (size_t)r * XBCW + c0) = ov;
#pragma unroll
            for (int j = 0; j < 8; ++j) { f0[j] = f1[j]; f1[j] = f2[j]; f2[j] = f3[j]; f3[j] = f4[j]; }
        }
    }
    if (I.tid == 0) { unsigned idn; CV_CLAIM_WAIT(nclaim, idn); slot[par ^ 1] = idn; }
    __syncthreads();
    par ^= 1; uid = slot[par];
    }
#undef UNPK
#undef LDROW
#undef CV_CLAIM_WAIT
}

__device__ __forceinline__ void phase_ssd(const Ids I_, LAS unsigned char* lds, int l) {
    const Ids I = fresh(I_);
    const KA ka = ka_fresh(); unsigned char* ws = KWS(ka);
    const bf16* XBC = (const bf16*)(ws + WS_XBC); const float* DT = (const float*)(ws + WS_DT); bf16* Y = (bf16*)(ws + WS_Y);
    const int tid = I.tid, id = I.vcu, b = id >> 6, h = (id >> 1) & 31, ph = id & 1, grp = h >> 2;
    const int pl = tid >> 4, nq = tid & 15;
    LAS float* XS = (LAS float*)lds;
    LAS unsigned char* BT = lds + 8192;
    LAS unsigned char* CT = lds + 24576;
    LAS float* DTT = (LAS float*)(lds + 40960);
    LAS float* YB = (LAS float*)(lds + 41216);
    const float Dsum = KIN(ka, 12)[l * 64 + h] + KIN(ka, 12)[l * 64 + 32 + h];
    for (int dir = 0; dir < 2; ++dir) {
        const float A = -__expf(KIN(ka, 11)[l * 64 + dir * 32 + h]);
        float S[8];
#pragma unroll
        for (int i = 0; i < 8; ++i) S[i] = 0.f;
        for (int part = 0; part < 2; ++part) {
            const int rows0 = part == 0 ? MLAT + b * CTXL : b * SEQ, ntile = (part == 0 ? CTXL : SEQ) / 64;
            for (int ti = 0; ti < ntile; ++ti) {
                const int tile = dir ? ntile - 1 - ti : ti, r0 = rows0 + tile * 64;
                __syncthreads();
#pragma unroll
                for (int q = 0; q < 2; ++q) { const int ch = tid + q * 512, row = ch >> 4, c16 = ch & 15;
                    *(LAS v4u*)(BT + ch * 16) = *(const v4u*)(XBC + (size_t)(r0 + row) * XBCW + 2048 + grp * 128 + c16 * 8);
                    *(LAS v4u*)(CT + ch * 16) = *(const v4u*)(XBC + (size_t)(r0 + row) * XBCW + 3072 + grp * 128 + c16 * 8); }
                if (tid < 256) { const int row = tid >> 2, c = tid & 3; const v4u xv = *(const v4u*)(XBC + (size_t)(r0 + row) * XBCW + h * 64 + ph * 32 + c * 8);
                    LAS float* d = XS + row * 32 + c * 8; d[0] = bf_lo(xv.x); d[1] = bf_hi(xv.x); d[2] = bf_lo(xv.y); d[3] = bf_hi(xv.y); d[4] = bf_lo(xv.z); d[5] = bf_hi(xv.z); d[6] = bf_lo(xv.w); d[7] = bf_hi(xv.w);
                    if (dir == 1) { const v4u yv = *(const v4u*)(Y + (size_t)(r0 + row) * DI + h * 64 + ph * 32 + c * 8);
                        LAS float* e = YB + row * 32 + c * 8; e[0] = bf_lo(yv.x); e[1] = bf_hi(yv.x); e[2] = bf_lo(yv.y); e[3] = bf_hi(yv.y); e[4] = bf_lo(yv.z); e[5] = bf_hi(yv.z); e[6] = bf_lo(yv.w); e[7] = bf_hi(yv.w); } }
                else if (tid < 320) DTT[tid - 256] = DT[(size_t)(dir * 32 + h) * MTOT + r0 + tid - 256];
                __syncthreads();
                for (int s = 0; s < 64; ++s) {
                    const int tt = dir ? 63 - s : s;
                    const float dtv = DTT[tt], a = __expf(dtv * A), xv = XS[tt * 32 + pl], xdt = xv * dtv;
                    const v4u bv = *(const LAS v4u*)(BT + tt * 256 + nq * 16), cv = *(const LAS v4u*)(CT + tt * 256 + nq * 16);
                    float yp;
                    S[0] = S[0] * a + xdt * bf_lo(bv.x); yp = bf_lo(cv.x) * S[0];
                    S[1] = S[1] * a + xdt * bf_hi(bv.x); yp += bf_hi(cv.x) * S[1];
                    S[2] = S[2] * a + xdt * bf_lo(bv.y); yp += bf_lo(cv.y) * S[2];
                    S[3] = S[3] * a + xdt * bf_hi(bv.y); yp += bf_hi(cv.y) * S[3];
                    S[4] = S[4] * a + xdt * bf_lo(bv.z); yp += bf_lo(cv.z) * S[4];
                    S[5] = S[5] * a + xdt * bf_hi(bv.z); yp += bf_hi(cv.z) * S[5];
                    S[6] = S[6] * a + xdt * bf_lo(bv.w); yp += bf_lo(cv.w) * S[6];
                    S[7] = S[7] * a + xdt * bf_hi(bv.w); yp += bf_hi(cv.w) * S[7];
                    yp += pg8::lane_xor<1>(yp); yp += pg8::lane_xor<2>(yp); yp += pg8::lane_xor<4>(yp); yp += pg8::lane_xor<8>(yp);
                    if (nq == 0) { if (dir == 0) YB[tt * 32 + pl] = yp + Dsum * xv; else YB[tt * 32 + pl] += yp; }
                }
                __syncthreads();
                if (tid < 256) { const int row = tid >> 2, c = tid & 3; const LAS float* e = YB + row * 32 + c * 8;
                    v4u o; o.x = pk2(e[0], e[1]); o.y = pk2(e[2], e[3]); o.z = pk2(e[4], e[5]); o.w = pk2(e[6], e[7]);
                    *(v4u*)(Y + (size_t)(r0 + row) * DI + h * 64 + ph * 32 + c * 8) = o; }
            }
        }
        VM_WAIT(); __syncthreads();
    }
}

namespace ssd {
typedef short bf16x8 __attribute__((ext_vector_type(8)));
typedef short s16x4 __attribute__((ext_vector_type(4)));
constexpr int ROW = 272;
constexpr int L_CS = 0, L_BS = 34816, L_XN = 69632  , L_XF = 79872, L_XB = 88576, L_XD = 97280, L_SS0 = 105984, L_SS1 = 114688;
constexpr int L_TAB = 123392;
constexpr int L_DT = L_TAB + 4096;
#define SSD_MFMA(a, b, c) __builtin_amdgcn_mfma_f32_16x16x32_bf16((a), (b), (c), 0, 0, 0)
template <int N> __device__ __forceinline__ float row_shr(float v) { return __int_as_float(__builtin_amdgcn_update_dpp(0, __float_as_int(v), 0x110 + N, 0xf, 0xf, false)); }
__device__ __forceinline__ void scan128(LAS float* dst, LAS float* ej, const LAS float* dt, float A, bool reverse, int lane) {
    const int e0 = reverse ? 127 - 2 * lane : 2 * lane, e1 = reverse ? 126 - 2 * lane : 2 * lane + 1;
    const float v0 = dt[e0] * A, v1 = dt[e1] * A; float sc = v0 + v1;
    sc += row_shr<1>(sc); sc += row_shr<2>(sc); sc += row_shr<4>(sc); sc += row_shr<8>(sc);
    const float t0 = __int_as_float(__builtin_amdgcn_readlane(__float_as_int(sc), 15)), t1 = __int_as_float(__builtin_amdgcn_readlane(__float_as_int(sc), 31)), t2 = __int_as_float(__builtin_amdgcn_readlane(__float_as_int(sc), 47));
    const int row = lane >> 4; sc += (row >= 1 ? t0 : 0.f) + (row >= 2 ? t1 : 0.f) + (row >= 3 ? t2 : 0.f);
    const float ex = sc - (v0 + v1), c0 = ex + v0, c1 = ex + v0 + v1; dst[e0] = c0; dst[e1] = c1;
    LDS_WAIT(); asm volatile("" ::: "memory");
    const float ref = dst[reverse ? (e0 & ~15) : (e0 | 15)];
    ej[e0] = __expf(ref - c0) * dt[e0]; ej[e1] = __expf(ref - c1) * dt[e1];
}
__device__ __forceinline__ bf16x8 pack8f(const float (&m)[8]) { v4u t; t.x = pk2(m[0], m[1]); t.y = pk2(m[2], m[3]); t.z = pk2(m[4], m[5]); t.w = pk2(m[6], m[7]); return __builtin_bit_cast(bf16x8, t); }
__device__ __forceinline__ bf16x8 ld2x8(const LAS unsigned char* p0, const LAS unsigned char* p1) { const v2u a = *(const LAS v2u*)p0, b = *(const LAS v2u*)p1; v4u t; t.x = a.x; t.y = a.y; t.z = b.x; t.w = b.y; return __builtin_bit_cast(bf16x8, t); }
__device__ __forceinline__ unsigned short bf1(float v) { return (unsigned short)(pk2(v, 0.f) & 0xffffu); }
}

template <int SWEEP> __device__ __forceinline__ void ssd_sweep(const Ids I_, LAS unsigned char* lds, int l) {
    constexpr int sweep = SWEEP, NSET = SWEEP ? 2 : 1;
    using namespace ssd;
    const Ids I = fresh(I_);
    const KA ka = ka_fresh(); unsigned char* ws = KWS(ka);
    const bf16* XBC = (const bf16*)(ws + WS_XBC); const float* DT = (const float*)(ws + WS_DT); bf16* Y = (bf16*)(ws + WS_Y);
    const int tid = I.tid, lane = I.lane, w = I.wave, li = lane & 15, lg = lane >> 4;
    const int id = I.vcu, b = id >> 6, h = (id >> 1) & 31, ph = id & 1, grp = h >> 2;
    const float Dsum = KIN(ka, 12)[l * 64 + h] + KIN(ka, 12)[l * 64 + 32 + h];
    const float A_f = -__expf(KIN(ka, 11)[l * 64 + h]), A_b = -__expf(KIN(ka, 11)[l * 64 + 32 + h]);
    const size_t xcol = (size_t)h * 64 + ph * 32;
    const int srow = tid >> 2, sc4 = tid & 3;

    {
        auto row_of = [&](int idx) -> int { const int c = idx < 2 ? (sweep ? 1 - idx : idx) : (sweep ? 31 - (idx - 2) : idx - 2); return idx < 2 ? MLAT + b * CTXL + 128 * c : b * SEQ + 128 * c; };
#define SSD_TAB(par) ((LAS float*)(lds + L_TAB + (par) * 2048))
#define SSD_DTP(par) ((LAS float*)(lds + L_DT + (par) * 1024))
#define SSD_LDDT(idx_) (DT[(size_t)((tid >> 7) * 32 + h) * MTOT + row_of(idx_) + (tid & 127)])
#define SSD_SCAN(par) do { if (sweep == 0) { if (w == 0) scan128(SSD_TAB(par), SSD_TAB(par) + 256, SSD_DTP(par), A_f, false, lane); else if (w == 1) scan128(SSD_TAB(par) + 128, SSD_TAB(par) + 384, SSD_DTP(par) + 128, A_b, true, lane); } \
        else { if (w == 0) scan128(SSD_TAB(par) + 128, SSD_TAB(par) + 384, SSD_DTP(par) + 128, A_b, true, lane); } } while (0)
        v4u pc[NSET][4], pb[NSET][4], px[NSET]; float pdt = 0.f;
#define SSD_ISSUE(idx_, u_) do { const int r0_ = row_of(idx_); \
        _Pragma("unroll") for (int q = 0; q < 4; ++q) { const int ch = tid + 512 * q, row = ch >> 4, c16 = ch & 15; \
            pc[u_][q] = *(const v4u*)(XBC + (size_t)(r0_ + row) * XBCW + 3072 + grp * 128 + c16 * 8); pb[u_][q] = *(const v4u*)(XBC + (size_t)(r0_ + row) * XBCW + 2048 + grp * 128 + c16 * 8); } \
        px[u_] = *(const v4u*)(XBC + (size_t)(r0_ + srow) * XBCW + xcol + sc4 * 8); } while (0)
        __syncthreads();
        for (int i = tid; i < (2 * 8704) / 4; i += NWAVES * 64) ((LAS unsigned*)(lds + L_SS0))[i] = 0u;
        f32x4 sacc[2] = {{0.f, 0.f, 0.f, 0.f}, {0.f, 0.f, 0.f, 0.f}};
        _Pragma("unroll") for (int u = 0; u < NSET; ++u) SSD_ISSUE(u, u);
        if (tid < 256) SSD_DTP(0)[tid] = SSD_LDDT(0);
        __syncthreads();
        SSD_SCAN(0);
        if (tid < 256) pdt = SSD_LDDT(1);
        for (int idx0 = 0; idx0 < 34; idx0 += NSET)
#pragma unroll
        for (int u = 0; u < NSET; ++u) {
            const int idx = idx0 + u;
            const int r0 = row_of(idx), par = idx & 1;
            const bool need_y = !(l == 1 && idx < 2);
            LAS unsigned char* SScur = lds + (par ? L_SS1 : L_SS0); LAS unsigned char* SSnxt = lds + (par ? L_SS0 : L_SS1);
            LAS float* AF = SSD_TAB(par); LAS float* RB = AF + 128; LAS float* EJF = AF + 256; LAS float* EJB = AF + 384; LAS float* DTF = SSD_DTP(par); LAS float* DTB = DTF + 128;
            __syncthreads();
#pragma unroll
            for (int q = 0; q < 4; ++q) { const int ch = tid + 512 * q, row = ch >> 4, c16 = ch & 15; *(LAS v4u*)(lds + L_CS + row * ROW + c16 * 16) = pc[u][q]; *(LAS v4u*)(lds + L_BS + row * ROW + c16 * 16) = pb[u][q]; }
            *(LAS v4u*)(lds + L_XN + srow * 80 + sc4 * 16) = px[u];
            {
                const v4u pxu = px[u]; const float xv[8] = {bf_lo(pxu.x), bf_hi(pxu.x), bf_lo(pxu.y), bf_hi(pxu.y), bf_lo(pxu.z), bf_hi(pxu.z), bf_lo(pxu.w), bf_hi(pxu.w)};
                LAS unsigned short* xf = (LAS unsigned short*)(lds + L_XF + (4 * sc4) * ROW) + srow; LAS unsigned short* xb = (LAS unsigned short*)(lds + L_XB + (4 * sc4) * ROW) + srow; LAS unsigned short* xd = (LAS unsigned short*)(lds + L_XD + (4 * sc4) * ROW) + srow;
                if (sweep == 0) { const float f = DTF[srow], gg = DTB[srow], e = f * __expf(AF[127] - AF[srow]);
#pragma unroll
                    for (int q = 0; q < 8; ++q) { const int ro = (16 * (q >> 2) + (q & 3)) * (ROW / 2); xf[ro] = bf1(xv[q]); xd[ro] = bf1(xv[q] * e); } (void)gg; (void)xb; }
                else { const float e = DTB[srow] * __expf(RB[0] - RB[srow]);
#pragma unroll
                    for (int q = 0; q < 8; ++q) xd[(16 * (q >> 2) + (q & 3)) * (ROW / 2)] = bf1(xv[q] * e); }
            }
            if (tid < 256 && idx + 1 < 34) SSD_DTP(par ^ 1)[tid] = pdt;
            __syncthreads();
            if (idx + NSET < 34) SSD_ISSUE(idx + NSET, u);
            if (idx + 1 < 34) SSD_SCAN(par ^ 1);
            if (tid < 256 && idx + 2 < 34) pdt = SSD_LDDT(idx + 2);
            v4u yold = {0u, 0u, 0u, 0u};
            if (sweep == 1 && need_y) yold = *(const v4u*)(Y + (size_t)(r0 + 16 * w + li) * DI + xcol + 8 * lg);
            bf16x8 cf[4];
#pragma unroll
            for (int ks = 0; ks < 4; ++ks) cf[ks] = *(const LAS bf16x8*)(lds + L_CS + (16 * w + li) * ROW + (32 * ks + 8 * lg) * 2);
            f32x4 yacc[2] = {{0.f, 0.f, 0.f, 0.f}, {0.f, 0.f, 0.f, 0.f}}, yi[2] = {{0.f, 0.f, 0.f, 0.f}, {0.f, 0.f, 0.f, 0.f}};
            if (need_y) {
            {
                bf16x8 sf[8];
#pragma unroll
                for (int ks = 0; ks < 4; ++ks)
#pragma unroll
                    for (int pt = 0; pt < 2; ++pt) sf[2 * ks + pt] = *(const LAS bf16x8*)(SScur + (16 * pt + li) * ROW + (32 * ks + 8 * lg) * 2);
                __builtin_amdgcn_sched_barrier(0);
#pragma unroll
                for (int ks = 0; ks < 4; ++ks)
#pragma unroll
                    for (int pt = 0; pt < 2; ++pt) yi[pt] = SSD_MFMA(sf[2 * ks + pt], cf[ks], yi[pt]);
            }
            float escale;
            if (sweep == 0) {
                const float af_i = AF[16 * w + li], rb_i = RB[16 * w + li];
                escale = __expf(af_i);
                f32x4 g[8];
                {
                    bf16x8 fa[8], fb[8];
#define SSD_GLOAD(dst, jp) do { _Pragma("unroll") for (int q_ = 0; q_ < 8; ++q_) dst[q_] = *(const LAS bf16x8*)(lds + L_BS + (16 * (2 * (jp) + (q_ >> 2)) + li) * ROW + (32 * (q_ & 3) + 8 * lg) * 2); } while (0)
#define SSD_GMMA(src, jp) do { g[2 * (jp)] = (f32x4){0.f, 0.f, 0.f, 0.f}; g[2 * (jp) + 1] = (f32x4){0.f, 0.f, 0.f, 0.f}; \
                        _Pragma("unroll") for (int q_ = 0; q_ < 8; ++q_) g[2 * (jp) + (q_ >> 2)] = SSD_MFMA(src[q_], cf[q_ & 3], g[2 * (jp) + (q_ >> 2)]); } while (0)
                    SSD_GLOAD(fa, 0); __builtin_amdgcn_sched_barrier(0);
                    SSD_GLOAD(fb, 1); __builtin_amdgcn_sched_barrier(0); SSD_GMMA(fa, 0); __builtin_amdgcn_sched_barrier(0);
                    SSD_GLOAD(fa, 2); __builtin_amdgcn_sched_barrier(0); SSD_GMMA(fb, 1); __builtin_amdgcn_sched_barrier(0);
                    SSD_GLOAD(fb, 3); __builtin_amdgcn_sched_barrier(0); SSD_GMMA(fa, 2); __builtin_amdgcn_sched_barrier(0);
                    SSD_GMMA(fb, 3); __builtin_amdgcn_sched_barrier(0);
#undef SSD_GLOAD
#undef SSD_GMMA
                }
#define SSD_TILE_F(t, mo) do { if ((t) < w) { const float ei = __expf(af_i - AF[16 * (t) + 15]); const f32x4 ejv = *(const LAS f32x4*)(EJF + 16 * (t) + 4 * lg); \
                        _Pragma("unroll") for (int r = 0; r < 4; ++r) m[(mo) + r] = g[t][r] * (ei * ejv[r]); } \
                    else if ((t) == w) { const f32x4 av = *(const LAS f32x4*)(AF + 16 * (t) + 4 * lg), dv = *(const LAS f32x4*)(DTF + 16 * (t) + 4 * lg); \
                        _Pragma("unroll") for (int r = 0; r < 4; ++r) m[(mo) + r] = (4 * lg + r <= li) ? g[t][r] * (dv[r] * __expf(fminf(af_i - av[r], 0.f))) : 0.f; } \
                    else { _Pragma("unroll") for (int r = 0; r < 4; ++r) m[(mo) + r] = 0.f; } } while (0)
#define SSD_TILE_B(t, mo) do { if ((t) > w) { const float ei = __expf(rb_i - RB[16 * (t)]); const f32x4 ejv = *(const LAS f32x4*)(EJB + 16 * (t) + 4 * lg); \
                        _Pragma("unroll") for (int r = 0; r < 4; ++r) m[(mo) + r] = g[t][r] * (ei * ejv[r]); } \
                    else if ((t) == w) { const f32x4 av = *(const LAS f32x4*)(RB + 16 * (t) + 4 * lg), dv = *(const LAS f32x4*)(DTB + 16 * (t) + 4 * lg); \
                        _Pragma("unroll") for (int r = 0; r < 4; ++r) m[(mo) + r] = (4 * lg + r >= li) ? g[t][r] * (dv[r] * __expf(fminf(rb_i - av[r], 0.f))) : 0.f; } \
                    else { _Pragma("unroll") for (int r = 0; r < 4; ++r) m[(mo) + r] = 0.f; } } while (0)
#pragma unroll
                for (int kk = 0; kk < 4; ++kk) {
                    const int t0 = 2 * kk, t1 = 2 * kk + 1;
                    if (t0 <= w) {
                        float m[8]; SSD_TILE_F(t0, 0); SSD_TILE_F(t1, 4);
                        const bf16x8 bfr = pack8f(m);
#pragma unroll
                        for (int pt = 0; pt < 2; ++pt) { const LAS unsigned char* rp = lds + L_XF + (16 * pt + li) * ROW; const bf16x8 a = ld2x8(rp + (32 * kk + 4 * lg) * 2, rp + (32 * kk + 16 + 4 * lg) * 2); yacc[pt] = SSD_MFMA(a, bfr, yacc[pt]); }
                    }
                    if (t1 >= w) {
                        float m[8]; SSD_TILE_B(t0, 0); SSD_TILE_B(t1, 4);
                        const bf16x8 bfr = pack8f(m);
#pragma unroll
                        for (int pt = 0; pt < 2; ++pt) { const LAS unsigned char* rp = lds + L_XF + (16 * pt + li) * ROW; const bf16x8 a = ld2x8(rp + (32 * kk + 4 * lg) * 2, rp + (32 * kk + 16 + 4 * lg) * 2); yacc[pt] = SSD_MFMA(a, bfr, yacc[pt]); }
                    }
                }
#undef SSD_TILE_F
#undef SSD_TILE_B
            } else escale = __expf(RB[16 * w + li]);
            {
                bf16* yp = Y + (size_t)(r0 + 16 * w + li) * DI + xcol + 8 * lg;
                float o[8];
                if (sweep == 0) { const v4u xv = *(const LAS v4u*)(lds + L_XN + (16 * w + li) * 80 + (8 * lg) * 2);
                    const float xs[8] = {bf_lo(xv.x), bf_hi(xv.x), bf_lo(xv.y), bf_hi(xv.y), bf_lo(xv.z), bf_hi(xv.z), bf_lo(xv.w), bf_hi(xv.w)};
#pragma unroll
                    for (int pt = 0; pt < 2; ++pt)
#pragma unroll
                        for (int r = 0; r < 4; ++r) o[4 * pt + r] = yacc[pt][r] + escale * yi[pt][r] + Dsum * xs[4 * pt + r]; }
                else { const float ys[8] = {bf_lo(yold.x), bf_hi(yold.x), bf_lo(yold.y), bf_hi(yold.y), bf_lo(yold.z), bf_hi(yold.z), bf_lo(yold.w), bf_hi(yold.w)};
#pragma unroll
                    for (int pt = 0; pt < 2; ++pt)
#pragma unroll
                        for (int r = 0; r < 4; ++r) o[4 * pt + r] = ys[4 * pt + r] + escale * yi[pt][r]; }
                v4u ov; ov.x = pk2(o[0], o[1]); ov.y = pk2(o[2], o[3]); ov.z = pk2(o[4], o[5]); ov.w = pk2(o[6], o[7]); *(v4u*)yp = ov;
            }
            }
            {
                const float atot = __expf(sweep == 0 ? AF[127] : RB[0]);
                sacc[0] = sacc[0] * atot; sacc[1] = sacc[1] * atot;
                const int q = li >> 2, pq = li & 3;
                bf16x8 ta[4], xd[8];
#pragma unroll
                for (int ks = 0; ks < 4; ++ks) {
                    const LAS unsigned char* tp = lds + L_BS + (32 * ks + 8 * lg + q) * ROW + (16 * w + 4 * pq) * 2;
                    const s16x4 lo = __builtin_amdgcn_ds_read_tr16_b64_v4i16((LAS s16x4*)tp), hi = __builtin_amdgcn_ds_read_tr16_b64_v4i16((LAS s16x4*)(tp + 4 * ROW));
                    ta[ks] = __builtin_shufflevector(lo, hi, 0, 1, 2, 3, 4, 5, 6, 7);
#pragma unroll
                    for (int pt = 0; pt < 2; ++pt) xd[2 * ks + pt] = *(const LAS bf16x8*)(lds + L_XD + (16 * pt + li) * ROW + (32 * ks + 8 * lg) * 2);
                }
                __builtin_amdgcn_sched_barrier(0);
#pragma unroll
                for (int ks = 0; ks < 4; ++ks)
#pragma unroll
                    for (int pt = 0; pt < 2; ++pt) sacc[pt] = SSD_MFMA(ta[ks], xd[2 * ks + pt], sacc[pt]);
#pragma unroll
                for (int pt = 0; pt < 2; ++pt) { v2u sv; sv.x = pk2(sacc[pt][0], sacc[pt][1]); sv.y = pk2(sacc[pt][2], sacc[pt][3]); *(LAS v2u*)(SSnxt + (16 * pt + li) * ROW + (16 * w + 4 * lg) * 2) = sv; }
            }
        }
#undef SSD_ISSUE
#undef SSD_SCAN
#undef SSD_LDDT
#undef SSD_TAB
#undef SSD_DTP
        VM_WAIT(); __syncthreads();
    }
}
__device__ __forceinline__ void phase_ssd_mfma(const Ids I, LAS unsigned char* lds, int l) { ssd_sweep<0>(I, lds, l); ssd_sweep<1>(I, lds, l); }
namespace ssdd {
constexpr int ROW = 272;
constexpr int XFP = 144;
constexpr int L_CS = 0, L_BS = 34816, L_XF = 69632  , L_XD = 88064  , L_SS0 = 106496, L_SS1 = 123904, L_TAB = 141312  , L_DT = 143360  ;
constexpr int FLAG_OFF = 90112;
}
template <int DIR> __device__ __forceinline__ void ssd_dir(const Ids I_, LAS unsigned char* lds, int l) {
    using namespace ssdd;
    using ssd::scan128; using ssd::pack8f; using ssd::ld2x8; using ssd::bf1; using ssd::bf16x8; using ssd::s16x4;
    const Ids I = fresh(I_);
    const KA ka = ka_fresh(); unsigned char* ws = KWS(ka);
    const bf16* XBC = (const bf16*)(ws + WS_XBC); const float* DT = (const float*)(ws + WS_DT); bf16* Y = (bf16*)(ws + WS_Y);
    const int tid = I.tid, lane = I.lane, w = I.wave, li = lane & 15, lg = lane >> 4;
    const int wt = w < 4 ? w : 11 - w;
    const int id = I.vcu, b = id >> 6, h = (id >> 1) & 31, grp = h >> 2;
    const float Dsum = KIN(ka, 12)[l * 64 + h] + KIN(ka, 12)[l * 64 + 32 + h];
    const float A_d = -__expf(KIN(ka, 11)[l * 64 + DIR * 32 + h]);
    const size_t xcol = (size_t)h * 64;
    const int srow = tid >> 2, sc4 = tid & 3;
    pg8::pg8_gu32* flags = (pg8::pg8_gu32*)(ws + WS_CTL) + FLAG_OFF + (size_t)((l * 128 + b * 32 + h) * 34) * 8 + w;
    const __amdgpu_buffer_rsrc_t rsY = __builtin_amdgcn_make_buffer_rsrc((void*)Y, (short)0, 17408 * 2048 * 2, 0x00020000);
    auto chunk_of = [&](int idx) -> int { return idx < 2 ? (DIR ? 1 - idx : idx) : 2 + (DIR ? 31 - (idx - 2) : idx - 2); };
    auto row_of = [&](int idx) -> int { const int c = chunk_of(idx); return c < 2 ? MLAT + b * CTXL + 128 * c : b * SEQ + 128 * (c - 2); };
#define SD_TAB(par) ((LAS float*)(lds + L_TAB + (par) * 1024))
#define SD_DTP(par) ((LAS float*)(lds + L_DT + (par) * 512))
    const int tl = tid - (DIR ? 256 : 0);
#define SD_LDDT(idx_) (DT[(size_t)(DIR * 32 + h) * MTOT + row_of(idx_) + tl])
#define SD_SCAN(par) do { if (w == (DIR ? 4 : 0)) scan128(SD_TAB(par), SD_TAB(par) + 128, SD_DTP(par), A_d, DIR != 0, lane); } while (0)
    v4u pc[4], pb[4], px[2]; float pdt = 0.f;
#define SD_ISSUE(idx_) do { const int r0_ = row_of(idx_); \
        _Pragma("unroll") for (int q = 0; q < 4; ++q) { const int ch = tid + 512 * q, row = ch >> 4, c16 = ch & 15; \
            pc[q] = *(const v4u*)(XBC + (size_t)(r0_ + row) * XBCW + 3072 + grp * 128 + c16 * 8); pb[q] = *(const v4u*)(XBC + (size_t)(r0_ + row) * XBCW + 2048 + grp * 128 + c16 * 8); } \
        px[0] = *(const v4u*)(XBC + (size_t)(r0_ + srow) * XBCW + xcol + sc4 * 16); px[1] = *(const v4u*)(XBC + (size_t)(r0_ + srow) * XBCW + xcol + sc4 * 16 + 8); } while (0)
    __syncthreads();
    for (int i = tid; i < (2 * 17408) / 4; i += NWAVES * 64) ((LAS unsigned*)(lds + L_SS0))[i] = 0u;
    f32x4 sacc[4];
#pragma unroll
    for (int pt = 0; pt < 4; ++pt) sacc[pt] = (f32x4){0.f, 0.f, 0.f, 0.f};
    if ((DIR == 0 ? wt : 7 - wt) >= 4) __builtin_amdgcn_s_setprio(2);
    SD_ISSUE(0);
    if ((unsigned)tl < 128u) SD_DTP(0)[tl] = SD_LDDT(0);
    __syncthreads();
    SD_SCAN(0);
    if ((unsigned)tl < 128u) pdt = SD_LDDT(1);
    int pend = -1;
    for (int idx = 0; idx < 34; ++idx) {
        const int r0 = row_of(idx), par = idx & 1, cid = chunk_of(idx);
        const bool need_y = !(l == 1 && idx < 2);
        const bool first = idx < 2 ? (idx == 0) : (idx <= 17);
        unsigned fl = 1u;
        if (need_y && !first) fl = __hip_atomic_load(flags + cid * 8, __ATOMIC_RELAXED, __HIP_MEMORY_SCOPE_AGENT);
        LAS unsigned char* SScur = lds + (par ? L_SS1 : L_SS0); LAS unsigned char* SSnxt = lds + (par ? L_SS0 : L_SS1);
        LAS float* AC = SD_TAB(par); LAS float* EJ = AC + 128; LAS float* DTC = SD_DTP(par);
        __syncthreads();
#pragma unroll
        for (int q = 0; q < 4; ++q) { const int ch = tid + 512 * q, row = ch >> 4, c16 = ch & 15; *(LAS v4u*)(lds + L_CS + row * ROW + c16 * 16) = pc[q]; *(LAS v4u*)(lds + L_BS + row * ROW + c16 * 16) = pb[q]; }
        {
            const v4u p0 = px[0], p1 = px[1];
            const float xv[16] = {bf_lo(p0.x), bf_hi(p0.x), bf_lo(p0.y), bf_hi(p0.y), bf_lo(p0.z), bf_hi(p0.z), bf_lo(p0.w), bf_hi(p0.w), bf_lo(p1.x), bf_hi(p1.x), bf_lo(p1.y), bf_hi(p1.y), bf_lo(p1.z), bf_hi(p1.z), bf_lo(p1.w), bf_hi(p1.w)};
            {
                LAS unsigned char* xr_ = lds + L_XF + srow * XFP + (4 * sc4) * 2;
                v2u t0; t0.x = p0.x; t0.y = p0.y; *(LAS v2u*)(xr_) = t0; t0.x = p0.z; t0.y = p0.w; *(LAS v2u*)(xr_ + 32) = t0; t0.x = p1.x; t0.y = p1.y; *(LAS v2u*)(xr_ + 64) = t0; t0.x = p1.z; t0.y = p1.w; *(LAS v2u*)(xr_ + 96) = t0; }
            const float e = DTC[srow] * __expf(AC[DIR ? 0 : 127] - AC[srow]);
#pragma unroll
            for (int g4 = 0; g4 < 4; ++g4) { v2u t1; t1.x = pk2(xv[4 * g4] * e, xv[4 * g4 + 1] * e); t1.y = pk2(xv[4 * g4 + 2] * e, xv[4 * g4 + 3] * e); *(LAS v2u*)(lds + L_XD + srow * XFP + (16 * g4 + 4 * sc4) * 2) = t1; }
        }
        if ((unsigned)tl < 128u && idx + 1 < 34) SD_DTP(par ^ 1)[tl] = pdt;
        if (pend >= 0) { asm volatile("s_waitcnt vmcnt(0)" ::: "memory"); if (lane == 0) __hip_atomic_store(flags + pend * 8, 1u, __ATOMIC_RELAXED, __HIP_MEMORY_SCOPE_AGENT); pend = -1; }
        __syncthreads();
        if (idx + 1 < 34) SD_SCAN(par ^ 1);
        if ((unsigned)tl < 128u && idx + 2 < 34) pdt = SD_LDDT(idx + 2);
        const unsigned yoff = (unsigned)(((size_t)(r0 + 16 * wt + li) * DI + xcol + 16 * lg) * 2);
        v4u yo0 = {0u, 0u, 0u, 0u}, yo1 = {0u, 0u, 0u, 0u};
        if (need_y) {
            if (!first) {
                unsigned sp = 0;
                while (__builtin_amdgcn_readfirstlane(fl) == 0u) { __builtin_amdgcn_s_sleep(2); fl = __hip_atomic_load(flags + cid * 8, __ATOMIC_RELAXED, __HIP_MEMORY_SCOPE_AGENT);
                    if ((++sp & 255u) == 0u) { pg8::pg8_gu32* tmo = (pg8::pg8_gu32*)(ws + WS_CTL) + CW_BAR + XB_TMO; if (__hip_atomic_load(tmo, __ATOMIC_RELAXED, __HIP_MEMORY_SCOPE_AGENT) != 0u) break; if (sp > (1u << 20)) { if (lane == 0) __hip_atomic_fetch_add(tmo, 1u, __ATOMIC_RELAXED, __HIP_MEMORY_SCOPE_AGENT); break; } } }
                asm volatile("" ::: "memory");
                yo0 = __builtin_amdgcn_raw_buffer_load_b128(rsY, yoff, 0, 17); yo1 = __builtin_amdgcn_raw_buffer_load_b128(rsY, yoff + 16, 0, 17);
            }
        }
        bf16x8 cf[4];
#pragma unroll
        for (int ks = 0; ks < 4; ++ks) cf[ks] = *(const LAS bf16x8*)(lds + L_CS + (16 * wt + li) * ROW + (32 * ks + 8 * lg) * 2);
        f32x4 yacc[4], yi[4];
#pragma unroll
        for (int pt = 0; pt < 4; ++pt) { yacc[pt] = (f32x4){0.f, 0.f, 0.f, 0.f}; yi[pt] = (f32x4){0.f, 0.f, 0.f, 0.f}; }
        if (need_y) {
            {
#pragma unroll
                for (int ks = 0; ks < 4; ++ks) {
                    bf16x8 sf[4];
#pragma unroll
                    for (int pt = 0; pt < 4; ++pt) sf[pt] = *(const LAS bf16x8*)(SScur + (16 * pt + li) * ROW + (32 * ks + 8 * lg) * 2);
#pragma unroll
                    for (int pt = 0; pt < 4; ++pt) yi[pt] = SSD_MFMA(sf[pt], cf[ks], yi[pt]);
                }
            }
            if (idx + 1 < 34) SD_ISSUE(idx + 1);
            const float a_i = AC[16 * wt + li];
            const float escale = __expf(a_i);
            f32x4 g[8];
            {
                bf16x8 fa[8], fb[8];
#define SD_GLOAD(dst, jp) do { _Pragma("unroll") for (int q_ = 0; q_ < 8; ++q_) dst[q_] = *(const LAS bf16x8*)(lds + L_BS + (16 * (2 * (jp) + (q_ >> 2)) + li) * ROW + (32 * (q_ & 3) + 8 * lg) * 2); } while (0)
#define SD_GMMA(src, jp) do { g[2 * (jp)] = (f32x4){0.f, 0.f, 0.f, 0.f}; g[2 * (jp) + 1] = (f32x4){0.f, 0.f, 0.f, 0.f}; \
                    _Pragma("unroll") for (int q_ = 0; q_ < 8; ++q_) g[2 * (jp) + (q_ >> 2)] = SSD_MFMA(src[q_], cf[q_ & 3], g[2 * (jp) + (q_ >> 2)]); } while (0)
#define SD_NEED(jp) (DIR == 0 ? (2 * (jp) <= wt) : (2 * (jp) + 1 >= wt))
                if (DIR == 0 ? (wt >= 6) : (wt <= 1)) {
                    SD_GLOAD(fa, 0); __builtin_amdgcn_sched_barrier(0);
                    SD_GLOAD(fb, 1); __builtin_amdgcn_sched_barrier(0); SD_GMMA(fa, 0); __builtin_amdgcn_sched_barrier(0);
                    SD_GLOAD(fa, 2); __builtin_amdgcn_sched_barrier(0); SD_GMMA(fb, 1); __builtin_amdgcn_sched_barrier(0);
                    SD_GLOAD(fb, 3); __builtin_amdgcn_sched_barrier(0); SD_GMMA(fa, 2); __builtin_amdgcn_sched_barrier(0);
                    SD_GMMA(fb, 3); __builtin_amdgcn_sched_barrier(0);
                } else {
#pragma unroll
                    for (int jp = 0; jp < 4; ++jp) {
                        if (SD_NEED(jp)) { SD_GLOAD(fa, jp); __builtin_amdgcn_sched_barrier(0); SD_GMMA(fa, jp); __builtin_amdgcn_sched_barrier(0); }
                        else { g[2 * jp] = (f32x4){0.f, 0.f, 0.f, 0.f}; g[2 * jp + 1] = (f32x4){0.f, 0.f, 0.f, 0.f}; }
                    }
                    (void)fb;
                }
#undef SD_NEED
#undef SD_GLOAD
#undef SD_GMMA
            }
#define SD_TILE(t, mo) do { if (DIR == 0 ? ((t) < wt) : ((t) > wt)) { const float ei = __expf(a_i - AC[DIR == 0 ? 16 * (t) + 15 : 16 * (t)]); const f32x4 ejv = *(const LAS f32x4*)(EJ + 16 * (t) + 4 * lg); \
                    _Pragma("unroll") for (int r = 0; r < 4; ++r) m[(mo) + r] = g[t][r] * (ei * ejv[r]); } \
                else if ((t) == wt) { const f32x4 av = *(const LAS f32x4*)(AC + 16 * (t) + 4 * lg), dv = *(const LAS f32x4*)(DTC + 16 * (t) + 4 * lg); \
                    _Pragma("unroll") for (int r = 0; r < 4; ++r) m[(mo) + r] = (DIR == 0 ? (4 * lg + r <= li) : (4 * lg + r >= li)) ? g[t][r] * (dv[r] * __expf(fminf(a_i - av[r], 0.f))) : 0.f; } \
                else { _Pragma("unroll") for (int r = 0; r < 4; ++r) m[(mo) + r] = 0.f; } } while (0)
#pragma unroll
            for (int kk = 0; kk < 4; ++kk) {
                const int t0 = 2 * kk, t1 = 2 * kk + 1;
                if (DIR == 0 ? (t0 <= wt) : (t1 >= wt)) {
                    float m[8]; SD_TILE(t0, 0); SD_TILE(t1, 4);
                    const bf16x8 bfr = pack8f(m);
#pragma unroll
                    for (int pt = 0; pt < 4; ++pt) {
                        const LAS unsigned char* tp = lds + L_XF + (32 * kk + 4 * lg + (li >> 2)) * XFP + (16 * pt + 4 * (li & 3)) * 2;
                        const s16x4 lo = __builtin_amdgcn_ds_read_tr16_b64_v4i16((LAS s16x4*)tp), hi = __builtin_amdgcn_ds_read_tr16_b64_v4i16((LAS s16x4*)(tp + 16 * XFP));
                        const bf16x8 a = __builtin_shufflevector(lo, hi, 0, 1, 2, 3, 4, 5, 6, 7); yacc[pt] = SSD_MFMA(a, bfr, yacc[pt]); }
                }
            }
#undef SD_TILE
            {
                float o[16];
#pragma unroll
                for (int pt = 0; pt < 4; ++pt)
#pragma unroll
                    for (int r = 0; r < 4; ++r) o[4 * pt + r] = yacc[pt][r] + escale * yi[pt][r];
                if (DIR == 0) {
#pragma unroll
                    for (int pt = 0; pt < 4; ++pt) { const v2u xw = *(const LAS v2u*)(lds + L_XF + (16 * wt + li) * XFP + (16 * pt + 4 * lg) * 2);
                        o[4 * pt] += Dsum * bf_lo(xw.x); o[4 * pt + 1] += Dsum * bf_hi(xw.x); o[4 * pt + 2] += Dsum * bf_lo(xw.y); o[4 * pt + 3] += Dsum * bf_hi(xw.y); } }
                if (!first) { const float ys[16] = {bf_lo(yo0.x), bf_hi(yo0.x), bf_lo(yo0.y), bf_hi(yo0.y), bf_lo(yo0.z), bf_hi(yo0.z), bf_lo(yo0.w), bf_hi(yo0.w), bf_lo(yo1.x), bf_hi(yo1.x), bf_lo(yo1.y), bf_hi(yo1.y), bf_lo(yo1.z), bf_hi(yo1.z), bf_lo(yo1.w), bf_hi(yo1.w)};
#pragma unroll
                    for (int q = 0; q < 16; ++q) o[q] += ys[q]; }
                v4u ov0, ov1; ov0.x = pk2(o[0], o[1]); ov0.y = pk2(o[2], o[3]); ov0.z = pk2(o[4], o[5]); ov0.w = pk2(o[6], o[7]); ov1.x = pk2(o[8], o[9]); ov1.y = pk2(o[10], o[11]); ov1.z = pk2(o[12], o[13]); ov1.w = pk2(o[14], o[15]);
                if (first) { __builtin_amdgcn_raw_buffer_store_b128(ov0, rsY, yoff, 0, 16); __builtin_amdgcn_raw_buffer_store_b128(ov1, rsY, yoff + 16, 0, 16); pend = cid; }
                else { __builtin_amdgcn_raw_buffer_store_b128(ov0, rsY, yoff, 0, 0); __builtin_amdgcn_raw_buffer_store_b128(ov1, rsY, yoff + 16, 0, 0); }
            }
        }
        else if (idx + 1 < 34) SD_ISSUE(idx + 1);
        {
            const float atot = __expf(AC[DIR ? 0 : 127]);
#pragma unroll
            for (int pt = 0; pt < 4; ++pt) sacc[pt] = sacc[pt] * atot;
            const int q = li >> 2, pq = li & 3;
#pragma unroll
            for (int ks = 0; ks < 4; ++ks) {
                const LAS unsigned char* tp = lds + L_BS + (32 * ks + 8 * lg + q) * ROW + (16 * w + 4 * pq) * 2;
                const s16x4 lo = __builtin_amdgcn_ds_read_tr16_b64_v4i16((LAS s16x4*)tp), hi = __builtin_amdgcn_ds_read_tr16_b64_v4i16((LAS s16x4*)(tp + 4 * ROW));
                const bf16x8 ta = __builtin_shufflevector(lo, hi, 0, 1, 2, 3, 4, 5, 6, 7);
                bf16x8 xdv[4];
#pragma unroll
                for (int pt = 0; pt < 4; ++pt) { const LAS unsigned char* xp_ = lds + L_XD + (32 * ks + 8 * lg + q) * XFP + (16 * pt + 4 * pq) * 2;
                    const s16x4 xl_ = __builtin_amdgcn_ds_read_tr16_b64_v4i16((LAS s16x4*)xp_), xh_ = __builtin_amdgcn_ds_read_tr16_b64_v4i16((LAS s16x4*)(xp_ + 4 * XFP)); xdv[pt] = __builtin_shufflevector(xl_, xh_, 0, 1, 2, 3, 4, 5, 6, 7); }
#pragma unroll
                for (int pt = 0; pt < 4; ++pt) sacc[pt] = SSD_MFMA(ta, xdv[pt], sacc[pt]);
            }
#pragma unroll
            for (int pt = 0; pt < 4; ++pt) { v2u sv; sv.x = pk2(sacc[pt][0], sacc[pt][1]); sv.y = pk2(sacc[pt][2], sacc[pt][3]); *(LAS v2u*)(SSnxt + (16 * pt + li) * ROW + (16 * w + 4 * lg) * 2) = sv; }
        }
    }
    __builtin_amdgcn_s_setprio(0);
    asm volatile("s_waitcnt vmcnt(0)" ::: "memory");
    if (pend >= 0 && lane == 0) __hip_atomic_store(flags + pend * 8, 1u, __ATOMIC_RELAXED, __HIP_MEMORY_SCOPE_AGENT);
#undef SD_ISSUE
#undef SD_SCAN
#undef SD_LDDT
#undef SD_TAB
#undef SD_DTP
    __syncthreads();
}
__device__ __forceinline__ void phase_ssd_dir(const Ids I, LAS unsigned char* lds, int l) { if (I.vcu & 1) ssd_dir<1>(I, lds, l); else ssd_dir<0>(I, lds, l); }

namespace ssd3 {
typedef short bf16x8 __attribute__((ext_vector_type(8)));
typedef short s16x4 __attribute__((ext_vector_type(4)));
constexpr int ROW = 272;
constexpr int L_BS = 0, L_XF = 69632, L_XB = L_XF + 17408, L_XD = L_XB + 17408, L_SS = L_XD + 17408, L_TAB = L_SS + 17408;
constexpr int T_AFL = 0, T_RBL = 128, T_EJF = 256, T_EJB = 384, T_TF = 512, T_TB = 520, T_FLOATS = 528;
#define SSD3_MFMA32(a, b, c) __builtin_amdgcn_mfma_f32_16x16x32_bf16((a), (b), (c), 0, 0, 0)
#define SSD3_MFMA16(a, b, c) __builtin_amdgcn_mfma_f32_16x16x16bf16_1k((a), (b), (c), 0, 0, 0)
template <int N> __device__ __forceinline__ float row_shr(float v) { return __int_as_float(__builtin_amdgcn_update_dpp(0, __float_as_int(v), 0x110 + N, 0xf, 0xf, false)); }
__device__ __forceinline__ float rdlane(float v, int l) { return __int_as_float(__builtin_amdgcn_readlane(__float_as_int(v), l)); }
__device__ __forceinline__ float scan16x4(float a, int lane, float& tot) {
    float s = a; s += row_shr<4>(s); s += row_shr<8>(s);
    const float t0 = rdlane(s, 15), t1 = rdlane(s, 31), t2 = rdlane(s, 47), t3 = rdlane(s, 63); const int dr = lane >> 4;
    s += (dr >= 1 ? t0 : 0.f) + (dr >= 2 ? t1 : 0.f) + (dr >= 3 ? t2 : 0.f); tot = (t0 + t1) + (t2 + t3); return s;
}
__device__ __forceinline__ bf16x8 pack8f(const float (&m)[8]) { v4u t; t.x = pk2(m[0], m[1]); t.y = pk2(m[2], m[3]); t.z = pk2(m[4], m[5]); t.w = pk2(m[6], m[7]); return __builtin_bit_cast(bf16x8, t); }
__device__ __forceinline__ bf16x8 ld2x8(const LAS unsigned char* p0, const LAS unsigned char* p1) { const v2u a = *(const LAS v2u*)p0, b = *(const LAS v2u*)p1; v4u t; t.x = a.x; t.y = a.y; t.z = b.x; t.w = b.y; return __builtin_bit_cast(bf16x8, t); }
__device__ __forceinline__ unsigned short bf1(float v) { return (unsigned short)(pk2(v, 0.f) & 0xffffu); }
}

template <int SWEEP> __device__ __forceinline__ void ssd3_sweep(const Ids I_, LAS unsigned char* lds, int l) {
    using namespace ssd3;
    constexpr int sweep = SWEEP;
    const Ids I = fresh(I_);
    const KA ka = ka_fresh(); unsigned char* ws = KWS(ka);
    const bf16* XBC = (const bf16*)(ws + WS_XBC); const float* DT = (const float*)(ws + WS_DT); bf16* Y = (bf16*)(ws + WS_Y);
    const int tid = I.tid, lane = I.lane, w = I.wave, li = lane & 15, lg = lane >> 4;
    const int id = I.vcu, b = id >> 6, h = (id >> 1) & 31, ph = id & 1, grp = h >> 2;
    const float Dsum = KIN(ka, 12)[l * 64 + h] + KIN(ka, 12)[l * 64 + 32 + h];
    const float A_f = -__expf(KIN(ka, 11)[l * 64 + h]), A_b = -__expf(KIN(ka, 11)[l * 64 + 32 + h]);
    const size_t xcol = (size_t)h * 64 + ph * 32;
    const int srow = tid >> 2, sc4 = tid & 3;
    auto row_of = [&](int idx) -> int { const int c = idx < 2 ? (sweep ? 1 - idx : idx) : (sweep ? 31 - (idx - 2) : idx - 2); return idx < 2 ? MLAT + b * CTXL + 128 * c : b * SEQ + 128 * c; };

    v4u pb[4], px; float pdf = 0.f, pdb = 0.f; v4u pcn[4]; v2u pxo[2];
#define SSD3_LOAD_S(idx_) do { const int r0_ = row_of(idx_); \
        _Pragma("unroll") for (int q = 0; q < 4; ++q) { const int ch = tid + 512 * q; pb[q] = *(const v4u*)(XBC + (size_t)(r0_ + (ch >> 4)) * XBCW + 2048 + grp * 128 + (ch & 15) * 8); } \
        px = *(const v4u*)(XBC + (size_t)(r0_ + srow) * XBCW + xcol + sc4 * 8); pdf = DT[(size_t)h * MTOT + r0_ + srow]; pdb = DT[(size_t)(32 + h) * MTOT + r0_ + srow]; } while (0)
#define SSD3_LOAD_C(idx_) do { const int r0_ = row_of(idx_); \
        _Pragma("unroll") for (int q = 0; q < 4; ++q) pcn[q] = *(const v4u*)(XBC + (size_t)(r0_ + 16 * w + li) * XBCW + 3072 + grp * 128 + (4 * q + lg) * 8); \
        if (sweep == 0) { _Pragma("unroll") for (int pt = 0; pt < 2; ++pt) pxo[pt] = *(const v2u*)(XBC + (size_t)(r0_ + 16 * w + li) * XBCW + xcol + 16 * pt + 4 * lg); } } while (0)
#define SSD3_STAGE(gen) do { \
        LAS float* T_ = (LAS float*)(lds + L_TAB) + (gen) * T_FLOATS; \
        float tf_, tb_; const float af_ = scan16x4(pdf * A_f, lane, tf_); const float bv_ = pdb * A_b; const float sb_ = scan16x4(bv_, lane, tb_); \
        const float rb_ = tb_ - sb_ + bv_, ejf_ = __expf(tf_ - af_), ejb_ = __expf(tb_ - rb_); \
        if (sc4 == 0) { T_[T_AFL + srow] = af_; T_[T_RBL + srow] = rb_; T_[T_EJF + srow] = ejf_; T_[T_EJB + srow] = ejb_; } \
        if (lane == 0) { T_[T_TF + w] = tf_; T_[T_TB + w] = tb_; } \
        _Pragma("unroll") for (int q = 0; q < 4; ++q) { const int ch = tid + 512 * q; *(LAS v4u*)(lds + L_BS + (gen) * 34816 + (ch >> 4) * ROW + (ch & 15) * 16) = pb[q]; } \
        const float xv_[8] = {bf_lo(px.x), bf_hi(px.x), bf_lo(px.y), bf_hi(px.y), bf_lo(px.z), bf_hi(px.z), bf_lo(px.w), bf_hi(px.w)}; \
        LAS unsigned short* xd_ = (LAS unsigned short*)(lds + L_XD + (gen) * 8704 + (8 * sc4) * ROW) + srow; \
        if (sweep == 0) { LAS unsigned short* xf_ = (LAS unsigned short*)(lds + L_XF + (gen) * 8704 + (8 * sc4) * ROW) + srow; LAS unsigned short* xb_ = (LAS unsigned short*)(lds + L_XB + (gen) * 8704 + (8 * sc4) * ROW) + srow; \
            const float e_ = pdf * ejf_; \
            _Pragma("unroll") for (int q = 0; q < 8; ++q) { xf_[q * (ROW / 2)] = bf1(xv_[q] * pdf); xb_[q * (ROW / 2)] = bf1(xv_[q] * pdb); xd_[q * (ROW / 2)] = bf1(xv_[q] * e_); } } \
        else { const float e_ = pdb * ejb_; _Pragma("unroll") for (int q = 0; q < 8; ++q) xd_[q * (ROW / 2)] = bf1(xv_[q] * e_); } } while (0)

    __syncthreads();
    for (int i = tid; i < 17408 / 4; i += NWAVES * 64) ((LAS unsigned*)(lds + L_SS))[i] = 0u;
    f32x4 sacc[2] = {{0.f, 0.f, 0.f, 0.f}, {0.f, 0.f, 0.f, 0.f}};
    SSD3_LOAD_S(0); SSD3_STAGE(0);
    SSD3_LOAD_S(1); SSD3_LOAD_C(0);
    for (int idx = 0; idx < 34; ++idx) {
        const int r0 = row_of(idx), par = idx & 1;
        const bool need_y = !(l == 1 && idx < 2);
        __syncthreads();
        if (idx + 1 < 34) SSD3_STAGE(par ^ 1);
        bf16x8 cf[4]; v2u xo[2] = {{0u, 0u}, {0u, 0u}};
#pragma unroll
        for (int ks = 0; ks < 4; ++ks) cf[ks] = __builtin_bit_cast(bf16x8, pcn[ks]);
        if (sweep == 0) { xo[0] = pxo[0]; xo[1] = pxo[1]; }
        if (idx + 2 < 34) SSD3_LOAD_S(idx + 2);
        if (idx + 1 < 34) SSD3_LOAD_C(idx + 1);
        const LAS unsigned char* BSc = lds + L_BS + par * 34816; const LAS unsigned char* XFc = lds + L_XF + par * 8704; const LAS unsigned char* XBc = lds + L_XB + par * 8704; const LAS unsigned char* XDc = lds + L_XD + par * 8704;
        const LAS unsigned char* SScur = lds + L_SS + par * 8704; LAS unsigned char* SSnxt = lds + L_SS + (par ^ 1) * 8704;
        const LAS float* T = (const LAS float*)(lds + L_TAB) + par * T_FLOATS;
        v2u yold[2] = {{0u, 0u}, {0u, 0u}};
        if (sweep == 1 && need_y) { _Pragma("unroll") for (int pt = 0; pt < 2; ++pt) yold[pt] = *(const v2u*)(Y + (size_t)(r0 + 16 * w + li) * DI + xcol + 16 * pt + 4 * lg); }
        float PF[9], SB[9], TFv[8], TBv[8];
#pragma unroll
        for (int t = 0; t < 8; ++t) { TFv[t] = T[T_TF + t]; TBv[t] = T[T_TB + t]; }
        PF[0] = 0.f; SB[8] = 0.f;
#pragma unroll
        for (int t = 0; t < 8; ++t) { PF[t + 1] = PF[t] + TFv[t]; SB[7 - t] = SB[8 - t] + TBv[7 - t]; }
        float PFw = 0.f, SBw1 = 0.f;
#pragma unroll
        for (int t = 0; t < 8; ++t) { PFw = (t == w) ? PF[t] : PFw; SBw1 = (t == w) ? SB[t + 1] : SBw1; }
        const float afl_i = T[T_AFL + 16 * w + li], rbl_i = T[T_RBL + 16 * w + li];
        const float af_i = PFw + afl_i, rb_i = SBw1 + rbl_i;
        if (need_y) {
        f32x4 yacc[2] = {{0.f, 0.f, 0.f, 0.f}, {0.f, 0.f, 0.f, 0.f}}, yi[2] = {{0.f, 0.f, 0.f, 0.f}, {0.f, 0.f, 0.f, 0.f}};
        {
            bf16x8 sf[8];
#pragma unroll
            for (int ks = 0; ks < 4; ++ks)
#pragma unroll
                for (int pt = 0; pt < 2; ++pt) sf[2 * ks + pt] = *(const LAS bf16x8*)(SScur + (16 * pt + li) * ROW + (32 * ks + 8 * lg) * 2);
            __builtin_amdgcn_sched_barrier(0);
#pragma unroll
            for (int ks = 0; ks < 4; ++ks)
#pragma unroll
                for (int pt = 0; pt < 2; ++pt) yi[pt] = SSD3_MFMA32(sf[2 * ks + pt], cf[ks], yi[pt]);
        }
        const float escale = __expf(sweep == 0 ? af_i : rb_i);
        if (sweep == 0) {
            f32x4 g[8];
            {
                bf16x8 fa[8], fb[8];
#define SSD3_GLOAD(dst, jp) do { _Pragma("unroll") for (int q_ = 0; q_ < 8; ++q_) dst[q_] = *(const LAS bf16x8*)(BSc + (16 * (2 * (jp) + (q_ >> 2)) + li) * ROW + (32 * (q_ & 3) + 8 * lg) * 2); } while (0)
#define SSD3_GMMA(src, jp) do { g[2 * (jp)] = (f32x4){0.f, 0.f, 0.f, 0.f}; g[2 * (jp) + 1] = (f32x4){0.f, 0.f, 0.f, 0.f}; \
                    _Pragma("unroll") for (int q_ = 0; q_ < 8; ++q_) g[2 * (jp) + (q_ >> 2)] = SSD3_MFMA32(src[q_], cf[q_ & 3], g[2 * (jp) + (q_ >> 2)]); } while (0)
                SSD3_GLOAD(fa, 0); __builtin_amdgcn_sched_barrier(0);
                SSD3_GLOAD(fb, 1); __builtin_amdgcn_sched_barrier(0); SSD3_GMMA(fa, 0); __builtin_amdgcn_sched_barrier(0);
                SSD3_GLOAD(fa, 2); __builtin_amdgcn_sched_barrier(0); SSD3_GMMA(fb, 1); __builtin_amdgcn_sched_barrier(0);
                SSD3_GLOAD(fb, 3); __builtin_amdgcn_sched_barrier(0); SSD3_GMMA(fa, 2); __builtin_amdgcn_sched_barrier(0);
                SSD3_GMMA(fb, 3); __builtin_amdgcn_sched_barrier(0);
#undef SSD3_GLOAD
#undef SSD3_GMMA
            }
#define SSD3_TILE_F(t, mo) do { if ((t) < w) { const float ei = __expf(af_i - PF[(t) + 1]); const f32x4 ejv = *(const LAS f32x4*)(T + T_EJF + 16 * (t) + 4 * lg); \
                    _Pragma("unroll") for (int r = 0; r < 4; ++r) m[(mo) + r] = g[t][r] * (ei * ejv[r]); } \
                else if ((t) == w) { const f32x4 av = *(const LAS f32x4*)(T + T_AFL + 16 * (t) + 4 * lg); \
                    _Pragma("unroll") for (int r = 0; r < 4; ++r) m[(mo) + r] = (4 * lg + r <= li) ? g[t][r] * __expf(fminf(afl_i - av[r], 0.f)) : 0.f; } \
                else { _Pragma("unroll") for (int r = 0; r < 4; ++r) m[(mo) + r] = 0.f; } } while (0)
#define SSD3_TILE_B(t, mo) do { if ((t) > w) { const float ei = __expf(rb_i - SB[t]); const f32x4 ejv = *(const LAS f32x4*)(T + T_EJB + 16 * (t) + 4 * lg); \
                    _Pragma("unroll") for (int r = 0; r < 4; ++r) m[(mo) + r] = g[t][r] * (ei * ejv[r]); } \
                else if ((t) == w) { const f32x4 av = *(const LAS f32x4*)(T + T_RBL + 16 * (t) + 4 * lg); \
                    _Pragma("unroll") for (int r = 0; r < 4; ++r) m[(mo) + r] = (4 * lg + r >= li) ? g[t][r] * __expf(fminf(rbl_i - av[r], 0.f)) : 0.f; } \
                else { _Pragma("unroll") for (int r = 0; r < 4; ++r) m[(mo) + r] = 0.f; } } while (0)
#pragma unroll
            for (int kk = 0; kk < 4; ++kk) {
                const int t0 = 2 * kk, t1 = 2 * kk + 1;
                if (t0 <= w) {
                    float m[8]; SSD3_TILE_F(t0, 0); SSD3_TILE_F(t1, 4);
                    const bf16x8 bfr = pack8f(m);
#pragma unroll
                    for (int pt = 0; pt < 2; ++pt) { const LAS unsigned char* rp = XFc + (16 * pt + li) * ROW; const bf16x8 a = ld2x8(rp + (32 * kk + 4 * lg) * 2, rp + (32 * kk + 16 + 4 * lg) * 2); yacc[pt] = SSD3_MFMA32(a, bfr, yacc[pt]); }
                }
                if (t1 >= w) {
                    float m[8]; SSD3_TILE_B(t0, 0); SSD3_TILE_B(t1, 4);
                    const bf16x8 bfr = pack8f(m);
#pragma unroll
                    for (int pt = 0; pt < 2; ++pt) { const LAS unsigned char* rp = XBc + (16 * pt + li) * ROW; const bf16x8 a = ld2x8(rp + (32 * kk + 4 * lg) * 2, rp + (32 * kk + 16 + 4 * lg) * 2); yacc[pt] = SSD3_MFMA32(a, bfr, yacc[pt]); }
                }
            }
#undef SSD3_TILE_F
#undef SSD3_TILE_B
        }
#pragma unroll
        for (int pt = 0; pt < 2; ++pt) {
            bf16* yp = Y + (size_t)(r0 + 16 * w + li) * DI + xcol + 16 * pt + 4 * lg;
            float o[4];
            if (sweep == 0) { const v2u xv = xo[pt];
                o[0] = yacc[pt][0] + escale * yi[pt][0] + Dsum * bf_lo(xv.x); o[1] = yacc[pt][1] + escale * yi[pt][1] + Dsum * bf_hi(xv.x);
                o[2] = yacc[pt][2] + escale * yi[pt][2] + Dsum * bf_lo(xv.y); o[3] = yacc[pt][3] + escale * yi[pt][3] + Dsum * bf_hi(xv.y); }
            else { const v2u yv = yold[pt];
                o[0] = bf_lo(yv.x) + escale * yi[pt][0]; o[1] = bf_hi(yv.x) + escale * yi[pt][1]; o[2] = bf_lo(yv.y) + escale * yi[pt][2]; o[3] = bf_hi(yv.y) + escale * yi[pt][3]; }
            v2u ov; ov.x = pk2(o[0], o[1]); ov.y = pk2(o[2], o[3]); *(v2u*)yp = ov;
        }
        }
        {
            const int q = li >> 2, pq = li & 3;
            s16x4 ta[8]; s16x4 xd[8][2];
#pragma unroll
            for (int t = 0; t < 8; ++t) { ta[t] = __builtin_amdgcn_ds_read_tr16_b64_v4i16((LAS s16x4*)(BSc + (16 * t + 4 * lg + q) * ROW + (16 * w + 4 * pq) * 2));
#pragma unroll
                for (int pt = 0; pt < 2; ++pt) xd[t][pt] = *(const LAS s16x4*)(XDc + (16 * pt + li) * ROW + (16 * t + 4 * lg) * 2); }
            __builtin_amdgcn_sched_barrier(0);
#pragma unroll
            for (int tt = 0; tt < 8; ++tt) { const int t = sweep == 0 ? tt : 7 - tt; const float dec = __expf(sweep == 0 ? TFv[t] : TBv[t]);
#pragma unroll
                for (int pt = 0; pt < 2; ++pt) { sacc[pt] = sacc[pt] * dec; sacc[pt] = SSD3_MFMA16(ta[t], xd[t][pt], sacc[pt]); } }
#pragma unroll
            for (int pt = 0; pt < 2; ++pt) { v2u sv; sv.x = pk2(sacc[pt][0], sacc[pt][1]); sv.y = pk2(sacc[pt][2], sacc[pt][3]); *(LAS v2u*)(SSnxt + (16 * pt + li) * ROW + (16 * w + 4 * lg) * 2) = sv; }
        }
    }
#undef SSD3_LOAD_S
#undef SSD3_LOAD_C
#undef SSD3_STAGE
    VM_WAIT(); __syncthreads();
}
__device__ __forceinline__ void phase_ssd3(const Ids I, LAS unsigned char* lds, int l) { ssd3_sweep<0>(I, lds, l); ssd3_sweep<1>(I, lds, l); }

__device__ __forceinline__ void phase_pool(const Ids I_, LAS unsigned char* lds_base, int l) {
    LAS unsigned char* lds_misc = lds_base + MISC_OFF;
    const Ids I = fresh(I_);
    const KA ka = ka_fresh(); unsigned char* ws = KWS(ka);
    const bf16* UPOOL = (const bf16*)(ws + WS_XBC + XO_UPOOL);
    bf16* PML = (bf16*)(ws + WS_XBC + XO_UPOOL); bf16* PMC = (bf16*)(ws + WS_DT);
    const int nitems = (l == 0) ? 1024 + 64 : 1024;
    pg8::pg8_gu32* work = (pg8::pg8_gu32*)(ws + WS_CTL) + CW_WORK + 64 * l; pg8::pg8_gu32* cp_ = cnt_arr(ws, l, 0); pg8::pg8_gu32* tmo = (pg8::pg8_gu32*)(ws + WS_CTL) + CW_BAR + XB_TMO;
#define POOL_GEOM(item_) int seqb, L, w0, gi; \
        if ((item_) < 1024) { seqb = ((item_) >> 2) * 64; L = 64; w0 = 0; gi = (item_) & 3; } \
        else { const int ci = (item_) - 1024; gi = ci & 3; w0 = 64 * ((ci >> 2) & 3); seqb = MLAT + 256 * (ci >> 4); L = 256; } \
        const int cp = I.tid & 127, rs = I.tid >> 7, t0 = w0 + 16 * rs, col = gi * 256 + 2 * cp;
#define POOL_OUT(HK) do { _Pragma("unroll") for (int i = 0; i < 16; ++i) { const int t = t0 + i; const float slo = plo[i + 8 + HK] - plo[i + 8 - HK], shi = phi[i + 8 + HK] - phi[i + 8 - HK]; \
            const int lo = t - HK < 0 ? 0 : t - HK, hi = t + HK > L ? L : t + HK; const float inv = __builtin_amdgcn_rcpf((float)(hi - lo)); \
            *(unsigned*)(pout + (size_t)t * 1024 + col) = pk2(slo * inv - bf_lo(r_[i + 8]), shi * inv - bf_hi(r_[i + 8])); } } while (0)
#define POOL_CLAIM_WAIT(claim_) do { const int it_ = 2 * (int)(claim_); \
        if (it_ < nitems) { const int pmi_ = it_ < 1024 ? (it_ >> 4) : 64 + ((it_ - 1024) >> 4); unsigned sp_ = 0; \
            while (__hip_atomic_load(cp_ + 64 * pmi_, __ATOMIC_RELAXED, __HIP_MEMORY_SCOPE_AGENT) < 32u) { __builtin_amdgcn_s_sleep(2); \
                if ((++sp_ & 255u) == 0u) { if (__hip_atomic_load(tmo, __ATOMIC_RELAXED, __HIP_MEMORY_SCOPE_AGENT) != 0u) break; if (sp_ > (1u << 20)) { __hip_atomic_fetch_add(tmo, 1u, __ATOMIC_RELAXED, __HIP_MEMORY_SCOPE_AGENT); break; } } } \
            __builtin_amdgcn_fence(__ATOMIC_ACQUIRE, "agent"); asm volatile("s_waitcnt vmcnt(0)" ::: "memory"); } } while (0)
#define POOL_LOAD(r_, item_) do { POOL_GEOM(item_) \
        _Pragma("unroll") for (int i = 0; i < 32; ++i) { const int t = t0 - 8 + i; unsigned v = 0u; if (t >= 0 && t < L) v = *(const unsigned*)(UPOOL + (size_t)(seqb + t) * 1024 + col); r_[i] = v; } } while (0)
#define POOL_COMP(rr_, item_) do { POOL_GEOM(item_) const unsigned (&r_)[32] = rr_; bf16* pout = (item_) < 1024 ? PML + (size_t)seqb * 1024 : PMC + (size_t)(seqb - MLAT) * 1024; \
        float plo[33], phi[33]; plo[0] = 0.f; phi[0] = 0.f; \
        _Pragma("unroll") for (int i = 0; i < 32; ++i) { plo[i + 1] = plo[i] + bf_lo(r_[i]); phi[i + 1] = phi[i] + bf_hi(r_[i]); } \
        if (gi == 0) POOL_OUT(1); else if (gi == 1) POOL_OUT(2); else if (gi == 2) POOL_OUT(4); else POOL_OUT(8); } while (0)
    volatile LAS unsigned* slot = (volatile LAS unsigned*)(lds_misc) + 40;
    if (I.tid == 0) { const unsigned c0 = __hip_atomic_fetch_add(work, 1u, __ATOMIC_RELAXED, __HIP_MEMORY_SCOPE_AGENT); POOL_CLAIM_WAIT(c0); slot[0] = c0; }
    __syncthreads();
    int item = 2 * (int)slot[0], par = 0;
    while (item < nitems) {
        unsigned nclaim = 0u;
        unsigned ra[32], rb[32];
        POOL_LOAD(ra, item); POOL_LOAD(rb, item + 1);
        asm volatile("s_waitcnt vmcnt(0)" ::: "memory"); __syncthreads();
        if (I.tid == 0) nclaim = __hip_atomic_fetch_add(work, 1u, __ATOMIC_RELAXED, __HIP_MEMORY_SCOPE_AGENT);
        POOL_COMP(ra, item); POOL_COMP(rb, item + 1);
        if (I.tid == 0) { POOL_CLAIM_WAIT(nclaim); slot[par ^ 1] = nclaim; }
        __syncthreads();
        par ^= 1; item = 2 * (int)slot[par];
    }
#undef POOL_COMP
#undef POOL_LOAD
#undef POOL_CLAIM_WAIT
#undef POOL_OUT
#undef POOL_GEOM
}

__device__ __forceinline__ void phase_final(const Ids I_) {
    const Ids I = fresh(I_);
    const KA ka = ka_fresh(); float* OUT = KOUT(ka); const float* g = KIN(ka, 22);
    const bool dead = xb_ld((gu32*)(KWS(ka) + WS_CTL) + CW_BAR + XB_TMO) != 0u;
    v2u ta[4], tb[4];
    f32x4 gfin[4];
#pragma unroll
    for (int j = 0; j < 4; ++j) gfin[j] = ((const f32x4*)g)[I.lane + 64 * j];
#define FIN_LOAD(t_, mm) do { const v2u* q_ = (const v2u*)((const bf16*)OUT + (size_t)(mm) * 2048) + I.lane; _Pragma("unroll") for (int j = 0; j < 4; ++j) t_[j] = q_[64 * j]; } while (0)
#define FIN_ROW(t_, mm) do { f32x4 v[4]; float s = 0.f; \
        _Pragma("unroll") for (int j = 0; j < 4; ++j) { const v2u t = t_[j]; v[j] = (f32x4){bf_lo(t.x), bf_hi(t.x), bf_lo(t.y), bf_hi(t.y)}; s += (v[j].x * v[j].x + v[j].y * v[j].y) + (v[j].z * v[j].z + v[j].w * v[j].w); } \
        if ((mm) + 2 * I.NGW < MLAT) FIN_LOAD(t_, (mm) + 2 * I.NGW); \
        const float rstd = rsqrtf(wave_sum(s) * (1.f / D) + 1e-6f); \
        f32x4* xr = (f32x4*)(OUT + (size_t)(mm) * D) + I.lane; \
        _Pragma("unroll") for (int j = 0; j < 4; ++j) { f32x4 o = v[j] * rstd * gfin[j]; if (dead) { const float qn = __builtin_nanf(""); o = (f32x4){qn, qn, qn, qn}; } xr[64 * j] = o; } } while (0)
    int m = I.gw;
    if (m < MLAT) FIN_LOAD(ta, m);
    if (m + I.NGW < MLAT) FIN_LOAD(tb, m + I.NGW);
    for (; m < MLAT; m += 2 * I.NGW) {
        FIN_ROW(ta, m);
        const int m1 = m + I.NGW; if (m1 >= MLAT) break;
        FIN_ROW(tb, m1);
    }
#undef FIN_ROW
#undef FIN_LOAD
}

#ifndef DBG_STOP
#define DBG_STOP 0
#endif
__device__ __forceinline__ void phase_dump(const Ids I_, size_t ws_off, int cols, bool ctx_rows, bool isf32, bool accum = false) {
    const Ids I = fresh(I_);
    const KA ka = ka_fresh(); float* OUT = KOUT(ka); unsigned char* base = KWS(ka) + ws_off;
    for (int m = I.gw; m < MLAT; m += I.NGW) {
        for (int c = I.lane; c < 1024; c += 64) { float s = 0.f;
            for (int j = 0; j < cols / 1024; ++j) {
                if (isf32) { s += ((const float*)base)[(size_t)m * cols + c + 1024 * j]; }
                else {
#ifdef DBG_ATOMIC_DUMP
                    { const size_t e = (size_t)m * cols + c + 1024 * j; const unsigned w = __hip_atomic_fetch_or((unsigned*)base + (e >> 1), 0u, __ATOMIC_RELAXED, __HIP_MEMORY_SCOPE_AGENT); s += (e & 1) ? bf_hi(w) : bf_lo(w); }
                    if (ctx_rows) { const size_t e = (size_t)(MLAT + (m & 1023)) * cols + c + 1024 * j; const unsigned w = __hip_atomic_fetch_or((unsigned*)base + (e >> 1), 0u, __ATOMIC_RELAXED, __HIP_MEMORY_SCOPE_AGENT); s += (e & 1) ? bf_hi(w) : bf_lo(w); }
#else
                    s += bf_lo(((const bf16*)base)[(size_t)m * cols + c + 1024 * j]); if (ctx_rows) s += bf_lo(((const bf16*)base)[(size_t)(MLAT + (m & 1023)) * cols + c + 1024 * j]);
#endif
                } }
            if (accum) s += OUT[(size_t)m * D + c]; OUT[(size_t)m * D + c] = s; } }
}

__global__ void __launch_bounds__(NWAVES * 64, 2) fwd_kernel(Args args) {
    LAS unsigned char* lds = (LAS unsigned char*)pg8::lds_dyn;
    volatile LAS unsigned* MISC = (volatile LAS unsigned*)(lds + MISC_OFF);
    LAS unsigned char* xl = lds + XL_OFF;
    if ((threadIdx.x & 63u) == 0u) ((volatile LAS unsigned*)(lds + pg8::WAVE_TAB_OFF))[pg8::hw_slot()] = threadIdx.x >> 6;
    __syncthreads();
    Ids I; I.wave = pg8::wave_now(); I.tid = I.wave * 64 + pg8::lane_now(); I.lane = I.tid & 63;
    I.G = gridDim.x; I.bx = blockIdx.x; I.vcu = (I.G % 8 == 0) ? (I.bx % 8) * (I.G / 8) + I.bx / 8 : I.bx;
    I.gw = I.vcu * NWAVES + I.wave; I.NGW = I.G * NWAVES;
    const int G = I.G, bx = I.bx;

    for (int u = I.tid; u < 64; u += NWAVES * 64) MISC[u] = 0u;
    __syncthreads();
    XcdBarrier bar = xcd_barrier_post((gu32*)(KWS(ka_fresh()) + WS_CTL) + CW_BAR, MISC + 8);
#ifdef TSEL
    unsigned long long t_prev = __builtin_amdgcn_s_memrealtime(), t_acc = 0ull; int t_stage = 0;
#define GRID_BAR() do { xcd_barrier(bar); { const unsigned long long t_now = __builtin_amdgcn_s_memrealtime(); if ((TSEL >> t_stage) & 1ull) t_acc += t_now - t_prev; t_prev = t_now; ++t_stage; } } while (0)
#else
#define GRID_BAR() xcd_barrier(bar)
#endif

    phase_mod(I, lds);
    conv_mixer(I, lds, 0, false, 2);
    GRID_BAR();

    for (int l = 0; l < 2; ++l) {
        const int Mfull = (l == 0) ? MTOT : MLAT;
        phase_norm(I, lds, l, 0, MTOT, l == 0);
        GRID_BAR();
        if (DBG_STOP != 11) {
            const KA ka = ka_fresh(); unsigned char* ws = KWS(ka);
            pg8::Gemm g{(const bf16*)(ws + WS_H), (const bf16*)(ws + WS_WIN), 1024, 1024, MTOT, NB1, 1024, 0};
            pg8::PanelOrder S; S.init(MTOT, NB1, G, bx); S.set_base(ws + WS_CTL); S.wait0 = -1; S.need0 = 0u; S.wait1 = -1; S.need1 = 0u; S.done_cnt = cnt_off(l, 3); S.tmo = CW_BAR + XB_TMO;
            pg8::EpiXbcDt E{(bf16*)(ws + WS_XBC), (bf16*)(ws + WS_Y), (float*)(ws + WS_DT), KIN(ka, 10) + l * 64};
            pg8::gemm_phase<pg8::EpiXbcDt, pg8::PanelOrder>(lds, xl, g, S, E);
        }
        phase_conv(I, lds, l);
        GRID_BAR();
        if (DBG_STOP == 2) { phase_dump(I, WS_XBC, 4096, true, false); return; }
#ifdef SSD_NAIVE
        phase_ssd(I, lds, l);
#elif defined(SSD_V2)
        phase_ssd_dir(I, lds, l);
#else
        phase_ssd3(I, lds, l);
#ifdef REP_SSD
        phase_ssd_mfma(I, lds, l);
#endif
#endif
        GRID_BAR();
        if (DBG_STOP == 1) { phase_dump(I, WS_Y, 2048, true, false); return; }
        if (DBG_STOP == 9) { phase_dump(I, WS_H, 1024, true, false); phase_dump(I, WS_WIN, 1024, false, false, true); return; }
        {
            const KA ka = ka_fresh(); unsigned char* ws = KWS(ka);
            pg8::Gemm g{(const bf16*)(ws + WS_H), (const bf16*)(ws + WS_WIN) + (size_t)NB1 * 1024, 1024, 1024, Mfull, NB2, 1024, 0};
            pg8::PoolChainOrder S; S.init(Mfull, NB2, G, bx); S.set_base(ws + WS_CTL); S.wait0 = -1; S.need0 = 0u; S.wait1 = -1; S.need1 = 0u; S.done_cnt = cnt_off(l, 0); S.tmo = CW_BAR + XB_TMO;
            pg8::EpiZPG E{(bf16*)(ws + WS_Y), (bf16*)(ws + WS_XBC + XO_UPOOL), (bf16*)(ws + WS_XBC + XO_GATES)};
            pg8::gemm_phase<pg8::EpiZPG, pg8::PoolChainOrder>(lds, xl, g, S, E);
        }
        phase_pool(I, lds, l);
        GRID_BAR();
        if (DBG_STOP == 5) { phase_dump(I, WS_Y, 2048, true, false); phase_dump(I, WS_XBC + XO_GATES, 2048, true, false, true); phase_dump(I, WS_XBC + XO_UPOOL, 1024, true, false, true); return; }
        if (DBG_STOP == 8) { { const unsigned long long t0 = __builtin_amdgcn_s_memrealtime(); while (__builtin_amdgcn_s_memrealtime() - t0 < 50000ull) __builtin_amdgcn_s_sleep(32); } GRID_BAR(); phase_dump(I, WS_XBC + XO_GATES, 2048, true, false); phase_dump(I, WS_XBC + XO_UPOOL, 1024, true, false, true); return; }
        if (l == 0) {
            const KA ka = ka_fresh(); unsigned char* ws = KWS(ka);
            {   pg8::Gemm g{(const bf16*)(ws + WS_Y), (const bf16*)(ws + WS_WSSD), 2048, 2048, MTOT, 1024, 256, 0};
                pg8::SplitChain S; S.init(MTOT, 1024, G, bx < 128 ? bx : (1 << 20)); S.nun = 128; S.nsl = 8; S.ksb = 512; S.a_pm_sub = 0; S.set_base(ws + WS_CTL); S.wait0 = -1; S.need0 = 0u; S.wait1 = -1; S.need1 = 0u; S.done_cnt = cnt_off(l, 5); S.tmo = CW_BAR + XB_TMO;
                pg8::EpiPartW<16, true> E{(float*)(ws + WS_H), 0};
                pg8::gemm_phase<pg8::EpiPartW<16, true>, pg8::SplitChain>(lds, xl, g, S, E); }
            {   pg8::Gemm g{(const bf16*)(ws + WS_DT), (const bf16*)(ws + WS_WPC), 1024, 1024, MTOT, 1024, 256, 0};
                pg8::SplitChain S; S.init(MTOT, 1024, G, (bx >= 128 && bx < 192) ? bx - 128 : (1 << 20)); S.nun = 64; S.nsl = 4; S.ksb = 512; S.a_pm_sub = 64; S.set_base(ws + WS_CTL); S.wait0 = -1; S.need0 = 0u; S.wait1 = -1; S.need1 = 0u; S.done_cnt = cnt_off(l, 5); S.tmo = CW_BAR + XB_TMO;
                pg8::EpiPartW<16, true> E{(float*)(ws + WS_H), 8};
                pg8::gemm_phase<pg8::EpiPartW<16, true>, pg8::SplitChain>(lds, xl, g, S, E); }
        }
        {
            const KA ka = ka_fresh(); unsigned char* ws = KWS(ka);
            pg8::Gemm g{(const bf16*)(ws + WS_Y), (const bf16*)(ws + WS_WSSD), 2048, 2048, MLAT, 1024, 2048, 0};
            pg8::ChainOrder S; S.init(MLAT, 1024, G, bx); S.set_base(ws + WS_CTL); S.wait0 = -1; S.need0 = 0u; S.wait1 = -1; S.need1 = 0u; S.done_cnt = cnt_off(l, 1); S.tmo = CW_BAR + XB_TMO;
            pg8::EpiGate<0> E{(bf16*)(ws + WS_XBC + XO_M1), (const bf16*)(ws + WS_XBC + XO_GATES)};
            pg8::gemm_phase<pg8::EpiGate<0>, pg8::ChainOrder>(lds, xl, g, S, E);
        }
        if (l == 0) phase_m1ctx(I, l);
        {
            const KA ka = ka_fresh(); unsigned char* ws = KWS(ka);
            pg8::Gemm g{(const bf16*)(ws + WS_XBC + XO_UPOOL), (const bf16*)(ws + (l == 0 ? WS_WPC : WS_WPC1)), 1024, 1024, MLAT, 1024, 1024, 0};
            pg8::FOrder S; S.ctx_delta = (size_t)((long long)WS_DT - (long long)(WS_XBC + XO_UPOOL) - 64ll * 256 * 1024 * 2); S.init(MLAT, 1024, G, (bx + 16) % G); S.set_base(ws + WS_CTL); S.wait0 = cnt_off(l, 1); S.need0 = 32u; S.wait1 = -1; S.need1 = 0u; S.done_cnt = cnt_off(l, 2); S.tmo = CW_BAR + XB_TMO;
            pg8::EpiGate<1> E{(bf16*)(ws + WS_XBC + XO_M1), (const bf16*)(ws + WS_XBC + XO_GATES)};
            pg8::gemm_phase<pg8::EpiGate<1>, pg8::FOrder>(lds, xl, g, S, E);
        }
        {
            const KA ka = ka_fresh(); unsigned char* ws = KWS(ka);
            pg8::Gemm g{(const bf16*)(ws + WS_XBC + XO_M1), (const bf16*)(ws + WS_WOUT), 1024, 1024, MLAT, 1024, 1024, 0};
            pg8::ChainOrder S; S.init(MLAT, 1024, G, (bx + 32) % G); S.set_base(ws + WS_CTL); S.wait0 = cnt_off(l, 2); S.need0 = 32u; S.wait1 = -1; S.need1 = 0u; S.done_cnt = cnt_off(l, 4); S.tmo = CW_BAR + XB_TMO;
            if (l == 0) { pg8::EpiRes<false, 16> E{KIN(ka, 0), (bf16*)KOUT(ka), KIN(ka, 2), (float*)(ws + WS_CX), (const float*)(ws + WS_MOD) + 2048};
                pg8::gemm_phase<pg8::EpiRes<false, 16>, pg8::ChainOrder>(lds, xl, g, S, E); }
            else { pg8::EpiRes<true, 16> E{nullptr, (bf16*)KOUT(ka), (const float*)(ws + WS_CX), (float*)(ws + WS_CX), (const float*)(ws + WS_MOD) + (size_t)5 * 6144 + 2048};
                pg8::gemm_phase<pg8::EpiRes<true, 16>, pg8::ChainOrder>(lds, xl, g, S, E); }
        }
        if (l == 0) {
            const KA ka = ka_fresh(); unsigned char* ws = KWS(ka);
            pg8::Gemm g{(const bf16*)(ws + WS_XBC + XO_M1), (const bf16*)(ws + WS_WOUT), 1024, 1024, MTOT, 1024, 256, 0};
            pg8::SplitChain S; S.init(MTOT, 1024, G, bx < 64 ? bx : (1 << 20)); S.nun = 64; S.nsl = 4; S.ksb = 512; S.a_pm_sub = 0; S.set_base(ws + WS_CTL); S.wait0 = cnt_off(l, 6); S.need0 = 256u; S.wait1 = -1; S.need1 = 0u; S.done_cnt = cnt_off(l, 4); S.tmo = CW_BAR + XB_TMO;
            pg8::EpiPartW<16, true> E{(float*)(ws + WS_PG), 0};
            pg8::gemm_phase<pg8::EpiPartW<16, true>, pg8::SplitChain>(lds, xl, g, S, E);
        }
        if (l == 0) conv_win_dyn(I, lds, 1);
        phase_norm2_dyn(I, lds, l, Mfull);
        conv_ffn(I, lds, l);
        if (l == 0) conv_mixer(I, lds, 1, true, 0);
        GRID_BAR();
        {
            const KA ka = ka_fresh(); unsigned char* ws = KWS(ka);
            pg8::Gemm g{(const bf16*)(ws + WS_H), (const bf16*)(ws + WS_XBC + XO_WGU), 1024, 1024, Mfull, 2 * FFH, 1024, 0}; pg8::StaticOrder S; S.init(Mfull, 2 * FFH, G, bx);
            pg8::EpiSwiglu E{(bf16*)(ws + WS_XBC + XO_ACT)};
            pg8::gemm_phase<pg8::EpiSwiglu, pg8::StaticOrder>(lds, xl, g, S, E);
        }
        GRID_BAR();
        if (DBG_STOP == 4) { phase_dump(I, WS_XBC + XO_ACT, 2048, false, false); return; }
        {
            const KA ka = ka_fresh(); unsigned char* ws = KWS(ka);
            pg8::Gemm g{(const bf16*)(ws + WS_XBC + XO_ACT), (const bf16*)(ws + WS_XBC + XO_WDN), FFH, FFH, MLAT, 1024, FFH, 0}; pg8::StaticOrder S; S.init(MLAT, 1024, G, bx);
            pg8::EpiRes<true> E{nullptr, (bf16*)KOUT(ka), (const float*)(ws + WS_CX), (float*)(ws + WS_CX), (const float*)(ws + WS_MOD) + (size_t)l * 5 * 6144 + 5120};
            pg8::gemm_phase<pg8::EpiRes<true>, pg8::StaticOrder>(lds, xl, g, S, E);
        }
        if (l == 0) {
            const KA ka = ka_fresh(); unsigned char* ws = KWS(ka);
            pg8::Gemm g{(const bf16*)(ws + WS_XBC + XO_ACT), (const bf16*)(ws + WS_XBC + XO_WDN), FFH, FFH, MTOT, 1024, 256, 0}; pg8::SplitKOrder S; S.G = G; S.c = bx;
            pg8::EpiPartW<0> E{(float*)(ws + WS_Y), 0};
            pg8::gemm_phase<pg8::EpiPartW<0>, pg8::SplitKOrder>(lds, xl, g, S, E);
        }
        GRID_BAR();
    }
#ifdef TSEL
    {
        gu32* tw = (gu32*)(KWS(ka_fresh()) + WS_CTL) + 8192;
        if (I.bx == 0 && I.tid == 0) __hip_atomic_store(tw, (unsigned)t_acc, __ATOMIC_RELAXED, __HIP_MEMORY_SCOPE_AGENT);
        xcd_barrier(bar);
        const unsigned long long dur = (unsigned long long)__hip_atomic_load(tw, __ATOMIC_RELAXED, __HIP_MEMORY_SCOPE_AGENT) * TMUL;
        const unsigned long long t0 = __builtin_amdgcn_s_memrealtime(); while (__builtin_amdgcn_s_memrealtime() - t0 < dur) __builtin_amdgcn_s_sleep(16);
    }
#endif
    phase_final(I);
}

extern "C" void kernel_launch(void* const* d_in, const int* in_sizes, int n_in, void* d_out, int out_size, void* d_ws, size_t ws_size, hipStream_t stream) {
    static int grid = 0;
    if (grid == 0) {
        if (n_in != 23 || in_sizes[0] != MLAT * D || out_size != MLAT * D || ws_size < WS_END2) { fprintf(stderr, "kernel_launch: unexpected shapes / workspace (n_in %d, ws %zu, need %zu); nothing launched\n", n_in, ws_size, (size_t)WS_END2); grid = -1; return; }
        int dev = 0, cus = 0, per_cu = 0;
        if (hipGetDevice(&dev) != hipSuccess || hipDeviceGetAttribute(&cus, hipDeviceAttributeMultiprocessorCount, dev) != hipSuccess) { grid = -1; return; }
        if (hipFuncSetAttribute((const void*)fwd_kernel, hipFuncAttributeMaxDynamicSharedMemorySize, LDS_BYTES) != hipSuccess) { fprintf(stderr, "kernel_launch: hipFuncSetAttribute failed\n"); grid = -1; return; }
        if (hipOccupancyMaxActiveBlocksPerMultiprocessor(&per_cu, (const void*)fwd_kernel, NWAVES * 64, LDS_BYTES) != hipSuccess || per_cu < 1) { fprintf(stderr, "kernel_launch: occupancy query says %d blocks per CU; nothing launched\n", per_cu); (void)hipGetLastError(); grid = -1; return; }
        grid = cus;
        if (grid != 256) { fprintf(stderr, "kernel_launch: built for a 256-CU device (got %d)\n", grid); grid = -1; return; }
    }
    if (grid < 0) return;
    if (hipMemsetAsync((char*)d_ws + WS_CTL, 0, CTL_ZERO_BYTES, stream) != hipSuccess) return;
    Args a{};
    for (int i = 0; i < 23; ++i) a.in[i] = (const float*)d_in[i];
    a.out = (float*)d_out; a.ws = (unsigned char*)d_ws;
    hipLaunchKernelGGL(fwd_kernel, dim3(grid), dim3(NWAVES * 64), LDS_BYTES, stream, a);
}
```
